# Optimizing an MI355X kernel written in HIP

```python
import jax, jax.numpy as jnp
from jax import lax
import numpy as np

D_MODEL = 1024
BATCH = 8
SEQ = 2048
DEPTH = 2
DEC_BATCH = 128
DEC_SEQ = 4
PAST_LEN = 16384
PAGE_SIZE = 128

N_META = 16
CHUNK = 64
N_MIXERS = 4
GROUP_WIDTH = D_MODEL // N_MIXERS
N_HEADS = 4
HEAD_DIM = GROUP_WIDTH // N_HEADS
GLA_DK = HEAD_DIM // 2
GLA_RANK = 16
GLA_GATE_NORM = 16.0
CONV_W = 4
D_FF = -((-8 * D_MODEL) // (3 * 256)) * 256
ALPHA = (2 * DEPTH) ** 0.25
BETA = (8 * DEPTH) ** -0.25
RET_THETA_BASE = 10000.0
LN_EPS = 1e-5
NORM_EPS = 1e-6
GATE_CLAMP = 1e-6
IN_SPLITS = (GROUP_WIDTH, GROUP_WIDTH, GROUP_WIDTH, N_HEADS, N_HEADS, GROUP_WIDTH,
             GROUP_WIDTH, GROUP_WIDTH, GROUP_WIDTH, GROUP_WIDTH,
             N_HEADS * GLA_DK, N_HEADS * GLA_DK, GROUP_WIDTH, GLA_RANK, GROUP_WIDTH,
             GROUP_WIDTH, GROUP_WIDTH, GROUP_WIDTH, GROUP_WIDTH)
VALUE_SPLITS = (2, 8, 12, 17)
D_IN = sum(IN_SPLITS)

kernel_name = "hymba_delta_hgrn2_gla_retnet_step"


def _layer_norm(x, g, b):
    xf = x.astype(jnp.float32)
    mu = jnp.mean(xf, -1, keepdims=True)
    var = jnp.mean(jnp.square(xf - mu), -1, keepdims=True)
    return ((xf - mu) * lax.rsqrt(var + LN_EPS) * g + b).astype(x.dtype)


def _head_rms(o, g):
    o = o * lax.rsqrt(jnp.mean(jnp.square(o), -1, keepdims=True) + NORM_EPS)
    return o.reshape(o.shape[:2] + (-1,)) * g


def _head_group_norm(o, g):
    mu = jnp.mean(o, -1, keepdims=True)
    var = jnp.mean(jnp.square(o - mu), -1, keepdims=True)
    o = (o - mu) * lax.rsqrt(var + LN_EPS)
    return o.reshape(o.shape[:2] + (-1,)) * g


def _l2norm(x):
    x = x.astype(jnp.float32)
    return x * lax.rsqrt(jnp.sum(jnp.square(x), -1, keepdims=True) + NORM_EPS)


def _masked_exp(diff, mask):
    return jnp.where(mask, jnp.exp(jnp.where(mask, diff, 0.0)), 0.0)


def _rope(x, pos):
    half = x.shape[-1] // 2
    inv = 1.0 / (RET_THETA_BASE ** jnp.linspace(0.0, 1.0, half, dtype=jnp.float32))
    ang = pos[:, None] * inv[None, :]
    cos = jnp.cos(ang)[None, :, None, :]
    sin = jnp.sin(ang)[None, :, None, :]
    x1, x2 = x[..., :half], x[..., half:]
    return jnp.concatenate([x1 * cos - x2 * sin, x1 * sin + x2 * cos], -1)


def _gla_chunk(s, inp):
    q, k, v, g = (a.astype(jnp.float32) for a in inp)
    c = q.shape[1]
    b = jnp.cumsum(g, axis=1)
    incl = jnp.tril(jnp.ones((c, c), bool))[None, :, :, None, None]
    diff = b[:, :, None] - b[:, None, :]
    dec = _masked_exp(diff, incl)
    att = jnp.einsum('bthk,bshk,btshk->bhts', q, k, dec)
    o = (jnp.einsum('bthk,bhkv->bthv', q * jnp.exp(b), s)
         + jnp.einsum('bhts,bshv->bthv', att, v))
    b_last = b[:, -1]
    s_new = (jnp.exp(b_last)[..., None] * s
             + jnp.einsum('bshk,bshv->bhkv', k * jnp.exp(b_last[:, None] - b), v))
    return s_new, o


def _delta_chunk(s, inp):
    q, k, v, beta, g = (a.astype(jnp.float32) for a in inp)
    c = q.shape[1]
    b = jnp.cumsum(g, axis=1)
    incl = jnp.tril(jnp.ones((c, c), bool))
    strict = jnp.tril(jnp.ones((c, c), bool), -1)
    diff = (b[:, :, None] - b[:, None, :]).transpose(0, 3, 1, 2)
    dec = _masked_exp(diff, incl[None, None])
    kk = jnp.einsum('bthk,bshk->bhts', k, k)
    qk = jnp.einsum('bthk,bshk->bhts', q, k)
    a_mat = jnp.where(strict, beta.transpose(0, 2, 1)[..., None] * dec * kk, 0.0)
    gam = jnp.exp(b)
    rhs = (beta[..., None] * (v - gam[..., None] * jnp.einsum('bthk,bhkv->bthv', k, s))).transpose(0, 2, 1, 3)
    u = lax.linalg.triangular_solve(a_mat + jnp.eye(c, dtype=jnp.float32), rhs,
                                    left_side=True, lower=True, unit_diagonal=True)
    o = (gam[..., None] * jnp.einsum('bthk,bhkv->bthv', q, s)
         + jnp.einsum('bhts,bhsv->bthv', dec * qk, u))
    b_last = b[:, -1]
    s_new = (jnp.exp(b_last)[..., None, None] * s
             + jnp.einsum('bshk,bhsv->bhkv', k * jnp.exp(b_last[:, None] - b)[..., None], u))
    return s_new, o


def _segmented(step, s0, xs, lead, chunk):
    s = s0.astype(jnp.float32)
    outs = []
    if lead > 0:
        s, o = step(s, tuple(a[:, :lead] for a in xs))
        outs.append(o)
        xs = tuple(a[:, lead:] for a in xs)
    bsz, t = xs[0].shape[:2]
    n = t // chunk
    blocks = tuple(jnp.moveaxis(a.reshape((bsz, n, chunk) + a.shape[2:]), 1, 0) for a in xs)
    s, o = lax.scan(step, s, blocks)
    outs.append(jnp.moveaxis(o, 0, 1).reshape((bsz, t) + o.shape[3:]))
    return s.astype(s0.dtype), jnp.concatenate(outs, axis=1)


def _mixers(h, conv_buf, s_delta, s_hgrn, s_gla, s_ret, pos, lead, chunk, lb,
            w_in, conv_w, a_log, dt_bias, delta_g, hgrn_g, gla_wg, gla_bg, gla_g, ret_g, w_out):
    bsz, t, _ = h.shape
    f32 = jnp.float32
    heads = lambda a: a.reshape(bsz, t, N_HEADS, -1)
    silu = jax.nn.silu
    proj = h @ w_in
    (a_q, a_k, a_v, a_beta, a_alpha, a_gate, b_q, b_f, b_i, b_gate,
     c_q, c_k, c_v, c_lr, c_gate, d_q, d_k, d_v, d_gate) = jnp.split(
        proj, np.cumsum(IN_SPLITS)[:-1].tolist(), axis=-1)

    conv_in = jnp.concatenate([conv_buf.astype(proj.dtype),
                               jnp.concatenate([a_q, a_k, a_v], -1)], axis=1)
    new_conv = conv_in[:, conv_in.shape[1] - (CONV_W - 1):]
    conv_out = silu(sum(conv_in[:, j:j + t] * conv_w[j] for j in range(CONV_W)))
    aq, ak, av = jnp.split(conv_out, 3, axis=-1)
    aq = _l2norm(heads(aq)) * HEAD_DIM ** -0.5
    ak = _l2norm(heads(ak))
    beta = jax.nn.sigmoid(a_beta.astype(f32))
    log_alpha = -jnp.exp(a_log.astype(f32)) * jax.nn.softplus(a_alpha.astype(f32) + dt_bias)
    s_a, o_a = _segmented(_delta_chunk, s_delta, (aq, ak, heads(av), beta, log_alpha), lead, chunk)
    o_a = _head_rms(o_a, delta_g) * silu(a_gate.astype(f32))

    z = heads(b_f).astype(f32)
    lbh = lb.reshape(N_HEADS, HEAD_DIM).astype(f32)
    b_k = (1.0 - lbh) * jax.nn.sigmoid(-z)
    log_f = jnp.log1p(-jnp.clip(b_k, 0.0, 1.0 - GATE_CLAMP))
    s_b, o_b = _segmented(_gla_chunk, s_hgrn, (silu(heads(b_q)), b_k, heads(b_i), log_f), lead, chunk)
    o_b = _head_rms(o_b, hgrn_g) * silu(b_gate.astype(f32))

    c_logg = jax.nn.log_sigmoid((c_lr @ gla_wg + gla_bg).astype(f32)) / GLA_GATE_NORM
    s_c, o_c = _segmented(_gla_chunk, s_gla,
                          (heads(c_q) * GLA_DK ** -0.5, heads(c_k), heads(c_v), heads(c_logg)),
                          lead, chunk)
    o_c = _head_rms(o_c, gla_g) * silu(c_gate.astype(f32))

    dq = _rope(heads(d_q).astype(f32), pos)
    dk = _rope(heads(d_k).astype(f32), pos) * HEAD_DIM ** -0.5
    log_gamma = jnp.log1p(-jnp.exp2(-5.0 - jnp.arange(N_HEADS, dtype=f32)))
    d_logg = jnp.broadcast_to(log_gamma[:, None], dq.shape)
    s_d, o_d = _segmented(_gla_chunk, s_ret, (dq, dk, heads(d_v), d_logg), lead, chunk)
    o_d = _head_group_norm(o_d, ret_g) * silu(d_gate.astype(f32))

    o = jnp.concatenate([o_a, o_b, o_c, o_d], -1).astype(h.dtype) @ w_out
    return o, new_conv, s_a, s_b, s_c, s_d


def _trunk(x, conv_bufs, s_delta, s_hgrn, s_gla, s_ret, pos, lead, chunk, lb,
           w_in, conv_w, delta_a_log, delta_dt_bias, delta_norm_g, hgrn_norm_g,
           gla_w_gate, gla_b_gate, gla_norm_g, ret_norm_g, w_out, ln1_g, ln1_b,
           w_ffn_gate, w_ffn_up, w_ffn_down, ln2_g, ln2_b):
    new = ([], [], [], [], [])
    for l in range(DEPTH):
        m, *st = _mixers(x, conv_bufs[l], s_delta[l], s_hgrn[l], s_gla[l], s_ret[l], pos, lead, chunk,
                         lb[l], w_in[l], conv_w[l], delta_a_log[l], delta_dt_bias[l], delta_norm_g[l],
                         hgrn_norm_g[l], gla_w_gate[l], gla_b_gate[l], gla_norm_g[l], ret_norm_g[l],
                         w_out[l])
        for lst, s in zip(new, st):
            lst.append(s)
        x = _layer_norm(ALPHA * x + m, ln1_g[l], ln1_b[l])
        f = (jax.nn.silu(x @ w_ffn_gate[l]) * (x @ w_ffn_up[l])) @ w_ffn_down[l]
        x = _layer_norm(ALPHA * x + f, ln2_g[l], ln2_b[l])
    return (x,) + tuple(jnp.stack(lst) for lst in new)


def setup_inputs(seed: int = 0) -> dict:
    key = jax.random.key(seed)
    ks = jax.random.split(key, 32)
    f32 = jnp.float32
    nrm = lambda k, shape, scale: jax.random.normal(k, shape, f32) * scale
    col_scale = jnp.concatenate([jnp.full((n,), BETA if i in VALUE_SPLITS else 1.0, f32)
                                 for i, n in enumerate(IN_SPLITS)])
    dt = jnp.exp(jax.random.uniform(ks[13], (DEPTH, N_HEADS), f32, np.log(1e-3), np.log(1e-1)))
    return {
        "x_prompt": nrm(ks[0], (BATCH, SEQ, D_MODEL), 1.0),
        "x_sample": nrm(ks[1], (DEC_BATCH, DEC_SEQ, D_MODEL), 1.0),
        "state_delta_conv": nrm(ks[2], (DEPTH, DEC_BATCH, CONV_W - 1, 3 * GROUP_WIDTH), 1.0),
        "state_delta": nrm(ks[3], (DEPTH, DEC_BATCH, N_HEADS, HEAD_DIM, HEAD_DIM), 0.1),
        "state_hgrn": nrm(ks[4], (DEPTH, DEC_BATCH, N_HEADS, HEAD_DIM, HEAD_DIM), 0.5),
        "state_gla": nrm(ks[5], (DEPTH, DEC_BATCH, N_HEADS, GLA_DK, HEAD_DIM), 0.5),
        "state_ret": nrm(ks[6], (DEPTH, DEC_BATCH, N_HEADS, HEAD_DIM, HEAD_DIM), 0.5),
        "meta_tokens": nrm(ks[7], (N_META, D_MODEL), 1.0),
        "emb_ln_g": 1.0 + nrm(ks[8], (D_MODEL,), 0.02),
        "emb_ln_b": nrm(ks[9], (D_MODEL,), 0.02),
        "w_in": nrm(ks[10], (DEPTH, D_MODEL, D_IN), D_MODEL ** -0.5) * col_scale,
        "conv_w": nrm(ks[11], (DEPTH, CONV_W, 3 * GROUP_WIDTH), CONV_W ** -0.5),
        "delta_a_log": jnp.log(jax.random.uniform(ks[12], (DEPTH, N_HEADS), f32, 1.0, 16.0)),
        "delta_dt_bias": dt + jnp.log(-jnp.expm1(-dt)),
        "delta_norm_g": 1.0 + nrm(ks[14], (DEPTH, GROUP_WIDTH), 0.02),
        "hgrn_lb_logits": nrm(ks[15], (DEPTH, GROUP_WIDTH), 1.0),
        "hgrn_norm_g": 1.0 + nrm(ks[16], (DEPTH, GROUP_WIDTH), 0.02),
        "gla_w_gate": nrm(ks[17], (DEPTH, GLA_RANK, N_HEADS * GLA_DK), GLA_RANK ** -0.5),
        "gla_b_gate": nrm(ks[18], (DEPTH, N_HEADS * GLA_DK), 0.1),
        "gla_norm_g": 1.0 + nrm(ks[19], (DEPTH, GROUP_WIDTH), 0.02),
        "ret_norm_g": 1.0 + nrm(ks[20], (DEPTH, GROUP_WIDTH), 0.02),
        "w_out": nrm(ks[21], (DEPTH, N_MIXERS * GROUP_WIDTH, D_MODEL), D_MODEL ** -0.5) * BETA,
        "ln1_g": 1.0 + nrm(ks[22], (DEPTH, D_MODEL), 0.02),
        "ln1_b": nrm(ks[23], (DEPTH, D_MODEL), 0.02),
        "w_ffn_gate": nrm(ks[24], (DEPTH, D_MODEL, D_FF), D_MODEL ** -0.5) * BETA,
        "w_ffn_up": nrm(ks[25], (DEPTH, D_MODEL, D_FF), D_MODEL ** -0.5) * BETA,
        "w_ffn_down": nrm(ks[26], (DEPTH, D_FF, D_MODEL), D_FF ** -0.5) * BETA,
        "ln2_g": 1.0 + nrm(ks[27], (DEPTH, D_MODEL), 0.02),
        "ln2_b": nrm(ks[28], (DEPTH, D_MODEL), 0.02),
    }


def reference(x_prompt, x_sample, state_delta_conv, state_delta, state_hgrn, state_gla, state_ret,
              meta_tokens, emb_ln_g, emb_ln_b, w_in, conv_w, delta_a_log, delta_dt_bias,
              delta_norm_g, hgrn_lb_logits, hgrn_norm_g, gla_w_gate, gla_b_gate, gla_norm_g,
              ret_norm_g, w_out, ln1_g, ln1_b, w_ffn_gate, w_ffn_up, w_ffn_down, ln2_g, ln2_b):
    f32 = jnp.float32
    p = jax.nn.softmax(hgrn_lb_logits.astype(f32), axis=0)
    lb = jnp.cumsum(p, axis=0) - p[0]
    weights = (lb, w_in, conv_w, delta_a_log, delta_dt_bias, delta_norm_g, hgrn_norm_g,
               gla_w_gate, gla_b_gate, gla_norm_g, ret_norm_g, w_out, ln1_g, ln1_b,
               w_ffn_gate, w_ffn_up, w_ffn_down, ln2_g, ln2_b)

    bsz = x_prompt.shape[0]
    meta = jnp.broadcast_to(meta_tokens.astype(x_prompt.dtype)[None], (bsz, N_META, D_MODEL))
    xp = _layer_norm(jnp.concatenate([meta, x_prompt], axis=1), emb_ln_g, emb_ln_b)
    pos_p = jnp.arange(N_META + x_prompt.shape[1], dtype=f32)
    conv0 = jnp.zeros((DEPTH, bsz, CONV_W - 1, 3 * GROUP_WIDTH), x_prompt.dtype)
    sq0 = jnp.zeros((DEPTH, bsz, N_HEADS, HEAD_DIM, HEAD_DIM), f32)
    sg0 = jnp.zeros((DEPTH, bsz, N_HEADS, GLA_DK, HEAD_DIM), f32)
    yp, conv_p, delta_p, hgrn_p, gla_p, ret_p = _trunk(
        xp, conv0, sq0, sq0, sg0, sq0, pos_p, N_META, CHUNK, *weights)
    y_prompt = yp[:, N_META:]

    xs = _layer_norm(x_sample, emb_ln_g, emb_ln_b)
    pos_s = PAST_LEN + jnp.arange(x_sample.shape[1], dtype=f32)
    y_sample, conv_s, delta_s, hgrn_s, gla_s, ret_s = _trunk(
        xs, state_delta_conv, state_delta, state_hgrn, state_gla, state_ret,
        pos_s, 0, x_sample.shape[1], *weights)

    return (y_prompt, y_sample, conv_p, conv_s, delta_p, delta_s, hgrn_p, hgrn_s,
            gla_p, gla_s, ret_p, ret_s)
```

```cpp
#include <hip/hip_runtime.h>
#include <hip/hip_cooperative_groups.h>
#include <cstdio>
#include <cstdint>
namespace cg = cooperative_groups;

#ifndef COOP
#define COOP 1
#endif

typedef unsigned short bf16_t;
typedef short bf16x8 __attribute__((ext_vector_type(8)));
typedef float f32x4 __attribute__((ext_vector_type(4)));

constexpr int DM = 1024, NB = 8, TPR = 2064, NSB = 128, TS = 4;
constexpr int MP = NB * TPR;
constexpr int MS = NSB * TS;
constexpr int MT = MP + MS;
constexpr int DIN = 3864, DINP = 3968, DFF = 2816;
constexpr float ALPHA = 1.41421356237309515f;

constexpr size_t SZ_WIN = (size_t)DINP * 1024 * 2, SZ_WOUT = (size_t)1024 * 1024 * 2, SZ_WGU = (size_t)5632 * 1024 * 2, SZ_WDN = (size_t)1024 * 2816 * 2;
constexpr size_t OFF_CS = 0;
constexpr size_t OFF_WIN = 532480;
constexpr size_t OFF_WOUT = OFF_WIN + 2 * SZ_WIN;
constexpr size_t OFF_WGU = OFF_WOUT + 2 * SZ_WOUT;
constexpr size_t OFF_WDN = OFF_WGU + 2 * SZ_WGU;
constexpr size_t OFF_X = OFF_WDN + 2 * SZ_WDN;
constexpr size_t OFF_P = OFF_X + (size_t)MT * 1024 * 4;
constexpr size_t OFF_X1B = OFF_P;
constexpr size_t OFF_H = OFF_P + (size_t)MT * 1024 * 2;
constexpr size_t WS_NEED = OFF_P + (size_t)MT * DINP * 2;

constexpr size_t O_YP = 0, O_YS = 16777216, O_CP = 17301504, O_CS = 17338368, O_DP = 17928192, O_DS = 18190336,
                 O_HP = 22384640, O_HS = 22646784, O_GP = 26841088, O_GS = 26972160, O_RP = 29069312, O_RS = 29331456;

struct Params {
  const float* in[29];
  float* out;
  unsigned char* ws;
};

__device__ __forceinline__ unsigned f2bf(float f) {
  unsigned u = __float_as_uint(f);
  u += 0x7fffu + ((u >> 16) & 1u);
  return u >> 16;
}
__device__ __forceinline__ unsigned pk2(float lo, float hi) { return f2bf(lo) | (f2bf(hi) << 16); }
__device__ __forceinline__ float bflo(unsigned u) { return __uint_as_float(u << 16); }
__device__ __forceinline__ float bfhi(unsigned u) { return __uint_as_float(u & 0xffff0000u); }
__device__ __forceinline__ void unpack8(const uint4& r, float* x) {
  x[0] = bflo(r.x); x[1] = bfhi(r.x); x[2] = bflo(r.y); x[3] = bfhi(r.y);
  x[4] = bflo(r.z); x[5] = bfhi(r.z); x[6] = bflo(r.w); x[7] = bfhi(r.w);
}
__device__ __forceinline__ float sigmoidf_(float x) { return 1.0f / (1.0f + __expf(-x)); }
__device__ __forceinline__ float siluf_(float x) { return x / (1.0f + __expf(-x)); }
__device__ __forceinline__ float softplusf_(float x) { return fmaxf(x, 0.f) + log1pf(__expf(-fabsf(x))); }
__device__ __forceinline__ float red8(float x) {
  x += __shfl_xor(x, 1); x += __shfl_xor(x, 2); x += __shfl_xor(x, 4); return x;
}
__device__ __forceinline__ float dpp_x1(float x) {
  return __int_as_float(__builtin_amdgcn_update_dpp(0, __float_as_int(x), 0xB1, 0xF, 0xF, true));
}
__device__ __forceinline__ float dpp_x2(float x) {
  return __int_as_float(__builtin_amdgcn_update_dpp(0, __float_as_int(x), 0x4E, 0xF, 0xF, true));
}
__device__ __forceinline__ float red4(float x) { x += dpp_x1(x); x += dpp_x2(x); return x; }
__device__ __forceinline__ float wave_sum(float x) {
#pragma unroll
  for (int o = 32; o >= 1; o >>= 1) x += __shfl_xor(x, o);
  return x;
}

__device__ __forceinline__ void convert_weights(const Params& p, char* lds, int bid, int nb, const int tid) {
  float* tile = (float*)lds;
  for (int w = bid; w < 6720; w += nb) {
    const int l = w / 3360; int r = w % 3360;
    int mat, kt, rt;
    if (r < 992) { mat = 0; kt = r / 62; rt = r % 62; }
    else if (r < 1248) { r -= 992; mat = 1; kt = r / 16; rt = r % 16; }
    else if (r < 2656) { r -= 1248; mat = 2; kt = r / 88; rt = r % 88; }
    else { r -= 2656; mat = 3; kt = r / 16; rt = r % 16; }
    {
      const int rr = tid & 63, R = rt * 64 + rr;
      const float* src; int ns; bool valid = true;
      if (mat == 0) { src = p.in[10] + (size_t)l * 1024 * DIN + R; ns = DIN; valid = R < DIN; }
      else if (mat == 1) { src = p.in[21] + (size_t)l * 1024 * 1024 + R; ns = 1024; }
      else if (mat == 2) { const int blk = R >> 5, ty = (R >> 4) & 1, hid = blk * 16 + (R & 15);
        src = (ty ? p.in[25] : p.in[24]) + (size_t)l * 1024 * DFF + hid; ns = DFF; }
      else { src = p.in[26] + (size_t)l * DFF * 1024 + R; ns = 1024; }
#pragma unroll 4
      for (int i = 0; i < 16; ++i) {
        const int k = i * 4 + (tid >> 6);
        const float v = valid ? src[(size_t)(kt * 64 + k) * ns] : 0.f;
        tile[rr * 65 + k] = v;
      }
    }
    __syncthreads();
    {
      const int rr = tid >> 2, kc = (tid & 3) * 16;
      const int Kd = (mat == 3) ? DFF : 1024;
      bf16_t* base;
      if (mat == 0) base = (bf16_t*)(p.ws + OFF_WIN + l * SZ_WIN);
      else if (mat == 1) base = (bf16_t*)(p.ws + OFF_WOUT + l * SZ_WOUT);
      else if (mat == 2) base = (bf16_t*)(p.ws + OFF_WGU + l * SZ_WGU);
      else base = (bf16_t*)(p.ws + OFF_WDN + l * SZ_WDN);
      bf16_t* dst = base + (size_t)(rt * 64 + rr) * Kd + kt * 64 + kc;
      const float* s = tile + rr * 65 + kc;
      uint4 a, b;
      a.x = pk2(s[0], s[1]); a.y = pk2(s[2], s[3]); a.z = pk2(s[4], s[5]); a.w = pk2(s[6], s[7]);
      b.x = pk2(s[8], s[9]); b.y = pk2(s[10], s[11]); b.z = pk2(s[12], s[13]); b.w = pk2(s[14], s[15]);
      *(uint4*)dst = a; *(uint4*)(dst + 8) = b;
    }
    __syncthreads();
  }
}

__device__ __forceinline__ void ln_row_regs(f32x4 (&v)[4], const float* g, const float* bb, int lane) {
  float s = 0.f;
#pragma unroll
  for (int i = 0; i < 4; ++i) s += (v[i][0] + v[i][1]) + (v[i][2] + v[i][3]);
  const float mu = wave_sum(s) * (1.0f / 1024.0f);
  float q = 0.f;
#pragma unroll
  for (int i = 0; i < 4; ++i) { const f32x4 d = v[i] - mu; q += (d[0] * d[0] + d[1] * d[1]) + (d[2] * d[2] + d[3] * d[3]); }
  const float rs = rsqrtf(wave_sum(q) * (1.0f / 1024.0f) + 1e-5f);
#pragma unroll
  for (int i = 0; i < 4; ++i) {
    const f32x4 gg = *(const f32x4*)(g + lane * 4 + i * 256), b4 = *(const f32x4*)(bb + lane * 4 + i * 256);
    v[i] = (v[i] - mu) * rs * gg + b4;
  }
}

__device__ __forceinline__ void embed_ln(const Params& p, int bid, int nb, const int tid) {
  const int lane = tid & 63, wv = tid >> 6;
  float* X = (float*)(p.ws + OFF_X);
  bf16_t* Xb = (bf16_t*)p.out;
  for (int row = bid * 4 + wv; row < MT; row += nb * 4) {
    const float* src;
    if (row < MP) { const int b = row / TPR, t = row % TPR;
      src = (t < 16) ? p.in[7] + (size_t)t * 1024 : p.in[0] + ((size_t)b * 2048 + (t - 16)) * 1024; }
    else src = p.in[1] + (size_t)(row - MP) * 1024;
    f32x4 v[4];
#pragma unroll
    for (int i = 0; i < 4; ++i) v[i] = *(const f32x4*)(src + lane * 4 + i * 256);
    ln_row_regs(v, p.in[8], p.in[9], lane);
#pragma unroll
    for (int i = 0; i < 4; ++i) {
      *(f32x4*)(X + (size_t)row * 1024 + lane * 4 + i * 256) = v[i];
      uint2 o; o.x = pk2(v[i][0], v[i][1]); o.y = pk2(v[i][2], v[i][3]);
      *(uint2*)(Xb + (size_t)row * 1024 + lane * 4 + i * 256) = o;
    }
  }
}

__device__ __forceinline__ void rope_table(const Params& p, int bid, int nb, const int tid) {
  float2* cs = (float2*)(p.ws + OFF_CS);
  for (int e = bid * 256 + tid; e < 2068 * 32; e += nb * 256) {
    const int idx = e >> 5, i = e & 31;
    const double pos = (idx < 2064) ? (double)idx : (double)(16384 + idx - 2064);
    const double inv = exp(-((double)i / 31.0) * 9.210340371976184);
    const double ang = pos * inv;
    cs[e] = make_float2((float)cos(ang), (float)sin(ang));
  }
}

__device__ __forceinline__ void ln_phase(const Params& p, const float* g, const float* bb, bf16_t* xb, int final_, int bid, int nb, const int tid) {
  const int lane = tid & 63, wv = tid >> 6;
  float* X = (float*)(p.ws + OFF_X);
  for (int row = bid * 4 + wv; row < MT; row += nb * 4) {
    f32x4 v[4];
#pragma unroll
    for (int i = 0; i < 4; ++i) v[i] = *(const f32x4*)(X + (size_t)row * 1024 + lane * 4 + i * 256);
    ln_row_regs(v, g, bb, lane);
    if (!final_) {
#pragma unroll
      for (int i = 0; i < 4; ++i) {
        *(f32x4*)(X + (size_t)row * 1024 + lane * 4 + i * 256) = v[i];
        uint2 o; o.x = pk2(v[i][0], v[i][1]); o.y = pk2(v[i][2], v[i][3]);
        *(uint2*)(xb + (size_t)row * 1024 + lane * 4 + i * 256) = o;
      }
    } else {
      float* dst = nullptr;
      if (row < MP) { const int b = row / TPR, t = row % TPR; if (t >= 16) dst = p.out + O_YP + ((size_t)b * 2048 + (t - 16)) * 1024; }
      else dst = p.out + O_YS + (size_t)(row - MP) * 1024;
      if (dst) {
#pragma unroll
        for (int i = 0; i < 4; ++i) *(f32x4*)(dst + lane * 4 + i * 256) = v[i];
      }
    }
  }
}

enum { EPI_BF16 = 0, EPI_RESID = 1, EPI_SWIGLU = 2 };

template <int EPI>
__device__ __forceinline__ void gemm_tile(const bf16_t* __restrict__ A, const int lda, const bf16_t* __restrict__ Bt, const int ldb,
                                          const int K, const int m0, const int n0, void* Cout, const int ldc, char* lds, const int tid) {
  const int wid = tid >> 6, lane = tid & 63, wr = wid >> 1, wc = wid & 1, fr = lane & 15, fq = lane >> 4;
  f32x4 acc[4][4];
#pragma unroll
  for (int m = 0; m < 4; ++m)
#pragma unroll
    for (int n = 0; n < 4; ++n) acc[m][n] = (f32x4){0.f, 0.f, 0.f, 0.f};
  const int nt = K >> 6;
  auto stage = [&](int kt, int buf) {
#pragma unroll
    for (int i = 0; i < 4; ++i) {
      const int off = tid * 16 + i * 4096;
      const int panel = off >> 13, rem = off & 8191, r = rem >> 6, c = (rem & 63) >> 1;
      const bf16_t* ga = A + (size_t)(m0 + r) * lda + kt * 64 + panel * 32 + c;
      const bf16_t* gb = Bt + (size_t)(n0 + r) * ldb + kt * 64 + panel * 32 + c;
      __builtin_amdgcn_global_load_lds((const unsigned*)ga, (__attribute__((address_space(3))) unsigned*)(lds + buf * 32768 + off), 16, 0, 0);
      __builtin_amdgcn_global_load_lds((const unsigned*)gb, (__attribute__((address_space(3))) unsigned*)(lds + buf * 32768 + 16384 + off), 16, 0, 0);
    }
  };
  stage(0, 0);
  for (int kt = 0; kt < nt; ++kt) {
    asm volatile("s_waitcnt vmcnt(0)" ::: "memory");
    __syncthreads();
    if (kt + 1 < nt) stage(kt + 1, (kt + 1) & 1);
    const char* sa = lds + (kt & 1) * 32768;
    const char* sb = sa + 16384;
#pragma unroll
    for (int ks = 0; ks < 2; ++ks) {
      bf16x8 af[4], bfr[4];
#pragma unroll
      for (int m = 0; m < 4; ++m) af[m] = *(const bf16x8*)(sa + ks * 8192 + (wr * 64 + m * 16 + fr) * 64 + fq * 16);
#pragma unroll
      for (int n = 0; n < 4; ++n) bfr[n] = *(const bf16x8*)(sb + ks * 8192 + (wc * 64 + n * 16 + fr) * 64 + fq * 16);
#pragma unroll
      for (int m = 0; m < 4; ++m)
#pragma unroll
        for (int n = 0; n < 4; ++n) acc[m][n] = __builtin_amdgcn_mfma_f32_16x16x32_bf16(bfr[n], af[m], acc[m][n], 0, 0, 0);
    }
  }
#pragma unroll
  for (int m = 0; m < 4; ++m) {
    const int row = m0 + wr * 64 + m * 16 + fr;
    if (EPI == EPI_BF16) {
      bf16_t* C = (bf16_t*)Cout + (size_t)row * ldc + n0 + wc * 64 + fq * 4;
#pragma unroll
      for (int n = 0; n < 4; ++n) { uint2 o; o.x = pk2(acc[m][n][0], acc[m][n][1]); o.y = pk2(acc[m][n][2], acc[m][n][3]); *(uint2*)(C + n * 16) = o; }
    } else if (EPI == EPI_RESID) {
      float* C = (float*)Cout + (size_t)row * ldc + n0 + wc * 64 + fq * 4;
#pragma unroll
      for (int n = 0; n < 4; ++n) { const f32x4 x = *(const f32x4*)(C + n * 16); *(f32x4*)(C + n * 16) = x * ALPHA + acc[m][n]; }
    } else {
      bf16_t* C = (bf16_t*)Cout + (size_t)row * ldc + (n0 >> 1) + wc * 32 + fq * 4;
#pragma unroll
      for (int np = 0; np < 2; ++np) {
        const f32x4 g = acc[m][2 * np], u = acc[m][2 * np + 1];
        uint2 o; o.x = pk2(siluf_(g[0]) * u[0], siluf_(g[1]) * u[1]); o.y = pk2(siluf_(g[2]) * u[2], siluf_(g[3]) * u[3]);
        *(uint2*)(C + np * 16) = o;
      }
    }
  }
}

template <int EPI>
__device__ __forceinline__ void gemm_phase(const bf16_t* A, int lda, const bf16_t* Bt, int ldb, int K, int ntn, void* C, int ldc, char* lds, int bid, int nb, const int tid) {
  const int ntiles = (MT / 128) * ntn;
  for (int t = bid; t < ntiles; t += nb) {
    const int mt = t / ntn, nn = t % ntn;
    gemm_tile<EPI>(A, lda, Bt, ldb, K, mt * 128, nn * 128, C, ldc, lds, tid);
  }
}

__device__ __forceinline__ void conv8(const bf16_t* rawb, const float* cwl, int tt, int sub, int comp, float (&x)[8]) {
#pragma unroll
  for (int i = 0; i < 8; ++i) x[i] = 0.f;
#pragma unroll
  for (int j = 0; j < 4; ++j) {
    const uint4 rv = *(const uint4*)(rawb + (tt + j) * 192 + comp * 64 + sub * 8);
    float xv[8]; unpack8(rv, xv);
    const f32x4 w0 = *(const f32x4*)(cwl + j * 192 + comp * 64 + sub * 8), w1 = *(const f32x4*)(cwl + j * 192 + comp * 64 + sub * 8 + 4);
#pragma unroll
    for (int i = 0; i < 4; ++i) { x[i] += w0[i] * xv[i]; x[4 + i] += w1[i] * xv[4 + i]; }
    asm volatile("" : "+v"(x[0]), "+v"(x[1]), "+v"(x[2]), "+v"(x[3]), "+v"(x[4]), "+v"(x[5]), "+v"(x[6]), "+v"(x[7]) :: "memory");
  }
#pragma unroll
  for (int i = 0; i < 8; ++i) x[i] = siluf_(x[i]);
}

template <int MIX>
__device__ __forceinline__ void load_chunk_fn(const unsigned char* ws, const bf16_t* Pb, const int t, const int T, const int h, const int sub, const int posb,
                                              uint4& R0, uint4& R1, uint4& R2, uint4& R3, uint4& R4, uint4& R5, unsigned& ex0, unsigned& ex1) {
  if (t < T) {
    const bf16_t* pr = Pb + (size_t)t * DINP;
    if (MIX == 0) {
      R0 = *(const uint4*)(pr + 0 + h * 64 + sub * 8); R1 = *(const uint4*)(pr + 256 + h * 64 + sub * 8);
      R2 = *(const uint4*)(pr + 512 + h * 64 + sub * 8); R3 = *(const uint4*)(pr + 776 + h * 64 + sub * 8);
      ex0 = pr[768 + h]; ex1 = pr[772 + h];
    } else if (MIX == 1) {
      R0 = *(const uint4*)(pr + 1032 + h * 64 + sub * 8); R1 = *(const uint4*)(pr + 1288 + h * 64 + sub * 8);
      R2 = *(const uint4*)(pr + 1544 + h * 64 + sub * 8); R3 = *(const uint4*)(pr + 1800 + h * 64 + sub * 8);
    } else if (MIX == 2) {
      const uint2 q2 = *(const uint2*)(pr + 2056 + h * 32 + sub * 4), k2 = *(const uint2*)(pr + 2184 + h * 32 + sub * 4);
      R0 = make_uint4(q2.x, q2.y, k2.x, k2.y);
      R1 = *(const uint4*)(pr + 2568); R4 = *(const uint4*)(pr + 2576);
      R2 = *(const uint4*)(pr + 2312 + h * 64 + sub * 8); R3 = *(const uint4*)(pr + 2584 + h * 64 + sub * 8);
    } else {
      const uint2 ql = *(const uint2*)(pr + 2840 + h * 64 + sub * 4), qh = *(const uint2*)(pr + 2840 + h * 64 + 32 + sub * 4);
      const uint2 kl = *(const uint2*)(pr + 3096 + h * 64 + sub * 4), kh = *(const uint2*)(pr + 3096 + h * 64 + 32 + sub * 4);
      R0 = make_uint4(ql.x, ql.y, qh.x, qh.y); R1 = make_uint4(kl.x, kl.y, kh.x, kh.y);
      R2 = *(const uint4*)(pr + 3352 + h * 64 + sub * 8); R3 = *(const uint4*)(pr + 3608 + h * 64 + sub * 8);
      const uint4* cs = (const uint4*)(ws + OFF_CS + ((size_t)(posb + t) * 32 + sub * 4) * 8);
      R4 = cs[0]; R5 = cs[1];
    }
  }
}

template <int MIX>
__device__ __forceinline__ void scan_unit(const Params& p, const int layer, const int smp, const int b, const int h, char* lds, const int tid) {
  constexpr int DK = (MIX == 2) ? 32 : 64;
  constexpr int KPL = DK / 4;
  float* qkdv = (float*)lds;
  float* obuf = (float*)(lds + 32768);
  float* scal = (float*)(lds + 40960);
  bf16_t* rawb = (bf16_t*)(lds + 41472);
  float* cwl = (float*)(lds + 54912);
  float* wgl = (float*)(lds + 41472);

  const int lane = tid & 63, wv = tid >> 6;
  const int tt = tid >> 3, sub = tid & 7;
  const int col = wv * 16 + (lane >> 2), kg = lane & 3;
  const int T = smp ? 4 : TPR;
  const int row0 = smp ? MP + b * 4 : b * TPR;
  const int nBatch = smp ? NSB : NB;
  const bf16_t* Pb = (const bf16_t*)(p.ws + OFF_P) + (size_t)row0 * DINP;
  bf16_t* Ob = (bf16_t*)p.out + (size_t)row0 * 1024 + MIX * 256 + h * 64;
  const int posb = smp ? 2064 : 0;

  __syncthreads();
  float S[KPL];
  if (smp) {
    const float* sin_ = p.in[3 + MIX] + ((size_t)(layer * NSB + b) * 4 + h) * DK * 64;
#pragma unroll
    for (int i = 0; i < KPL; ++i) S[i] = sin_[(kg * KPL + i) * 64 + col];
  } else {
#pragma unroll
    for (int i = 0; i < KPL; ++i) S[i] = 0.f;
  }
  float g8[8];
  {
    const float* gsrc = (MIX == 0) ? p.in[14] : (MIX == 1) ? p.in[16] : (MIX == 2) ? p.in[19] : p.in[20];
#pragma unroll
    for (int i = 0; i < 8; ++i) g8[i] = gsrc[layer * 256 + h * 64 + sub * 8 + i];
  }
  float c8[8];
  float Aexp = 0.f, dtb = 0.f, gam = 0.f;
  if (MIX == 0) {
    Aexp = __expf(p.in[12][layer * 4 + h]); dtb = p.in[13][layer * 4 + h];
    for (int e = tid; e < 768; e += 256) { const int j = e / 192, r = e % 192, comp = r >> 6, d = r & 63;
      cwl[e] = p.in[11][(size_t)(layer * 4 + j) * 768 + comp * 256 + h * 64 + d]; }
    for (int e = tid; e < 576; e += 256) { const int j = e / 192, r = e % 192, comp = r >> 6, d = r & 63;
      float v = 0.f; if (smp) v = p.in[2][((size_t)(layer * NSB + b) * 3 + j) * 768 + comp * 256 + h * 64 + d];
      rawb[e] = (bf16_t)f2bf(v); }
  } else if (MIX == 1) {
#pragma unroll
    for (int i = 0; i < 8; ++i) {
      const int d = h * 64 + sub * 8 + i;
      c8[i] = (layer == 0) ? 1.0f : sigmoidf_(p.in[15][d] - p.in[15][256 + d]);
    }
  } else if (MIX == 2) {
    for (int e = tid; e < 512; e += 256) { const int r = e >> 5, j = e & 31; wgl[e] = p.in[17][(size_t)(layer * 16 + r) * 128 + h * 32 + j]; }
#pragma unroll
    for (int i = 0; i < 4; ++i) c8[i] = p.in[18][layer * 128 + h * 32 + sub * 4 + i];
  } else {
    gam = 1.0f - exp2f(-5.0f - (float)h);
  }
  __syncthreads();

  uint4 R0 = make_uint4(0,0,0,0), R1 = R0, R2 = R0, R3 = R0, R4 = R0, R5 = R0; unsigned ex0 = 0, ex1 = 0;
  load_chunk_fn<MIX>(p.ws, Pb, tt, T, h, sub, posb, R0, R1, R2, R3, R4, R5, ex0, ex1);
  int ntok_last = 0;
  for (int t0 = 0; t0 < T; t0 += 32) {
    const int ntok = min(32, T - t0);
    ntok_last = ntok;
    const bool valid = tt < ntok;
    float* dst = qkdv + tt * 256;
    uint4 gcur = R3;
    if (MIX == 0) {
      if (valid) {
        *(uint4*)(rawb + (3 + tt) * 192 + 0 + sub * 8) = R0;
        *(uint4*)(rawb + (3 + tt) * 192 + 64 + sub * 8) = R1;
        *(uint4*)(rawb + (3 + tt) * 192 + 128 + sub * 8) = R2;
      }
      __syncthreads();
      if (valid) {
        float xq[8], xk[8], xv[8];
        conv8(rawb, cwl, tt, sub, 0, xq);
        conv8(rawb, cwl, tt, sub, 1, xk);
        conv8(rawb, cwl, tt, sub, 2, xv);
        *(f32x4*)(dst + 192 + sub * 8) = (f32x4){xv[0], xv[1], xv[2], xv[3]}; *(f32x4*)(dst + 192 + sub * 8 + 4) = (f32x4){xv[4], xv[5], xv[6], xv[7]};
        float ssq = 0.f, ssk = 0.f;
#pragma unroll
        for (int i = 0; i < 8; ++i) { ssq += xq[i] * xq[i]; ssk += xk[i] * xk[i]; }
        ssq = red8(ssq); ssk = red8(ssk);
        const float rq = rsqrtf(ssq + 1e-6f) * 0.125f, rk = rsqrtf(ssk + 1e-6f);
        float qk = 0.f;
#pragma unroll
        for (int i = 0; i < 8; ++i) { xq[i] *= rq; xk[i] *= rk; qk += xq[i] * xk[i]; }
        qk = red8(qk);
        *(f32x4*)(dst + sub * 8) = (f32x4){xq[0], xq[1], xq[2], xq[3]}; *(f32x4*)(dst + sub * 8 + 4) = (f32x4){xq[4], xq[5], xq[6], xq[7]};
        *(f32x4*)(dst + 64 + sub * 8) = (f32x4){xk[0], xk[1], xk[2], xk[3]}; *(f32x4*)(dst + 64 + sub * 8 + 4) = (f32x4){xk[4], xk[5], xk[6], xk[7]};
        if (sub == 0) {
          const float be = sigmoidf_(bflo(ex0)), al = bflo(ex1);
          const float a = __expf(-Aexp * softplusf_(al + dtb));
          scal[tt * 4 + 0] = a; scal[tt * 4 + 1] = be; scal[tt * 4 + 2] = qk;
        }
      }
    } else if (MIX == 1) {
      if (valid) {
        float q[8], z[8], vi[8]; unpack8(R0, q); unpack8(R1, z); unpack8(R2, vi);
        float kk[8], dd[8];
#pragma unroll
        for (int i = 0; i < 8; ++i) { q[i] = siluf_(q[i]); kk[i] = c8[i] * sigmoidf_(-z[i]); dd[i] = 1.0f - fminf(kk[i], 1.0f - 1e-6f); }
        *(f32x4*)(dst + sub * 8) = (f32x4){q[0], q[1], q[2], q[3]}; *(f32x4*)(dst + sub * 8 + 4) = (f32x4){q[4], q[5], q[6], q[7]};
        *(f32x4*)(dst + 64 + sub * 8) = (f32x4){kk[0], kk[1], kk[2], kk[3]}; *(f32x4*)(dst + 64 + sub * 8 + 4) = (f32x4){kk[4], kk[5], kk[6], kk[7]};
        *(f32x4*)(dst + 128 + sub * 8) = (f32x4){dd[0], dd[1], dd[2], dd[3]}; *(f32x4*)(dst + 128 + sub * 8 + 4) = (f32x4){dd[4], dd[5], dd[6], dd[7]};
        *(f32x4*)(dst + 192 + sub * 8) = (f32x4){vi[0], vi[1], vi[2], vi[3]}; *(f32x4*)(dst + 192 + sub * 8 + 4) = (f32x4){vi[4], vi[5], vi[6], vi[7]};
      }
    } else if (MIX == 2) {
      if (valid) {
        float lr[16]; unpack8(R1, lr); unpack8(R4, lr + 8);
        float vi[8]; unpack8(R2, vi);
        const float q0 = bflo(R0.x), q1 = bfhi(R0.x), q2 = bflo(R0.y), q3 = bfhi(R0.y);
        const float k0 = bflo(R0.z), k1 = bfhi(R0.z), k2 = bflo(R0.w), k3 = bfhi(R0.w);
        const float sc = 0.17677669529663687f;
        f32x4 xg = (f32x4){c8[0], c8[1], c8[2], c8[3]};
#pragma unroll
        for (int r = 0; r < 16; ++r) xg += lr[r] * *(const f32x4*)(wgl + r * 32 + sub * 4);
        f32x4 dd;
#pragma unroll
        for (int i = 0; i < 4; ++i) { const float ls = fminf(xg[i], 0.f) - log1pf(__expf(-fabsf(xg[i]))); dd[i] = __expf(ls * 0.0625f); }
        *(f32x4*)(dst + sub * 4) = (f32x4){q0 * sc, q1 * sc, q2 * sc, q3 * sc};
        *(f32x4*)(dst + 64 + sub * 4) = (f32x4){k0, k1, k2, k3};
        *(f32x4*)(dst + 128 + sub * 4) = dd;
        *(f32x4*)(dst + 192 + sub * 8) = (f32x4){vi[0], vi[1], vi[2], vi[3]}; *(f32x4*)(dst + 192 + sub * 8 + 4) = (f32x4){vi[4], vi[5], vi[6], vi[7]};
      }
    } else {
      if (valid) {
        float vi[8]; unpack8(R2, vi);
        const float ql[4] = {bflo(R0.x), bfhi(R0.x), bflo(R0.y), bfhi(R0.y)}, qh[4] = {bflo(R0.z), bfhi(R0.z), bflo(R0.w), bfhi(R0.w)};
        const float kl[4] = {bflo(R1.x), bfhi(R1.x), bflo(R1.y), bfhi(R1.y)}, kh[4] = {bflo(R1.z), bfhi(R1.z), bflo(R1.w), bfhi(R1.w)};
        const float cc[4] = {__uint_as_float(R4.x), __uint_as_float(R4.z), __uint_as_float(R5.x), __uint_as_float(R5.z)};
        const float sn[4] = {__uint_as_float(R4.y), __uint_as_float(R4.w), __uint_as_float(R5.y), __uint_as_float(R5.w)};
        f32x4 qa, qb, ka, kb;
#pragma unroll
        for (int i = 0; i < 4; ++i) {
          qa[i] = ql[i] * cc[i] - qh[i] * sn[i]; qb[i] = ql[i] * sn[i] + qh[i] * cc[i];
          ka[i] = (kl[i] * cc[i] - kh[i] * sn[i]) * 0.125f; kb[i] = (kl[i] * sn[i] + kh[i] * cc[i]) * 0.125f;
        }
        *(f32x4*)(dst + sub * 4) = qa; *(f32x4*)(dst + 32 + sub * 4) = qb;
        *(f32x4*)(dst + 64 + sub * 4) = ka; *(f32x4*)(dst + 96 + sub * 4) = kb;
        *(f32x4*)(dst + 192 + sub * 8) = (f32x4){vi[0], vi[1], vi[2], vi[3]}; *(f32x4*)(dst + 192 + sub * 8 + 4) = (f32x4){vi[4], vi[5], vi[6], vi[7]};
      }
    }
    __syncthreads();
    if (MIX == 0 && t0 + 32 < T) {
      if (tid < 72) { const uint4 v = *(const uint4*)(rawb + 32 * 192 + tid * 8); *(uint4*)(rawb + tid * 8) = v; }
    }
    if (t0 + 32 < T) load_chunk_fn<MIX>(p.ws, Pb, t0 + 32 + tt, T, h, sub, posb, R0, R1, R2, R3, R4, R5, ex0, ex1);
    for (int t = 0; t < ntok; ++t) {
      const float* base = qkdv + t * 256;
      const float v = base[192 + col];
      float qv[KPL], kv[KPL];
#pragma unroll
      for (int i = 0; i < KPL; i += 4) {
        const f32x4 a = *(const f32x4*)(base + kg * KPL + i), bq = *(const f32x4*)(base + 64 + kg * KPL + i);
        qv[i] = a[0]; qv[i + 1] = a[1]; qv[i + 2] = a[2]; qv[i + 3] = a[3];
        kv[i] = bq[0]; kv[i + 1] = bq[1]; kv[i + 2] = bq[2]; kv[i + 3] = bq[3];
      }
      float o;
      if (MIX == 0) {
        const float a = scal[t * 4 + 0], be = scal[t * 4 + 1], qk = scal[t * 4 + 2];
        float kS0 = 0.f, kS1 = 0.f, qS0 = 0.f, qS1 = 0.f;
#pragma unroll
        for (int i = 0; i < KPL; i += 2) { kS0 += kv[i] * S[i]; kS1 += kv[i + 1] * S[i + 1]; qS0 += qv[i] * S[i]; qS1 += qv[i + 1] * S[i + 1]; }
        const float kS = red4(kS0 + kS1), qS = red4(qS0 + qS1);
        const float w = be * (v - a * kS);
#pragma unroll
        for (int i = 0; i < KPL; ++i) S[i] = a * S[i] + kv[i] * w;
        o = a * qS + qk * w;
      } else {
        float dv[KPL];
        if (MIX == 3) {
#pragma unroll
          for (int i = 0; i < KPL; ++i) dv[i] = gam;
        } else {
#pragma unroll
          for (int i = 0; i < KPL; i += 4) { const f32x4 d4 = *(const f32x4*)(base + 128 + kg * KPL + i); dv[i] = d4[0]; dv[i + 1] = d4[1]; dv[i + 2] = d4[2]; dv[i + 3] = d4[3]; }
        }
        float o0 = 0.f, o1 = 0.f;
#pragma unroll
        for (int i = 0; i < KPL; i += 2) {
          S[i] = dv[i] * S[i] + kv[i] * v; S[i + 1] = dv[i + 1] * S[i + 1] + kv[i + 1] * v;
          o0 += qv[i] * S[i]; o1 += qv[i + 1] * S[i + 1];
        }
        o = red4(o0 + o1);
      }
      if (kg == 0) obuf[t * 64 + col] = o;
    }
    __syncthreads();
    if (valid) {
      const f32x4 oa = *(const f32x4*)(obuf + tt * 64 + sub * 8), ob = *(const f32x4*)(obuf + tt * 64 + sub * 8 + 4);
      float ov[8] = {oa[0], oa[1], oa[2], oa[3], ob[0], ob[1], ob[2], ob[3]};
      float gt[8]; unpack8(gcur, gt);
      float mu = 0.f, rs;
      if (MIX == 3) {
        float s = 0.f;
#pragma unroll
        for (int i = 0; i < 8; ++i) s += ov[i];
        mu = red8(s) * (1.0f / 64.0f);
        float q = 0.f;
#pragma unroll
        for (int i = 0; i < 8; ++i) { ov[i] -= mu; q += ov[i] * ov[i]; }
        rs = rsqrtf(red8(q) * (1.0f / 64.0f) + 1e-5f);
      } else {
        float q = 0.f;
#pragma unroll
        for (int i = 0; i < 8; ++i) q += ov[i] * ov[i];
        rs = rsqrtf(red8(q) * (1.0f / 64.0f) + 1e-6f);
      }
      float r[8];
#pragma unroll
      for (int i = 0; i < 8; ++i) r[i] = ov[i] * rs * g8[i] * siluf_(gt[i]);
      uint4 o4; o4.x = pk2(r[0], r[1]); o4.y = pk2(r[2], r[3]); o4.z = pk2(r[4], r[5]); o4.w = pk2(r[6], r[7]);
      *(uint4*)(Ob + (size_t)(t0 + tt) * 1024 + sub * 8) = o4;
    }
  }
  {
    const size_t obase = (MIX == 0) ? (smp ? O_DS : O_DP) : (MIX == 1) ? (smp ? O_HS : O_HP) : (MIX == 2) ? (smp ? O_GS : O_GP) : (smp ? O_RS : O_RP);
    float* so = p.out + obase + ((size_t)(layer * nBatch + b) * 4 + h) * DK * 64;
#pragma unroll
    for (int i = 0; i < KPL; ++i) so[(kg * KPL + i) * 64 + col] = S[i];
  }
  if (MIX == 0) {
    float* co = p.out + (smp ? O_CS : O_CP) + (size_t)(layer * nBatch + b) * 3 * 768;
    for (int e = tid; e < 576; e += 256) { const int j = e / 192, r = e % 192, comp = r >> 6, d = r & 63;
      co[j * 768 + comp * 256 + h * 64 + d] = bflo((unsigned)rawb[(ntok_last + j) * 192 + r]); }
  }
}

__device__ __forceinline__ void scan_dispatch(const Params& p, int layer, int u, char* lds, const int tid) {
  int smp, b, mh;
  if (u < 128) { smp = 0; b = u >> 4; mh = u & 15; }
  else { smp = 1; b = (u - 128) >> 4; mh = (u - 128) & 15; }
  const int mix = mh >> 2, h = mh & 3;
  if (mix == 0) scan_unit<0>(p, layer, smp, b, h, lds, tid);
  else if (mix == 1) scan_unit<1>(p, layer, smp, b, h, lds, tid);
  else if (mix == 2) scan_unit<2>(p, layer, smp, b, h, lds, tid);
  else scan_unit<3>(p, layer, smp, b, h, lds, tid);
}

__device__ __forceinline__ void scan_phase(const Params& p, int layer, char* lds, int bid, int nb, const int tid) {
  for (int u = bid; u < 128; u += nb) scan_dispatch(p, layer, u, lds, tid);
  if (nb > 128) { if (bid >= 128) for (int s = bid - 128; s < 2048; s += nb - 128) scan_dispatch(p, layer, 128 + s, lds, tid); }
  else for (int s = bid; s < 2048; s += nb) scan_dispatch(p, layer, 128 + s, lds, tid);
}

constexpr int NPHASE = 15;
__global__ void __launch_bounds__(256, 2) hymba_fwd(Params p_, int ph_lo, int ph_hi) {
  __shared__ __attribute__((aligned(16))) char lds[65536];
  for (int ph = ph_lo; ph < ph_hi; ++ph) {
    if (ph > ph_lo) cg::this_grid().sync();
    int tid = threadIdx.x, bid = blockIdx.x, nb = gridDim.x;
    asm volatile("" : "+v"(tid));
    asm volatile("" : "+s"(bid), "+s"(nb));
    const Params* pp = (const Params*)__builtin_amdgcn_kernarg_segment_ptr();
    asm volatile("" : "+s"(pp));
    const Params& p = *pp;
    if (ph == 0) {
      convert_weights(p, lds, bid, nb, tid);
      embed_ln(p, bid, nb, tid);
      rope_table(p, bid, nb, tid);
    } else {
      const int l = (ph - 1) / 7, s = (ph - 1) % 7;
      const bf16_t* Xb = (const bf16_t*)p.out;
      bf16_t* X1b = (bf16_t*)(p.ws + OFF_X1B);
      bf16_t* Hb = (bf16_t*)(p.ws + OFF_H);
      float* X = (float*)(p.ws + OFF_X);
      if (s == 0) gemm_phase<EPI_BF16>(Xb, 1024, (const bf16_t*)(p.ws + OFF_WIN + l * SZ_WIN), 1024, 1024, DINP / 128, p.ws + OFF_P, DINP, lds, bid, nb, tid);
      else if (s == 1) scan_phase(p, l, lds, bid, nb, tid);
      else if (s == 2) gemm_phase<EPI_RESID>(Xb, 1024, (const bf16_t*)(p.ws + OFF_WOUT + l * SZ_WOUT), 1024, 1024, 8, X, 1024, lds, bid, nb, tid);
      else if (s == 3) ln_phase(p, p.in[22] + l * 1024, p.in[23] + l * 1024, X1b, 0, bid, nb, tid);
      else if (s == 4) gemm_phase<EPI_SWIGLU>(X1b, 1024, (const bf16_t*)(p.ws + OFF_WGU + l * SZ_WGU), 1024, 1024, 44, Hb, DFF, lds, bid, nb, tid);
      else if (s == 5) gemm_phase<EPI_RESID>(Hb, DFF, (const bf16_t*)(p.ws + OFF_WDN + l * SZ_WDN), DFF, DFF, 8, X, 1024, lds, bid, nb, tid);
      else ln_phase(p, p.in[27] + l * 1024, p.in[28] + l * 1024, (bf16_t*)p.out, l == 1, bid, nb, tid);
    }
  }
}

extern "C" void kernel_launch(void* const* d_in, const int* in_sizes, int n_in, void* d_out, int out_size, void* d_ws, size_t ws_size,
                              hipStream_t stream) {
  (void)in_sizes; (void)out_size;
  if (n_in < 29 || ws_size < WS_NEED) { fprintf(stderr, "bad args: n_in %d ws %zu need %zu\n", n_in, ws_size, (size_t)WS_NEED); return; }
  Params p{};
  for (int i = 0; i < 29; ++i) p.in[i] = (const float*)d_in[i];
  p.out = (float*)d_out;
  p.ws = (unsigned char*)d_ws;
  static int grid_blocks = 0;
  if (!grid_blocks) {
    int dev = 0, cus = 0, per_cu = 0;
    hipGetDevice(&dev);
    hipDeviceGetAttribute(&cus, hipDeviceAttributeMultiprocessorCount, dev);
    hipOccupancyMaxActiveBlocksPerMultiprocessor(&per_cu, hymba_fwd, 256, 0);
    if (per_cu > 2) per_cu = 2;
    if (per_cu < 1) per_cu = 1;
    grid_blocks = cus * per_cu;
  }
#if COOP
  int lo = 0, hi = NPHASE;
  void* args[] = {&p, &lo, &hi};
  hipError_t e = hipLaunchCooperativeKernel((void*)hymba_fwd, dim3(grid_blocks), dim3(256), args, 0, stream);
  if (e != hipSuccess) fprintf(stderr, "cooperative launch failed: %s (grid %d)\n", hipGetErrorString(e), grid_blocks);
#else
  for (int ph = 0; ph < NPHASE; ++ph) hymba_fwd<<<grid_blocks, 256, 0, stream>>>(p, ph, ph + 1);
#endif
}
```

```cpp
#include <hip/hip_runtime.h>
#include <hip/hip_cooperative_groups.h>
#include <cstdio>
#include <cstdint>
namespace cg = cooperative_groups;

#ifndef COOP
#define COOP 1
#endif

typedef unsigned short bf16_t;
typedef short bf16x8 __attribute__((ext_vector_type(8)));
typedef float f32x4 __attribute__((ext_vector_type(4)));

constexpr int DM = 1024, NB = 8, TPR = 2064, NSB = 128, TS = 4;
constexpr int MP = NB * TPR;
constexpr int MS = NSB * TS;
constexpr int MT = MP + MS;
constexpr int DIN = 3864, DINP = 3968, DFF = 2816;
constexpr float ALPHA = 1.41421356237309515f;

constexpr size_t SZ_WIN = (size_t)DINP * 1024 * 2, SZ_WOUT = (size_t)1024 * 1024 * 2, SZ_WGU = (size_t)5632 * 1024 * 2, SZ_WDN = (size_t)1024 * 2816 * 2;
constexpr size_t OFF_CS = 0;
constexpr size_t OFF_WIN = 532480;
constexpr size_t OFF_WOUT = OFF_WIN + 2 * SZ_WIN;
constexpr size_t OFF_WGU = OFF_WOUT + 2 * SZ_WOUT;
constexpr size_t OFF_WDN = OFF_WGU + 2 * SZ_WGU;
constexpr size_t OFF_X = OFF_WDN + 2 * SZ_WDN;
constexpr size_t OFF_P = OFF_X + (size_t)MT * 1024 * 4;
constexpr size_t OFF_X1B = OFF_P;
constexpr size_t OFF_H = OFF_P + (size_t)MT * 1024 * 2;
constexpr size_t OFF_BAR = OFF_P + (size_t)MT * DINP * 2;
constexpr size_t OFF_PS = OFF_BAR + 16384;
constexpr size_t WS_NEED = OFF_PS + (size_t)MT * 64 * 4;

constexpr size_t O_YP = 0, O_YS = 16777216, O_CP = 17301504, O_CS = 17338368, O_DP = 17928192, O_DS = 18190336,
                 O_HP = 22384640, O_HS = 22646784, O_GP = 26841088, O_GS = 26972160, O_RP = 29069312, O_RS = 29331456;

#define GAS __attribute__((address_space(1)))
struct Params {
  const float* in[29];
  float* out;
  unsigned char* ws;
  __device__ __forceinline__ const float* I(int i) const { return (const float*)(const GAS float*)in[i]; }
  __device__ __forceinline__ float* O() const { return (float*)(GAS float*)out; }
  __device__ __forceinline__ unsigned char* W() const { return (unsigned char*)(GAS unsigned char*)ws; }
};

__device__ __forceinline__ unsigned f2bf(float f) {
  unsigned u = __float_as_uint(f);
  u += 0x7fffu + ((u >> 16) & 1u);
  return u >> 16;
}
__device__ __forceinline__ unsigned pk2(float lo, float hi) { return f2bf(lo) | (f2bf(hi) << 16); }
__device__ __forceinline__ float bflo(unsigned u) { return __uint_as_float(u << 16); }
__device__ __forceinline__ float bfhi(unsigned u) { return __uint_as_float(u & 0xffff0000u); }
__device__ __forceinline__ void unpack8(const uint4& r, float* x) {
  x[0] = bflo(r.x); x[1] = bfhi(r.x); x[2] = bflo(r.y); x[3] = bfhi(r.y);
  x[4] = bflo(r.z); x[5] = bfhi(r.z); x[6] = bflo(r.w); x[7] = bfhi(r.w);
}
__device__ __forceinline__ float sigmoidf_(float x) { return 1.0f / (1.0f + __expf(-x)); }
__device__ __forceinline__ float siluf_(float x) { return x / (1.0f + __expf(-x)); }
__device__ __forceinline__ float softplusf_(float x) { return fmaxf(x, 0.f) + log1pf(__expf(-fabsf(x))); }
__device__ __forceinline__ float red8(float x) {
  x += __shfl_xor(x, 1); x += __shfl_xor(x, 2); x += __shfl_xor(x, 4); return x;
}
__device__ __forceinline__ float dpp_x1(float x) {
  return __int_as_float(__builtin_amdgcn_update_dpp(0, __float_as_int(x), 0xB1, 0xF, 0xF, true));
}
__device__ __forceinline__ float dpp_x2(float x) {
  return __int_as_float(__builtin_amdgcn_update_dpp(0, __float_as_int(x), 0x4E, 0xF, 0xF, true));
}
__device__ __forceinline__ float red4(float x) { x += dpp_x1(x); x += dpp_x2(x); return x; }
__device__ __forceinline__ float wave_sum(float x) {
#pragma unroll
  for (int o = 32; o >= 1; o >>= 1) x += __shfl_xor(x, o);
  return x;
}

__device__ __forceinline__ void convert_weights(const Params& p, char* lds, int bid, int nb, const int tid) {
  float* tile = (float*)lds;
  for (int w = bid; w < 6720; w += nb) {
    const int l = w / 3360; int r = w % 3360;
    int mat, kt, rt;
    if (r < 992) { mat = 0; kt = r / 62; rt = r % 62; }
    else if (r < 1248) { r -= 992; mat = 1; kt = r / 16; rt = r % 16; }
    else if (r < 2656) { r -= 1248; mat = 2; kt = r / 88; rt = r % 88; }
    else { r -= 2656; mat = 3; kt = r / 16; rt = r % 16; }
    {
      const int rr = tid & 63, R = rt * 64 + rr;
      const float* src; int ns; bool valid = true;
      if (mat == 0) { src = p.I(10) + (size_t)l * 1024 * DIN + R; ns = DIN; valid = R < DIN; }
      else if (mat == 1) { src = p.I(21) + (size_t)l * 1024 * 1024 + R; ns = 1024; }
      else if (mat == 2) { const int blk = R >> 5, ty = (R >> 4) & 1, hid = blk * 16 + (R & 15);
        src = (ty ? p.I(25) : p.I(24)) + (size_t)l * 1024 * DFF + hid; ns = DFF; }
      else { src = p.I(26) + (size_t)l * DFF * 1024 + R; ns = 1024; }
#pragma unroll 4
      for (int i = 0; i < 16; ++i) {
        const int k = i * 4 + (tid >> 6);
        const float v = valid ? src[(size_t)(kt * 64 + k) * ns] : 0.f;
        tile[rr * 65 + k] = v;
      }
    }
    __syncthreads();
    {
      const int rr = tid >> 2, kc = (tid & 3) * 16;
      const int Kd = (mat == 3) ? DFF : 1024;
      bf16_t* base;
      if (mat == 0) base = (bf16_t*)(p.W() + OFF_WIN + l * SZ_WIN);
      else if (mat == 1) base = (bf16_t*)(p.W() + OFF_WOUT + l * SZ_WOUT);
      else if (mat == 2) base = (bf16_t*)(p.W() + OFF_WGU + l * SZ_WGU);
      else base = (bf16_t*)(p.W() + OFF_WDN + l * SZ_WDN);
      bf16_t* dst = base + (size_t)(rt * 64 + rr) * Kd + kt * 64 + kc;
      const float* s = tile + rr * 65 + kc;
      uint4 a, b;
      a.x = pk2(s[0], s[1]); a.y = pk2(s[2], s[3]); a.z = pk2(s[4], s[5]); a.w = pk2(s[6], s[7]);
      b.x = pk2(s[8], s[9]); b.y = pk2(s[10], s[11]); b.z = pk2(s[12], s[13]); b.w = pk2(s[14], s[15]);
      *(uint4*)dst = a; *(uint4*)(dst + 8) = b;
    }
    __syncthreads();
  }
}

__device__ __forceinline__ void ln_row_regs(f32x4 (&v)[4], const float* g, const float* bb, int lane) {
  float s = 0.f;
#pragma unroll
  for (int i = 0; i < 4; ++i) s += (v[i][0] + v[i][1]) + (v[i][2] + v[i][3]);
  const float mu = wave_sum(s) * (1.0f / 1024.0f);
  float q = 0.f;
#pragma unroll
  for (int i = 0; i < 4; ++i) { const f32x4 d = v[i] - mu; q += (d[0] * d[0] + d[1] * d[1]) + (d[2] * d[2] + d[3] * d[3]); }
  const float rs = rsqrtf(wave_sum(q) * (1.0f / 1024.0f) + 1e-5f);
#pragma unroll
  for (int i = 0; i < 4; ++i) {
    const f32x4 gg = *(const f32x4*)(g + lane * 4 + i * 256), b4 = *(const f32x4*)(bb + lane * 4 + i * 256);
    v[i] = (v[i] - mu) * rs * gg + b4;
  }
}

__device__ __forceinline__ void embed_ln(const Params& p, int bid, int nb, const int tid) {
  const int lane = tid & 63, wv = tid >> 6;
  float* X = (float*)(p.W() + OFF_X);
  bf16_t* Xb = (bf16_t*)p.O();
  for (int row = bid * 4 + wv; row < MT; row += nb * 4) {
    const float* src;
    if (row < MP) { const int b = row / TPR, t = row % TPR;
      src = (t < 16) ? p.I(7) + (size_t)t * 1024 : p.I(0) + ((size_t)b * 2048 + (t - 16)) * 1024; }
    else src = p.I(1) + (size_t)(row - MP) * 1024;
    f32x4 v[4];
#pragma unroll
    for (int i = 0; i < 4; ++i) v[i] = *(const f32x4*)(src + lane * 4 + i * 256);
    ln_row_regs(v, p.I(8), p.I(9), lane);
#pragma unroll
    for (int i = 0; i < 4; ++i) {
      *(f32x4*)(X + (size_t)row * 1024 + lane * 4 + i * 256) = v[i];
      uint2 o; o.x = pk2(v[i][0], v[i][1]); o.y = pk2(v[i][2], v[i][3]);
      *(uint2*)(Xb + (size_t)row * 1024 + lane * 4 + i * 256) = o;
    }
  }
}

__device__ __forceinline__ void rope_table(const Params& p, int bid, int nb, const int tid) {
  float2* cs = (float2*)(p.W() + OFF_CS);
  for (int e = bid * 256 + tid; e < 2068 * 32; e += nb * 256) {
    const int idx = e >> 5, i = e & 31;
    const double pos = (idx < 2064) ? (double)idx : (double)(16384 + idx - 2064);
    const double inv = exp(-((double)i / 31.0) * 9.210340371976184);
    const double ang = pos * inv;
    cs[e] = make_float2((float)cos(ang), (float)sin(ang));
  }
}

__device__ __forceinline__ void ln_phase(const Params& p, const float* g, const float* bb, bf16_t* xb, int final_, int bid, int nb, const int tid) {
  const int lane = tid & 63, wv = tid >> 6;
  float* X = (float*)(p.W() + OFF_X);
  for (int row = bid * 4 + wv; row < MT; row += nb * 4) {
    f32x4 v[4];
#pragma unroll
    for (int i = 0; i < 4; ++i) v[i] = *(const f32x4*)(X + (size_t)row * 1024 + lane * 4 + i * 256);
    ln_row_regs(v, g, bb, lane);
    if (!final_) {
#pragma unroll
      for (int i = 0; i < 4; ++i) {
        *(f32x4*)(X + (size_t)row * 1024 + lane * 4 + i * 256) = v[i];
        uint2 o; o.x = pk2(v[i][0], v[i][1]); o.y = pk2(v[i][2], v[i][3]);
        *(uint2*)(xb + (size_t)row * 1024 + lane * 4 + i * 256) = o;
      }
    } else {
      float* dst = nullptr;
      if (row < MP) { const int b = row / TPR, t = row % TPR; if (t >= 16) dst = p.O() + O_YP + ((size_t)b * 2048 + (t - 16)) * 1024; }
      else dst = p.O() + O_YS + (size_t)(row - MP) * 1024;
      if (dst) {
#pragma unroll
        for (int i = 0; i < 4; ++i) *(f32x4*)(dst + lane * 4 + i * 256) = v[i];
      }
    }
  }
}

enum { EPI_BF16 = 0, EPI_RESID = 1, EPI_SWIGLU = 2 };

template <int EPI>
__device__ __forceinline__ void gemm_tile(const bf16_t* __restrict__ A, const int lda, const bf16_t* __restrict__ Bt, const int ldb,
                                          const int K, const int m0, const int n0, void* Cout, const int ldc, char* lds, const int tid) {
  const int wid = tid >> 6, lane = tid & 63, wr = wid >> 1, wc = wid & 1, fr = lane & 15, fq = lane >> 4;
  f32x4 acc[4][4];
#pragma unroll
  for (int m = 0; m < 4; ++m)
#pragma unroll
    for (int n = 0; n < 4; ++n) acc[m][n] = (f32x4){0.f, 0.f, 0.f, 0.f};
  const int nt = K >> 6;
  auto stage = [&](int kt, int buf) {
#pragma unroll
    for (int i = 0; i < 4; ++i) {
      const int off = tid * 16 + i * 4096;
      const int panel = off >> 13, rem = off & 8191, r = rem >> 6, c = (rem & 63) >> 1;
      const bf16_t* ga = A + (size_t)(m0 + r) * lda + kt * 64 + panel * 32 + c;
      const bf16_t* gb = Bt + (size_t)(n0 + r) * ldb + kt * 64 + panel * 32 + c;
      __builtin_amdgcn_global_load_lds((const unsigned*)ga, (__attribute__((address_space(3))) unsigned*)(lds + buf * 32768 + off), 16, 0, 0);
      __builtin_amdgcn_global_load_lds((const unsigned*)gb, (__attribute__((address_space(3))) unsigned*)(lds + buf * 32768 + 16384 + off), 16, 0, 0);
    }
  };
  stage(0, 0);
  for (int kt = 0; kt < nt; ++kt) {
    asm volatile("s_waitcnt vmcnt(0)" ::: "memory");
    __syncthreads();
    if (kt + 1 < nt) stage(kt + 1, (kt + 1) & 1);
    const char* sa = lds + (kt & 1) * 32768;
    const char* sb = sa + 16384;
#pragma unroll
    for (int ks = 0; ks < 2; ++ks) {
      bf16x8 af[4], bfr[4];
#pragma unroll
      for (int m = 0; m < 4; ++m) af[m] = *(const bf16x8*)(sa + ks * 8192 + (wr * 64 + m * 16 + fr) * 64 + fq * 16);
#pragma unroll
      for (int n = 0; n < 4; ++n) bfr[n] = *(const bf16x8*)(sb + ks * 8192 + (wc * 64 + n * 16 + fr) * 64 + fq * 16);
#pragma unroll
      for (int m = 0; m < 4; ++m)
#pragma unroll
        for (int n = 0; n < 4; ++n) acc[m][n] = __builtin_amdgcn_mfma_f32_16x16x32_bf16(bfr[n], af[m], acc[m][n], 0, 0, 0);
    }
  }
#pragma unroll
  for (int m = 0; m < 4; ++m) {
    const int row = m0 + wr * 64 + m * 16 + fr;
    if (EPI == EPI_BF16) {
      bf16_t* C = (bf16_t*)Cout + (size_t)row * ldc + n0 + wc * 64 + fq * 4;
#pragma unroll
      for (int n = 0; n < 4; ++n) { uint2 o; o.x = pk2(acc[m][n][0], acc[m][n][1]); o.y = pk2(acc[m][n][2], acc[m][n][3]); *(uint2*)(C + n * 16) = o; }
    } else if (EPI == EPI_RESID) {
      float* C = (float*)Cout + (size_t)row * ldc + n0 + wc * 64 + fq * 4;
#pragma unroll
      for (int n = 0; n < 4; ++n) { const f32x4 x = *(const f32x4*)(C + n * 16); *(f32x4*)(C + n * 16) = x * ALPHA + acc[m][n]; }
    } else {
      bf16_t* C = (bf16_t*)Cout + (size_t)row * ldc + (n0 >> 1) + wc * 32 + fq * 4;
#pragma unroll
      for (int np = 0; np < 2; ++np) {
        const f32x4 g = acc[m][2 * np], u = acc[m][2 * np + 1];
        uint2 o; o.x = pk2(siluf_(g[0]) * u[0], siluf_(g[1]) * u[1]); o.y = pk2(siluf_(g[2]) * u[2], siluf_(g[3]) * u[3]);
        *(uint2*)(C + np * 16) = o;
      }
    }
  }
}

template <int EPI>
__device__ __forceinline__ void gemm_phase(const bf16_t* A, int lda, const bf16_t* Bt, int ldb, int K, int ntn, void* C, int ldc, char* lds, int bid, int nb, const int tid) {
  const int ntiles = (MT / 128) * ntn;
  for (int t = bid; t < ntiles; t += nb) {
    const int mt = t / ntn, nn = t % ntn;
    gemm_tile<EPI>(A, lda, Bt, ldb, K, mt * 128, nn * 128, C, ldc, lds, tid);
  }
}

#define XB_TMO      128
#define XB_XCNT(j)  (256  + 64 * (j))
#define XB_XSUB(j)  (1280 + 64 * (j))
#define XB_XGEN(j)  (2304 + 64 * (j))
#define XB_TOP      3328
#define XB_TOPGEN   3392
#define XCD_BAR_WORDS 3456
#define XB_SPIN_CAP (1u << 22)
__device__ __forceinline__ unsigned xb_ld(unsigned* p) { return __hip_atomic_load(p, __ATOMIC_RELAXED, __HIP_MEMORY_SCOPE_AGENT); }
__device__ __forceinline__ unsigned xb_add(unsigned* p, unsigned v) { return __hip_atomic_fetch_add(p, v, __ATOMIC_RELAXED, __HIP_MEMORY_SCOPE_AGENT); }
__device__ __forceinline__ unsigned xb_xcc_id() { return (unsigned)__builtin_amdgcn_s_getreg((3 << 11) | 20) & 0xFu; }
#define XB_SPIN(cond, bar) do { unsigned _sp = 0; while (cond) { __builtin_amdgcn_s_sleep(1); \
    if ((++_sp & 255u) == 0u) { if (xb_ld(&(bar)[XB_TMO])) break; if (_sp > XB_SPIN_CAP) { atomicAdd(&(bar)[XB_TMO], 1u); break; } } } } while (0)
struct XcdBarrier { unsigned* bar; unsigned x; unsigned nloc, nx; };
__device__ __forceinline__ void xcd_barrier_complete(unsigned* bar, unsigned x, unsigned G, unsigned& nloc, unsigned& nx) {
  unsigned sum, cnt, mine, sp = 0u;
  for (;;) {
    sum = 0u; cnt = 0u; mine = 0u;
#pragma unroll
    for (unsigned j = 0; j < 16; ++j) { const unsigned c = xb_ld(&bar[XB_XCNT(j)]); sum += c; cnt += (c > 0u) ? 1u : 0u; mine = (j == x) ? c : mine; }
    if (sum == G) break;
    __builtin_amdgcn_s_sleep(1);
    if ((++sp & 255u) == 0u) { if (xb_ld(&bar[XB_TMO])) break; if (sp > XB_SPIN_CAP) { atomicAdd(&bar[XB_TMO], 1u); break; } }
  }
  nloc = mine > 0u ? mine : 1u; nx = cnt > 0u ? cnt : 1u;
}
__device__ __forceinline__ void xcd_barrier(XcdBarrier& b, const int tid, const unsigned G) {
  asm volatile("s_waitcnt vmcnt(0)" ::: "memory");
  __syncthreads();
  if (tid == 0) {
    unsigned* bar = b.bar;
    __builtin_amdgcn_s_waitcnt(0);
    if (b.nloc == 0u) xcd_barrier_complete(bar, b.x, G, b.nloc, b.nx);
    const unsigned nloc = b.nloc, nx = b.nx;
    const unsigned old = xb_add(&bar[XB_XSUB(b.x)], 1u);
    const unsigned gen = old / nloc;
    if (old + 1u == (gen + 1u) * nloc) {
      __builtin_amdgcn_fence(__ATOMIC_RELEASE, "agent");
      asm volatile("s_waitcnt vmcnt(0)" ::: "memory");
      const unsigned og = xb_add(&bar[XB_TOP], 1u);
      const unsigned tg = og / nx;
      if (og + 1u == (tg + 1u) * nx) xb_add(&bar[XB_TOPGEN], 1u);
      else XB_SPIN(xb_ld(&bar[XB_TOPGEN]) == tg, bar);
      __builtin_amdgcn_fence(__ATOMIC_ACQUIRE, "agent");
      xb_add(&bar[XB_XGEN(b.x)], 1u);
      asm volatile("s_waitcnt vmcnt(0)" ::: "memory");
    } else {
      XB_SPIN(xb_ld(&bar[XB_XGEN(b.x)]) == gen, bar);
      __builtin_amdgcn_fence(__ATOMIC_ACQUIRE, "agent");
      asm volatile("s_waitcnt vmcnt(0)" ::: "memory");
    }
  }
  __syncthreads();
}

template <int N>
__device__ __forceinline__ void convN(const bf16_t* rawb, const float* cwl, int tt, int off, float (&x)[N]) {
#pragma unroll
  for (int i = 0; i < N; ++i) x[i] = 0.f;
#pragma unroll
  for (int j = 0; j < 4; ++j) {
    float xv[N];
    if (N == 8) { const uint4 rv = *(const uint4*)(rawb + (tt + j) * 160 + off); unpack8(rv, xv); }
    else { const uint2 rv = *(const uint2*)(rawb + (tt + j) * 160 + off); xv[0] = bflo(rv.x); xv[1] = bfhi(rv.x); xv[2] = bflo(rv.y); xv[3] = bfhi(rv.y); }
#pragma unroll
    for (int i = 0; i < N; i += 4) {
      const f32x4 w = *(const f32x4*)(cwl + j * 160 + off + i);
      x[i] += w[0] * xv[i]; x[i + 1] += w[1] * xv[i + 1]; x[i + 2] += w[2] * xv[i + 2]; x[i + 3] += w[3] * xv[i + 3];
    }
    if (N == 8) asm volatile("" : "+v"(x[0]), "+v"(x[1]), "+v"(x[2]), "+v"(x[3]), "+v"(x[4 % N]), "+v"(x[5 % N]), "+v"(x[6 % N]), "+v"(x[7 % N]) :: "memory");
    else asm volatile("" : "+v"(x[0]), "+v"(x[1]), "+v"(x[2]), "+v"(x[3]) :: "memory");
  }
#pragma unroll
  for (int i = 0; i < N; ++i) x[i] = siluf_(x[i]);
}

template <int MIX>
__device__ __forceinline__ void load_chunk_fn(const unsigned char* ws, const bf16_t* Pb, const int t, const int T, const int h, const int half, const int sub, const int posb,
                                              uint4& R0, uint4& R1, uint2& R2, uint4& R4, uint4& R5, unsigned& ex0, unsigned& ex1) {
  if (t < T) {
    const bf16_t* pr = Pb + (size_t)t * DINP;
    if (MIX == 0) {
      R0 = *(const uint4*)(pr + 0 + h * 64 + sub * 8); R1 = *(const uint4*)(pr + 256 + h * 64 + sub * 8);
      R2 = *(const uint2*)(pr + 512 + h * 64 + half * 32 + sub * 4);
      ex0 = pr[768 + h]; ex1 = pr[772 + h];
    } else if (MIX == 1) {
      R0 = *(const uint4*)(pr + 1032 + h * 64 + sub * 8); R1 = *(const uint4*)(pr + 1288 + h * 64 + sub * 8);
      R2 = *(const uint2*)(pr + 1544 + h * 64 + half * 32 + sub * 4);
    } else if (MIX == 2) {
      const uint2 q2 = *(const uint2*)(pr + 2056 + h * 32 + sub * 4), k2 = *(const uint2*)(pr + 2184 + h * 32 + sub * 4);
      R0 = make_uint4(q2.x, q2.y, k2.x, k2.y);
      R1 = *(const uint4*)(pr + 2568); R4 = *(const uint4*)(pr + 2576);
      R2 = *(const uint2*)(pr + 2312 + h * 64 + half * 32 + sub * 4);
    } else {
      const uint2 ql = *(const uint2*)(pr + 2840 + h * 64 + sub * 4), qh = *(const uint2*)(pr + 2840 + h * 64 + 32 + sub * 4);
      const uint2 kl = *(const uint2*)(pr + 3096 + h * 64 + sub * 4), kh = *(const uint2*)(pr + 3096 + h * 64 + 32 + sub * 4);
      R0 = make_uint4(ql.x, ql.y, qh.x, qh.y); R1 = make_uint4(kl.x, kl.y, kh.x, kh.y);
      R2 = *(const uint2*)(pr + 3352 + h * 64 + half * 32 + sub * 4);
      const uint4* cs = (const uint4*)(ws + OFF_CS + ((size_t)(posb + t) * 32 + sub * 4) * 8);
      R4 = cs[0]; R5 = cs[1];
    }
  }
}

__device__ __forceinline__ float dpp_hm(float x) {
  return __int_as_float(__builtin_amdgcn_update_dpp(0, __float_as_int(x), 0x141, 0xF, 0xF, true));
}
__device__ __forceinline__ float red8d(float x) { x += dpp_x1(x); x += dpp_x2(x); x += dpp_hm(x); return x; }

template <int MIX, int KPL>
struct StepIn { float q[KPL], k[KPL], d[KPL]; float v, a, be, qk; };

template <int MIX, int KPL>
__device__ __forceinline__ void load_step(const float* qkdv, const float* scal, int t, int kg, int col, StepIn<MIX, KPL>& s) {
  const float* base = qkdv + t * 256;
#pragma unroll
  for (int i = 0; i < KPL; i += 4) {
    const f32x4 a = *(const f32x4*)(base + kg * KPL + i), b = *(const f32x4*)(base + 64 + kg * KPL + i);
    s.q[i] = a[0]; s.q[i + 1] = a[1]; s.q[i + 2] = a[2]; s.q[i + 3] = a[3];
    s.k[i] = b[0]; s.k[i + 1] = b[1]; s.k[i + 2] = b[2]; s.k[i + 3] = b[3];
    if (MIX == 1 || MIX == 2) { const f32x4 d = *(const f32x4*)(base + 128 + kg * KPL + i); s.d[i] = d[0]; s.d[i + 1] = d[1]; s.d[i + 2] = d[2]; s.d[i + 3] = d[3]; }
  }
  s.v = base[192 + col];
  if (MIX == 0) { const f32x4 c = *(const f32x4*)(scal + t * 4); s.a = c[0]; s.be = c[1]; s.qk = c[2]; }
}

template <int MIX, int KPL>
__device__ __forceinline__ float do_step(const StepIn<MIX, KPL>& s, float (&S)[KPL], const float gam) {
  if (MIX == 0) {
    float kS0 = 0.f, kS1 = 0.f, qS0 = 0.f, qS1 = 0.f;
#pragma unroll
    for (int i = 0; i < KPL; i += 2) { kS0 += s.k[i] * S[i]; kS1 += s.k[i + 1] * S[i + 1]; qS0 += s.q[i] * S[i]; qS1 += s.q[i + 1] * S[i + 1]; }
    const float kS = red8d(kS0 + kS1), qS = red8d(qS0 + qS1);
    const float w = s.be * (s.v - s.a * kS);
#pragma unroll
    for (int i = 0; i < KPL; ++i) S[i] = s.a * S[i] + s.k[i] * w;
    return s.a * qS + s.qk * w;
  } else {
    float o0 = 0.f, o1 = 0.f;
#pragma unroll
    for (int i = 0; i < KPL; i += 2) {
      const float d0 = (MIX == 3) ? gam : s.d[i], d1 = (MIX == 3) ? gam : s.d[i + 1];
      S[i] = d0 * S[i] + s.k[i] * s.v; S[i + 1] = d1 * S[i + 1] + s.k[i + 1] * s.v;
      o0 += s.q[i] * S[i]; o1 += s.q[i + 1] * S[i + 1];
    }
    return red8d(o0 + o1);
  }
}

template <int MIX>
__device__ __forceinline__ void scan_half(const Params& p, const int layer, const int smp, const int b, const int h, const int half, char* lds, const int tid) {
  constexpr int DK = (MIX == 2) ? 32 : 64;
  constexpr int KPL = DK / 8;
  float* qkdv = (float*)lds;
  float* obuf = (float*)(lds + 32768);
  float* scal = (float*)(lds + 36864);
  bf16_t* rawb = (bf16_t*)(lds + 37376);
  float* cwl = (float*)(lds + 48576);
  float* wgl = (float*)(lds + 37376);

  const int lane = tid & 63, wv = tid >> 6;
  const int tt = tid >> 3, sub = tid & 7;
  const int col = wv * 8 + (lane >> 3), kg = lane & 7;
  const int T = smp ? 4 : TPR;
  const int row0 = smp ? MP + b * 4 : b * TPR;
  const int nBatch = smp ? NSB : NB;
  const bf16_t* Pb = (const bf16_t*)(p.W() + OFF_P) + (size_t)row0 * DINP;
  bf16_t* Ob = (bf16_t*)p.O() + (size_t)row0 * 1024 + MIX * 256 + h * 64 + half * 32;
  float* PS = (float*)(p.W() + OFF_PS) + (size_t)row0 * 64 + (MIX * 4 + h) * 4 + half * 2;
  const int posb = smp ? 2064 : 0;

  uint4 R0 = make_uint4(0, 0, 0, 0), R1 = R0, R4 = R0, R5 = R0; uint2 R2 = make_uint2(0, 0); unsigned ex0 = 0, ex1 = 0;
  load_chunk_fn<MIX>(p.W(), Pb, tt, T, h, half, sub, posb, R0, R1, R2, R4, R5, ex0, ex1);

  __syncthreads();
  float S[KPL];
  if (smp) {
    const float* sin_ = p.I(3 + MIX) + ((size_t)(layer * NSB + b) * 4 + h) * DK * 64 + half * 32;
#pragma unroll
    for (int i = 0; i < KPL; ++i) S[i] = sin_[(kg * KPL + i) * 64 + col];
  } else {
#pragma unroll
    for (int i = 0; i < KPL; ++i) S[i] = 0.f;
  }
  float c8[8];
  float Aexp = 0.f, dtb = 0.f, gam = 0.f;
  if (MIX == 0) {
    Aexp = __expf(p.I(12)[layer * 4 + h]); dtb = p.I(13)[layer * 4 + h];
    for (int e = tid; e < 640; e += 256) { const int j = e / 160, r = e % 160;
      const int cc = (r < 64) ? (h * 64 + r) : (r < 128) ? (256 + h * 64 + r - 64) : (512 + h * 64 + half * 32 + r - 128);
      cwl[e] = p.I(11)[(size_t)(layer * 4 + j) * 768 + cc]; }
    for (int e = tid; e < 480; e += 256) { const int j = e / 160, r = e % 160;
      const int cc = (r < 64) ? (h * 64 + r) : (r < 128) ? (256 + h * 64 + r - 64) : (512 + h * 64 + half * 32 + r - 128);
      float v = 0.f; if (smp) v = p.I(2)[((size_t)(layer * NSB + b) * 3 + j) * 768 + cc];
      rawb[e] = (bf16_t)f2bf(v); }
  } else if (MIX == 1) {
#pragma unroll
    for (int i = 0; i < 8; ++i) {
      const int d = h * 64 + sub * 8 + i;
      c8[i] = (layer == 0) ? 1.0f : sigmoidf_(p.I(15)[d] - p.I(15)[256 + d]);
    }
  } else if (MIX == 2) {
    for (int e = tid; e < 512; e += 256) { const int r = e >> 5, j = e & 31; wgl[e] = p.I(17)[(size_t)(layer * 16 + r) * 128 + h * 32 + j]; }
#pragma unroll
    for (int i = 0; i < 4; ++i) c8[i] = p.I(18)[layer * 128 + h * 32 + sub * 4 + i];
  } else {
    gam = 1.0f - exp2f(-5.0f - (float)h);
  }
  __syncthreads();

  int ntok_last = 0;
  for (int t0 = 0; t0 < T; t0 += 32) {
    const int ntok = min(32, T - t0);
    ntok_last = ntok;
    const bool valid = tt < ntok;
    float* dst = qkdv + tt * 256;
    if (MIX == 0) {
      if (valid) {
        *(uint4*)(rawb + (3 + tt) * 160 + 0 + sub * 8) = R0;
        *(uint4*)(rawb + (3 + tt) * 160 + 64 + sub * 8) = R1;
        *(uint2*)(rawb + (3 + tt) * 160 + 128 + sub * 4) = R2;
      }
      __syncthreads();
      if (valid) {
        float xq[8], xk[8], xv[4];
        convN<8>(rawb, cwl, tt, sub * 8, xq);
        convN<8>(rawb, cwl, tt, 64 + sub * 8, xk);
        convN<4>(rawb, cwl, tt, 128 + sub * 4, xv);
        *(f32x4*)(dst + 192 + sub * 4) = (f32x4){xv[0], xv[1], xv[2], xv[3]};
        float ssq = 0.f, ssk = 0.f;
#pragma unroll
        for (int i = 0; i < 8; ++i) { ssq += xq[i] * xq[i]; ssk += xk[i] * xk[i]; }
        ssq = red8(ssq); ssk = red8(ssk);
        const float rq = rsqrtf(ssq + 1e-6f) * 0.125f, rk = rsqrtf(ssk + 1e-6f);
        float qk = 0.f;
#pragma unroll
        for (int i = 0; i < 8; ++i) { xq[i] *= rq; xk[i] *= rk; qk += xq[i] * xk[i]; }
        qk = red8(qk);
        *(f32x4*)(dst + sub * 8) = (f32x4){xq[0], xq[1], xq[2], xq[3]}; *(f32x4*)(dst + sub * 8 + 4) = (f32x4){xq[4], xq[5], xq[6], xq[7]};
        *(f32x4*)(dst + 64 + sub * 8) = (f32x4){xk[0], xk[1], xk[2], xk[3]}; *(f32x4*)(dst + 64 + sub * 8 + 4) = (f32x4){xk[4], xk[5], xk[6], xk[7]};
        if (sub == 0) {
          const float be = sigmoidf_(bflo(ex0)), al = bflo(ex1);
          const float a = __expf(-Aexp * softplusf_(al + dtb));
          *(f32x4*)(scal + tt * 4) = (f32x4){a, be, qk, 0.f};
        }
      }
    } else if (MIX == 1) {
      if (valid) {
        float q[8], z[8]; unpack8(R0, q); unpack8(R1, z);
        float kk[8], dd[8];
#pragma unroll
        for (int i = 0; i < 8; ++i) { q[i] = siluf_(q[i]); kk[i] = c8[i] * sigmoidf_(-z[i]); dd[i] = 1.0f - fminf(kk[i], 1.0f - 1e-6f); }
        *(f32x4*)(dst + sub * 8) = (f32x4){q[0], q[1], q[2], q[3]}; *(f32x4*)(dst + sub * 8 + 4) = (f32x4){q[4], q[5], q[6], q[7]};
        *(f32x4*)(dst + 64 + sub * 8) = (f32x4){kk[0], kk[1], kk[2], kk[3]}; *(f32x4*)(dst + 64 + sub * 8 + 4) = (f32x4){kk[4], kk[5], kk[6], kk[7]};
        *(f32x4*)(dst + 128 + sub * 8) = (f32x4){dd[0], dd[1], dd[2], dd[3]}; *(f32x4*)(dst + 128 + sub * 8 + 4) = (f32x4){dd[4], dd[5], dd[6], dd[7]};
        *(f32x4*)(dst + 192 + sub * 4) = (f32x4){bflo(R2.x), bfhi(R2.x), bflo(R2.y), bfhi(R2.y)};
      }
    } else if (MIX == 2) {
      if (valid) {
        float lr[16]; unpack8(R1, lr); unpack8(R4, lr + 8);
        const float q0 = bflo(R0.x), q1 = bfhi(R0.x), q2 = bflo(R0.y), q3 = bfhi(R0.y);
        const float k0 = bflo(R0.z), k1 = bfhi(R0.z), k2 = bflo(R0.w), k3 = bfhi(R0.w);
        const float sc = 0.17677669529663687f;
        f32x4 xg = (f32x4){c8[0], c8[1], c8[2], c8[3]};
#pragma unroll
        for (int r = 0; r < 16; ++r) xg += lr[r] * *(const f32x4*)(wgl + r * 32 + sub * 4);
        f32x4 dd;
#pragma unroll
        for (int i = 0; i < 4; ++i) { const float ls = fminf(xg[i], 0.f) - log1pf(__expf(-fabsf(xg[i]))); dd[i] = __expf(ls * 0.0625f); }
        *(f32x4*)(dst + sub * 4) = (f32x4){q0 * sc, q1 * sc, q2 * sc, q3 * sc};
        *(f32x4*)(dst + 64 + sub * 4) = (f32x4){k0, k1, k2, k3};
        *(f32x4*)(dst + 128 + sub * 4) = dd;
        *(f32x4*)(dst + 192 + sub * 4) = (f32x4){bflo(R2.x), bfhi(R2.x), bflo(R2.y), bfhi(R2.y)};
      }
    } else {
      if (valid) {
        const float ql[4] = {bflo(R0.x), bfhi(R0.x), bflo(R0.y), bfhi(R0.y)}, qh[4] = {bflo(R0.z), bfhi(R0.z), bflo(R0.w), bfhi(R0.w)};
        const float kl[4] = {bflo(R1.x), bfhi(R1.x), bflo(R1.y), bfhi(R1.y)}, kh[4] = {bflo(R1.z), bfhi(R1.z), bflo(R1.w), bfhi(R1.w)};
        const float cc[4] = {__uint_as_float(R4.x), __uint_as_float(R4.z), __uint_as_float(R5.x), __uint_as_float(R5.z)};
        const float sn[4] = {__uint_as_float(R4.y), __uint_as_float(R4.w), __uint_as_float(R5.y), __uint_as_float(R5.w)};
        f32x4 qa, qb, ka, kb;
#pragma unroll
        for (int i = 0; i < 4; ++i) {
          qa[i] = ql[i] * cc[i] - qh[i] * sn[i]; qb[i] = ql[i] * sn[i] + qh[i] * cc[i];
          ka[i] = (kl[i] * cc[i] - kh[i] * sn[i]) * 0.125f; kb[i] = (kl[i] * sn[i] + kh[i] * cc[i]) * 0.125f;
        }
        *(f32x4*)(dst + sub * 4) = qa; *(f32x4*)(dst + 32 + sub * 4) = qb;
        *(f32x4*)(dst + 64 + sub * 4) = ka; *(f32x4*)(dst + 96 + sub * 4) = kb;
        *(f32x4*)(dst + 192 + sub * 4) = (f32x4){bflo(R2.x), bfhi(R2.x), bflo(R2.y), bfhi(R2.y)};
      }
    }
    __syncthreads();
    if (MIX == 0 && t0 + 32 < T) {
      if (tid < 60) { const uint4 v = *(const uint4*)(rawb + 32 * 160 + tid * 8); *(uint4*)(rawb + tid * 8) = v; }
    }
    if (t0 + 32 < T) load_chunk_fn<MIX>(p.W(), Pb, t0 + 32 + tt, T, h, half, sub, posb, R0, R1, R2, R4, R5, ex0, ex1);
    {
      StepIn<MIX, KPL> sa, sb;
      load_step<MIX, KPL>(qkdv, scal, 0, kg, col, sa);
      for (int t = 0; t < ntok; t += 2) {
        load_step<MIX, KPL>(qkdv, scal, t + 1, kg, col, sb);
        const float oa = do_step<MIX, KPL>(sa, S, gam);
        if (kg == 0) obuf[t * 32 + col] = oa;
        load_step<MIX, KPL>(qkdv, scal, min(t + 2, ntok - 1), kg, col, sa);
        const float ob = do_step<MIX, KPL>(sb, S, gam);
        if (kg == 0) obuf[(t + 1) * 32 + col] = ob;
      }
    }
    __syncthreads();
    if (valid) {
      const f32x4 o = *(const f32x4*)(obuf + tt * 32 + sub * 4);
      float s1 = (o[0] + o[1]) + (o[2] + o[3]), s2 = (o[0] * o[0] + o[1] * o[1]) + (o[2] * o[2] + o[3] * o[3]);
      s1 = red8(s1); s2 = red8(s2);
      uint2 o2; o2.x = pk2(o[0], o[1]); o2.y = pk2(o[2], o[3]);
      *(uint2*)(Ob + (size_t)(t0 + tt) * 1024 + sub * 4) = o2;
      if (sub == 0) *(float2*)(PS + (size_t)(t0 + tt) * 64) = make_float2(s1, s2);
    }
  }
  {
    const size_t obase = (MIX == 0) ? (smp ? O_DS : O_DP) : (MIX == 1) ? (smp ? O_HS : O_HP) : (MIX == 2) ? (smp ? O_GS : O_GP) : (smp ? O_RS : O_RP);
    float* so = p.O() + obase + ((size_t)(layer * nBatch + b) * 4 + h) * DK * 64 + half * 32;
#pragma unroll
    for (int i = 0; i < KPL; ++i) so[(kg * KPL + i) * 64 + col] = S[i];
  }
  if (MIX == 0) {
    float* co = p.O() + (smp ? O_CS : O_CP) + (size_t)(layer * nBatch + b) * 3 * 768;
    for (int e = tid; e < 480; e += 256) { const int j = e / 160, r = e % 160;
      const float v = bflo((unsigned)rawb[(ntok_last + j) * 160 + r]);
      if (r < 128) { if (half == 0) co[j * 768 + ((r < 64) ? (h * 64 + r) : (256 + h * 64 + r - 64))] = v; }
      else co[j * 768 + 512 + h * 64 + half * 32 + r - 128] = v; }
  }
}

__device__ __forceinline__ void scan_dispatch(const Params& p, int layer, int item, char* lds, const int tid) {
  int smp = 0, it = item;
  if (item >= 256) { smp = 1; it = item - 256; }
  const int b = it >> 5, mh = (it & 31) >> 1, half = it & 1;
  const int mix = mh >> 2, h = mh & 3;
  if (mix == 0) scan_half<0>(p, layer, smp, b, h, half, lds, tid);
  else if (mix == 1) scan_half<1>(p, layer, smp, b, h, half, lds, tid);
  else if (mix == 2) scan_half<2>(p, layer, smp, b, h, half, lds, tid);
  else scan_half<3>(p, layer, smp, b, h, half, lds, tid);
}

__device__ __forceinline__ void scan_phase(const Params& p, int layer, char* lds, int bid, int nb, const int tid) {
  for (int u = bid; u < 256; u += nb) scan_dispatch(p, layer, u, lds, tid);
  if (nb > 256) { if (bid >= 256) for (int s = bid - 256; s < 4096; s += nb - 256) scan_dispatch(p, layer, 256 + s, lds, tid); }
  else for (int s = bid; s < 4096; s += nb) scan_dispatch(p, layer, 256 + s, lds, tid);
}

__device__ __forceinline__ void norm_phase(const Params& p, int layer, int bid, int nb, const int tid) {
  bf16_t* O = (bf16_t*)p.O();
  const bf16_t* P = (const bf16_t*)(p.W() + OFF_P);
  const float* PS = (const float*)(p.W() + OFF_PS);
  const int cg8 = tid & 127;
  const int mh = cg8 >> 3, mix = mh >> 2, h = mh & 3, j0 = (cg8 & 7) * 8;
  const int gcol = (mix == 0) ? 776 : (mix == 1) ? 1800 : (mix == 2) ? 2584 : 3608;
  const float* gsrc = (mix == 0) ? p.I(14) : (mix == 1) ? p.I(16) : (mix == 2) ? p.I(19) : p.I(20);
  float g8[8];
#pragma unroll
  for (int i = 0; i < 8; ++i) g8[i] = gsrc[layer * 256 + h * 64 + j0 + i];
  for (int row = bid * 2 + (tid >> 7); row < MT; row += nb * 2) {
    const uint4 ov = *(const uint4*)(O + (size_t)row * 1024 + cg8 * 8);
    const uint4 gv = *(const uint4*)(P + (size_t)row * DINP + gcol + h * 64 + j0);
    const f32x4 ps = *(const f32x4*)(PS + (size_t)row * 64 + mh * 4);
    float o[8], gt[8]; unpack8(ov, o); unpack8(gv, gt);
    float mu = 0.f, rs;
    if (mix == 3) { mu = (ps[0] + ps[2]) * (1.0f / 64.0f); const float var = fmaxf((ps[1] + ps[3]) * (1.0f / 64.0f) - mu * mu, 0.f); rs = rsqrtf(var + 1e-5f); }
    else rs = rsqrtf((ps[1] + ps[3]) * (1.0f / 64.0f) + 1e-6f);
    float r[8];
#pragma unroll
    for (int i = 0; i < 8; ++i) r[i] = (o[i] - mu) * rs * g8[i] * siluf_(gt[i]);
    uint4 o4; o4.x = pk2(r[0], r[1]); o4.y = pk2(r[2], r[3]); o4.z = pk2(r[4], r[5]); o4.w = pk2(r[6], r[7]);
    *(uint4*)(O + (size_t)row * 1024 + cg8 * 8) = o4;
  }
}

constexpr int NPHASE = 17;
__global__ void __launch_bounds__(256, 2) hymba_fwd(Params p_, int ph_lo, int ph_hi) {
  __shared__ __attribute__((aligned(16))) char lds[65536];
  XcdBarrier xb; xb.bar = (unsigned*)(p_.ws + OFF_BAR); xb.x = xb_xcc_id(); xb.nloc = 0u; xb.nx = 0u;
  if (threadIdx.x == 0) (void)xb_add(&xb.bar[XB_XCNT(xb.x)], 1u);
  if (ph_hi < 0) cg::this_grid().sync();
  for (int ph = ph_lo; ph < ph_hi; ++ph) {
    int tid = threadIdx.x, bid = blockIdx.x, nb = gridDim.x;
    asm volatile("" : "+v"(tid));
    asm volatile("" : "+s"(bid), "+s"(nb));
    if (ph > ph_lo) xcd_barrier(xb, tid, (unsigned)nb);
    const Params& p = p_;
    if (ph == 0) {
      convert_weights(p, lds, bid, nb, tid);
      embed_ln(p, bid, nb, tid);
      rope_table(p, bid, nb, tid);
    } else {
      const int l = (ph - 1) / 8, s = (ph - 1) % 8;
      const bf16_t* Xb = (const bf16_t*)p.O();
      bf16_t* X1b = (bf16_t*)(p.W() + OFF_X1B);
      bf16_t* Hb = (bf16_t*)(p.W() + OFF_H);
      float* X = (float*)(p.W() + OFF_X);
      if (s == 0) gemm_phase<EPI_BF16>(Xb, 1024, (const bf16_t*)(p.W() + OFF_WIN + l * SZ_WIN), 1024, 1024, DINP / 128, p.W() + OFF_P, DINP, lds, bid, nb, tid);
      else if (s == 1) scan_phase(p, l, lds, bid, nb, tid);
      else if (s == 2) norm_phase(p, l, bid, nb, tid);
      else if (s == 3) gemm_phase<EPI_RESID>(Xb, 1024, (const bf16_t*)(p.W() + OFF_WOUT + l * SZ_WOUT), 1024, 1024, 8, X, 1024, lds, bid, nb, tid);
      else if (s == 4) ln_phase(p, p.I(22) + l * 1024, p.I(23) + l * 1024, X1b, 0, bid, nb, tid);
      else if (s == 5) gemm_phase<EPI_SWIGLU>(X1b, 1024, (const bf16_t*)(p.W() + OFF_WGU + l * SZ_WGU), 1024, 1024, 44, Hb, DFF, lds, bid, nb, tid);
      else if (s == 6) gemm_phase<EPI_RESID>(Hb, DFF, (const bf16_t*)(p.W() + OFF_WDN + l * SZ_WDN), DFF, DFF, 8, X, 1024, lds, bid, nb, tid);
      else ln_phase(p, p.I(27) + l * 1024, p.I(28) + l * 1024, (bf16_t*)p.O(), l == 1, bid, nb, tid);
    }
  }
}

extern "C" void kernel_launch(void* const* d_in, const int* in_sizes, int n_in, void* d_out, int out_size, void* d_ws, size_t ws_size,
                              hipStream_t stream) {
  (void)in_sizes; (void)out_size;
  if (n_in < 29 || ws_size < WS_NEED) { fprintf(stderr, "bad args: n_in %d ws %zu need %zu\n", n_in, ws_size, (size_t)WS_NEED); return; }
  Params p{};
  for (int i = 0; i < 29; ++i) p.in[i] = (const float*)d_in[i];
  p.out = (float*)d_out;
  p.ws = (unsigned char*)d_ws;
  static int grid_blocks = 0;
  if (!grid_blocks) {
    int dev = 0, cus = 0, per_cu = 0;
    (void)hipGetDevice(&dev);
    (void)hipDeviceGetAttribute(&cus, hipDeviceAttributeMultiprocessorCount, dev);
    (void)hipOccupancyMaxActiveBlocksPerMultiprocessor(&per_cu, hymba_fwd, 256, 0);
    if (per_cu > 2) per_cu = 2;
    if (per_cu < 1) per_cu = 1;
    grid_blocks = cus * per_cu;
  }
  (void)hipMemsetAsync((unsigned char*)d_ws + OFF_BAR, 0, XCD_BAR_WORDS * 4, stream);
  int lo = 0, hi = NPHASE;
  void* args[] = {&p, &lo, &hi};
  hipError_t e = hipLaunchCooperativeKernel((void*)hymba_fwd, dim3(grid_blocks), dim3(256), args, 0, stream);
  if (e != hipSuccess) fprintf(stderr, "cooperative launch failed: %s (grid %d)\n", hipGetErrorString(e), grid_blocks);
}
```

```cpp
#include <hip/hip_runtime.h>
#include <hip/hip_cooperative_groups.h>
#include <cstdio>
#include <cstdint>
namespace cg = cooperative_groups;

#ifndef COOP
#define COOP 1
#endif

typedef unsigned short bf16_t;
typedef short bf16x8 __attribute__((ext_vector_type(8)));
typedef float f32x4 __attribute__((ext_vector_type(4)));

constexpr int DM = 1024, NB = 8, TPR = 2064, NSB = 128, TS = 4;
constexpr int MP = NB * TPR;
constexpr int MS = NSB * TS;
constexpr int MT = MP + MS;
constexpr int DIN = 3864, DINP = 3968, DFF = 2816;
constexpr float ALPHA = 1.41421356237309515f;

constexpr size_t SZ_WIN = (size_t)DINP * 1024 * 2, SZ_WOUT = (size_t)1024 * 1024 * 2, SZ_WGU = (size_t)5632 * 1024 * 2, SZ_WDN = (size_t)1024 * 2816 * 2;
constexpr size_t OFF_CS = 0;
constexpr size_t OFF_WIN = 532480;
constexpr size_t OFF_WOUT = OFF_WIN + 2 * SZ_WIN;
constexpr size_t OFF_WGU = OFF_WOUT + 2 * SZ_WOUT;
constexpr size_t OFF_WDN = OFF_WGU + 2 * SZ_WGU;
constexpr size_t OFF_X = OFF_WDN + 2 * SZ_WDN;
constexpr size_t OFF_P = OFF_X + (size_t)MT * 1024 * 4;
constexpr size_t OFF_X1B = OFF_P;
constexpr size_t OFF_H = OFF_P + (size_t)MT * 1024 * 2;
constexpr size_t OFF_BAR = OFF_P + (size_t)MT * DINP * 2;
constexpr size_t OFF_PS = OFF_BAR + 16384;
constexpr size_t WS_NEED = OFF_PS + (size_t)MT * 64 * 4;

constexpr size_t O_YP = 0, O_YS = 16777216, O_CP = 17301504, O_CS = 17338368, O_DP = 17928192, O_DS = 18190336,
                 O_HP = 22384640, O_HS = 22646784, O_GP = 26841088, O_GS = 26972160, O_RP = 29069312, O_RS = 29331456;

#define GAS __attribute__((address_space(1)))
struct Params {
  const float* in[29];
  float* out;
  unsigned char* ws;
  __device__ __forceinline__ const float* I(int i) const { return (const float*)(const GAS float*)in[i]; }
  __device__ __forceinline__ float* O() const { return (float*)(GAS float*)out; }
  __device__ __forceinline__ unsigned char* W() const { return (unsigned char*)(GAS unsigned char*)ws; }
};

__device__ __forceinline__ unsigned f2bf(float f) {
  unsigned u = __float_as_uint(f);
  u += 0x7fffu + ((u >> 16) & 1u);
  return u >> 16;
}
__device__ __forceinline__ unsigned pk2(float lo, float hi) { return f2bf(lo) | (f2bf(hi) << 16); }
__device__ __forceinline__ float bflo(unsigned u) { return __uint_as_float(u << 16); }
__device__ __forceinline__ float bfhi(unsigned u) { return __uint_as_float(u & 0xffff0000u); }
__device__ __forceinline__ void unpack8(const uint4& r, float* x) {
  x[0] = bflo(r.x); x[1] = bfhi(r.x); x[2] = bflo(r.y); x[3] = bfhi(r.y);
  x[4] = bflo(r.z); x[5] = bfhi(r.z); x[6] = bflo(r.w); x[7] = bfhi(r.w);
}
__device__ __forceinline__ float sigmoidf_(float x) { return 1.0f / (1.0f + __expf(-x)); }
__device__ __forceinline__ float siluf_(float x) { return x / (1.0f + __expf(-x)); }
__device__ __forceinline__ float softplusf_(float x) { return fmaxf(x, 0.f) + log1pf(__expf(-fabsf(x))); }
__device__ __forceinline__ float red8(float x) {
  x += __shfl_xor(x, 1); x += __shfl_xor(x, 2); x += __shfl_xor(x, 4); return x;
}
__device__ __forceinline__ float dpp_x1(float x) {
  return __int_as_float(__builtin_amdgcn_update_dpp(0, __float_as_int(x), 0xB1, 0xF, 0xF, true));
}
__device__ __forceinline__ float dpp_x2(float x) {
  return __int_as_float(__builtin_amdgcn_update_dpp(0, __float_as_int(x), 0x4E, 0xF, 0xF, true));
}
__device__ __forceinline__ float red4(float x) { x += dpp_x1(x); x += dpp_x2(x); return x; }
__device__ __forceinline__ float wave_sum(float x) {
#pragma unroll
  for (int o = 32; o >= 1; o >>= 1) x += __shfl_xor(x, o);
  return x;
}

__device__ __forceinline__ void convert_weights(const Params& p, char* lds, int bid, int nb, const int tid) {
  float* tile = (float*)lds;
  for (int w = bid; w < 6720; w += nb) {
    const int l = w / 3360; int r = w % 3360;
    int mat, kt, rt;
    if (r < 992) { mat = 0; kt = r / 62; rt = r % 62; }
    else if (r < 1248) { r -= 992; mat = 1; kt = r / 16; rt = r % 16; }
    else if (r < 2656) { r -= 1248; mat = 2; kt = r / 88; rt = r % 88; }
    else { r -= 2656; mat = 3; kt = r / 16; rt = r % 16; }
    {
      const int r4 = (tid & 15) * 4, R = rt * 64 + r4, kq = tid >> 4;
      const float* src; int ns; bool valid = true;
      if (mat == 0) { src = p.I(10) + (size_t)l * 1024 * DIN + R; ns = DIN; valid = R < DIN; }
      else if (mat == 1) { src = p.I(21) + (size_t)l * 1024 * 1024 + R; ns = 1024; }
      else if (mat == 2) { const int blk = R >> 5, ty = (R >> 4) & 1, hid = blk * 16 + (R & 15);
        src = (ty ? p.I(25) : p.I(24)) + (size_t)l * 1024 * DFF + hid; ns = DFF; }
      else { src = p.I(26) + (size_t)l * DFF * 1024 + R; ns = 1024; }
      f32x4 v[4];
#pragma unroll
      for (int i = 0; i < 4; ++i) v[i] = valid ? *(const f32x4*)(src + (size_t)(kt * 64 + kq + 16 * i) * ns) : (f32x4){0.f, 0.f, 0.f, 0.f};
#pragma unroll
      for (int i = 0; i < 4; ++i) {
        const int k = kq + 16 * i;
        tile[(r4 + 0) * 65 + k] = v[i][0]; tile[(r4 + 1) * 65 + k] = v[i][1]; tile[(r4 + 2) * 65 + k] = v[i][2]; tile[(r4 + 3) * 65 + k] = v[i][3];
      }
    }
    __syncthreads();
    {
      const int rr = tid >> 2, kc = (tid & 3) * 16;
      const int Kd = (mat == 3) ? DFF : 1024;
      bf16_t* base;
      if (mat == 0) base = (bf16_t*)(p.W() + OFF_WIN + l * SZ_WIN);
      else if (mat == 1) base = (bf16_t*)(p.W() + OFF_WOUT + l * SZ_WOUT);
      else if (mat == 2) base = (bf16_t*)(p.W() + OFF_WGU + l * SZ_WGU);
      else base = (bf16_t*)(p.W() + OFF_WDN + l * SZ_WDN);
      bf16_t* dst = base + (size_t)(rt * 64 + rr) * Kd + kt * 64 + kc;
      const float* s = tile + rr * 65 + kc;
      uint4 a, b;
      a.x = pk2(s[0], s[1]); a.y = pk2(s[2], s[3]); a.z = pk2(s[4], s[5]); a.w = pk2(s[6], s[7]);
      b.x = pk2(s[8], s[9]); b.y = pk2(s[10], s[11]); b.z = pk2(s[12], s[13]); b.w = pk2(s[14], s[15]);
      *(uint4*)dst = a; *(uint4*)(dst + 8) = b;
    }
    __syncthreads();
  }
}

__device__ __forceinline__ void ln_row_regs(f32x4 (&v)[4], const float* g, const float* bb, int lane) {
  float s = 0.f;
#pragma unroll
  for (int i = 0; i < 4; ++i) s += (v[i][0] + v[i][1]) + (v[i][2] + v[i][3]);
  const float mu = wave_sum(s) * (1.0f / 1024.0f);
  float q = 0.f;
#pragma unroll
  for (int i = 0; i < 4; ++i) { const f32x4 d = v[i] - mu; q += (d[0] * d[0] + d[1] * d[1]) + (d[2] * d[2] + d[3] * d[3]); }
  const float rs = rsqrtf(wave_sum(q) * (1.0f / 1024.0f) + 1e-5f);
#pragma unroll
  for (int i = 0; i < 4; ++i) {
    const f32x4 gg = *(const f32x4*)(g + lane * 4 + i * 256), b4 = *(const f32x4*)(bb + lane * 4 + i * 256);
    v[i] = (v[i] - mu) * rs * gg + b4;
  }
}

__device__ __forceinline__ void embed_ln(const Params& p, int bid, int nb, const int tid) {
  const int lane = tid & 63, wv = tid >> 6;
  float* X = (float*)(p.W() + OFF_X);
  bf16_t* Xb = (bf16_t*)p.O();
  for (int row = bid * 4 + wv; row < MT; row += nb * 4) {
    const float* src;
    if (row < MP) { const int b = row / TPR, t = row % TPR;
      src = (t < 16) ? p.I(7) + (size_t)t * 1024 : p.I(0) + ((size_t)b * 2048 + (t - 16)) * 1024; }
    else src = p.I(1) + (size_t)(row - MP) * 1024;
    f32x4 v[4];
#pragma unroll
    for (int i = 0; i < 4; ++i) v[i] = *(const f32x4*)(src + lane * 4 + i * 256);
    ln_row_regs(v, p.I(8), p.I(9), lane);
#pragma unroll
    for (int i = 0; i < 4; ++i) {
      *(f32x4*)(X + (size_t)row * 1024 + lane * 4 + i * 256) = v[i];
      uint2 o; o.x = pk2(v[i][0], v[i][1]); o.y = pk2(v[i][2], v[i][3]);
      *(uint2*)(Xb + (size_t)row * 1024 + lane * 4 + i * 256) = o;
    }
  }
}

__device__ __forceinline__ void rope_table(const Params& p, int bid, int nb, const int tid) {
  float2* cs = (float2*)(p.W() + OFF_CS);
  for (int e = bid * 256 + tid; e < 2068 * 32; e += nb * 256) {
    const int idx = e >> 5, i = e & 31;
    const double pos = (idx < 2064) ? (double)idx : (double)(16384 + idx - 2064);
    const double inv = exp(-((double)i / 31.0) * 9.210340371976184);
    const double ang = pos * inv;
    cs[e] = make_float2((float)cos(ang), (float)sin(ang));
  }
}

__device__ __forceinline__ void ln_phase(const Params& p, const float* g, const float* bb, bf16_t* xb, int final_, int bid, int nb, const int tid) {
  const int lane = tid & 63, wv = tid >> 6;
  float* X = (float*)(p.W() + OFF_X);
  for (int row = bid * 4 + wv; row < MT; row += nb * 4) {
    f32x4 v[4];
#pragma unroll
    for (int i = 0; i < 4; ++i) v[i] = *(const f32x4*)(X + (size_t)row * 1024 + lane * 4 + i * 256);
    ln_row_regs(v, g, bb, lane);
    if (!final_) {
#pragma unroll
      for (int i = 0; i < 4; ++i) {
        *(f32x4*)(X + (size_t)row * 1024 + lane * 4 + i * 256) = v[i];
        uint2 o; o.x = pk2(v[i][0], v[i][1]); o.y = pk2(v[i][2], v[i][3]);
        *(uint2*)(xb + (size_t)row * 1024 + lane * 4 + i * 256) = o;
      }
    } else {
      float* dst = nullptr;
      if (row < MP) { const int b = row / TPR, t = row % TPR; if (t >= 16) dst = p.O() + O_YP + ((size_t)b * 2048 + (t - 16)) * 1024; }
      else dst = p.O() + O_YS + (size_t)(row - MP) * 1024;
      if (dst) {
#pragma unroll
        for (int i = 0; i < 4; ++i) *(f32x4*)(dst + lane * 4 + i * 256) = v[i];
      }
    }
  }
}

enum { EPI_BF16 = 0, EPI_RESID = 1, EPI_SWIGLU = 2 };

template <int EPI>
__device__ __forceinline__ void gemm_tile(const bf16_t* __restrict__ A, const int lda, const bf16_t* __restrict__ Bt, const int ldb,
                                          const int K, const int m0, const int n0, void* Cout, const int ldc, char* lds, const int tid) {
  const int wid = tid >> 6, lane = tid & 63, wr = wid >> 1, wc = wid & 1, fr = lane & 15, fq = lane >> 4;
  f32x4 acc[4][4];
#pragma unroll
  for (int m = 0; m < 4; ++m)
#pragma unroll
    for (int n = 0; n < 4; ++n) acc[m][n] = (f32x4){0.f, 0.f, 0.f, 0.f};
  const int nt = K >> 6;
  auto stage = [&](int kt, int buf) {
#pragma unroll
    for (int i = 0; i < 4; ++i) {
      const int off = tid * 16 + i * 4096;
      const int panel = off >> 13, rem = off & 8191, r = rem >> 6, c = (rem & 63) >> 1;
      const bf16_t* ga = A + (size_t)(m0 + r) * lda + kt * 64 + panel * 32 + c;
      const bf16_t* gb = Bt + (size_t)(n0 + r) * ldb + kt * 64 + panel * 32 + c;
      __builtin_amdgcn_global_load_lds((const unsigned*)ga, (__attribute__((address_space(3))) unsigned*)(lds + buf * 32768 + off), 16, 0, 0);
      __builtin_amdgcn_global_load_lds((const unsigned*)gb, (__attribute__((address_space(3))) unsigned*)(lds + buf * 32768 + 16384 + off), 16, 0, 0);
    }
  };
  stage(0, 0);
  for (int kt = 0; kt < nt; ++kt) {
    asm volatile("s_waitcnt vmcnt(0)" ::: "memory");
    __syncthreads();
    if (kt + 1 < nt) stage(kt + 1, (kt + 1) & 1);
    const char* sa = lds + (kt & 1) * 32768;
    const char* sb = sa + 16384;
#pragma unroll
    for (int ks = 0; ks < 2; ++ks) {
      bf16x8 af[4], bfr[4];
#pragma unroll
      for (int m = 0; m < 4; ++m) af[m] = *(const bf16x8*)(sa + ks * 8192 + (wr * 64 + m * 16 + fr) * 64 + fq * 16);
#pragma unroll
      for (int n = 0; n < 4; ++n) bfr[n] = *(const bf16x8*)(sb + ks * 8192 + (wc * 64 + n * 16 + fr) * 64 + fq * 16);
#pragma unroll
      for (int m = 0; m < 4; ++m)
#pragma unroll
        for (int n = 0; n < 4; ++n) acc[m][n] = __builtin_amdgcn_mfma_f32_16x16x32_bf16(bfr[n], af[m], acc[m][n], 0, 0, 0);
    }
  }
#pragma unroll
  for (int m = 0; m < 4; ++m) {
    const int row = m0 + wr * 64 + m * 16 + fr;
    if (EPI == EPI_BF16) {
      bf16_t* C = (bf16_t*)Cout + (size_t)row * ldc + n0 + wc * 64 + fq * 4;
#pragma unroll
      for (int n = 0; n < 4; ++n) { uint2 o; o.x = pk2(acc[m][n][0], acc[m][n][1]); o.y = pk2(acc[m][n][2], acc[m][n][3]); *(uint2*)(C + n * 16) = o; }
    } else if (EPI == EPI_RESID) {
      float* C = (float*)Cout + (size_t)row * ldc + n0 + wc * 64 + fq * 4;
#pragma unroll
      for (int n = 0; n < 4; ++n) { const f32x4 x = *(const f32x4*)(C + n * 16); *(f32x4*)(C + n * 16) = x * ALPHA + acc[m][n]; }
    } else {
      bf16_t* C = (bf16_t*)Cout + (size_t)row * ldc + (n0 >> 1) + wc * 32 + fq * 4;
#pragma unroll
      for (int np = 0; np < 2; ++np) {
        const f32x4 g = acc[m][2 * np], u = acc[m][2 * np + 1];
        uint2 o; o.x = pk2(siluf_(g[0]) * u[0], siluf_(g[1]) * u[1]); o.y = pk2(siluf_(g[2]) * u[2], siluf_(g[3]) * u[3]);
        *(uint2*)(C + np * 16) = o;
      }
    }
  }
}

template <int EPI>
__device__ __forceinline__ void gemm_phase(const bf16_t* A, int lda, const bf16_t* Bt, int ldb, int K, int ntn, void* C, int ldc, char* lds, int bid, int nb, const int tid) {
  constexpr int GM = 8, nM = MT / 128;
  const int ntiles = nM * ntn, nig = GM * ntn;
  const int pos = ((nb & 7) == 0) ? (bid & 7) * (nb >> 3) + (bid >> 3) : bid;
  for (int L = pos; L < ntiles; L += nb) {
    const int gid = L / nig, fm = gid * GM, gsz = min(nM - fm, GM), rem = L - gid * nig;
    const int mt = fm + rem % gsz, nn = rem / gsz;
    gemm_tile<EPI>(A, lda, Bt, ldb, K, mt * 128, nn * 128, C, ldc, lds, tid);
  }
}

#define XB_TMO      128
#define XB_XCNT(j)  (256  + 64 * (j))
#define XB_XSUB(j)  (1280 + 64 * (j))
#define XB_XGEN(j)  (2304 + 64 * (j))
#define XB_TOP      3328
#define XB_TOPGEN   3392
#define XCD_BAR_WORDS 3456
#define XB_SPIN_CAP (1u << 22)
__device__ __forceinline__ unsigned xb_ld(unsigned* p) { return __hip_atomic_load(p, __ATOMIC_RELAXED, __HIP_MEMORY_SCOPE_AGENT); }
__device__ __forceinline__ unsigned xb_add(unsigned* p, unsigned v) { return __hip_atomic_fetch_add(p, v, __ATOMIC_RELAXED, __HIP_MEMORY_SCOPE_AGENT); }
__device__ __forceinline__ unsigned xb_xcc_id() { return (unsigned)__builtin_amdgcn_s_getreg((3 << 11) | 20) & 0xFu; }
#define XB_SPIN(cond, bar) do { unsigned _sp = 0; while (cond) { __builtin_amdgcn_s_sleep(1); \
    if ((++_sp & 255u) == 0u) { if (xb_ld(&(bar)[XB_TMO])) break; if (_sp > XB_SPIN_CAP) { atomicAdd(&(bar)[XB_TMO], 1u); break; } } } } while (0)
struct XcdBarrier { unsigned* bar; unsigned x; unsigned nloc, nx; };
__device__ __forceinline__ void xcd_barrier_complete(unsigned* bar, unsigned x, unsigned G, unsigned& nloc, unsigned& nx) {
  unsigned sum, cnt, mine, sp = 0u;
  for (;;) {
    sum = 0u; cnt = 0u; mine = 0u;
#pragma unroll
    for (unsigned j = 0; j < 16; ++j) { const unsigned c = xb_ld(&bar[XB_XCNT(j)]); sum += c; cnt += (c > 0u) ? 1u : 0u; mine = (j == x) ? c : mine; }
    if (sum == G) break;
    __builtin_amdgcn_s_sleep(1);
    if ((++sp & 255u) == 0u) { if (xb_ld(&bar[XB_TMO])) break; if (sp > XB_SPIN_CAP) { atomicAdd(&bar[XB_TMO], 1u); break; } }
  }
  nloc = mine > 0u ? mine : 1u; nx = cnt > 0u ? cnt : 1u;
}
__device__ __forceinline__ void xcd_barrier(XcdBarrier& b, const int tid, const unsigned G) {
  asm volatile("s_waitcnt vmcnt(0)" ::: "memory");
  __syncthreads();
  if (tid == 0) {
    unsigned* bar = b.bar;
    __builtin_amdgcn_s_waitcnt(0);
    if (b.nloc == 0u) xcd_barrier_complete(bar, b.x, G, b.nloc, b.nx);
    const unsigned nloc = b.nloc, nx = b.nx;
    const unsigned old = xb_add(&bar[XB_XSUB(b.x)], 1u);
    const unsigned gen = old / nloc;
    if (old + 1u == (gen + 1u) * nloc) {
      __builtin_amdgcn_fence(__ATOMIC_RELEASE, "agent");
      asm volatile("s_waitcnt vmcnt(0)" ::: "memory");
      const unsigned og = xb_add(&bar[XB_TOP], 1u);
      const unsigned tg = og / nx;
      if (og + 1u == (tg + 1u) * nx) xb_add(&bar[XB_TOPGEN], 1u);
      else XB_SPIN(xb_ld(&bar[XB_TOPGEN]) == tg, bar);
      __builtin_amdgcn_fence(__ATOMIC_ACQUIRE, "agent");
      xb_add(&bar[XB_XGEN(b.x)], 1u);
      asm volatile("s_waitcnt vmcnt(0)" ::: "memory");
    } else {
      XB_SPIN(xb_ld(&bar[XB_XGEN(b.x)]) == gen, bar);
      __builtin_amdgcn_fence(__ATOMIC_ACQUIRE, "agent");
      asm volatile("s_waitcnt vmcnt(0)" ::: "memory");
    }
  }
  __syncthreads();
}

template <int N>
__device__ __forceinline__ void convN(const bf16_t* rawb, const float* cwl, int tt, int off, float (&x)[N]) {
#pragma unroll
  for (int i = 0; i < N; ++i) x[i] = 0.f;
#pragma unroll
  for (int j = 0; j < 4; ++j) {
    float xv[N];
    if (N == 8) { const uint4 rv = *(const uint4*)(rawb + (tt + j) * 160 + off); unpack8(rv, xv); }
    else { const uint2 rv = *(const uint2*)(rawb + (tt + j) * 160 + off); xv[0] = bflo(rv.x); xv[1] = bfhi(rv.x); xv[2] = bflo(rv.y); xv[3] = bfhi(rv.y); }
#pragma unroll
    for (int i = 0; i < N; i += 4) {
      const f32x4 w = *(const f32x4*)(cwl + j * 160 + off + i);
      x[i] += w[0] * xv[i]; x[i + 1] += w[1] * xv[i + 1]; x[i + 2] += w[2] * xv[i + 2]; x[i + 3] += w[3] * xv[i + 3];
    }
  }
  if (N == 8) asm volatile("" : "+v"(x[0]), "+v"(x[1]), "+v"(x[2]), "+v"(x[3]), "+v"(x[4 % N]), "+v"(x[5 % N]), "+v"(x[6 % N]), "+v"(x[7 % N]) :: "memory");
  else asm volatile("" : "+v"(x[0]), "+v"(x[1]), "+v"(x[2]), "+v"(x[3]) :: "memory");
#pragma unroll
  for (int i = 0; i < N; ++i) x[i] = siluf_(x[i]);
}

template <int MIX>
__device__ __forceinline__ void load_chunk_fn(const unsigned char* ws, const bf16_t* Pb, const int t, const int T, const int h, const int half, const int sub, const int posb,
                                              uint4& R0, uint4& R1, uint2& R2, uint4& R4, uint4& R5, unsigned& ex0, unsigned& ex1) {
  if (t < T) {
    const bf16_t* pr = Pb + (size_t)t * DINP;
    if (MIX == 0) {
      R0 = *(const uint4*)(pr + 0 + h * 64 + sub * 8); R1 = *(const uint4*)(pr + 256 + h * 64 + sub * 8);
      R2 = *(const uint2*)(pr + 512 + h * 64 + half * 32 + sub * 4);
      ex0 = pr[768 + h]; ex1 = pr[772 + h];
    } else if (MIX == 1) {
      R0 = *(const uint4*)(pr + 1032 + h * 64 + sub * 8); R1 = *(const uint4*)(pr + 1288 + h * 64 + sub * 8);
      R2 = *(const uint2*)(pr + 1544 + h * 64 + half * 32 + sub * 4);
    } else if (MIX == 2) {
      const uint2 q2 = *(const uint2*)(pr + 2056 + h * 32 + sub * 4), k2 = *(const uint2*)(pr + 2184 + h * 32 + sub * 4);
      R0 = make_uint4(q2.x, q2.y, k2.x, k2.y);
      R1 = *(const uint4*)(pr + 2568); R4 = *(const uint4*)(pr + 2576);
      R2 = *(const uint2*)(pr + 2312 + h * 64 + half * 32 + sub * 4);
    } else {
      const uint2 ql = *(const uint2*)(pr + 2840 + h * 64 + sub * 4), qh = *(const uint2*)(pr + 2840 + h * 64 + 32 + sub * 4);
      const uint2 kl = *(const uint2*)(pr + 3096 + h * 64 + sub * 4), kh = *(const uint2*)(pr + 3096 + h * 64 + 32 + sub * 4);
      R0 = make_uint4(ql.x, ql.y, qh.x, qh.y); R1 = make_uint4(kl.x, kl.y, kh.x, kh.y);
      R2 = *(const uint2*)(pr + 3352 + h * 64 + half * 32 + sub * 4);
      const uint4* cs = (const uint4*)(ws + OFF_CS + ((size_t)(posb + t) * 32 + sub * 4) * 8);
      R4 = cs[0]; R5 = cs[1];
    }
  }
}

__device__ __forceinline__ float dpp_hm(float x) {
  return __int_as_float(__builtin_amdgcn_update_dpp(0, __float_as_int(x), 0x141, 0xF, 0xF, true));
}
__device__ __forceinline__ float red8d(float x) { x += dpp_x1(x); x += dpp_x2(x); x += dpp_hm(x); return x; }

template <int MIX, int KPL>
struct StepIn { float q[KPL], k[KPL], d[KPL]; float v, a, be, qk; };

template <int MIX, int KPL>
__device__ __forceinline__ void load_step(const float* qkdv, const float* scal, int t, int kg, int col, StepIn<MIX, KPL>& s) {
  const float* base = qkdv + t * 256;
#pragma unroll
  for (int i = 0; i < KPL; i += 4) {
    const f32x4 a = *(const f32x4*)(base + kg * KPL + i), b = *(const f32x4*)(base + 64 + kg * KPL + i);
    s.q[i] = a[0]; s.q[i + 1] = a[1]; s.q[i + 2] = a[2]; s.q[i + 3] = a[3];
    s.k[i] = b[0]; s.k[i + 1] = b[1]; s.k[i + 2] = b[2]; s.k[i + 3] = b[3];
    if (MIX == 1 || MIX == 2) { const f32x4 d = *(const f32x4*)(base + 128 + kg * KPL + i); s.d[i] = d[0]; s.d[i + 1] = d[1]; s.d[i + 2] = d[2]; s.d[i + 3] = d[3]; }
  }
  s.v = base[192 + col];
  if (MIX == 0) { const f32x4 c = *(const f32x4*)(scal + t * 4); s.a = c[0]; s.be = c[1]; s.qk = c[2]; }
}

template <int MIX, int KPL>
__device__ __forceinline__ float do_step(const StepIn<MIX, KPL>& s, float (&S)[KPL], const float gam) {
  if (MIX == 0) {
    float kS0 = 0.f, kS1 = 0.f, qS0 = 0.f, qS1 = 0.f;
#pragma unroll
    for (int i = 0; i < KPL; i += 2) { kS0 += s.k[i] * S[i]; kS1 += s.k[i + 1] * S[i + 1]; qS0 += s.q[i] * S[i]; qS1 += s.q[i + 1] * S[i + 1]; }
    const float kS = red8d(kS0 + kS1), qS = red8d(qS0 + qS1);
    const float w = s.be * (s.v - s.a * kS);
#pragma unroll
    for (int i = 0; i < KPL; ++i) S[i] = s.a * S[i] + s.k[i] * w;
    return s.a * qS + s.qk * w;
  } else {
    float o0 = 0.f, o1 = 0.f;
#pragma unroll
    for (int i = 0; i < KPL; i += 2) {
      const float d0 = (MIX == 3) ? gam : s.d[i], d1 = (MIX == 3) ? gam : s.d[i + 1];
      S[i] = d0 * S[i] + s.k[i] * s.v; S[i + 1] = d1 * S[i + 1] + s.k[i + 1] * s.v;
      o0 += s.q[i] * S[i]; o1 += s.q[i + 1] * S[i + 1];
    }
    return red8d(o0 + o1);
  }
}

template <int MIX>
__device__ __forceinline__ void scan_half(const Params& p, const int layer, const int smp, const int b, const int h, const int half, char* lds, const int tid) {
  constexpr int DK = (MIX == 2) ? 32 : 64;
  constexpr int KPL = DK / 8;
  float* qkdv = (float*)lds;
  float* obuf = (float*)(lds + 32768);
  float* scal = (float*)(lds + 36864);
  bf16_t* rawb = (bf16_t*)(lds + 37376);
  float* cwl = (float*)(lds + 48576);
  float* wgl = (float*)(lds + 37376);

  const int lane = tid & 63, wv = tid >> 6;
  const int tt = tid >> 3, sub = tid & 7;
  const int col = wv * 8 + (lane >> 3), kg = lane & 7;
  const int T = smp ? 4 : TPR;
  const int row0 = smp ? MP + b * 4 : b * TPR;
  const int nBatch = smp ? NSB : NB;
  const bf16_t* Pb = (const bf16_t*)(p.W() + OFF_P) + (size_t)row0 * DINP;
  bf16_t* Ob = (bf16_t*)p.O() + (size_t)row0 * 1024 + MIX * 256 + h * 64 + half * 32;
  float* PS = (float*)(p.W() + OFF_PS) + (size_t)row0 * 64 + (MIX * 4 + h) * 4 + half * 2;
  const int posb = smp ? 2064 : 0;

  uint4 R0 = make_uint4(0, 0, 0, 0), R1 = R0, R4 = R0, R5 = R0; uint2 R2 = make_uint2(0, 0); unsigned ex0 = 0, ex1 = 0;
  load_chunk_fn<MIX>(p.W(), Pb, tt, T, h, half, sub, posb, R0, R1, R2, R4, R5, ex0, ex1);

  __syncthreads();
  float S[KPL];
  if (smp) {
    const float* sin_ = p.I(3 + MIX) + ((size_t)(layer * NSB + b) * 4 + h) * DK * 64 + half * 32;
#pragma unroll
    for (int i = 0; i < KPL; ++i) S[i] = sin_[(kg * KPL + i) * 64 + col];
  } else {
#pragma unroll
    for (int i = 0; i < KPL; ++i) S[i] = 0.f;
  }
  float c8[8];
  float Aexp = 0.f, dtb = 0.f, gam = 0.f;
  if (MIX == 0) {
    Aexp = __expf(p.I(12)[layer * 4 + h]); dtb = p.I(13)[layer * 4 + h];
    for (int e = tid; e < 640; e += 256) { const int j = e / 160, r = e % 160;
      const int cc = (r < 64) ? (h * 64 + r) : (r < 128) ? (256 + h * 64 + r - 64) : (512 + h * 64 + half * 32 + r - 128);
      cwl[e] = p.I(11)[(size_t)(layer * 4 + j) * 768 + cc]; }
    for (int e = tid; e < 480; e += 256) { const int j = e / 160, r = e % 160;
      const int cc = (r < 64) ? (h * 64 + r) : (r < 128) ? (256 + h * 64 + r - 64) : (512 + h * 64 + half * 32 + r - 128);
      float v = 0.f; if (smp) v = p.I(2)[((size_t)(layer * NSB + b) * 3 + j) * 768 + cc];
      rawb[e] = (bf16_t)f2bf(v); }
  } else if (MIX == 1) {
#pragma unroll
    for (int i = 0; i < 8; ++i) {
      const int d = h * 64 + sub * 8 + i;
      c8[i] = (layer == 0) ? 1.0f : sigmoidf_(p.I(15)[d] - p.I(15)[256 + d]);
    }
  } else if (MIX == 2) {
    for (int e = tid; e < 512; e += 256) { const int r = e >> 5, j = e & 31; wgl[e] = p.I(17)[(size_t)(layer * 16 + r) * 128 + h * 32 + j]; }
#pragma unroll
    for (int i = 0; i < 4; ++i) c8[i] = p.I(18)[layer * 128 + h * 32 + sub * 4 + i];
  } else {
    gam = 1.0f - exp2f(-5.0f - (float)h);
  }
  __syncthreads();

  int ntok_last = 0;
  for (int t0 = 0; t0 < T; t0 += 32) {
    const int ntok = min(32, T - t0);
    ntok_last = ntok;
    const bool valid = tt < ntok;
    float* dst = qkdv + tt * 256;
    if (MIX == 0) {
      if (valid) {
        *(uint4*)(rawb + (3 + tt) * 160 + 0 + sub * 8) = R0;
        *(uint4*)(rawb + (3 + tt) * 160 + 64 + sub * 8) = R1;
        *(uint2*)(rawb + (3 + tt) * 160 + 128 + sub * 4) = R2;
      }
      __syncthreads();
      if (valid) {
        float xq[8], xk[8], xv[4];
        convN<8>(rawb, cwl, tt, sub * 8, xq);
        convN<8>(rawb, cwl, tt, 64 + sub * 8, xk);
        convN<4>(rawb, cwl, tt, 128 + sub * 4, xv);
        *(f32x4*)(dst + 192 + sub * 4) = (f32x4){xv[0], xv[1], xv[2], xv[3]};
        float ssq = 0.f, ssk = 0.f;
#pragma unroll
        for (int i = 0; i < 8; ++i) { ssq += xq[i] * xq[i]; ssk += xk[i] * xk[i]; }
        ssq = red8d(ssq); ssk = red8d(ssk);
        const float rq = rsqrtf(ssq + 1e-6f) * 0.125f, rk = rsqrtf(ssk + 1e-6f);
        float qk = 0.f;
#pragma unroll
        for (int i = 0; i < 8; ++i) { xq[i] *= rq; xk[i] *= rk; qk += xq[i] * xk[i]; }
        qk = red8d(qk);
        *(f32x4*)(dst + sub * 8) = (f32x4){xq[0], xq[1], xq[2], xq[3]}; *(f32x4*)(dst + sub * 8 + 4) = (f32x4){xq[4], xq[5], xq[6], xq[7]};
        *(f32x4*)(dst + 64 + sub * 8) = (f32x4){xk[0], xk[1], xk[2], xk[3]}; *(f32x4*)(dst + 64 + sub * 8 + 4) = (f32x4){xk[4], xk[5], xk[6], xk[7]};
        if (sub == 0) {
          const float be = sigmoidf_(bflo(ex0)), al = bflo(ex1);
          const float a = __expf(-Aexp * softplusf_(al + dtb));
          *(f32x4*)(scal + tt * 4) = (f32x4){a, be, qk, 0.f};
        }
      }
    } else if (MIX == 1) {
      if (valid) {
        float q[8], z[8]; unpack8(R0, q); unpack8(R1, z);
        float kk[8], dd[8];
#pragma unroll
        for (int i = 0; i < 8; ++i) { q[i] = siluf_(q[i]); kk[i] = c8[i] * sigmoidf_(-z[i]); dd[i] = 1.0f - fminf(kk[i], 1.0f - 1e-6f); }
        *(f32x4*)(dst + sub * 8) = (f32x4){q[0], q[1], q[2], q[3]}; *(f32x4*)(dst + sub * 8 + 4) = (f32x4){q[4], q[5], q[6], q[7]};
        *(f32x4*)(dst + 64 + sub * 8) = (f32x4){kk[0], kk[1], kk[2], kk[3]}; *(f32x4*)(dst + 64 + sub * 8 + 4) = (f32x4){kk[4], kk[5], kk[6], kk[7]};
        *(f32x4*)(dst + 128 + sub * 8) = (f32x4){dd[0], dd[1], dd[2], dd[3]}; *(f32x4*)(dst + 128 + sub * 8 + 4) = (f32x4){dd[4], dd[5], dd[6], dd[7]};
        *(f32x4*)(dst + 192 + sub * 4) = (f32x4){bflo(R2.x), bfhi(R2.x), bflo(R2.y), bfhi(R2.y)};
      }
    } else if (MIX == 2) {
      if (valid) {
        float lr[16]; unpack8(R1, lr); unpack8(R4, lr + 8);
        const float q0 = bflo(R0.x), q1 = bfhi(R0.x), q2 = bflo(R0.y), q3 = bfhi(R0.y);
        const float k0 = bflo(R0.z), k1 = bfhi(R0.z), k2 = bflo(R0.w), k3 = bfhi(R0.w);
        const float sc = 0.17677669529663687f;
        f32x4 xg = (f32x4){c8[0], c8[1], c8[2], c8[3]};
#pragma unroll
        for (int r = 0; r < 16; ++r) xg += lr[r] * *(const f32x4*)(wgl + r * 32 + sub * 4);
        f32x4 dd;
#pragma unroll
        for (int i = 0; i < 4; ++i) { const float ls = fminf(xg[i], 0.f) - log1pf(__expf(-fabsf(xg[i]))); dd[i] = __expf(ls * 0.0625f); }
        *(f32x4*)(dst + sub * 4) = (f32x4){q0 * sc, q1 * sc, q2 * sc, q3 * sc};
        *(f32x4*)(dst + 64 + sub * 4) = (f32x4){k0, k1, k2, k3};
        *(f32x4*)(dst + 128 + sub * 4) = dd;
        *(f32x4*)(dst + 192 + sub * 4) = (f32x4){bflo(R2.x), bfhi(R2.x), bflo(R2.y), bfhi(R2.y)};
      }
    } else {
      if (valid) {
        const float ql[4] = {bflo(R0.x), bfhi(R0.x), bflo(R0.y), bfhi(R0.y)}, qh[4] = {bflo(R0.z), bfhi(R0.z), bflo(R0.w), bfhi(R0.w)};
        const float kl[4] = {bflo(R1.x), bfhi(R1.x), bflo(R1.y), bfhi(R1.y)}, kh[4] = {bflo(R1.z), bfhi(R1.z), bflo(R1.w), bfhi(R1.w)};
        const float cc[4] = {__uint_as_float(R4.x), __uint_as_float(R4.z), __uint_as_float(R5.x), __uint_as_float(R5.z)};
        const float sn[4] = {__uint_as_float(R4.y), __uint_as_float(R4.w), __uint_as_float(R5.y), __uint_as_float(R5.w)};
        f32x4 qa, qb, ka, kb;
#pragma unroll
        for (int i = 0; i < 4; ++i) {
          qa[i] = ql[i] * cc[i] - qh[i] * sn[i]; qb[i] = ql[i] * sn[i] + qh[i] * cc[i];
          ka[i] = (kl[i] * cc[i] - kh[i] * sn[i]) * 0.125f; kb[i] = (kl[i] * sn[i] + kh[i] * cc[i]) * 0.125f;
        }
        *(f32x4*)(dst + sub * 4) = qa; *(f32x4*)(dst + 32 + sub * 4) = qb;
        *(f32x4*)(dst + 64 + sub * 4) = ka; *(f32x4*)(dst + 96 + sub * 4) = kb;
        *(f32x4*)(dst + 192 + sub * 4) = (f32x4){bflo(R2.x), bfhi(R2.x), bflo(R2.y), bfhi(R2.y)};
      }
    }
    __syncthreads();
    if (MIX == 0 && t0 + 32 < T) {
      if (tid < 60) { const uint4 v = *(const uint4*)(rawb + 32 * 160 + tid * 8); *(uint4*)(rawb + tid * 8) = v; }
    }
    if (t0 + 32 < T) load_chunk_fn<MIX>(p.W(), Pb, t0 + 32 + tt, T, h, half, sub, posb, R0, R1, R2, R4, R5, ex0, ex1);
    {
      StepIn<MIX, KPL> sa, sb;
      load_step<MIX, KPL>(qkdv, scal, 0, kg, col, sa);
      for (int t = 0; t < ntok; t += 2) {
        load_step<MIX, KPL>(qkdv, scal, t + 1, kg, col, sb);
        const float oa = do_step<MIX, KPL>(sa, S, gam);
        if (kg == 0) obuf[t * 32 + col] = oa;
        load_step<MIX, KPL>(qkdv, scal, min(t + 2, ntok - 1), kg, col, sa);
        const float ob = do_step<MIX, KPL>(sb, S, gam);
        if (kg == 0) obuf[(t + 1) * 32 + col] = ob;
      }
    }
    __syncthreads();
    if (valid) {
      const f32x4 o = *(const f32x4*)(obuf + tt * 32 + sub * 4);
      float s1 = (o[0] + o[1]) + (o[2] + o[3]), s2 = (o[0] * o[0] + o[1] * o[1]) + (o[2] * o[2] + o[3] * o[3]);
      s1 = red8d(s1); s2 = red8d(s2);
      uint2 o2; o2.x = pk2(o[0], o[1]); o2.y = pk2(o[2], o[3]);
      *(uint2*)(Ob + (size_t)(t0 + tt) * 1024 + sub * 4) = o2;
      if (sub == 0) *(float2*)(PS + (size_t)(t0 + tt) * 64) = make_float2(s1, s2);
    }
  }
  {
    const size_t obase = (MIX == 0) ? (smp ? O_DS : O_DP) : (MIX == 1) ? (smp ? O_HS : O_HP) : (MIX == 2) ? (smp ? O_GS : O_GP) : (smp ? O_RS : O_RP);
    float* so = p.O() + obase + ((size_t)(layer * nBatch + b) * 4 + h) * DK * 64 + half * 32;
#pragma unroll
    for (int i = 0; i < KPL; ++i) so[(kg * KPL + i) * 64 + col] = S[i];
  }
  if (MIX == 0) {
    float* co = p.O() + (smp ? O_CS : O_CP) + (size_t)(layer * nBatch + b) * 3 * 768;
    for (int e = tid; e < 480; e += 256) { const int j = e / 160, r = e % 160;
      const float v = bflo((unsigned)rawb[(ntok_last + j) * 160 + r]);
      if (r < 128) { if (half == 0) co[j * 768 + ((r < 64) ? (h * 64 + r) : (256 + h * 64 + r - 64))] = v; }
      else co[j * 768 + 512 + h * 64 + half * 32 + r - 128] = v; }
  }
}

__device__ __forceinline__ void scan_dispatch(const Params& p, int layer, int item, char* lds, const int tid) {
  int smp = 0, it = item;
  if (item >= 256) { smp = 1; it = item - 256; }
  const int b = it >> 5, mh = (it & 31) >> 1, half = it & 1;
  const int mix = mh >> 2, h = mh & 3;
  if (mix == 0) scan_half<0>(p, layer, smp, b, h, half, lds, tid);
  else if (mix == 1) scan_half<1>(p, layer, smp, b, h, half, lds, tid);
  else if (mix == 2) scan_half<2>(p, layer, smp, b, h, half, lds, tid);
  else scan_half<3>(p, layer, smp, b, h, half, lds, tid);
}

__device__ __forceinline__ void scan_phase(const Params& p, int layer, char* lds, int bid, int nb, const int tid) {
  for (int u = bid; u < 256; u += nb) scan_dispatch(p, layer, u, lds, tid);
  if (nb > 256) { if (bid >= 256) for (int s = bid - 256; s < 4096; s += nb - 256) scan_dispatch(p, layer, 256 + s, lds, tid); }
  else for (int s = bid; s < 4096; s += nb) scan_dispatch(p, layer, 256 + s, lds, tid);
}

__device__ __forceinline__ void norm_phase(const Params& p, int layer, int bid, int nb, const int tid) {
  bf16_t* O = (bf16_t*)p.O();
  const bf16_t* P = (const bf16_t*)(p.W() + OFF_P);
  const float* PS = (const float*)(p.W() + OFF_PS);
  const int cg8 = tid & 127;
  const int mh = cg8 >> 3, mix = mh >> 2, h = mh & 3, j0 = (cg8 & 7) * 8;
  const int gcol = (mix == 0) ? 776 : (mix == 1) ? 1800 : (mix == 2) ? 2584 : 3608;
  const float* gsrc = (mix == 0) ? p.I(14) : (mix == 1) ? p.I(16) : (mix == 2) ? p.I(19) : p.I(20);
  float g8[8];
#pragma unroll
  for (int i = 0; i < 8; ++i) g8[i] = gsrc[layer * 256 + h * 64 + j0 + i];
  for (int row = bid * 2 + (tid >> 7); row < MT; row += nb * 2) {
    const uint4 ov = *(const uint4*)(O + (size_t)row * 1024 + cg8 * 8);
    const uint4 gv = *(const uint4*)(P + (size_t)row * DINP + gcol + h * 64 + j0);
    const f32x4 ps = *(const f32x4*)(PS + (size_t)row * 64 + mh * 4);
    float o[8], gt[8]; unpack8(ov, o); unpack8(gv, gt);
    float mu = 0.f, rs;
    if (mix == 3) { mu = (ps[0] + ps[2]) * (1.0f / 64.0f); const float var = fmaxf((ps[1] + ps[3]) * (1.0f / 64.0f) - mu * mu, 0.f); rs = rsqrtf(var + 1e-5f); }
    else rs = rsqrtf((ps[1] + ps[3]) * (1.0f / 64.0f) + 1e-6f);
    float r[8];
#pragma unroll
    for (int i = 0; i < 8; ++i) r[i] = (o[i] - mu) * rs * g8[i] * siluf_(gt[i]);
    uint4 o4; o4.x = pk2(r[0], r[1]); o4.y = pk2(r[2], r[3]); o4.z = pk2(r[4], r[5]); o4.w = pk2(r[6], r[7]);
    *(uint4*)(O + (size_t)row * 1024 + cg8 * 8) = o4;
  }
}

constexpr int NPHASE = 17;
__global__ void __launch_bounds__(256, 2) hymba_fwd(Params p_, int ph_lo, int ph_hi) {
  __shared__ __attribute__((aligned(16))) char lds[65536];
  XcdBarrier xb; xb.bar = (unsigned*)(p_.ws + OFF_BAR); xb.x = xb_xcc_id(); xb.nloc = 0u; xb.nx = 0u;
  if (threadIdx.x == 0) (void)xb_add(&xb.bar[XB_XCNT(xb.x)], 1u);
  if (ph_hi < 0) cg::this_grid().sync();
  for (int ph = ph_lo; ph < ph_hi; ++ph) {
    int tid = threadIdx.x, bid = blockIdx.x, nb = gridDim.x;
    asm volatile("" : "+v"(tid));
    asm volatile("" : "+s"(bid), "+s"(nb));
    if (ph > ph_lo) xcd_barrier(xb, tid, (unsigned)nb);
    const Params& p = p_;
    if (ph == 0) {
      convert_weights(p, lds, bid, nb, tid);
      embed_ln(p, bid, nb, tid);
      rope_table(p, bid, nb, tid);
    } else {
      const int l = (ph - 1) / 8, s = (ph - 1) % 8;
      const bf16_t* Xb = (const bf16_t*)p.O();
      bf16_t* X1b = (bf16_t*)(p.W() + OFF_X1B);
      bf16_t* Hb = (bf16_t*)(p.W() + OFF_H);
      float* X = (float*)(p.W() + OFF_X);
      if (s == 0) gemm_phase<EPI_BF16>(Xb, 1024, (const bf16_t*)(p.W() + OFF_WIN + l * SZ_WIN), 1024, 1024, DINP / 128, p.W() + OFF_P, DINP, lds, bid, nb, tid);
      else if (s == 1) scan_phase(p, l, lds, bid, nb, tid);
      else if (s == 2) norm_phase(p, l, bid, nb, tid);
      else if (s == 3) gemm_phase<EPI_RESID>(Xb, 1024, (const bf16_t*)(p.W() + OFF_WOUT + l * SZ_WOUT), 1024, 1024, 8, X, 1024, lds, bid, nb, tid);
      else if (s == 4) ln_phase(p, p.I(22) + l * 1024, p.I(23) + l * 1024, X1b, 0, bid, nb, tid);
      else if (s == 5) gemm_phase<EPI_SWIGLU>(X1b, 1024, (const bf16_t*)(p.W() + OFF_WGU + l * SZ_WGU), 1024, 1024, 44, Hb, DFF, lds, bid, nb, tid);
      else if (s == 6) gemm_phase<EPI_RESID>(Hb, DFF, (const bf16_t*)(p.W() + OFF_WDN + l * SZ_WDN), DFF, DFF, 8, X, 1024, lds, bid, nb, tid);
      else ln_phase(p, p.I(27) + l * 1024, p.I(28) + l * 1024, (bf16_t*)p.O(), l == 1, bid, nb, tid);
    }
  }
}

extern "C" void kernel_launch(void* const* d_in, const int* in_sizes, int n_in, void* d_out, int out_size, void* d_ws, size_t ws_size,
                              hipStream_t stream) {
  (void)in_sizes; (void)out_size;
  if (n_in < 29 || ws_size < WS_NEED) { fprintf(stderr, "bad args: n_in %d ws %zu need %zu\n", n_in, ws_size, (size_t)WS_NEED); return; }
  Params p{};
  for (int i = 0; i < 29; ++i) p.in[i] = (const float*)d_in[i];
  p.out = (float*)d_out;
  p.ws = (unsigned char*)d_ws;
  static int grid_blocks = 0;
  if (!grid_blocks) {
    int dev = 0, cus = 0, per_cu = 0;
    (void)hipGetDevice(&dev);
    (void)hipDeviceGetAttribute(&cus, hipDeviceAttributeMultiprocessorCount, dev);
    (void)hipOccupancyMaxActiveBlocksPerMultiprocessor(&per_cu, hymba_fwd, 256, 0);
    if (per_cu > 2) per_cu = 2;
    if (per_cu < 1) per_cu = 1;
    grid_blocks = cus * per_cu;
  }
  (void)hipMemsetAsync((unsigned char*)d_ws + OFF_BAR, 0, XCD_BAR_WORDS * 4, stream);
  int lo = 0, hi = NPHASE;
  void* args[] = {&p, &lo, &hi};
  hipError_t e = hipLaunchCooperativeKernel((void*)hymba_fwd, dim3(grid_blocks), dim3(256), args, 0, stream);
  if (e != hipSuccess) fprintf(stderr, "cooperative launch failed: %s (grid %d)\n", hipGetErrorString(e), grid_blocks);
}
```

```cpp
#include <hip/hip_runtime.h>
#include <hip/hip_cooperative_groups.h>
#include <cstdio>
#include <cstdint>
namespace cg = cooperative_groups;

#ifndef COOP
#define COOP 1
#endif

typedef unsigned short bf16_t;
typedef short bf16x8 __attribute__((ext_vector_type(8)));
typedef float f32x4 __attribute__((ext_vector_type(4)));

constexpr int DM = 1024, NB = 8, TPR = 2064, NSB = 128, TS = 4;
constexpr int MP = NB * TPR;
constexpr int MS = NSB * TS;
constexpr int MT = MP + MS;
constexpr int DIN = 3864, DINP = 3968, DFF = 2816;
constexpr float ALPHA = 1.41421356237309515f;

constexpr size_t SZ_WIN = (size_t)DINP * 1024 * 2, SZ_WOUT = (size_t)1024 * 1024 * 2, SZ_WGU = (size_t)5632 * 1024 * 2, SZ_WDN = (size_t)1024 * 2816 * 2;
constexpr size_t OFF_CS = 0;
constexpr size_t OFF_WIN = 532480;
constexpr size_t OFF_WOUT = OFF_WIN + 2 * SZ_WIN;
constexpr size_t OFF_WGU = OFF_WOUT + 2 * SZ_WOUT;
constexpr size_t OFF_WDN = OFF_WGU + 2 * SZ_WGU;
constexpr size_t OFF_X = OFF_WDN + 2 * SZ_WDN;
constexpr size_t OFF_P = OFF_X + (size_t)MT * 1024 * 4;
constexpr size_t OFF_X1B = OFF_P;
constexpr size_t OFF_H = OFF_P + (size_t)MT * 1024 * 2;
constexpr size_t OFF_BAR = OFF_P + (size_t)MT * DINP * 2;
constexpr int CEN_CNT = 3520, CEN_TAB = 4096, CEN_TAB2 = 8192;
constexpr size_t BAR_BYTES = 12288 * 4;
constexpr size_t WS_NEED = OFF_BAR + BAR_BYTES;
constexpr size_t DOUT_PS = 36000000;

constexpr size_t O_YP = 0, O_YS = 16777216, O_CP = 17301504, O_CS = 17338368, O_DP = 17928192, O_DS = 18190336,
                 O_HP = 22384640, O_HS = 22646784, O_GP = 26841088, O_GS = 26972160, O_RP = 29069312, O_RS = 29331456;

#define GAS __attribute__((address_space(1)))
struct Params {
  const float* in[29];
  float* out;
  unsigned char* ws;
  __device__ __forceinline__ const float* I(int i) const { return (const float*)(const GAS float*)in[i]; }
  __device__ __forceinline__ float* O() const { return (float*)(GAS float*)out; }
  __device__ __forceinline__ unsigned char* W() const { return (unsigned char*)(GAS unsigned char*)ws; }
};

__device__ __forceinline__ unsigned f2bf(float f) {
  unsigned u = __float_as_uint(f);
  u += 0x7fffu + ((u >> 16) & 1u);
  return u >> 16;
}
typedef float f32x2_t __attribute__((ext_vector_type(2)));
typedef __bf16 bf16x2_t __attribute__((ext_vector_type(2)));
__device__ __forceinline__ unsigned pk2(float lo, float hi) { const f32x2_t v = {lo, hi}; const bf16x2_t b = __builtin_convertvector(v, bf16x2_t); return __builtin_bit_cast(unsigned, b); }
__device__ __forceinline__ float bflo(unsigned u) { return __uint_as_float(u << 16); }
__device__ __forceinline__ float bfhi(unsigned u) { return __uint_as_float(u & 0xffff0000u); }
__device__ __forceinline__ void unpack8(const uint4& r, float* x) {
  x[0] = bflo(r.x); x[1] = bfhi(r.x); x[2] = bflo(r.y); x[3] = bfhi(r.y);
  x[4] = bflo(r.z); x[5] = bfhi(r.z); x[6] = bflo(r.w); x[7] = bfhi(r.w);
}
__device__ __forceinline__ float sigmoidf_(float x) { return __builtin_amdgcn_rcpf(1.0f + __expf(-x)); }
__device__ __forceinline__ float siluf_(float x) { return x * __builtin_amdgcn_rcpf(1.0f + __expf(-x)); }
__device__ __forceinline__ float softplusf_(float x) { return fmaxf(x, 0.f) + __logf(1.0f + __expf(-fabsf(x))); }
__device__ __forceinline__ float red8(float x) {
  x += __shfl_xor(x, 1); x += __shfl_xor(x, 2); x += __shfl_xor(x, 4); return x;
}
__device__ __forceinline__ float dpp_x1(float x) {
  return __int_as_float(__builtin_amdgcn_update_dpp(0, __float_as_int(x), 0xB1, 0xF, 0xF, true));
}
__device__ __forceinline__ float dpp_x2(float x) {
  return __int_as_float(__builtin_amdgcn_update_dpp(0, __float_as_int(x), 0x4E, 0xF, 0xF, true));
}
__device__ __forceinline__ float red4(float x) { x += dpp_x1(x); x += dpp_x2(x); return x; }
__device__ __forceinline__ float wave_sum(float x) {
#pragma unroll
  for (int o = 32; o >= 1; o >>= 1) x += __shfl_xor(x, o);
  return x;
}

__device__ __forceinline__ void convert_weights(const Params& p, char* lds, int w0, int w1, int wstep, const int tid) {
  float* tile = (float*)lds;
  for (int w = w0; w < w1; w += wstep) {
    const int l = w / 3360; int r = w % 3360;
    int mat, kt, rt;
    if (r < 992) { mat = 0; kt = r / 62; rt = r % 62; }
    else if (r < 1248) { r -= 992; mat = 1; kt = r / 16; rt = r % 16; }
    else if (r < 2656) { r -= 1248; mat = 2; kt = r / 88; rt = r % 88; }
    else { r -= 2656; mat = 3; kt = r / 16; rt = r % 16; }
    {
      const int r4 = (tid & 15) * 4, R = rt * 64 + r4, kq = tid >> 4;
      const float* src; int ns; bool valid = true;
      if (mat == 0) { src = p.I(10) + (size_t)l * 1024 * DIN + R; ns = DIN; valid = R < DIN; }
      else if (mat == 1) { src = p.I(21) + (size_t)l * 1024 * 1024 + R; ns = 1024; }
      else if (mat == 2) { const int blk = R >> 5, ty = (R >> 4) & 1, hid = blk * 16 + (R & 15);
        src = (ty ? p.I(25) : p.I(24)) + (size_t)l * 1024 * DFF + hid; ns = DFF; }
      else { src = p.I(26) + (size_t)l * DFF * 1024 + R; ns = 1024; }
      f32x4 v[4];
#pragma unroll
      for (int i = 0; i < 4; ++i) v[i] = valid ? *(const f32x4*)(src + (size_t)(kt * 64 + kq + 16 * i) * ns) : (f32x4){0.f, 0.f, 0.f, 0.f};
#pragma unroll
      for (int i = 0; i < 4; ++i) {
        const int k = kq + 16 * i;
        tile[(r4 + 0) * 65 + k] = v[i][0]; tile[(r4 + 1) * 65 + k] = v[i][1]; tile[(r4 + 2) * 65 + k] = v[i][2]; tile[(r4 + 3) * 65 + k] = v[i][3];
      }
    }
    __syncthreads();
    {
      const int rr = tid >> 2, kc = (tid & 3) * 16;
      const int Kd = (mat == 3) ? DFF : 1024;
      bf16_t* base;
      if (mat == 0) base = (bf16_t*)(p.W() + OFF_WIN + l * SZ_WIN);
      else if (mat == 1) base = (bf16_t*)(p.W() + OFF_WOUT + l * SZ_WOUT);
      else if (mat == 2) base = (bf16_t*)(p.W() + OFF_WGU + l * SZ_WGU);
      else base = (bf16_t*)(p.W() + OFF_WDN + l * SZ_WDN);
      bf16_t* dst = base + (size_t)(rt * 64 + rr) * Kd + kt * 64 + kc;
      const float* s = tile + rr * 65 + kc;
      uint4 a, b;
      a.x = pk2(s[0], s[1]); a.y = pk2(s[2], s[3]); a.z = pk2(s[4], s[5]); a.w = pk2(s[6], s[7]);
      b.x = pk2(s[8], s[9]); b.y = pk2(s[10], s[11]); b.z = pk2(s[12], s[13]); b.w = pk2(s[14], s[15]);
      *(uint4*)dst = a; *(uint4*)(dst + 8) = b;
    }
    __syncthreads();
  }
}

__device__ __forceinline__ void ln_row_regs(f32x4 (&v)[4], const float* g, const float* bb, int lane) {
  float s = 0.f;
#pragma unroll
  for (int i = 0; i < 4; ++i) s += (v[i][0] + v[i][1]) + (v[i][2] + v[i][3]);
  const float mu = wave_sum(s) * (1.0f / 1024.0f);
  float q = 0.f;
#pragma unroll
  for (int i = 0; i < 4; ++i) { const f32x4 d = v[i] - mu; q += (d[0] * d[0] + d[1] * d[1]) + (d[2] * d[2] + d[3] * d[3]); }
  const float rs = rsqrtf(wave_sum(q) * (1.0f / 1024.0f) + 1e-5f);
#pragma unroll
  for (int i = 0; i < 4; ++i) {
    const f32x4 gg = *(const f32x4*)(g + lane * 4 + i * 256), b4 = *(const f32x4*)(bb + lane * 4 + i * 256);
    v[i] = (v[i] - mu) * rs * gg + b4;
  }
}

__device__ __forceinline__ void embed_ln(const Params& p, int bid, int nb, const int tid) {
  const int lane = tid & 63, wv = tid >> 6;
  float* X = (float*)(p.W() + OFF_X);
  bf16_t* Xb = (bf16_t*)p.O();
  for (int row = bid * 4 + wv; row < MT; row += nb * 4) {
    const float* src;
    if (row < MP) { const int b = row / TPR, t = row % TPR;
      src = (t < 16) ? p.I(7) + (size_t)t * 1024 : p.I(0) + ((size_t)b * 2048 + (t - 16)) * 1024; }
    else src = p.I(1) + (size_t)(row - MP) * 1024;
    f32x4 v[4];
#pragma unroll
    for (int i = 0; i < 4; ++i) v[i] = *(const f32x4*)(src + lane * 4 + i * 256);
    ln_row_regs(v, p.I(8), p.I(9), lane);
#pragma unroll
    for (int i = 0; i < 4; ++i) {
      *(f32x4*)(X + (size_t)row * 1024 + lane * 4 + i * 256) = v[i];
      uint2 o; o.x = pk2(v[i][0], v[i][1]); o.y = pk2(v[i][2], v[i][3]);
      *(uint2*)(Xb + (size_t)row * 1024 + lane * 4 + i * 256) = o;
    }
  }
}

__device__ __forceinline__ void rope_table(const Params& p, int bid, int nb, const int tid) {
  float2* cs = (float2*)(p.W() + OFF_CS);
  for (int e = bid * 256 + tid; e < 2068 * 32; e += nb * 256) {
    const int idx = e >> 5, i = e & 31;
    const double pos = (idx < 2064) ? (double)idx : (double)(16384 + idx - 2064);
    const double inv = exp(-((double)i / 31.0) * 9.210340371976184);
    const double ang = pos * inv;
    cs[e] = make_float2((float)cos(ang), (float)sin(ang));
  }
}

__device__ __forceinline__ void ln_phase(const Params& p, const float* g, const float* bb, bf16_t* xb, int final_, int bid, int nb, const int tid) {
  const int lane = tid & 63, wv = tid >> 6;
  float* X = (float*)(p.W() + OFF_X);
  for (int row = bid * 4 + wv; row < MT; row += nb * 4) {
    f32x4 v[4];
#pragma unroll
    for (int i = 0; i < 4; ++i) v[i] = *(const f32x4*)(X + (size_t)row * 1024 + lane * 4 + i * 256);
    ln_row_regs(v, g, bb, lane);
    if (!final_) {
#pragma unroll
      for (int i = 0; i < 4; ++i) {
        *(f32x4*)(X + (size_t)row * 1024 + lane * 4 + i * 256) = v[i];
        uint2 o; o.x = pk2(v[i][0], v[i][1]); o.y = pk2(v[i][2], v[i][3]);
        *(uint2*)(xb + (size_t)row * 1024 + lane * 4 + i * 256) = o;
      }
    } else {
      float* dst = nullptr;
      if (row < MP) { const int b = row / TPR, t = row % TPR; if (t >= 16) dst = p.O() + O_YP + ((size_t)b * 2048 + (t - 16)) * 1024; }
      else dst = p.O() + O_YS + (size_t)(row - MP) * 1024;
      if (dst) {
#pragma unroll
        for (int i = 0; i < 4; ++i) *(f32x4*)(dst + lane * 4 + i * 256) = v[i];
      }
    }
  }
}

enum { EPI_BF16 = 0, EPI_RESID = 1, EPI_SWIGLU = 2 };

template <int EPI>
__device__ __forceinline__ void gemm_tile(const bf16_t* __restrict__ A, const int lda, const bf16_t* __restrict__ Bt, const int ldb,
                                          const int K, const int m0, const int n0, void* Cout, const int ldc, char* lds, const int tid) {
  const int wid = tid >> 6, lane = tid & 63, wr = wid >> 1, wc = wid & 1, fr = lane & 15, fq = lane >> 4;
  f32x4 acc[4][4];
#pragma unroll
  for (int m = 0; m < 4; ++m)
#pragma unroll
    for (int n = 0; n < 4; ++n) acc[m][n] = (f32x4){0.f, 0.f, 0.f, 0.f};
  const int nt = K >> 6;
  auto stage = [&](int kt, int buf) {
#pragma unroll
    for (int i = 0; i < 4; ++i) {
      const int off = tid * 16 + i * 4096;
      const int panel = off >> 13, rem = off & 8191, r = rem >> 6, c = (rem & 63) >> 1;
      const bf16_t* ga = A + (size_t)(m0 + r) * lda + kt * 64 + panel * 32 + c;
      const bf16_t* gb = Bt + (size_t)(n0 + r) * ldb + kt * 64 + panel * 32 + c;
      __builtin_amdgcn_global_load_lds((const unsigned*)ga, (__attribute__((address_space(3))) unsigned*)(lds + buf * 32768 + off), 16, 0, 0);
      __builtin_amdgcn_global_load_lds((const unsigned*)gb, (__attribute__((address_space(3))) unsigned*)(lds + buf * 32768 + 16384 + off), 16, 0, 0);
    }
  };
  stage(0, 0);
  for (int kt = 0; kt < nt; ++kt) {
    asm volatile("s_waitcnt vmcnt(0)" ::: "memory");
    __syncthreads();
    if (kt + 1 < nt) stage(kt + 1, (kt + 1) & 1);
    const char* sa = lds + (kt & 1) * 32768;
    const char* sb = sa + 16384;
#pragma unroll
    for (int ks = 0; ks < 2; ++ks) {
      bf16x8 af[4], bfr[4];
#pragma unroll
      for (int m = 0; m < 4; ++m) af[m] = *(const bf16x8*)(sa + ks * 8192 + (wr * 64 + m * 16 + fr) * 64 + fq * 16);
#pragma unroll
      for (int n = 0; n < 4; ++n) bfr[n] = *(const bf16x8*)(sb + ks * 8192 + (wc * 64 + n * 16 + fr) * 64 + fq * 16);
#pragma unroll
      for (int m = 0; m < 4; ++m)
#pragma unroll
        for (int n = 0; n < 4; ++n) acc[m][n] = __builtin_amdgcn_mfma_f32_16x16x32_bf16(bfr[n], af[m], acc[m][n], 0, 0, 0);
    }
  }
#pragma unroll
  for (int m = 0; m < 4; ++m) {
    const int row = m0 + wr * 64 + m * 16 + fr;
    if (EPI == EPI_BF16) {
      bf16_t* C = (bf16_t*)Cout + (size_t)row * ldc + n0 + wc * 64 + fq * 4;
#pragma unroll
      for (int n = 0; n < 4; ++n) { uint2 o; o.x = pk2(acc[m][n][0], acc[m][n][1]); o.y = pk2(acc[m][n][2], acc[m][n][3]); *(uint2*)(C + n * 16) = o; }
    } else if (EPI == EPI_RESID) {
      float* C = (float*)Cout + (size_t)row * ldc + n0 + wc * 64 + fq * 4;
#pragma unroll
      for (int n = 0; n < 4; ++n) { const f32x4 x = *(const f32x4*)(C + n * 16); *(f32x4*)(C + n * 16) = x * ALPHA + acc[m][n]; }
    } else {
      bf16_t* C = (bf16_t*)Cout + (size_t)row * ldc + (n0 >> 1) + wc * 32 + fq * 4;
#pragma unroll
      for (int np = 0; np < 2; ++np) {
        const f32x4 g = acc[m][2 * np], u = acc[m][2 * np + 1];
        uint2 o; o.x = pk2(siluf_(g[0]) * u[0], siluf_(g[1]) * u[1]); o.y = pk2(siluf_(g[2]) * u[2], siluf_(g[3]) * u[3]);
        *(uint2*)(C + np * 16) = o;
      }
    }
  }
}

template <int EPI>
__device__ __forceinline__ void gemm_phase(const bf16_t* A, int lda, const bf16_t* Bt, int ldb, int K, int ntn, void* C, int ldc, char* lds, int bid, int nb, const int tid) {
  constexpr int GM = 8, nM = MT / 128;
  const int ntiles = nM * ntn, nig = GM * ntn;
  const int pos = ((nb & 7) == 0) ? (bid & 7) * (nb >> 3) + (bid >> 3) : bid;
  for (int L = pos; L < ntiles; L += nb) {
    const int gid = L / nig, fm = gid * GM, gsz = min(nM - fm, GM), rem = L - gid * nig;
    const int mt = fm + rem % gsz, nn = rem / gsz;
    gemm_tile<EPI>(A, lda, Bt, ldb, K, mt * 128, nn * 128, C, ldc, lds, tid);
  }
}

#define XB_TMO      128
#define XB_XCNT(j)  (256  + 64 * (j))
#define XB_XSUB(j)  (1280 + 64 * (j))
#define XB_XGEN(j)  (2304 + 64 * (j))
#define XB_TOP      3328
#define XB_TOPGEN   3392
#define XCD_BAR_WORDS 3456
#define XB_SPIN_CAP (1u << 22)
__device__ __forceinline__ unsigned xb_ld(unsigned* p) { return __hip_atomic_load(p, __ATOMIC_RELAXED, __HIP_MEMORY_SCOPE_AGENT); }
__device__ __forceinline__ unsigned xb_add(unsigned* p, unsigned v) { return __hip_atomic_fetch_add(p, v, __ATOMIC_RELAXED, __HIP_MEMORY_SCOPE_AGENT); }
__device__ __forceinline__ unsigned xb_xcc_id() { return (unsigned)__builtin_amdgcn_s_getreg((3 << 11) | 20) & 0xFu; }
#define XB_SPIN(cond, bar) do { unsigned _sp = 0; while (cond) { __builtin_amdgcn_s_sleep(1); \
    if ((++_sp & 255u) == 0u) { if (xb_ld(&(bar)[XB_TMO])) break; if (_sp > XB_SPIN_CAP) { atomicAdd(&(bar)[XB_TMO], 1u); break; } } } } while (0)
struct XcdBarrier { unsigned* bar; unsigned x; unsigned nloc, nx; };
__device__ __forceinline__ void xcd_barrier_complete(unsigned* bar, unsigned x, unsigned G, unsigned& nloc, unsigned& nx) {
  unsigned sum, cnt, mine, sp = 0u;
  for (;;) {
    sum = 0u; cnt = 0u; mine = 0u;
#pragma unroll
    for (unsigned j = 0; j < 16; ++j) { const unsigned c = xb_ld(&bar[XB_XCNT(j)]); sum += c; cnt += (c > 0u) ? 1u : 0u; mine = (j == x) ? c : mine; }
    if (sum == G) break;
    __builtin_amdgcn_s_sleep(1);
    if ((++sp & 255u) == 0u) { if (xb_ld(&bar[XB_TMO])) break; if (sp > XB_SPIN_CAP) { atomicAdd(&bar[XB_TMO], 1u); break; } }
  }
  nloc = mine > 0u ? mine : 1u; nx = cnt > 0u ? cnt : 1u;
}
__device__ __forceinline__ void xcd_barrier(XcdBarrier& b, const int tid, const unsigned G) {
  asm volatile("s_waitcnt vmcnt(0)" ::: "memory");
  __syncthreads();
  if (tid == 0) {
    unsigned* bar = b.bar;
    __builtin_amdgcn_s_waitcnt(0);
    if (b.nloc == 0u) xcd_barrier_complete(bar, b.x, G, b.nloc, b.nx);
    const unsigned nloc = b.nloc, nx = b.nx;
    const unsigned old = xb_add(&bar[XB_XSUB(b.x)], 1u);
    const unsigned gen = old / nloc;
    if (old + 1u == (gen + 1u) * nloc) {
      __builtin_amdgcn_fence(__ATOMIC_RELEASE, "agent");
      asm volatile("s_waitcnt vmcnt(0)" ::: "memory");
      const unsigned og = xb_add(&bar[XB_TOP], 1u);
      const unsigned tg = og / nx;
      if (og + 1u == (tg + 1u) * nx) xb_add(&bar[XB_TOPGEN], 1u);
      else XB_SPIN(xb_ld(&bar[XB_TOPGEN]) == tg, bar);
      __builtin_amdgcn_fence(__ATOMIC_ACQUIRE, "agent");
      xb_add(&bar[XB_XGEN(b.x)], 1u);
      asm volatile("s_waitcnt vmcnt(0)" ::: "memory");
    } else {
      XB_SPIN(xb_ld(&bar[XB_XGEN(b.x)]) == gen, bar);
      __builtin_amdgcn_fence(__ATOMIC_ACQUIRE, "agent");
      asm volatile("s_waitcnt vmcnt(0)" ::: "memory");
    }
  }
  __syncthreads();
}

template <int N, int RS>
__device__ __forceinline__ void convN(const bf16_t* rawb, const float* cwl, int tt, int off, float (&x)[N]) {
#pragma unroll
  for (int i = 0; i < N; ++i) x[i] = 0.f;
#pragma unroll
  for (int j = 0; j < 4; ++j) {
    float xv[N];
    if (N == 8) { const uint4 rv = *(const uint4*)(rawb + (tt + j) * RS + off); unpack8(rv, xv); }
    else if (N == 4) { const uint2 rv = *(const uint2*)(rawb + (tt + j) * RS + off); xv[0] = bflo(rv.x); xv[1] = bfhi(rv.x); xv[2 % N] = bflo(rv.y); xv[3 % N] = bfhi(rv.y); }
    else { const unsigned rv = *(const unsigned*)(rawb + (tt + j) * RS + off); xv[0] = bflo(rv); xv[1] = bfhi(rv); }
#pragma unroll
    for (int i = 0; i < N; ++i) x[i] += cwl[j * RS + off + i] * xv[i];
  }
#pragma unroll
  for (int i = 0; i < N; ++i) asm volatile("" : "+v"(x[i]));
#pragma unroll
  for (int i = 0; i < N; ++i) x[i] = siluf_(x[i]);
}

template <int MIX, int VN>
__device__ __forceinline__ void load_chunk_fn(const unsigned char* ws, const bf16_t* Pb, const int t, const int T, const int h, const int vcol, const int sub, const int posb,
                                              uint4& R0, uint4& R1, uint2& R2, uint4& R4, uint4& R5, unsigned& ex0, unsigned& ex1) {
  if (t < T) {
    const bf16_t* pr = Pb + (size_t)t * DINP;
    const int vbase = (MIX == 0) ? 512 : (MIX == 1) ? 1544 : (MIX == 2) ? 2312 : 3352;
    if (VN == 4) R2 = *(const uint2*)(pr + vbase + h * 64 + vcol);
    else R2.x = *(const unsigned*)(pr + vbase + h * 64 + vcol);
    if (MIX == 0) {
      R0 = *(const uint4*)(pr + 0 + h * 64 + sub * 8); R1 = *(const uint4*)(pr + 256 + h * 64 + sub * 8);
      ex0 = pr[768 + h]; ex1 = pr[772 + h];
    } else if (MIX == 1) {
      R0 = *(const uint4*)(pr + 1032 + h * 64 + sub * 8); R1 = *(const uint4*)(pr + 1288 + h * 64 + sub * 8);
    } else if (MIX == 2) {
      const uint2 q2 = *(const uint2*)(pr + 2056 + h * 32 + sub * 4), k2 = *(const uint2*)(pr + 2184 + h * 32 + sub * 4);
      R0 = make_uint4(q2.x, q2.y, k2.x, k2.y);
      R1 = *(const uint4*)(pr + 2568); R4 = *(const uint4*)(pr + 2576);
    } else {
      const uint2 ql = *(const uint2*)(pr + 2840 + h * 64 + sub * 4), qh = *(const uint2*)(pr + 2840 + h * 64 + 32 + sub * 4);
      const uint2 kl = *(const uint2*)(pr + 3096 + h * 64 + sub * 4), kh = *(const uint2*)(pr + 3096 + h * 64 + 32 + sub * 4);
      R0 = make_uint4(ql.x, ql.y, qh.x, qh.y); R1 = make_uint4(kl.x, kl.y, kh.x, kh.y);
      const uint4* cs = (const uint4*)(ws + OFF_CS + ((size_t)(posb + t) * 32 + sub * 4) * 8);
      R4 = cs[0]; R5 = cs[1];
    }
  }
}

__device__ __forceinline__ float dpp_hm(float x) {
  return __int_as_float(__builtin_amdgcn_update_dpp(0, __float_as_int(x), 0x141, 0xF, 0xF, true));
}
__device__ __forceinline__ float dpp_rm(float x) {
  return __int_as_float(__builtin_amdgcn_update_dpp(0, __float_as_int(x), 0x140, 0xF, 0xF, true));
}
__device__ __forceinline__ float red8d(float x) { x += dpp_x1(x); x += dpp_x2(x); x += dpp_hm(x); return x; }
template <int KG> __device__ __forceinline__ float redKG(float x) { x = red8d(x); if (KG == 16) x += dpp_rm(x); return x; }

template <int MIX, int KPL>
struct StepIn { float q[KPL], k[KPL], d[KPL]; float v, a, be, qk; };

template <int MIX, int KPL>
__device__ __forceinline__ void load_step(const float* qkdv, const float* scal, int t, int kg, int col, StepIn<MIX, KPL>& s) {
  const float* base = qkdv + t * 256;
#pragma unroll
  for (int i = 0; i < KPL; i += 4) {
    const f32x4 a = *(const f32x4*)(base + kg * KPL + i), b = *(const f32x4*)(base + 64 + kg * KPL + i);
    s.q[i] = a[0]; s.q[i + 1] = a[1]; s.q[i + 2] = a[2]; s.q[i + 3] = a[3];
    s.k[i] = b[0]; s.k[i + 1] = b[1]; s.k[i + 2] = b[2]; s.k[i + 3] = b[3];
    if (MIX == 1 || MIX == 2) { const f32x4 d = *(const f32x4*)(base + 128 + kg * KPL + i); s.d[i] = d[0]; s.d[i + 1] = d[1]; s.d[i + 2] = d[2]; s.d[i + 3] = d[3]; }
  }
  s.v = base[192 + col];
  if (MIX == 0) { const f32x4 c = *(const f32x4*)(scal + t * 4); s.a = c[0]; s.be = c[1]; s.qk = c[2]; }
}

template <int MIX, int KPL, int KG>
__device__ __forceinline__ float do_step(const StepIn<MIX, KPL>& s, float (&S)[KPL], const float gam) {
  if (MIX == 0) {
    float kS0 = 0.f, kS1 = 0.f, qS0 = 0.f, qS1 = 0.f;
#pragma unroll
    for (int i = 0; i < KPL; i += 2) { kS0 += s.k[i] * S[i]; kS1 += s.k[i + 1] * S[i + 1]; qS0 += s.q[i] * S[i]; qS1 += s.q[i + 1] * S[i + 1]; }
    const float kS = redKG<KG>(kS0 + kS1), qS = redKG<KG>(qS0 + qS1);
    const float w = s.be * (s.v - s.a * kS);
#pragma unroll
    for (int i = 0; i < KPL; ++i) S[i] = s.a * S[i] + s.k[i] * w;
    return s.a * qS + s.qk * w;
  } else {
    float o0 = 0.f, o1 = 0.f;
#pragma unroll
    for (int i = 0; i < KPL; i += 2) {
      const float d0 = (MIX == 3) ? gam : s.d[i], d1 = (MIX == 3) ? gam : s.d[i + 1];
      S[i] = d0 * S[i] + s.k[i] * s.v; S[i + 1] = d1 * S[i + 1] + s.k[i + 1] * s.v;
      o0 += s.q[i] * S[i]; o1 += s.q[i + 1] * S[i + 1];
    }
    return redKG<KG>(o0 + o1);
  }
}

template <int MIX>
__device__ __forceinline__ void scan_part(const Params& p, const int layer, const int smp, const int b0, const int bstep, const int bend, const int h, const int part, char* lds, const int tid) {
  constexpr int DK = (MIX == 2) ? 32 : 64;
  constexpr int NS = (MIX == 0) ? 4 : 2;
  constexpr int CW = 64 / NS;
  constexpr int CPW = CW / 4;
  constexpr int KG = 64 / CPW;
  constexpr int KPL = DK / KG;
  constexpr int VN = CW / 8;
  constexpr int RS = 128 + CW;
  float* qkdv = (float*)lds;
  float* obuf = (float*)(lds + 32768);
  float* scal = (float*)(lds + 36864);
  bf16_t* rawb = (bf16_t*)(lds + 37376);
  float* cwl = (float*)(lds + 48576);
  float* wgl = (float*)(lds + 37376);

  const int lane = tid & 63, wv = tid >> 6;
  const int tt = tid >> 3, sub = tid & 7;
  const int col = wv * CPW + lane / KG, kg = lane % KG;
  const int T = smp ? 4 : TPR;
  const int nBatch = smp ? NSB : NB;
  const int posb = smp ? 2064 : 0;
  const int vcol = part * CW + sub * VN;
  __syncthreads();
  float c8[8];
  float Aexp = 0.f, dtb = 0.f, gam = 0.f;
  if (MIX == 0) {
    Aexp = __expf(p.I(12)[layer * 4 + h]); dtb = p.I(13)[layer * 4 + h];
    for (int e = tid; e < 4 * RS; e += 256) { const int j = e / RS, r = e % RS;
      const int cc = (r < 64) ? (h * 64 + r) : (r < 128) ? (256 + h * 64 + r - 64) : (512 + h * 64 + part * CW + r - 128);
      cwl[e] = p.I(11)[(size_t)(layer * 4 + j) * 768 + cc]; }
  } else if (MIX == 1) {
#pragma unroll
    for (int i = 0; i < 8; ++i) {
      const int d = h * 64 + sub * 8 + i;
      c8[i] = (layer == 0) ? 1.0f : sigmoidf_(p.I(15)[d] - p.I(15)[256 + d]);
    }
  } else if (MIX == 2) {
    for (int e = tid; e < 512; e += 256) { const int r = e >> 5, j = e & 31; wgl[e] = p.I(17)[(size_t)(layer * 16 + r) * 128 + h * 32 + j]; }
#pragma unroll
    for (int i = 0; i < 4; ++i) c8[i] = p.I(18)[layer * 128 + h * 32 + sub * 4 + i];
  } else {
    gam = 1.0f - exp2f(-5.0f - (float)h);
  }
  for (int b = b0; b < bend; b += bstep) {
  const int row0 = smp ? MP + b * 4 : b * TPR;
  const bf16_t* Pb = (const bf16_t*)(p.W() + OFF_P) + (size_t)row0 * DINP;
  bf16_t* Ob = (bf16_t*)p.O() + (size_t)row0 * 1024 + MIX * 256 + h * 64 + part * CW;
  float* PS = (float*)((unsigned char*)p.O() + DOUT_PS) + (size_t)row0 * 128 + (MIX * 4 + h) * 8 + part * 2;
  uint4 R0 = make_uint4(0, 0, 0, 0), R1 = R0, R4 = R0, R5 = R0; uint2 R2 = make_uint2(0, 0); unsigned ex0 = 0, ex1 = 0;
  load_chunk_fn<MIX, VN>(p.W(), Pb, tt, T, h, vcol, sub, posb, R0, R1, R2, R4, R5, ex0, ex1);
  float S[KPL];
  if (smp) {
    const float* sin_ = p.I(3 + MIX) + ((size_t)(layer * NSB + b) * 4 + h) * DK * 64 + part * CW;
#pragma unroll
    for (int i = 0; i < KPL; ++i) S[i] = sin_[(kg * KPL + i) * 64 + col];
  } else {
#pragma unroll
    for (int i = 0; i < KPL; ++i) S[i] = 0.f;
  }
  if (MIX == 0) {
    for (int e = tid; e < 3 * RS; e += 256) { const int j = e / RS, r = e % RS;
      const int cc = (r < 64) ? (h * 64 + r) : (r < 128) ? (256 + h * 64 + r - 64) : (512 + h * 64 + part * CW + r - 128);
      float v = 0.f; if (smp) v = p.I(2)[((size_t)(layer * NSB + b) * 3 + j) * 768 + cc];
      rawb[e] = (bf16_t)f2bf(v); }
  }
  __syncthreads();

  int ntok_last = 0;
  for (int t0 = 0; t0 < T; t0 += 32) {
    const int ntok = min(32, T - t0);
    ntok_last = ntok;
    const bool valid = tt < ntok;
    float* dst = qkdv + tt * 256;
    if (MIX != 0 && valid) {
      if (VN == 4) *(f32x4*)(dst + 192 + sub * 4) = (f32x4){bflo(R2.x), bfhi(R2.x), bflo(R2.y), bfhi(R2.y)};
      else *(float2*)(dst + 192 + sub * 2) = make_float2(bflo(R2.x), bfhi(R2.x));
    }
    if (MIX == 0) {
      if (valid) {
        *(uint4*)(rawb + (3 + tt) * RS + 0 + sub * 8) = R0;
        *(uint4*)(rawb + (3 + tt) * RS + 64 + sub * 8) = R1;
        if (VN == 4) *(uint2*)(rawb + (3 + tt) * RS + 128 + sub * 4) = R2;
        else *(unsigned*)(rawb + (3 + tt) * RS + 128 + sub * 2) = R2.x;
      }
      __syncthreads();
      if (valid) {
        float xq[8], xk[8], xv[VN];
        convN<8, RS>(rawb, cwl, tt, sub * 8, xq);
        convN<8, RS>(rawb, cwl, tt, 64 + sub * 8, xk);
        convN<VN, RS>(rawb, cwl, tt, 128 + sub * VN, xv);
#pragma unroll
        for (int i = 0; i < VN; ++i) dst[192 + sub * VN + i] = xv[i];
        float ssq = 0.f, ssk = 0.f;
#pragma unroll
        for (int i = 0; i < 8; ++i) { ssq += xq[i] * xq[i]; ssk += xk[i] * xk[i]; }
        ssq = red8d(ssq); ssk = red8d(ssk);
        const float rq = rsqrtf(ssq + 1e-6f) * 0.125f, rk = rsqrtf(ssk + 1e-6f);
        float qk = 0.f;
#pragma unroll
        for (int i = 0; i < 8; ++i) { xq[i] *= rq; xk[i] *= rk; qk += xq[i] * xk[i]; }
        qk = red8d(qk);
        *(f32x4*)(dst + sub * 8) = (f32x4){xq[0], xq[1], xq[2], xq[3]}; *(f32x4*)(dst + sub * 8 + 4) = (f32x4){xq[4], xq[5], xq[6], xq[7]};
        *(f32x4*)(dst + 64 + sub * 8) = (f32x4){xk[0], xk[1], xk[2], xk[3]}; *(f32x4*)(dst + 64 + sub * 8 + 4) = (f32x4){xk[4], xk[5], xk[6], xk[7]};
        if (sub == 0) {
          const float be = sigmoidf_(bflo(ex0)), al = bflo(ex1);
          const float a = __expf(-Aexp * softplusf_(al + dtb));
          *(f32x4*)(scal + tt * 4) = (f32x4){a, be, qk, 0.f};
        }
      }
    } else if (MIX == 1) {
      if (valid) {
        float q[8], z[8]; unpack8(R0, q); unpack8(R1, z);
        float kk[8], dd[8];
#pragma unroll
        for (int i = 0; i < 8; ++i) { q[i] = siluf_(q[i]); kk[i] = c8[i] * sigmoidf_(-z[i]); dd[i] = 1.0f - fminf(kk[i], 1.0f - 1e-6f); }
        *(f32x4*)(dst + sub * 8) = (f32x4){q[0], q[1], q[2], q[3]}; *(f32x4*)(dst + sub * 8 + 4) = (f32x4){q[4], q[5], q[6], q[7]};
        *(f32x4*)(dst + 64 + sub * 8) = (f32x4){kk[0], kk[1], kk[2], kk[3]}; *(f32x4*)(dst + 64 + sub * 8 + 4) = (f32x4){kk[4], kk[5], kk[6], kk[7]};
        *(f32x4*)(dst + 128 + sub * 8) = (f32x4){dd[0], dd[1], dd[2], dd[3]}; *(f32x4*)(dst + 128 + sub * 8 + 4) = (f32x4){dd[4], dd[5], dd[6], dd[7]};
      }
    } else if (MIX == 2) {
      if (valid) {
        float lr[16]; unpack8(R1, lr); unpack8(R4, lr + 8);
        const float q0 = bflo(R0.x), q1 = bfhi(R0.x), q2 = bflo(R0.y), q3 = bfhi(R0.y);
        const float k0 = bflo(R0.z), k1 = bfhi(R0.z), k2 = bflo(R0.w), k3 = bfhi(R0.w);
        const float sc = 0.17677669529663687f;
        f32x4 xg = (f32x4){c8[0], c8[1], c8[2], c8[3]};
#pragma unroll
        for (int r = 0; r < 16; ++r) xg += lr[r] * *(const f32x4*)(wgl + r * 32 + sub * 4);
        f32x4 dd;
#pragma unroll
        for (int i = 0; i < 4; ++i) { const float ls = fminf(xg[i], 0.f) - __logf(1.0f + __expf(-fabsf(xg[i]))); dd[i] = __expf(ls * 0.0625f); }
        *(f32x4*)(dst + sub * 4) = (f32x4){q0 * sc, q1 * sc, q2 * sc, q3 * sc};
        *(f32x4*)(dst + 64 + sub * 4) = (f32x4){k0, k1, k2, k3};
        *(f32x4*)(dst + 128 + sub * 4) = dd;
      }
    } else {
      if (valid) {
        const float ql[4] = {bflo(R0.x), bfhi(R0.x), bflo(R0.y), bfhi(R0.y)}, qh[4] = {bflo(R0.z), bfhi(R0.z), bflo(R0.w), bfhi(R0.w)};
        const float kl[4] = {bflo(R1.x), bfhi(R1.x), bflo(R1.y), bfhi(R1.y)}, kh[4] = {bflo(R1.z), bfhi(R1.z), bflo(R1.w), bfhi(R1.w)};
        const float cc[4] = {__uint_as_float(R4.x), __uint_as_float(R4.z), __uint_as_float(R5.x), __uint_as_float(R5.z)};
        const float sn[4] = {__uint_as_float(R4.y), __uint_as_float(R4.w), __uint_as_float(R5.y), __uint_as_float(R5.w)};
        f32x4 qa, qb, ka, kb;
#pragma unroll
        for (int i = 0; i < 4; ++i) {
          qa[i] = ql[i] * cc[i] - qh[i] * sn[i]; qb[i] = ql[i] * sn[i] + qh[i] * cc[i];
          ka[i] = (kl[i] * cc[i] - kh[i] * sn[i]) * 0.125f; kb[i] = (kl[i] * sn[i] + kh[i] * cc[i]) * 0.125f;
        }
        *(f32x4*)(dst + sub * 4) = qa; *(f32x4*)(dst + 32 + sub * 4) = qb;
        *(f32x4*)(dst + 64 + sub * 4) = ka; *(f32x4*)(dst + 96 + sub * 4) = kb;
      }
    }
    __syncthreads();
    if (MIX == 0 && t0 + 32 < T) {
      if (tid < 3 * RS / 8) { const uint4 v = *(const uint4*)(rawb + 32 * RS + tid * 8); *(uint4*)(rawb + tid * 8) = v; }
    }
    if (t0 + 32 < T) load_chunk_fn<MIX, VN>(p.W(), Pb, t0 + 32 + tt, T, h, vcol, sub, posb, R0, R1, R2, R4, R5, ex0, ex1);
    {
      StepIn<MIX, KPL> sa, sb;
      float osave = 0.f;
      load_step<MIX, KPL>(qkdv, scal, 0, kg, col, sa);
      for (int t = 0; t < ntok; t += 2) {
        load_step<MIX, KPL>(qkdv, scal, t + 1, kg, col, sb);
        __builtin_amdgcn_sched_barrier(0);
        const float oa = do_step<MIX, KPL, KG>(sa, S, gam);
        osave = (kg == (t & (KG - 1))) ? oa : osave;
        load_step<MIX, KPL>(qkdv, scal, min(t + 2, ntok - 1), kg, col, sa);
        __builtin_amdgcn_sched_barrier(0);
        const float ob = do_step<MIX, KPL, KG>(sb, S, gam);
        osave = (kg == ((t + 1) & (KG - 1))) ? ob : osave;
        if (((t + 2) & (KG - 1)) == 0) obuf[(t + 2 - KG + kg) * CW + col] = osave;
      }
      const int remn = ntok & (KG - 1);
      if (remn != 0 && kg < remn) obuf[(ntok - remn + kg) * CW + col] = osave;
    }
    __syncthreads();
    if (valid) {
      float o[VN];
#pragma unroll
      for (int i = 0; i < VN; ++i) o[i] = obuf[tt * CW + sub * VN + i];
      float s1 = 0.f, s2 = 0.f;
#pragma unroll
      for (int i = 0; i < VN; ++i) { s1 += o[i]; s2 += o[i] * o[i]; }
      s1 = red8d(s1); s2 = red8d(s2);
      if (VN == 4) { uint2 o2; o2.x = pk2(o[0], o[1]); o2.y = pk2(o[2 % VN], o[3 % VN]); *(uint2*)(Ob + (size_t)(t0 + tt) * 1024 + sub * 4) = o2; }
      else *(unsigned*)(Ob + (size_t)(t0 + tt) * 1024 + sub * 2) = pk2(o[0], o[1]);
      if (sub == 0) *(float2*)(PS + (size_t)(t0 + tt) * 128) = make_float2(s1, s2);
    }
  }
  {
    const size_t obase = (MIX == 0) ? (smp ? O_DS : O_DP) : (MIX == 1) ? (smp ? O_HS : O_HP) : (MIX == 2) ? (smp ? O_GS : O_GP) : (smp ? O_RS : O_RP);
    float* so = p.O() + obase + ((size_t)(layer * nBatch + b) * 4 + h) * DK * 64 + part * CW;
#pragma unroll
    for (int i = 0; i < KPL; ++i) so[(kg * KPL + i) * 64 + col] = S[i];
  }
  if (MIX == 0) {
    float* co = p.O() + (smp ? O_CS : O_CP) + (size_t)(layer * nBatch + b) * 3 * 768;
    for (int e = tid; e < 3 * RS; e += 256) { const int j = e / RS, r = e % RS;
      const float v = bflo((unsigned)rawb[(ntok_last + j) * RS + r]);
      if (r < 128) { if (part == 0) co[j * 768 + ((r < 64) ? (h * 64 + r) : (256 + h * 64 + r - 64))] = v; }
      else co[j * 768 + 512 + h * 64 + part * CW + r - 128] = v; }
  }
  __syncthreads();
  }
}

constexpr int ITEMS_PER_SEQ = 40;
__device__ __forceinline__ void scan_dispatch(const Params& p, int layer, int smp, int type, int b0, int bstep, int bend, char* lds, const int tid) {
  const int r = type;
  if (r < 16) scan_part<0>(p, layer, smp, b0, bstep, bend, r >> 2, r & 3, lds, tid);
  else {
    const int r2 = r - 16, mh = 4 + (r2 >> 1), part = r2 & 1, mix = mh >> 2, h = mh & 3;
    if (mix == 1) scan_part<1>(p, layer, smp, b0, bstep, bend, h, part, lds, tid);
    else if (mix == 2) scan_part<2>(p, layer, smp, b0, bstep, bend, h, part, lds, tid);
    else scan_part<3>(p, layer, smp, b0, bstep, bend, h, part, lds, tid);
  }
}

__device__ __forceinline__ int long_item_type(int u, int& b) {
  int type;
  if (u < 64) { b = u >> 3; type = 24 + (u & 7); }
  else if (u < 192) { const int v = u - 64; b = v >> 4; type = v & 15; }
  else if (u < 256) { const int v = u - 192; b = v >> 3; type = 16 + (v & 7); }
  else { const int v = u - 256; b = v >> 3; type = 32 + (v & 7); }
  return type;
}
__device__ __forceinline__ void scan_phase(const Params& p, int layer, char* lds, int bid, int nb, const int tid, const int role, const int ci, const int nprim, const int nsec) {
  constexpr int NPI = NB * ITEMS_PER_SEQ;
  const bool paired = (nprim == 256 && nsec == 256);
  int j = -1, nbs = 1;
  if (paired) {
    int u = -1;
    if (role == 0) u = ci; else if (ci < NPI - 256) u = 256 + ci;
    if (u >= 0) { int b; const int type = long_item_type(u, b); scan_dispatch(p, layer, 0, type, b, 1, b + 1, lds, tid); }
    else { j = ci - (NPI - 256); nbs = 256 - (NPI - 256); }
  } else {
    for (int u = bid; u < NPI; u += nb) { int b; const int type = long_item_type(u, b); scan_dispatch(p, layer, 0, type, b, 1, b + 1, lds, tid); }
    nbs = (nb > NPI) ? nb - NPI : nb; j = (nb > NPI) ? bid - NPI : bid;
  }
  if (j >= 0) {
    const int nsl = (nbs + ITEMS_PER_SEQ - 1) / ITEMS_PER_SEQ;
    for (int jj = j; jj < ITEMS_PER_SEQ * nsl; jj += nbs) scan_dispatch(p, layer, 1, jj % ITEMS_PER_SEQ, jj / ITEMS_PER_SEQ, nsl, NSB, lds, tid);
    if (layer == 0) { __syncthreads(); convert_weights(p, lds, 3360 + j, 6720, nbs, tid); }
  }
}

__device__ __forceinline__ void norm_phase(const Params& p, int layer, int bid, int nb, const int tid) {
  bf16_t* O = (bf16_t*)p.O();
  const bf16_t* P = (const bf16_t*)(p.W() + OFF_P);
  const float* PS = (const float*)((const unsigned char*)p.O() + DOUT_PS);
  const int cg8 = tid & 127;
  const int mh = cg8 >> 3, mix = mh >> 2, h = mh & 3, j0 = (cg8 & 7) * 8;
  const int gcol = (mix == 0) ? 776 : (mix == 1) ? 1800 : (mix == 2) ? 2584 : 3608;
  const float* gsrc = (mix == 0) ? p.I(14) : (mix == 1) ? p.I(16) : (mix == 2) ? p.I(19) : p.I(20);
  float g8[8];
#pragma unroll
  for (int i = 0; i < 8; ++i) g8[i] = gsrc[layer * 256 + h * 64 + j0 + i];
  for (int row = bid * 2 + (tid >> 7); row < MT; row += nb * 2) {
    const uint4 ov = *(const uint4*)(O + (size_t)row * 1024 + cg8 * 8);
    const uint4 gv = *(const uint4*)(P + (size_t)row * DINP + gcol + h * 64 + j0);
    const f32x4 ps = *(const f32x4*)(PS + (size_t)row * 128 + mh * 8);
    float s1 = ps[0] + ps[2], s2 = ps[1] + ps[3];
    if (mix == 0) { const f32x4 ps2 = *(const f32x4*)(PS + (size_t)row * 128 + mh * 8 + 4); s1 += ps2[0] + ps2[2]; s2 += ps2[1] + ps2[3]; }
    float o[8], gt[8]; unpack8(ov, o); unpack8(gv, gt);
    float mu = 0.f, rs;
    if (mix == 3) { mu = s1 * (1.0f / 64.0f); const float var = fmaxf(s2 * (1.0f / 64.0f) - mu * mu, 0.f); rs = rsqrtf(var + 1e-5f); }
    else rs = rsqrtf(s2 * (1.0f / 64.0f) + 1e-6f);
    float r[8];
#pragma unroll
    for (int i = 0; i < 8; ++i) r[i] = (o[i] - mu) * rs * g8[i] * siluf_(gt[i]);
    uint4 o4; o4.x = pk2(r[0], r[1]); o4.y = pk2(r[2], r[3]); o4.z = pk2(r[4], r[5]); o4.w = pk2(r[6], r[7]);
    *(uint4*)(O + (size_t)row * 1024 + cg8 * 8) = o4;
  }
}

constexpr int NPHASE = 17;
__global__ void __launch_bounds__(256, 2) hymba_fwd(Params p_, int ph_lo, int ph_hi) {
  __shared__ __attribute__((aligned(16))) char lds[65536];
  XcdBarrier xb; xb.bar = (unsigned*)(p_.ws + OFF_BAR); xb.x = xb_xcc_id(); xb.nloc = 0u; xb.nx = 0u;
  if (threadIdx.x == 0) (void)xb_add(&xb.bar[XB_XCNT(xb.x)], 1u);
  int role = 0, ci = 0;
  {
    const unsigned key = ((((unsigned)__builtin_amdgcn_s_getreg((31 << 11) | 4)) >> 8) & 0xFFu) | (xb.x << 8);
    if (threadIdx.x == 0) {
      const unsigned slot = xb_add(&xb.bar[CEN_TAB + key], 1u);
      unsigned r;
      if (slot == 0u) { r = xb_add(&xb.bar[CEN_CNT], 1u); __hip_atomic_store(&xb.bar[CEN_TAB2 + key], r + 1u, __ATOMIC_RELAXED, __HIP_MEMORY_SCOPE_AGENT); }
      else { (void)xb_add(&xb.bar[CEN_CNT + 1], 1u); r = 0u; }
      *(volatile unsigned*)(lds) = slot == 0u ? 0u : 1u; *(volatile unsigned*)(lds + 4) = r;
    }
    __syncthreads();
    role = (int)*(volatile unsigned*)(lds); ci = (int)*(volatile unsigned*)(lds + 4);
    __syncthreads();
    role = __builtin_amdgcn_readfirstlane(role); ci = __builtin_amdgcn_readfirstlane(ci);
    if (role != 0) ci = -1 - (int)key;
  }
  int nprim = 0, nsec = 0;
  if (ph_hi < 0) cg::this_grid().sync();
  for (int ph = ph_lo; ph < ph_hi; ++ph) {
    int tid = threadIdx.x, bid = blockIdx.x, nb = gridDim.x;
    asm volatile("" : "+v"(tid));
    asm volatile("" : "+s"(bid), "+s"(nb));
    if (ph > ph_lo) xcd_barrier(xb, tid, (unsigned)nb);
    if (ph == ph_lo + 1) {
      nprim = (int)xb_ld(&xb.bar[CEN_CNT]); nsec = (int)xb_ld(&xb.bar[CEN_CNT + 1]);
      if (role != 0) { const unsigned v = xb_ld(&xb.bar[CEN_TAB2 + (unsigned)(-1 - ci)]); ci = (v > 0u) ? (int)v - 1 : 0; }
      nprim = __builtin_amdgcn_readfirstlane(nprim); nsec = __builtin_amdgcn_readfirstlane(nsec); ci = __builtin_amdgcn_readfirstlane(ci);
    }
    const Params& p = p_;
    if (ph == 0) {
      convert_weights(p, lds, bid, 3360, nb, tid);
      embed_ln(p, bid, nb, tid);
      rope_table(p, bid, nb, tid);
    } else {
      const int l = (ph - 1) / 8, s = (ph - 1) % 8;
      const bf16_t* Xb = (const bf16_t*)p.O();
      bf16_t* X1b = (bf16_t*)(p.W() + OFF_X1B);
      bf16_t* Hb = (bf16_t*)(p.W() + OFF_H);
      float* X = (float*)(p.W() + OFF_X);
      if (s == 0) gemm_phase<EPI_BF16>(Xb, 1024, (const bf16_t*)(p.W() + OFF_WIN + l * SZ_WIN), 1024, 1024, DINP / 128, p.W() + OFF_P, DINP, lds, bid, nb, tid);
      else if (s == 1) scan_phase(p, l, lds, bid, nb, tid, role, ci, nprim, nsec);
      else if (s == 2) norm_phase(p, l, bid, nb, tid);
      else if (s == 3) gemm_phase<EPI_RESID>(Xb, 1024, (const bf16_t*)(p.W() + OFF_WOUT + l * SZ_WOUT), 1024, 1024, 8, X, 1024, lds, bid, nb, tid);
      else if (s == 4) ln_phase(p, p.I(22) + l * 1024, p.I(23) + l * 1024, X1b, 0, bid, nb, tid);
      else if (s == 5) gemm_phase<EPI_SWIGLU>(X1b, 1024, (const bf16_t*)(p.W() + OFF_WGU + l * SZ_WGU), 1024, 1024, 44, Hb, DFF, lds, bid, nb, tid);
      else if (s == 6) gemm_phase<EPI_RESID>(Hb, DFF, (const bf16_t*)(p.W() + OFF_WDN + l * SZ_WDN), DFF, DFF, 8, X, 1024, lds, bid, nb, tid);
      else ln_phase(p, p.I(27) + l * 1024, p.I(28) + l * 1024, (bf16_t*)p.O(), l == 1, bid, nb, tid);
    }
  }
}

extern "C" void kernel_launch(void* const* d_in, const int* in_sizes, int n_in, void* d_out, int out_size, void* d_ws, size_t ws_size,
                              hipStream_t stream) {
  (void)in_sizes; (void)out_size;
  if (n_in < 29 || ws_size < WS_NEED) { fprintf(stderr, "bad args: n_in %d ws %zu need %zu\n", n_in, ws_size, (size_t)WS_NEED); return; }
  Params p{};
  for (int i = 0; i < 29; ++i) p.in[i] = (const float*)d_in[i];
  p.out = (float*)d_out;
  p.ws = (unsigned char*)d_ws;
  static int grid_blocks = 0;
  if (!grid_blocks) {
    int dev = 0, cus = 0, per_cu = 0;
    (void)hipGetDevice(&dev);
    (void)hipDeviceGetAttribute(&cus, hipDeviceAttributeMultiprocessorCount, dev);
    (void)hipOccupancyMaxActiveBlocksPerMultiprocessor(&per_cu, hymba_fwd, 256, 0);
    if (per_cu > 2) per_cu = 2;
    if (per_cu < 1) per_cu = 1;
    grid_blocks = cus * per_cu;
  }
  (void)hipMemsetAsync((unsigned char*)d_ws + OFF_BAR, 0, BAR_BYTES, stream);
  int lo = 0, hi = NPHASE;
  void* args[] = {&p, &lo, &hi};
  hipError_t e = hipLaunchCooperativeKernel((void*)hymba_fwd, dim3(grid_blocks), dim3(256), args, 0, stream);
  if (e != hipSuccess) fprintf(stderr, "cooperative launch failed: %s (grid %d)\n", hipGetErrorString(e), grid_blocks);
}
```

```cpp
#include <hip/hip_runtime.h>
#include <hip/hip_cooperative_groups.h>
#include <cstdio>
#include <cstdint>
namespace cg = cooperative_groups;

#ifndef COOP
#define COOP 1
#endif

typedef unsigned short bf16_t;
typedef short bf16x8 __attribute__((ext_vector_type(8)));
typedef float f32x4 __attribute__((ext_vector_type(4)));

constexpr int DM = 1024, NB = 8, TPR = 2064, NSB = 128, TS = 4;
constexpr int MP = NB * TPR;
constexpr int MS = NSB * TS;
constexpr int MT = MP + MS;
constexpr int DIN = 3864, DINP = 3968, DFF = 2816;
constexpr float ALPHA = 1.41421356237309515f;

constexpr size_t SZ_WIN = (size_t)DINP * 1024 * 2, SZ_WOUT = (size_t)1024 * 1024 * 2, SZ_WGU = (size_t)5632 * 1024 * 2, SZ_WDN = (size_t)1024 * 2816 * 2;
constexpr size_t OFF_CS = 0;
constexpr size_t OFF_WIN = 532480;
constexpr size_t OFF_WOUT = OFF_WIN + 2 * SZ_WIN;
constexpr size_t OFF_WGU = OFF_WOUT + 2 * SZ_WOUT;
constexpr size_t OFF_WDN = OFF_WGU + 2 * SZ_WGU;
constexpr size_t OFF_X = OFF_WDN + 2 * SZ_WDN;
constexpr size_t OFF_P = OFF_X + (size_t)MT * 1024 * 4;
constexpr size_t OFF_X1B = OFF_P;
constexpr size_t OFF_H = OFF_P + (size_t)MT * 1024 * 2;
constexpr size_t OFF_BAR = OFF_P + (size_t)MT * DINP * 2;
constexpr int CEN_CNT = 3520, CEN_TAB = 4096, CEN_TAB2 = 8192;
constexpr size_t BAR_BYTES = 12288 * 4;
constexpr size_t WS_NEED = OFF_BAR + BAR_BYTES;
constexpr size_t DOUT_PS = 36000000;

constexpr size_t O_YP = 0, O_YS = 16777216, O_CP = 17301504, O_CS = 17338368, O_DP = 17928192, O_DS = 18190336,
                 O_HP = 22384640, O_HS = 22646784, O_GP = 26841088, O_GS = 26972160, O_RP = 29069312, O_RS = 29331456;

#define GAS __attribute__((address_space(1)))
struct Params {
  const float* in[29];
  float* out;
  unsigned char* ws;
  __device__ __forceinline__ const float* I(int i) const { return (const float*)(const GAS float*)in[i]; }
  __device__ __forceinline__ float* O() const { return (float*)(GAS float*)out; }
  __device__ __forceinline__ unsigned char* W() const { return (unsigned char*)(GAS unsigned char*)ws; }
};

__device__ __forceinline__ unsigned f2bf(float f) {
  unsigned u = __float_as_uint(f);
  u += 0x7fffu + ((u >> 16) & 1u);
  return u >> 16;
}
typedef float f32x2_t __attribute__((ext_vector_type(2)));
typedef __bf16 bf16x2_t __attribute__((ext_vector_type(2)));
__device__ __forceinline__ unsigned pk2(float lo, float hi) { const f32x2_t v = {lo, hi}; const bf16x2_t b = __builtin_convertvector(v, bf16x2_t); return __builtin_bit_cast(unsigned, b); }
__device__ __forceinline__ float bflo(unsigned u) { return __uint_as_float(u << 16); }
__device__ __forceinline__ float bfhi(unsigned u) { return __uint_as_float(u & 0xffff0000u); }
__device__ __forceinline__ void unpack8(const uint4& r, float* x) {
  x[0] = bflo(r.x); x[1] = bfhi(r.x); x[2] = bflo(r.y); x[3] = bfhi(r.y);
  x[4] = bflo(r.z); x[5] = bfhi(r.z); x[6] = bflo(r.w); x[7] = bfhi(r.w);
}
__device__ __forceinline__ float sigmoidf_(float x) { return __builtin_amdgcn_rcpf(1.0f + __expf(-x)); }
__device__ __forceinline__ float siluf_(float x) { return x * __builtin_amdgcn_rcpf(1.0f + __expf(-x)); }
__device__ __forceinline__ float softplusf_(float x) { return fmaxf(x, 0.f) + __logf(1.0f + __expf(-fabsf(x))); }
__device__ __forceinline__ float red8(float x) {
  x += __shfl_xor(x, 1); x += __shfl_xor(x, 2); x += __shfl_xor(x, 4); return x;
}
__device__ __forceinline__ float dpp_x1(float x) {
  return __int_as_float(__builtin_amdgcn_update_dpp(0, __float_as_int(x), 0xB1, 0xF, 0xF, true));
}
__device__ __forceinline__ float dpp_x2(float x) {
  return __int_as_float(__builtin_amdgcn_update_dpp(0, __float_as_int(x), 0x4E, 0xF, 0xF, true));
}
__device__ __forceinline__ float red4(float x) { x += dpp_x1(x); x += dpp_x2(x); return x; }
__device__ __forceinline__ float wave_sum(float x) {
#pragma unroll
  for (int o = 32; o >= 1; o >>= 1) x += __shfl_xor(x, o);
  return x;
}

__device__ __forceinline__ void convert_weights(const Params& p, char* lds, int w0, int w1, int wstep, const int tid) {
  float* tile = (float*)lds;
  for (int w = w0; w < w1; w += wstep) {
    const int l = w / 3360; int r = w % 3360;
    int mat, kt, rt;
    if (r < 992) { mat = 0; kt = r / 62; rt = r % 62; }
    else if (r < 1248) { r -= 992; mat = 1; kt = r / 16; rt = r % 16; }
    else if (r < 2656) { r -= 1248; mat = 2; kt = r / 88; rt = r % 88; }
    else { r -= 2656; mat = 3; kt = r / 16; rt = r % 16; }
    {
      const int r4 = (tid & 15) * 4, R = rt * 64 + r4, kq = tid >> 4;
      const float* src; int ns; bool valid = true;
      if (mat == 0) { const int rho = R & 31, scol = (R & ~31) + 8 * ((rho & 15) >> 2) + 4 * (rho >> 4) + (rho & 3);
        src = p.I(10) + (size_t)l * 1024 * DIN + scol; ns = DIN; valid = scol < DIN; }
      else if (mat == 1) { src = p.I(21) + (size_t)l * 1024 * 1024 + R; ns = 1024; }
      else if (mat == 2) { const int q = R & 63, f = q >> 4, i = q & 15, ty = f & 1, hid = (R >> 6) * 32 + 8 * (i >> 2) + 4 * (f >> 1) + (i & 3);
        src = (ty ? p.I(25) : p.I(24)) + (size_t)l * 1024 * DFF + hid; ns = DFF; }
      else { src = p.I(26) + (size_t)l * DFF * 1024 + R; ns = 1024; }
      f32x4 v[4];
#pragma unroll
      for (int i = 0; i < 4; ++i) v[i] = valid ? *(const f32x4*)(src + (size_t)(kt * 64 + kq + 16 * i) * ns) : (f32x4){0.f, 0.f, 0.f, 0.f};
#pragma unroll
      for (int i = 0; i < 4; ++i) {
        const int k = kq + 16 * i;
        tile[(r4 + 0) * 65 + k] = v[i][0]; tile[(r4 + 1) * 65 + k] = v[i][1]; tile[(r4 + 2) * 65 + k] = v[i][2]; tile[(r4 + 3) * 65 + k] = v[i][3];
      }
    }
    __syncthreads();
    {
      const int rr = tid >> 2, kc = (tid & 3) * 16;
      const int Kd = (mat == 3) ? DFF : 1024;
      bf16_t* base;
      if (mat == 0) base = (bf16_t*)(p.W() + OFF_WIN + l * SZ_WIN);
      else if (mat == 1) base = (bf16_t*)(p.W() + OFF_WOUT + l * SZ_WOUT);
      else if (mat == 2) base = (bf16_t*)(p.W() + OFF_WGU + l * SZ_WGU);
      else base = (bf16_t*)(p.W() + OFF_WDN + l * SZ_WDN);
      bf16_t* dst = base + (size_t)(rt * 64 + rr) * Kd + kt * 64 + kc;
      const float* s = tile + rr * 65 + kc;
      uint4 a, b;
      a.x = pk2(s[0], s[1]); a.y = pk2(s[2], s[3]); a.z = pk2(s[4], s[5]); a.w = pk2(s[6], s[7]);
      b.x = pk2(s[8], s[9]); b.y = pk2(s[10], s[11]); b.z = pk2(s[12], s[13]); b.w = pk2(s[14], s[15]);
      *(uint4*)dst = a; *(uint4*)(dst + 8) = b;
    }
    __syncthreads();
  }
}

__device__ __forceinline__ void ln_row_regs(f32x4 (&v)[4], const float* g, const float* bb, int lane) {
  float s = 0.f;
#pragma unroll
  for (int i = 0; i < 4; ++i) s += (v[i][0] + v[i][1]) + (v[i][2] + v[i][3]);
  const float mu = wave_sum(s) * (1.0f / 1024.0f);
  float q = 0.f;
#pragma unroll
  for (int i = 0; i < 4; ++i) { const f32x4 d = v[i] - mu; q += (d[0] * d[0] + d[1] * d[1]) + (d[2] * d[2] + d[3] * d[3]); }
  const float rs = rsqrtf(wave_sum(q) * (1.0f / 1024.0f) + 1e-5f);
#pragma unroll
  for (int i = 0; i < 4; ++i) {
    const f32x4 gg = *(const f32x4*)(g + lane * 4 + i * 256), b4 = *(const f32x4*)(bb + lane * 4 + i * 256);
    v[i] = (v[i] - mu) * rs * gg + b4;
  }
}

__device__ __forceinline__ void embed_ln(const Params& p, int bid, int nb, const int tid) {
  const int lane = tid & 63, wv = tid >> 6;
  float* X = (float*)(p.W() + OFF_X);
  bf16_t* Xb = (bf16_t*)p.O();
  for (int row = bid * 4 + wv; row < MT; row += nb * 4) {
    const float* src;
    if (row < MP) { const int b = row / TPR, t = row % TPR;
      src = (t < 16) ? p.I(7) + (size_t)t * 1024 : p.I(0) + ((size_t)b * 2048 + (t - 16)) * 1024; }
    else src = p.I(1) + (size_t)(row - MP) * 1024;
    f32x4 v[4];
#pragma unroll
    for (int i = 0; i < 4; ++i) v[i] = *(const f32x4*)(src + lane * 4 + i * 256);
    ln_row_regs(v, p.I(8), p.I(9), lane);
#pragma unroll
    for (int i = 0; i < 4; ++i) {
      *(f32x4*)(X + (size_t)row * 1024 + lane * 4 + i * 256) = v[i];
      uint2 o; o.x = pk2(v[i][0], v[i][1]); o.y = pk2(v[i][2], v[i][3]);
      *(uint2*)(Xb + (size_t)row * 1024 + lane * 4 + i * 256) = o;
    }
  }
}

__device__ __forceinline__ void rope_table(const Params& p, int bid, int nb, const int tid) {
  float2* cs = (float2*)(p.W() + OFF_CS);
  for (int e = bid * 256 + tid; e < 2068 * 32; e += nb * 256) {
    const int idx = e >> 5, i = e & 31;
    const double pos = (idx < 2064) ? (double)idx : (double)(16384 + idx - 2064);
    const double inv = exp(-((double)i / 31.0) * 9.210340371976184);
    const double ang = pos * inv;
    cs[e] = make_float2((float)cos(ang), (float)sin(ang));
  }
}

__device__ __forceinline__ void ln_phase(const Params& p, const float* g, const float* bb, bf16_t* xb, int final_, int bid, int nb, const int tid) {
  const int lane = tid & 63, wv = tid >> 6;
  float* X = (float*)(p.W() + OFF_X);
  for (int row = bid * 4 + wv; row < MT; row += nb * 4) {
    f32x4 v[4];
#pragma unroll
    for (int i = 0; i < 4; ++i) v[i] = *(const f32x4*)(X + (size_t)row * 1024 + lane * 4 + i * 256);
    ln_row_regs(v, g, bb, lane);
    if (!final_) {
#pragma unroll
      for (int i = 0; i < 4; ++i) {
        *(f32x4*)(X + (size_t)row * 1024 + lane * 4 + i * 256) = v[i];
        uint2 o; o.x = pk2(v[i][0], v[i][1]); o.y = pk2(v[i][2], v[i][3]);
        *(uint2*)(xb + (size_t)row * 1024 + lane * 4 + i * 256) = o;
      }
    } else {
      float* dst = nullptr;
      if (row < MP) { const int b = row / TPR, t = row % TPR; if (t >= 16) dst = p.O() + O_YP + ((size_t)b * 2048 + (t - 16)) * 1024; }
      else dst = p.O() + O_YS + (size_t)(row - MP) * 1024;
      if (dst) {
#pragma unroll
        for (int i = 0; i < 4; ++i) *(f32x4*)(dst + lane * 4 + i * 256) = v[i];
      }
    }
  }
}

enum { EPI_BF16 = 0, EPI_RESID = 1, EPI_SWIGLU = 2 };

template <int EPI>
__device__ __forceinline__ void gemm_tile(const bf16_t* __restrict__ A, const int lda, const bf16_t* __restrict__ Bt, const int ldb,
                                          const int K, const int m0, const int n0, void* Cout, const int ldc, char* lds, const int tid) {
  const int wid = tid >> 6, lane = tid & 63, wr = wid >> 1, wc = wid & 1, fr = lane & 15, fq = lane >> 4;
  f32x4 acc[4][4];
#pragma unroll
  for (int m = 0; m < 4; ++m)
#pragma unroll
    for (int n = 0; n < 4; ++n) acc[m][n] = (f32x4){0.f, 0.f, 0.f, 0.f};
  const int nt = K >> 6;
  auto stage = [&](int kt, int buf) {
#pragma unroll
    for (int i = 0; i < 4; ++i) {
      const int off = tid * 16 + i * 4096;
      const int panel = off >> 13, rem = off & 8191, r = rem >> 6, c = (rem & 63) >> 1;
      const bf16_t* ga = A + (size_t)(m0 + r) * lda + kt * 64 + panel * 32 + c;
      const bf16_t* gb = Bt + (size_t)(n0 + r) * ldb + kt * 64 + panel * 32 + c;
      __builtin_amdgcn_global_load_lds((const unsigned*)ga, (__attribute__((address_space(3))) unsigned*)(lds + buf * 32768 + off), 16, 0, 0);
      __builtin_amdgcn_global_load_lds((const unsigned*)gb, (__attribute__((address_space(3))) unsigned*)(lds + buf * 32768 + 16384 + off), 16, 0, 0);
    }
  };
  stage(0, 0);
  for (int kt = 0; kt < nt; ++kt) {
    asm volatile("s_waitcnt vmcnt(0)" ::: "memory");
    __syncthreads();
    if (kt + 1 < nt) stage(kt + 1, (kt + 1) & 1);
    const char* sa = lds + (kt & 1) * 32768;
    const char* sb = sa + 16384;
#pragma unroll
    for (int ks = 0; ks < 2; ++ks) {
      bf16x8 af[4], bfr[4];
#pragma unroll
      for (int m = 0; m < 4; ++m) af[m] = *(const bf16x8*)(sa + ks * 8192 + (wr * 64 + m * 16 + fr) * 64 + fq * 16);
#pragma unroll
      for (int n = 0; n < 4; ++n) bfr[n] = *(const bf16x8*)(sb + ks * 8192 + (wc * 64 + n * 16 + fr) * 64 + fq * 16);
#pragma unroll
      for (int m = 0; m < 4; ++m)
#pragma unroll
        for (int n = 0; n < 4; ++n) acc[m][n] = __builtin_amdgcn_mfma_f32_16x16x32_bf16(bfr[n], af[m], acc[m][n], 0, 0, 0);
    }
  }
  if (EPI == EPI_RESID) {
    float* C0 = (float*)Cout + (size_t)(m0 + wr * 64 + fr) * ldc + n0 + wc * 64 + fq * 4;
    f32x4 xin[4][4];
#pragma unroll
    for (int m = 0; m < 4; ++m)
#pragma unroll
      for (int n = 0; n < 4; ++n) xin[m][n] = *(const f32x4*)(C0 + (size_t)m * 16 * ldc + n * 16);
#pragma unroll
    for (int m = 0; m < 4; ++m)
#pragma unroll
      for (int n = 0; n < 4; ++n) asm volatile("" : "+v"(xin[m][n]));
#pragma unroll
    for (int m = 0; m < 4; ++m)
#pragma unroll
      for (int n = 0; n < 4; ++n) *(f32x4*)(C0 + (size_t)m * 16 * ldc + n * 16) = xin[m][n] * ALPHA + acc[m][n];
    return;
  }
#pragma unroll
  for (int m = 0; m < 4; ++m) {
    const int row = m0 + wr * 64 + m * 16 + fr;
    if (EPI == EPI_BF16) {
      bf16_t* C = (bf16_t*)Cout + (size_t)row * ldc + n0 + wc * 64 + fq * 8;
#pragma unroll
      for (int pq = 0; pq < 2; ++pq) { uint4 o; o.x = pk2(acc[m][2 * pq][0], acc[m][2 * pq][1]); o.y = pk2(acc[m][2 * pq][2], acc[m][2 * pq][3]);
        o.z = pk2(acc[m][2 * pq + 1][0], acc[m][2 * pq + 1][1]); o.w = pk2(acc[m][2 * pq + 1][2], acc[m][2 * pq + 1][3]); *(uint4*)(C + pq * 32) = o; }
    } else if (EPI == EPI_RESID) {
      float* C = (float*)Cout + (size_t)row * ldc + n0 + wc * 64 + fq * 4;
#pragma unroll
      for (int n = 0; n < 4; ++n) { const f32x4 x = *(const f32x4*)(C + n * 16); *(f32x4*)(C + n * 16) = x * ALPHA + acc[m][n]; }
    } else {
      bf16_t* C = (bf16_t*)Cout + (size_t)row * ldc + (n0 >> 1) + wc * 32 + fq * 8;
      const f32x4 g0 = acc[m][0], u0 = acc[m][1], g1 = acc[m][2], u1 = acc[m][3];
      uint4 o; o.x = pk2(siluf_(g0[0]) * u0[0], siluf_(g0[1]) * u0[1]); o.y = pk2(siluf_(g0[2]) * u0[2], siluf_(g0[3]) * u0[3]);
      o.z = pk2(siluf_(g1[0]) * u1[0], siluf_(g1[1]) * u1[1]); o.w = pk2(siluf_(g1[2]) * u1[2], siluf_(g1[3]) * u1[3]);
      *(uint4*)C = o;
    }
  }
}
template <int EPI>
__device__ __forceinline__ void gemm_phase(const bf16_t* A, int lda, const bf16_t* Bt, int ldb, int K, int ntn, void* C, int ldc, char* lds, int bid, int nb, const int tid) {
  constexpr int GM = 8, nM = MT / 128;
  const int ntiles = nM * ntn, nig = GM * ntn;
  const int pos = (EPI == EPI_BF16 && (nb & 7) == 0) ? (bid & 7) * (nb >> 3) + (bid >> 3) : bid;
  for (int L = pos; L < ntiles; L += nb) {
    int mt, nn;
    if (EPI != EPI_BF16) { mt = L / ntn; nn = L % ntn; }
    else { const int gid = L / nig, fm = gid * GM, gsz = min(nM - fm, GM), rem = L - gid * nig; mt = fm + rem % gsz; nn = rem / gsz; }
    gemm_tile<EPI>(A, lda, Bt, ldb, K, mt * 128, nn * 128, C, ldc, lds, tid);
  }
}

#define XB_TMO      128
#define XB_XCNT(j)  (256  + 64 * (j))
#define XB_XSUB(j)  (1280 + 64 * (j))
#define XB_XGEN(j)  (2304 + 64 * (j))
#define XB_TOP      3328
#define XB_TOPGEN   3392
#define XCD_BAR_WORDS 3456
#define XB_SPIN_CAP (1u << 22)
__device__ __forceinline__ unsigned xb_ld(unsigned* p) { return __hip_atomic_load(p, __ATOMIC_RELAXED, __HIP_MEMORY_SCOPE_AGENT); }
__device__ __forceinline__ unsigned xb_add(unsigned* p, unsigned v) { return __hip_atomic_fetch_add(p, v, __ATOMIC_RELAXED, __HIP_MEMORY_SCOPE_AGENT); }
__device__ __forceinline__ unsigned xb_xcc_id() { return (unsigned)__builtin_amdgcn_s_getreg((3 << 11) | 20) & 0xFu; }
#define XB_SPIN(cond, bar) do { unsigned _sp = 0; while (cond) { __builtin_amdgcn_s_sleep(1); \
    if ((++_sp & 255u) == 0u) { if (xb_ld(&(bar)[XB_TMO])) break; if (_sp > XB_SPIN_CAP) { atomicAdd(&(bar)[XB_TMO], 1u); break; } } } } while (0)
struct XcdBarrier { unsigned* bar; unsigned x; unsigned nloc, nx; };
__device__ __forceinline__ void xcd_barrier_complete(unsigned* bar, unsigned x, unsigned G, unsigned& nloc, unsigned& nx) {
  unsigned sum, cnt, mine, sp = 0u;
  for (;;) {
    sum = 0u; cnt = 0u; mine = 0u;
#pragma unroll
    for (unsigned j = 0; j < 16; ++j) { const unsigned c = xb_ld(&bar[XB_XCNT(j)]); sum += c; cnt += (c > 0u) ? 1u : 0u; mine = (j == x) ? c : mine; }
    if (sum == G) break;
    __builtin_amdgcn_s_sleep(1);
    if ((++sp & 255u) == 0u) { if (xb_ld(&bar[XB_TMO])) break; if (sp > XB_SPIN_CAP) { atomicAdd(&bar[XB_TMO], 1u); break; } }
  }
  nloc = mine > 0u ? mine : 1u; nx = cnt > 0u ? cnt : 1u;
}
__device__ __forceinline__ void xcd_barrier(XcdBarrier& b, const int tid, const unsigned G) {
  asm volatile("s_waitcnt vmcnt(0)" ::: "memory");
  __syncthreads();
  if (tid == 0) {
    unsigned* bar = b.bar;
    __builtin_amdgcn_s_waitcnt(0);
    if (b.nloc == 0u) xcd_barrier_complete(bar, b.x, G, b.nloc, b.nx);
    const unsigned nloc = b.nloc, nx = b.nx;
    const unsigned old = xb_add(&bar[XB_XSUB(b.x)], 1u);
    const unsigned gen = old / nloc;
    if (old + 1u == (gen + 1u) * nloc) {
      __builtin_amdgcn_fence(__ATOMIC_RELEASE, "agent");
      asm volatile("s_waitcnt vmcnt(0)" ::: "memory");
      const unsigned og = xb_add(&bar[XB_TOP], 1u);
      const unsigned tg = og / nx;
      if (og + 1u == (tg + 1u) * nx) xb_add(&bar[XB_TOPGEN], 1u);
      else XB_SPIN(xb_ld(&bar[XB_TOPGEN]) == tg, bar);
      __builtin_amdgcn_fence(__ATOMIC_ACQUIRE, "agent");
      xb_add(&bar[XB_XGEN(b.x)], 1u);
      asm volatile("s_waitcnt vmcnt(0)" ::: "memory");
    } else {
      XB_SPIN(xb_ld(&bar[XB_XGEN(b.x)]) == gen, bar);
      __builtin_amdgcn_fence(__ATOMIC_ACQUIRE, "agent");
      asm volatile("s_waitcnt vmcnt(0)" ::: "memory");
    }
  }
  __syncthreads();
}

template <int N, int RS>
__device__ __forceinline__ void convN(const bf16_t* rawb, const float* cwl, int tt, int off, float (&x)[N]) {
#pragma unroll
  for (int i = 0; i < N; ++i) x[i] = 0.f;
#pragma unroll
  for (int j = 0; j < 4; ++j) {
    float xv[N];
    if (N == 8) { const uint4 rv = *(const uint4*)(rawb + (tt + j) * RS + off); unpack8(rv, xv); }
    else if (N == 4) { const uint2 rv = *(const uint2*)(rawb + (tt + j) * RS + off); xv[0] = bflo(rv.x); xv[1] = bfhi(rv.x); xv[2 % N] = bflo(rv.y); xv[3 % N] = bfhi(rv.y); }
    else { const unsigned rv = *(const unsigned*)(rawb + (tt + j) * RS + off); xv[0] = bflo(rv); xv[1] = bfhi(rv); }
#pragma unroll
    for (int i = 0; i < N; ++i) x[i] += cwl[j * RS + off + i] * xv[i];
  }
#pragma unroll
  for (int i = 0; i < N; ++i) asm volatile("" : "+v"(x[i]));
#pragma unroll
  for (int i = 0; i < N; ++i) x[i] = siluf_(x[i]);
}

template <int MIX, int VN>
__device__ __forceinline__ void load_chunk_fn(const unsigned char* ws, const bf16_t* Pb, const int t, const int T, const int h, const int vcol, const int sub, const int posb,
                                              uint4& R0, uint4& R1, uint2& R2, uint4& R4, uint4& R5, unsigned& ex0, unsigned& ex1) {
  if (t < T) {
    const bf16_t* pr = Pb + (size_t)t * DINP;
    const int vbase = (MIX == 0) ? 512 : (MIX == 1) ? 1544 : (MIX == 2) ? 2312 : 3352;
    if (VN == 4) R2 = *(const uint2*)(pr + vbase + h * 64 + vcol);
    else R2.x = *(const unsigned*)(pr + vbase + h * 64 + vcol);
    if (MIX == 0) {
      R0 = *(const uint4*)(pr + 0 + h * 64 + sub * 8); R1 = *(const uint4*)(pr + 256 + h * 64 + sub * 8);
      ex0 = pr[768 + h]; ex1 = pr[772 + h];
    } else if (MIX == 1) {
      R0 = *(const uint4*)(pr + 1032 + h * 64 + sub * 8); R1 = *(const uint4*)(pr + 1288 + h * 64 + sub * 8);
    } else if (MIX == 2) {
      const uint2 q2 = *(const uint2*)(pr + 2056 + h * 32 + sub * 4), k2 = *(const uint2*)(pr + 2184 + h * 32 + sub * 4);
      R0 = make_uint4(q2.x, q2.y, k2.x, k2.y);
      R1 = *(const uint4*)(pr + 2568); R4 = *(const uint4*)(pr + 2576);
    } else {
      const uint2 ql = *(const uint2*)(pr + 2840 + h * 64 + sub * 4), qh = *(const uint2*)(pr + 2840 + h * 64 + 32 + sub * 4);
      const uint2 kl = *(const uint2*)(pr + 3096 + h * 64 + sub * 4), kh = *(const uint2*)(pr + 3096 + h * 64 + 32 + sub * 4);
      R0 = make_uint4(ql.x, ql.y, qh.x, qh.y); R1 = make_uint4(kl.x, kl.y, kh.x, kh.y);
      const uint4* cs = (const uint4*)(ws + OFF_CS + ((size_t)(posb + t) * 32 + sub * 4) * 8);
      R4 = cs[0]; R5 = cs[1];
    }
  }
}

__device__ __forceinline__ float dpp_hm(float x) {
  return __int_as_float(__builtin_amdgcn_update_dpp(0, __float_as_int(x), 0x141, 0xF, 0xF, true));
}
__device__ __forceinline__ float dpp_rm(float x) {
  return __int_as_float(__builtin_amdgcn_update_dpp(0, __float_as_int(x), 0x140, 0xF, 0xF, true));
}
__device__ __forceinline__ float red8d(float x) { x += dpp_x1(x); x += dpp_x2(x); x += dpp_hm(x); return x; }
template <int KG> __device__ __forceinline__ float redKG(float x) { x = red8d(x); if (KG == 16) x += dpp_rm(x); return x; }

template <int MIX, int KPL>
struct StepIn { float q[KPL], k[KPL], d[KPL]; float v, a, be, qk; };

template <int MIX, int KPL>
__device__ __forceinline__ void load_step(const float* qkdv, const float* scal, int t, int kg, int col, StepIn<MIX, KPL>& s) {
  const float* base = qkdv + t * 256;
#pragma unroll
  for (int i = 0; i < KPL; i += 4) {
    const f32x4 a = *(const f32x4*)(base + kg * KPL + i), b = *(const f32x4*)(base + 64 + kg * KPL + i);
    s.q[i] = a[0]; s.q[i + 1] = a[1]; s.q[i + 2] = a[2]; s.q[i + 3] = a[3];
    s.k[i] = b[0]; s.k[i + 1] = b[1]; s.k[i + 2] = b[2]; s.k[i + 3] = b[3];
    if (MIX == 1 || MIX == 2) { const f32x4 d = *(const f32x4*)(base + 128 + kg * KPL + i); s.d[i] = d[0]; s.d[i + 1] = d[1]; s.d[i + 2] = d[2]; s.d[i + 3] = d[3]; }
  }
  s.v = base[192 + col];
  if (MIX == 0) { const f32x4 c = *(const f32x4*)(scal + t * 4); s.a = c[0]; s.be = c[1]; s.qk = c[2]; }
}

template <int MIX, int KPL, int KG>
__device__ __forceinline__ float do_step(const StepIn<MIX, KPL>& s, float (&S)[KPL], const float gam) {
  if (MIX == 0) {
    float kS0 = 0.f, kS1 = 0.f, qS0 = 0.f, qS1 = 0.f;
#pragma unroll
    for (int i = 0; i < KPL; i += 2) { kS0 += s.k[i] * S[i]; kS1 += s.k[i + 1] * S[i + 1]; qS0 += s.q[i] * S[i]; qS1 += s.q[i + 1] * S[i + 1]; }
    const float kS = redKG<KG>(kS0 + kS1), qS = redKG<KG>(qS0 + qS1);
    const float w = s.be * (s.v - s.a * kS);
#pragma unroll
    for (int i = 0; i < KPL; ++i) S[i] = s.a * S[i] + s.k[i] * w;
    return s.a * qS + s.qk * w;
  } else {
    float o0 = 0.f, o1 = 0.f;
#pragma unroll
    for (int i = 0; i < KPL; i += 2) {
      const float d0 = (MIX == 3) ? gam : s.d[i], d1 = (MIX == 3) ? gam : s.d[i + 1];
      S[i] = d0 * S[i] + s.k[i] * s.v; S[i + 1] = d1 * S[i + 1] + s.k[i + 1] * s.v;
      o0 += s.q[i] * S[i]; o1 += s.q[i + 1] * S[i + 1];
    }
    return redKG<KG>(o0 + o1);
  }
}

template <int MIX>
__device__ __forceinline__ void scan_part(const Params& p, const int layer, const int smp, const int b0, const int bstep, const int bend, const int h, const int part, char* lds, const int tid) {
  constexpr int DK = (MIX == 2) ? 32 : 64;
  constexpr int NS = (MIX == 0) ? 4 : 2;
  constexpr int CW = 64 / NS;
  constexpr int CPW = CW / 4;
  constexpr int KG = 64 / CPW;
  constexpr int KPL = DK / KG;
  constexpr int VN = CW / 8;
  constexpr int RS = 128 + CW;
  float* qkdv = (float*)lds;
  float* obuf = (float*)(lds + 32768);
  float* scal = (float*)(lds + 36864);
  bf16_t* rawb = (bf16_t*)(lds + 37376);
  float* cwl = (float*)(lds + 48576);
  float* wgl = (float*)(lds + 37376);

  const int lane = tid & 63, wv = tid >> 6;
  const int tt = tid >> 3, sub = tid & 7;
  const int col = wv * CPW + lane / KG, kg = lane % KG;
  const int T = smp ? 4 : TPR;
  const int nBatch = smp ? NSB : NB;
  const int posb = smp ? 2064 : 0;
  const int vcol = part * CW + sub * VN;
  __syncthreads();
  float c8[8];
  float Aexp = 0.f, dtb = 0.f, gam = 0.f;
  if (MIX == 0) {
    Aexp = __expf(p.I(12)[layer * 4 + h]); dtb = p.I(13)[layer * 4 + h];
    for (int e = tid; e < 4 * RS; e += 256) { const int j = e / RS, r = e % RS;
      const int cc = (r < 64) ? (h * 64 + r) : (r < 128) ? (256 + h * 64 + r - 64) : (512 + h * 64 + part * CW + r - 128);
      cwl[e] = p.I(11)[(size_t)(layer * 4 + j) * 768 + cc]; }
  } else if (MIX == 1) {
#pragma unroll
    for (int i = 0; i < 8; ++i) {
      const int d = h * 64 + sub * 8 + i;
      c8[i] = (layer == 0) ? 1.0f : sigmoidf_(p.I(15)[d] - p.I(15)[256 + d]);
    }
  } else if (MIX == 2) {
    for (int e = tid; e < 512; e += 256) { const int r = e >> 5, j = e & 31; wgl[e] = p.I(17)[(size_t)(layer * 16 + r) * 128 + h * 32 + j]; }
#pragma unroll
    for (int i = 0; i < 4; ++i) c8[i] = p.I(18)[layer * 128 + h * 32 + sub * 4 + i];
  } else {
    gam = 1.0f - exp2f(-5.0f - (float)h);
  }
  for (int b = b0; b < bend; b += bstep) {
  const int row0 = smp ? MP + b * 4 : b * TPR;
  const bf16_t* Pb = (const bf16_t*)(p.W() + OFF_P) + (size_t)row0 * DINP;
  bf16_t* Ob = (bf16_t*)p.O() + (size_t)row0 * 1024 + MIX * 256 + h * 64 + part * CW;
  float* PS = (float*)((unsigned char*)p.O() + DOUT_PS) + (size_t)row0 * 128 + (MIX * 4 + h) * 8 + part * 2;
  uint4 R0 = make_uint4(0, 0, 0, 0), R1 = R0, R4 = R0, R5 = R0; uint2 R2 = make_uint2(0, 0); unsigned ex0 = 0, ex1 = 0;
  load_chunk_fn<MIX, VN>(p.W(), Pb, tt, T, h, vcol, sub, posb, R0, R1, R2, R4, R5, ex0, ex1);
  float S[KPL];
  if (smp) {
    const float* sin_ = p.I(3 + MIX) + ((size_t)(layer * NSB + b) * 4 + h) * DK * 64 + part * CW;
#pragma unroll
    for (int i = 0; i < KPL; ++i) S[i] = sin_[(kg * KPL + i) * 64 + col];
  } else {
#pragma unroll
    for (int i = 0; i < KPL; ++i) S[i] = 0.f;
  }
  if (MIX == 0) {
    for (int e = tid; e < 3 * RS; e += 256) { const int j = e / RS, r = e % RS;
      const int cc = (r < 64) ? (h * 64 + r) : (r < 128) ? (256 + h * 64 + r - 64) : (512 + h * 64 + part * CW + r - 128);
      float v = 0.f; if (smp) v = p.I(2)[((size_t)(layer * NSB + b) * 3 + j) * 768 + cc];
      rawb[e] = (bf16_t)f2bf(v); }
  }
  __syncthreads();

  int ntok_last = 0;
  for (int t0 = 0; t0 < T; t0 += 32) {
    const int ntok = min(32, T - t0);
    ntok_last = ntok;
    const bool valid = tt < ntok;
    float* dst = qkdv + tt * 256;
    if (MIX != 0 && valid) {
      if (VN == 4) *(f32x4*)(dst + 192 + sub * 4) = (f32x4){bflo(R2.x), bfhi(R2.x), bflo(R2.y), bfhi(R2.y)};
      else *(float2*)(dst + 192 + sub * 2) = make_float2(bflo(R2.x), bfhi(R2.x));
    }
    if (MIX == 0) {
      if (valid) {
        *(uint4*)(rawb + (3 + tt) * RS + 0 + sub * 8) = R0;
        *(uint4*)(rawb + (3 + tt) * RS + 64 + sub * 8) = R1;
        if (VN == 4) *(uint2*)(rawb + (3 + tt) * RS + 128 + sub * 4) = R2;
        else *(unsigned*)(rawb + (3 + tt) * RS + 128 + sub * 2) = R2.x;
      }
      __syncthreads();
      if (valid) {
        float xq[8], xk[8], xv[VN];
        convN<8, RS>(rawb, cwl, tt, sub * 8, xq);
        convN<8, RS>(rawb, cwl, tt, 64 + sub * 8, xk);
        convN<VN, RS>(rawb, cwl, tt, 128 + sub * VN, xv);
#pragma unroll
        for (int i = 0; i < VN; ++i) dst[192 + sub * VN + i] = xv[i];
        float ssq = 0.f, ssk = 0.f;
#pragma unroll
        for (int i = 0; i < 8; ++i) { ssq += xq[i] * xq[i]; ssk += xk[i] * xk[i]; }
        ssq = red8d(ssq); ssk = red8d(ssk);
        const float rq = rsqrtf(ssq + 1e-6f) * 0.125f, rk = rsqrtf(ssk + 1e-6f);
        float qk = 0.f;
#pragma unroll
        for (int i = 0; i < 8; ++i) { xq[i] *= rq; xk[i] *= rk; qk += xq[i] * xk[i]; }
        qk = red8d(qk);
        *(f32x4*)(dst + sub * 8) = (f32x4){xq[0], xq[1], xq[2], xq[3]}; *(f32x4*)(dst + sub * 8 + 4) = (f32x4){xq[4], xq[5], xq[6], xq[7]};
        *(f32x4*)(dst + 64 + sub * 8) = (f32x4){xk[0], xk[1], xk[2], xk[3]}; *(f32x4*)(dst + 64 + sub * 8 + 4) = (f32x4){xk[4], xk[5], xk[6], xk[7]};
        if (sub == 0) {
          const float be = sigmoidf_(bflo(ex0)), al = bflo(ex1);
          const float a = __expf(-Aexp * softplusf_(al + dtb));
          *(f32x4*)(scal + tt * 4) = (f32x4){a, be, qk, 0.f};
        }
      }
    } else if (MIX == 1) {
      if (valid) {
        float q[8], z[8]; unpack8(R0, q); unpack8(R1, z);
        float kk[8], dd[8];
#pragma unroll
        for (int i = 0; i < 8; ++i) { q[i] = siluf_(q[i]); kk[i] = c8[i] * sigmoidf_(-z[i]); dd[i] = 1.0f - fminf(kk[i], 1.0f - 1e-6f); }
        *(f32x4*)(dst + sub * 8) = (f32x4){q[0], q[1], q[2], q[3]}; *(f32x4*)(dst + sub * 8 + 4) = (f32x4){q[4], q[5], q[6], q[7]};
        *(f32x4*)(dst + 64 + sub * 8) = (f32x4){kk[0], kk[1], kk[2], kk[3]}; *(f32x4*)(dst + 64 + sub * 8 + 4) = (f32x4){kk[4], kk[5], kk[6], kk[7]};
        *(f32x4*)(dst + 128 + sub * 8) = (f32x4){dd[0], dd[1], dd[2], dd[3]}; *(f32x4*)(dst + 128 + sub * 8 + 4) = (f32x4){dd[4], dd[5], dd[6], dd[7]};
      }
    } else if (MIX == 2) {
      if (valid) {
        float lr[16]; unpack8(R1, lr); unpack8(R4, lr + 8);
        const float q0 = bflo(R0.x), q1 = bfhi(R0.x), q2 = bflo(R0.y), q3 = bfhi(R0.y);
        const float k0 = bflo(R0.z), k1 = bfhi(R0.z), k2 = bflo(R0.w), k3 = bfhi(R0.w);
        const float sc = 0.17677669529663687f;
        f32x4 xg = (f32x4){c8[0], c8[1], c8[2], c8[3]};
#pragma unroll
        for (int r = 0; r < 16; ++r) xg += lr[r] * *(const f32x4*)(wgl + r * 32 + sub * 4);
        f32x4 dd;
#pragma unroll
        for (int i = 0; i < 4; ++i) { const float ls = fminf(xg[i], 0.f) - __logf(1.0f + __expf(-fabsf(xg[i]))); dd[i] = __expf(ls * 0.0625f); }
        *(f32x4*)(dst + sub * 4) = (f32x4){q0 * sc, q1 * sc, q2 * sc, q3 * sc};
        *(f32x4*)(dst + 64 + sub * 4) = (f32x4){k0, k1, k2, k3};
        *(f32x4*)(dst + 128 + sub * 4) = dd;
      }
    } else {
      if (valid) {
        const float ql[4] = {bflo(R0.x), bfhi(R0.x), bflo(R0.y), bfhi(R0.y)}, qh[4] = {bflo(R0.z), bfhi(R0.z), bflo(R0.w), bfhi(R0.w)};
        const float kl[4] = {bflo(R1.x), bfhi(R1.x), bflo(R1.y), bfhi(R1.y)}, kh[4] = {bflo(R1.z), bfhi(R1.z), bflo(R1.w), bfhi(R1.w)};
        const float cc[4] = {__uint_as_float(R4.x), __uint_as_float(R4.z), __uint_as_float(R5.x), __uint_as_float(R5.z)};
        const float sn[4] = {__uint_as_float(R4.y), __uint_as_float(R4.w), __uint_as_float(R5.y), __uint_as_float(R5.w)};
        f32x4 qa, qb, ka, kb;
#pragma unroll
        for (int i = 0; i < 4; ++i) {
          qa[i] = ql[i] * cc[i] - qh[i] * sn[i]; qb[i] = ql[i] * sn[i] + qh[i] * cc[i];
          ka[i] = (kl[i] * cc[i] - kh[i] * sn[i]) * 0.125f; kb[i] = (kl[i] * sn[i] + kh[i] * cc[i]) * 0.125f;
        }
        *(f32x4*)(dst + sub * 4) = qa; *(f32x4*)(dst + 32 + sub * 4) = qb;
        *(f32x4*)(dst + 64 + sub * 4) = ka; *(f32x4*)(dst + 96 + sub * 4) = kb;
      }
    }
    __syncthreads();
    if (MIX == 0 && t0 + 32 < T) {
      if (tid < 3 * RS / 8) { const uint4 v = *(const uint4*)(rawb + 32 * RS + tid * 8); *(uint4*)(rawb + tid * 8) = v; }
    }
    if (t0 + 32 < T) load_chunk_fn<MIX, VN>(p.W(), Pb, t0 + 32 + tt, T, h, vcol, sub, posb, R0, R1, R2, R4, R5, ex0, ex1);
    {
      StepIn<MIX, KPL> sa, sb;
      float osave = 0.f;
      load_step<MIX, KPL>(qkdv, scal, 0, kg, col, sa);
      for (int t = 0; t < ntok; t += 2) {
        load_step<MIX, KPL>(qkdv, scal, t + 1, kg, col, sb);
        __builtin_amdgcn_sched_barrier(0);
        const float oa = do_step<MIX, KPL, KG>(sa, S, gam);
        osave = (kg == (t & (KG - 1))) ? oa : osave;
        load_step<MIX, KPL>(qkdv, scal, min(t + 2, ntok - 1), kg, col, sa);
        __builtin_amdgcn_sched_barrier(0);
        const float ob = do_step<MIX, KPL, KG>(sb, S, gam);
        osave = (kg == ((t + 1) & (KG - 1))) ? ob : osave;
        if (((t + 2) & (KG - 1)) == 0) obuf[(t + 2 - KG + kg) * CW + col] = osave;
      }
      const int remn = ntok & (KG - 1);
      if (remn != 0 && kg < remn) obuf[(ntok - remn + kg) * CW + col] = osave;
    }
    __syncthreads();
    if (valid) {
      float o[VN];
#pragma unroll
      for (int i = 0; i < VN; ++i) o[i] = obuf[tt * CW + sub * VN + i];
      float s1 = 0.f, s2 = 0.f;
#pragma unroll
      for (int i = 0; i < VN; ++i) { s1 += o[i]; s2 += o[i] * o[i]; }
      s1 = red8d(s1); s2 = red8d(s2);
      if (VN == 4) { uint2 o2; o2.x = pk2(o[0], o[1]); o2.y = pk2(o[2 % VN], o[3 % VN]); *(uint2*)(Ob + (size_t)(t0 + tt) * 1024 + sub * 4) = o2; }
      else *(unsigned*)(Ob + (size_t)(t0 + tt) * 1024 + sub * 2) = pk2(o[0], o[1]);
      if (sub == 0) *(float2*)(PS + (size_t)(t0 + tt) * 128) = make_float2(s1, s2);
    }
  }
  {
    const size_t obase = (MIX == 0) ? (smp ? O_DS : O_DP) : (MIX == 1) ? (smp ? O_HS : O_HP) : (MIX == 2) ? (smp ? O_GS : O_GP) : (smp ? O_RS : O_RP);
    float* so = p.O() + obase + ((size_t)(layer * nBatch + b) * 4 + h) * DK * 64 + part * CW;
#pragma unroll
    for (int i = 0; i < KPL; ++i) so[(kg * KPL + i) * 64 + col] = S[i];
  }
  if (MIX == 0) {
    float* co = p.O() + (smp ? O_CS : O_CP) + (size_t)(layer * nBatch + b) * 3 * 768;
    for (int e = tid; e < 3 * RS; e += 256) { const int j = e / RS, r = e % RS;
      const float v = bflo((unsigned)rawb[(ntok_last + j) * RS + r]);
      if (r < 128) { if (part == 0) co[j * 768 + ((r < 64) ? (h * 64 + r) : (256 + h * 64 + r - 64))] = v; }
      else co[j * 768 + 512 + h * 64 + part * CW + r - 128] = v; }
  }
  __syncthreads();
  }
}

constexpr int ITEMS_PER_SEQ = 40;
__device__ __forceinline__ void scan_dispatch(const Params& p, int layer, int smp, int type, int b0, int bstep, int bend, char* lds, const int tid) {
  const int r = type;
  if (r < 16) scan_part<0>(p, layer, smp, b0, bstep, bend, r >> 2, r & 3, lds, tid);
  else {
    const int r2 = r - 16, mh = 4 + (r2 >> 1), part = r2 & 1, mix = mh >> 2, h = mh & 3;
    if (mix == 1) scan_part<1>(p, layer, smp, b0, bstep, bend, h, part, lds, tid);
    else if (mix == 2) scan_part<2>(p, layer, smp, b0, bstep, bend, h, part, lds, tid);
    else scan_part<3>(p, layer, smp, b0, bstep, bend, h, part, lds, tid);
  }
}

__device__ __forceinline__ int long_item_type(int u, int& b) {
  int type;
  if (u < 64) { b = u >> 3; type = 24 + (u & 7); }
  else if (u < 192) { const int v = u - 64; b = v >> 4; type = v & 15; }
  else if (u < 256) { const int v = u - 192; b = v >> 3; type = 16 + (v & 7); }
  else { const int v = u - 256; b = v >> 3; type = 32 + (v & 7); }
  return type;
}
__device__ __forceinline__ void scan_phase(const Params& p, int layer, char* lds, int bid, int nb, const int tid, const int role, const int ci, const int nprim, const int nsec) {
  constexpr int NPI = NB * ITEMS_PER_SEQ;
  const bool paired = (nprim == 256 && nsec == 256);
  int j = -1, nbs = 1;
  if (paired) {
    int u = -1;
    if (role == 0) u = ci; else if (ci < NPI - 256) u = 256 + ci;
    if (u >= 0) { int b; const int type = long_item_type(u, b); scan_dispatch(p, layer, 0, type, b, 1, b + 1, lds, tid); }
    else { j = ci - (NPI - 256); nbs = 256 - (NPI - 256); }
  } else {
    for (int u = bid; u < NPI; u += nb) { int b; const int type = long_item_type(u, b); scan_dispatch(p, layer, 0, type, b, 1, b + 1, lds, tid); }
    nbs = (nb > NPI) ? nb - NPI : nb; j = (nb > NPI) ? bid - NPI : bid;
  }
  if (j >= 0) {
    const int nsl = (nbs + ITEMS_PER_SEQ - 1) / ITEMS_PER_SEQ;
    for (int jj = j; jj < ITEMS_PER_SEQ * nsl; jj += nbs) scan_dispatch(p, layer, 1, jj % ITEMS_PER_SEQ, jj / ITEMS_PER_SEQ, nsl, NSB, lds, tid);
    if (layer == 0) { __syncthreads(); convert_weights(p, lds, 3360 + j, 6720, nbs, tid); }
  }
}

__device__ __forceinline__ void norm_phase(const Params& p, int layer, int bid, int nb, const int tid) {
  bf16_t* O = (bf16_t*)p.O();
  const bf16_t* P = (const bf16_t*)(p.W() + OFF_P);
  const float* PS = (const float*)((const unsigned char*)p.O() + DOUT_PS);
  const int cg8 = tid & 127;
  const int mh = cg8 >> 3, mix = mh >> 2, h = mh & 3, j0 = (cg8 & 7) * 8;
  const int gcol = (mix == 0) ? 776 : (mix == 1) ? 1800 : (mix == 2) ? 2584 : 3608;
  const float* gsrc = (mix == 0) ? p.I(14) : (mix == 1) ? p.I(16) : (mix == 2) ? p.I(19) : p.I(20);
  float g8[8];
#pragma unroll
  for (int i = 0; i < 8; ++i) g8[i] = gsrc[layer * 256 + h * 64 + j0 + i];
  for (int row = bid * 2 + (tid >> 7); row < MT; row += nb * 2) {
    const uint4 ov = *(const uint4*)(O + (size_t)row * 1024 + cg8 * 8);
    const uint4 gv = *(const uint4*)(P + (size_t)row * DINP + gcol + h * 64 + j0);
    const f32x4 ps = *(const f32x4*)(PS + (size_t)row * 128 + mh * 8);
    float s1 = ps[0] + ps[2], s2 = ps[1] + ps[3];
    if (mix == 0) { const f32x4 ps2 = *(const f32x4*)(PS + (size_t)row * 128 + mh * 8 + 4); s1 += ps2[0] + ps2[2]; s2 += ps2[1] + ps2[3]; }
    float o[8], gt[8]; unpack8(ov, o); unpack8(gv, gt);
    float mu = 0.f, rs;
    if (mix == 3) { mu = s1 * (1.0f / 64.0f); const float var = fmaxf(s2 * (1.0f / 64.0f) - mu * mu, 0.f); rs = rsqrtf(var + 1e-5f); }
    else rs = rsqrtf(s2 * (1.0f / 64.0f) + 1e-6f);
    float r[8];
#pragma unroll
    for (int i = 0; i < 8; ++i) r[i] = (o[i] - mu) * rs * g8[i] * siluf_(gt[i]);
    uint4 o4; o4.x = pk2(r[0], r[1]); o4.y = pk2(r[2], r[3]); o4.z = pk2(r[4], r[5]); o4.w = pk2(r[6], r[7]);
    *(uint4*)(O + (size_t)row * 1024 + cg8 * 8) = o4;
  }
}

constexpr int NPHASE = 17;
__global__ void __launch_bounds__(256, 2) hymba_fwd(Params p_, int ph_lo, int ph_hi) {
  __shared__ __attribute__((aligned(16))) char lds[65536];
  XcdBarrier xb; xb.bar = (unsigned*)(p_.ws + OFF_BAR); xb.x = xb_xcc_id(); xb.nloc = 0u; xb.nx = 0u;
  if (threadIdx.x == 0) (void)xb_add(&xb.bar[XB_XCNT(xb.x)], 1u);
  int role = 0, ci = 0;
  {
    const unsigned key = ((((unsigned)__builtin_amdgcn_s_getreg((31 << 11) | 4)) >> 8) & 0xFFu) | (xb.x << 8);
    if (threadIdx.x == 0) {
      const unsigned slot = xb_add(&xb.bar[CEN_TAB + key], 1u);
      unsigned r;
      if (slot == 0u) { r = xb_add(&xb.bar[CEN_CNT], 1u); __hip_atomic_store(&xb.bar[CEN_TAB2 + key], r + 1u, __ATOMIC_RELAXED, __HIP_MEMORY_SCOPE_AGENT); }
      else { (void)xb_add(&xb.bar[CEN_CNT + 1], 1u); r = 0u; }
      *(volatile unsigned*)(lds) = slot == 0u ? 0u : 1u; *(volatile unsigned*)(lds + 4) = r;
    }
    __syncthreads();
    role = (int)*(volatile unsigned*)(lds); ci = (int)*(volatile unsigned*)(lds + 4);
    __syncthreads();
    role = __builtin_amdgcn_readfirstlane(role); ci = __builtin_amdgcn_readfirstlane(ci);
    if (role != 0) ci = -1 - (int)key;
  }
  int nprim = 0, nsec = 0;
  if (ph_hi < 0) cg::this_grid().sync();
  for (int ph = ph_lo; ph < ph_hi; ++ph) {
    int tid = threadIdx.x, bid = blockIdx.x, nb = gridDim.x;
    asm volatile("" : "+v"(tid));
    asm volatile("" : "+s"(bid), "+s"(nb));
    if (ph > ph_lo) xcd_barrier(xb, tid, (unsigned)nb);
    if (ph == ph_lo + 1) {
      nprim = (int)xb_ld(&xb.bar[CEN_CNT]); nsec = (int)xb_ld(&xb.bar[CEN_CNT + 1]);
      if (role != 0) { const unsigned v = xb_ld(&xb.bar[CEN_TAB2 + (unsigned)(-1 - ci)]); ci = (v > 0u) ? (int)v - 1 : 0; }
      nprim = __builtin_amdgcn_readfirstlane(nprim); nsec = __builtin_amdgcn_readfirstlane(nsec); ci = __builtin_amdgcn_readfirstlane(ci);
    }
    const Params& p = p_;
    if (ph == 0) {
      convert_weights(p, lds, bid, 3360, nb, tid);
      embed_ln(p, bid, nb, tid);
      rope_table(p, bid, nb, tid);
    } else {
      const int l = (ph - 1) / 8, s = (ph - 1) % 8;
      const bf16_t* Xb = (const bf16_t*)p.O();
      bf16_t* X1b = (bf16_t*)(p.W() + OFF_X1B);
      bf16_t* Hb = (bf16_t*)(p.W() + OFF_H);
      float* X = (float*)(p.W() + OFF_X);
      if (s == 0) gemm_phase<EPI_BF16>(Xb, 1024, (const bf16_t*)(p.W() + OFF_WIN + l * SZ_WIN), 1024, 1024, DINP / 128, p.W() + OFF_P, DINP, lds, bid, nb, tid);
      else if (s == 1) scan_phase(p, l, lds, bid, nb, tid, role, ci, nprim, nsec);
      else if (s == 2) norm_phase(p, l, bid, nb, tid);
      else if (s == 3) gemm_phase<EPI_RESID>(Xb, 1024, (const bf16_t*)(p.W() + OFF_WOUT + l * SZ_WOUT), 1024, 1024, 8, X, 1024, lds, bid, nb, tid);
      else if (s == 4) ln_phase(p, p.I(22) + l * 1024, p.I(23) + l * 1024, X1b, 0, bid, nb, tid);
      else if (s == 5) gemm_phase<EPI_SWIGLU>(X1b, 1024, (const bf16_t*)(p.W() + OFF_WGU + l * SZ_WGU), 1024, 1024, 44, Hb, DFF, lds, bid, nb, tid);
      else if (s == 6) gemm_phase<EPI_RESID>(Hb, DFF, (const bf16_t*)(p.W() + OFF_WDN + l * SZ_WDN), DFF, DFF, 8, X, 1024, lds, bid, nb, tid);
      else ln_phase(p, p.I(27) + l * 1024, p.I(28) + l * 1024, (bf16_t*)p.O(), l == 1, bid, nb, tid);
    }
  }
}

extern "C" void kernel_launch(void* const* d_in, const int* in_sizes, int n_in, void* d_out, int out_size, void* d_ws, size_t ws_size,
                              hipStream_t stream) {
  (void)in_sizes; (void)out_size;
  if (n_in < 29 || ws_size < WS_NEED) { fprintf(stderr, "bad args: n_in %d ws %zu need %zu\n", n_in, ws_size, (size_t)WS_NEED); return; }
  Params p{};
  for (int i = 0; i < 29; ++i) p.in[i] = (const float*)d_in[i];
  p.out = (float*)d_out;
  p.ws = (unsigned char*)d_ws;
  static int grid_blocks = 0;
  if (!grid_blocks) {
    int dev = 0, cus = 0, per_cu = 0;
    (void)hipGetDevice(&dev);
    (void)hipDeviceGetAttribute(&cus, hipDeviceAttributeMultiprocessorCount, dev);
    (void)hipOccupancyMaxActiveBlocksPerMultiprocessor(&per_cu, hymba_fwd, 256, 0);
    if (per_cu > 2) per_cu = 2;
    if (per_cu < 1) per_cu = 1;
    grid_blocks = cus * per_cu;
  }
  (void)hipMemsetAsync((unsigned char*)d_ws + OFF_BAR, 0, BAR_BYTES, stream);
  int lo = 0, hi = NPHASE;
  void* args[] = {&p, &lo, &hi};
  hipError_t e = hipLaunchCooperativeKernel((void*)hymba_fwd, dim3(grid_blocks), dim3(256), args, 0, stream);
  if (e != hipSuccess) fprintf(stderr, "cooperative launch failed: %s (grid %d)\n", hipGetErrorString(e), grid_blocks);
}
```

```cpp
#include <hip/hip_runtime.h>
#include <hip/hip_cooperative_groups.h>
#include <cstdio>
#include <cstdint>
namespace cg = cooperative_groups;

#ifndef COOP
#define COOP 1
#endif

typedef unsigned short bf16_t;
typedef short bf16x8 __attribute__((ext_vector_type(8)));
typedef float f32x4 __attribute__((ext_vector_type(4)));

constexpr int DM = 1024, NB = 8, TPR = 2064, NSB = 128, TS = 4;
constexpr int MP = NB * TPR;
constexpr int MS = NSB * TS;
constexpr int MT = MP + MS;
constexpr int DIN = 3864, DINP = 3968, DFF = 2816;
constexpr float ALPHA = 1.41421356237309515f;

constexpr size_t SZ_WIN = (size_t)DINP * 1024 * 2, SZ_WOUT = (size_t)1024 * 1024 * 2, SZ_WGU = (size_t)5632 * 1024 * 2, SZ_WDN = (size_t)1024 * 2816 * 2;
constexpr size_t OFF_CS = 0;
constexpr size_t OFF_WIN = 532480;
constexpr size_t OFF_WOUT = OFF_WIN + 2 * SZ_WIN;
constexpr size_t OFF_WGU = OFF_WOUT + 2 * SZ_WOUT;
constexpr size_t OFF_WDN = OFF_WGU + 2 * SZ_WGU;
constexpr size_t OFF_X = OFF_WDN + 2 * SZ_WDN;
constexpr size_t OFF_P = OFF_X + (size_t)MT * 1024 * 4;
constexpr size_t OFF_X1B = OFF_P;
constexpr size_t OFF_H = OFF_P + (size_t)MT * 1024 * 2;
constexpr size_t OFF_BAR = OFF_P + (size_t)MT * DINP * 2;
constexpr int CEN_CNT = 3520, CEN_TAB = 4096, CEN_TAB2 = 8192;
constexpr size_t BAR_BYTES = 12288 * 4;
constexpr size_t WS_NEED = OFF_BAR + BAR_BYTES;
constexpr size_t DOUT_PS = 36000000;

constexpr size_t O_YP = 0, O_YS = 16777216, O_CP = 17301504, O_CS = 17338368, O_DP = 17928192, O_DS = 18190336,
                 O_HP = 22384640, O_HS = 22646784, O_GP = 26841088, O_GS = 26972160, O_RP = 29069312, O_RS = 29331456;

#define GAS __attribute__((address_space(1)))
struct Params {
  const float* in[29];
  float* out;
  unsigned char* ws;
  __device__ __forceinline__ const float* I(int i) const { return (const float*)(const GAS float*)in[i]; }
  __device__ __forceinline__ float* O() const { return (float*)(GAS float*)out; }
  __device__ __forceinline__ unsigned char* W() const { return (unsigned char*)(GAS unsigned char*)ws; }
};

__device__ __forceinline__ unsigned f2bf(float f) {
  unsigned u = __float_as_uint(f);
  u += 0x7fffu + ((u >> 16) & 1u);
  return u >> 16;
}
typedef float f32x2_t __attribute__((ext_vector_type(2)));
typedef __bf16 bf16x2_t __attribute__((ext_vector_type(2)));
__device__ __forceinline__ unsigned pk2(float lo, float hi) { const f32x2_t v = {lo, hi}; const bf16x2_t b = __builtin_convertvector(v, bf16x2_t); return __builtin_bit_cast(unsigned, b); }
__device__ __forceinline__ float bflo(unsigned u) { return __uint_as_float(u << 16); }
__device__ __forceinline__ float bfhi(unsigned u) { return __uint_as_float(u & 0xffff0000u); }
__device__ __forceinline__ void unpack8(const uint4& r, float* x) {
  x[0] = bflo(r.x); x[1] = bfhi(r.x); x[2] = bflo(r.y); x[3] = bfhi(r.y);
  x[4] = bflo(r.z); x[5] = bfhi(r.z); x[6] = bflo(r.w); x[7] = bfhi(r.w);
}
__device__ __forceinline__ float sigmoidf_(float x) { return __builtin_amdgcn_rcpf(1.0f + __expf(-x)); }
__device__ __forceinline__ float siluf_(float x) { return x * __builtin_amdgcn_rcpf(1.0f + __expf(-x)); }
__device__ __forceinline__ float softplusf_(float x) { return fmaxf(x, 0.f) + __logf(1.0f + __expf(-fabsf(x))); }
__device__ __forceinline__ float red8(float x) {
  x += __shfl_xor(x, 1); x += __shfl_xor(x, 2); x += __shfl_xor(x, 4); return x;
}
__device__ __forceinline__ float dpp_x1(float x) {
  return __int_as_float(__builtin_amdgcn_update_dpp(0, __float_as_int(x), 0xB1, 0xF, 0xF, true));
}
__device__ __forceinline__ float dpp_x2(float x) {
  return __int_as_float(__builtin_amdgcn_update_dpp(0, __float_as_int(x), 0x4E, 0xF, 0xF, true));
}
__device__ __forceinline__ float red4(float x) { x += dpp_x1(x); x += dpp_x2(x); return x; }
__device__ __forceinline__ float wave_sum(float x) {
#pragma unroll
  for (int o = 32; o >= 1; o >>= 1) x += __shfl_xor(x, o);
  return x;
}

__device__ __forceinline__ void convert_weights(const Params& p, char* lds, int w0, int w1, int wstep, const int tid) {
  float* tile = (float*)lds;
  for (int w = w0; w < w1; w += wstep) {
    const int l = w / 3360; int r = w % 3360;
    int mat, kt, rt;
    if (r < 992) { mat = 0; kt = r / 62; rt = r % 62; }
    else if (r < 1248) { r -= 992; mat = 1; kt = r / 16; rt = r % 16; }
    else if (r < 2656) { r -= 1248; mat = 2; kt = r / 88; rt = r % 88; }
    else { r -= 2656; mat = 3; kt = r / 16; rt = r % 16; }
    {
      const int r4 = (tid & 15) * 4, R = rt * 64 + r4, kq = tid >> 4;
      const float* src; int ns; bool valid = true;
      if (mat == 0) { const int rho = R & 31, scol = (R & ~31) + 8 * ((rho & 15) >> 2) + 4 * (rho >> 4) + (rho & 3);
        src = p.I(10) + (size_t)l * 1024 * DIN + scol; ns = DIN; valid = scol < DIN; }
      else if (mat == 1) { src = p.I(21) + (size_t)l * 1024 * 1024 + R; ns = 1024; }
      else if (mat == 2) { const int q = R & 63, f = q >> 4, i = q & 15, ty = f & 1, hid = (R >> 6) * 32 + 8 * (i >> 2) + 4 * (f >> 1) + (i & 3);
        src = (ty ? p.I(25) : p.I(24)) + (size_t)l * 1024 * DFF + hid; ns = DFF; }
      else { src = p.I(26) + (size_t)l * DFF * 1024 + R; ns = 1024; }
      f32x4 v[4];
#pragma unroll
      for (int i = 0; i < 4; ++i) v[i] = valid ? *(const f32x4*)(src + (size_t)(kt * 64 + kq + 16 * i) * ns) : (f32x4){0.f, 0.f, 0.f, 0.f};
#pragma unroll
      for (int i = 0; i < 4; ++i) {
        const int k = kq + 16 * i;
        tile[(r4 + 0) * 65 + k] = v[i][0]; tile[(r4 + 1) * 65 + k] = v[i][1]; tile[(r4 + 2) * 65 + k] = v[i][2]; tile[(r4 + 3) * 65 + k] = v[i][3];
      }
    }
    __syncthreads();
    {
      const int rr = tid >> 2, kc = (tid & 3) * 16;
      const int Kd = (mat == 3) ? DFF : 1024;
      bf16_t* base;
      if (mat == 0) base = (bf16_t*)(p.W() + OFF_WIN + l * SZ_WIN);
      else if (mat == 1) base = (bf16_t*)(p.W() + OFF_WOUT + l * SZ_WOUT);
      else if (mat == 2) base = (bf16_t*)(p.W() + OFF_WGU + l * SZ_WGU);
      else base = (bf16_t*)(p.W() + OFF_WDN + l * SZ_WDN);
      bf16_t* dst = base + (size_t)(rt * 64 + rr) * Kd + kt * 64 + kc;
      const float* s = tile + rr * 65 + kc;
      uint4 a, b;
      a.x = pk2(s[0], s[1]); a.y = pk2(s[2], s[3]); a.z = pk2(s[4], s[5]); a.w = pk2(s[6], s[7]);
      b.x = pk2(s[8], s[9]); b.y = pk2(s[10], s[11]); b.z = pk2(s[12], s[13]); b.w = pk2(s[14], s[15]);
      *(uint4*)dst = a; *(uint4*)(dst + 8) = b;
    }
    __syncthreads();
  }
}

__device__ __forceinline__ void ln_row_regs(f32x4 (&v)[4], const float* g, const float* bb, int lane) {
  float s = 0.f;
#pragma unroll
  for (int i = 0; i < 4; ++i) s += (v[i][0] + v[i][1]) + (v[i][2] + v[i][3]);
  const float mu = wave_sum(s) * (1.0f / 1024.0f);
  float q = 0.f;
#pragma unroll
  for (int i = 0; i < 4; ++i) { const f32x4 d = v[i] - mu; q += (d[0] * d[0] + d[1] * d[1]) + (d[2] * d[2] + d[3] * d[3]); }
  const float rs = rsqrtf(wave_sum(q) * (1.0f / 1024.0f) + 1e-5f);
#pragma unroll
  for (int i = 0; i < 4; ++i) {
    const f32x4 gg = *(const f32x4*)(g + lane * 4 + i * 256), b4 = *(const f32x4*)(bb + lane * 4 + i * 256);
    v[i] = (v[i] - mu) * rs * gg + b4;
  }
}

__device__ __forceinline__ void embed_ln(const Params& p, int bid, int nb, const int tid) {
  const int lane = tid & 63, wv = tid >> 6;
  float* X = (float*)(p.W() + OFF_X);
  bf16_t* Xb = (bf16_t*)p.O();
  for (int row = bid * 4 + wv; row < MT; row += nb * 4) {
    const float* src;
    if (row < MP) { const int b = row / TPR, t = row % TPR;
      src = (t < 16) ? p.I(7) + (size_t)t * 1024 : p.I(0) + ((size_t)b * 2048 + (t - 16)) * 1024; }
    else src = p.I(1) + (size_t)(row - MP) * 1024;
    f32x4 v[4];
#pragma unroll
    for (int i = 0; i < 4; ++i) v[i] = *(const f32x4*)(src + lane * 4 + i * 256);
    ln_row_regs(v, p.I(8), p.I(9), lane);
#pragma unroll
    for (int i = 0; i < 4; ++i) {
      *(f32x4*)(X + (size_t)row * 1024 + lane * 4 + i * 256) = v[i];
      uint2 o; o.x = pk2(v[i][0], v[i][1]); o.y = pk2(v[i][2], v[i][3]);
      *(uint2*)(Xb + (size_t)row * 1024 + lane * 4 + i * 256) = o;
    }
  }
}

__device__ __forceinline__ void rope_table(const Params& p, int bid, int nb, const int tid) {
  float2* cs = (float2*)(p.W() + OFF_CS);
  for (int e = bid * 256 + tid; e < 2068 * 32; e += nb * 256) {
    const int idx = e >> 5, i = e & 31;
    const double pos = (idx < 2064) ? (double)idx : (double)(16384 + idx - 2064);
    const double inv = exp(-((double)i / 31.0) * 9.210340371976184);
    const double ang = pos * inv;
    cs[e] = make_float2((float)cos(ang), (float)sin(ang));
  }
}

__device__ __forceinline__ void ln_phase(const Params& p, const float* g, const float* bb, bf16_t* xb, int final_, int bid, int nb, const int tid) {
  const int lane = tid & 63, wv = tid >> 6;
  float* X = (float*)(p.W() + OFF_X);
  f32x4 nx[4];
  {
    const int r0 = min(bid * 4 + wv, MT - 1);
#pragma unroll
    for (int i = 0; i < 4; ++i) nx[i] = *(const f32x4*)(X + (size_t)r0 * 1024 + lane * 4 + i * 256);
  }
  for (int row = bid * 4 + wv; row < MT; row += nb * 4) {
    f32x4 v[4];
#pragma unroll
    for (int i = 0; i < 4; ++i) v[i] = nx[i];
    {
      const int rn = min(row + nb * 4, MT - 1);
#pragma unroll
      for (int i = 0; i < 4; ++i) nx[i] = *(const f32x4*)(X + (size_t)rn * 1024 + lane * 4 + i * 256);
    }
    ln_row_regs(v, g, bb, lane);
    if (!final_) {
#pragma unroll
      for (int i = 0; i < 4; ++i) {
        *(f32x4*)(X + (size_t)row * 1024 + lane * 4 + i * 256) = v[i];
        uint2 o; o.x = pk2(v[i][0], v[i][1]); o.y = pk2(v[i][2], v[i][3]);
        *(uint2*)(xb + (size_t)row * 1024 + lane * 4 + i * 256) = o;
      }
    } else {
      float* dst = nullptr;
      if (row < MP) { const int b = row / TPR, t = row % TPR; if (t >= 16) dst = p.O() + O_YP + ((size_t)b * 2048 + (t - 16)) * 1024; }
      else dst = p.O() + O_YS + (size_t)(row - MP) * 1024;
      if (dst) {
#pragma unroll
        for (int i = 0; i < 4; ++i) *(f32x4*)(dst + lane * 4 + i * 256) = v[i];
      }
    }
  }
}

enum { EPI_BF16 = 0, EPI_RESID = 1, EPI_SWIGLU = 2 };

template <int EPI>
__device__ __forceinline__ void gemm_tile(const bf16_t* __restrict__ A, const int lda, const bf16_t* __restrict__ Bt, const int ldb,
                                          const int K, const int m0, const int n0, void* Cout, const int ldc, char* lds, const int tid) {
  const int wid = tid >> 6, lane = tid & 63, wr = wid >> 1, wc = wid & 1, fr = lane & 15, fq = lane >> 4;
  f32x4 acc[4][4];
#pragma unroll
  for (int m = 0; m < 4; ++m)
#pragma unroll
    for (int n = 0; n < 4; ++n) acc[m][n] = (f32x4){0.f, 0.f, 0.f, 0.f};
  const int nt = K >> 6;
  auto stage = [&](int kt, int buf) {
#pragma unroll
    for (int i = 0; i < 4; ++i) {
      const int off = tid * 16 + i * 4096;
      const int panel = off >> 13, rem = off & 8191, r = rem >> 6, c = (rem & 63) >> 1;
      const bf16_t* ga = A + (size_t)(m0 + r) * lda + kt * 64 + panel * 32 + c;
      const bf16_t* gb = Bt + (size_t)(n0 + r) * ldb + kt * 64 + panel * 32 + c;
      __builtin_amdgcn_global_load_lds((const unsigned*)ga, (__attribute__((address_space(3))) unsigned*)(lds + buf * 32768 + off), 16, 0, 0);
      __builtin_amdgcn_global_load_lds((const unsigned*)gb, (__attribute__((address_space(3))) unsigned*)(lds + buf * 32768 + 16384 + off), 16, 0, 0);
    }
  };
  stage(0, 0);
  for (int kt = 0; kt < nt; ++kt) {
    asm volatile("s_waitcnt vmcnt(0)" ::: "memory");
    __syncthreads();
    const char* sa = lds + (kt & 1) * 32768;
    const char* sb = sa + 16384;
    bf16x8 af[2][4], bfr[2][4];
#pragma unroll
    for (int ks = 0; ks < 2; ++ks) {
#pragma unroll
      for (int m = 0; m < 4; ++m) af[ks][m] = *(const bf16x8*)(sa + ks * 8192 + (wr * 64 + m * 16 + fr) * 64 + fq * 16);
#pragma unroll
      for (int n = 0; n < 4; ++n) bfr[ks][n] = *(const bf16x8*)(sb + ks * 8192 + (wc * 64 + n * 16 + fr) * 64 + fq * 16);
    }
    if (kt + 1 < nt) stage(kt + 1, (kt + 1) & 1);
#pragma unroll
    for (int ks = 0; ks < 2; ++ks)
#pragma unroll
      for (int m = 0; m < 4; ++m)
#pragma unroll
        for (int n = 0; n < 4; ++n) acc[m][n] = __builtin_amdgcn_mfma_f32_16x16x32_bf16(bfr[ks][n], af[ks][m], acc[m][n], 0, 0, 0);
  }
  if (EPI == EPI_RESID) {
    float* C0 = (float*)Cout + (size_t)(m0 + wr * 64 + fr) * ldc + n0 + wc * 64 + fq * 4;
    f32x4 xin[4][4];
#pragma unroll
    for (int m = 0; m < 4; ++m)
#pragma unroll
      for (int n = 0; n < 4; ++n) xin[m][n] = *(const f32x4*)(C0 + (size_t)m * 16 * ldc + n * 16);
#pragma unroll
    for (int m = 0; m < 4; ++m)
#pragma unroll
      for (int n = 0; n < 4; ++n) asm volatile("" : "+v"(xin[m][n]));
#pragma unroll
    for (int m = 0; m < 4; ++m)
#pragma unroll
      for (int n = 0; n < 4; ++n) *(f32x4*)(C0 + (size_t)m * 16 * ldc + n * 16) = xin[m][n] * ALPHA + acc[m][n];
    return;
  }
#pragma unroll
  for (int m = 0; m < 4; ++m) {
    const int row = m0 + wr * 64 + m * 16 + fr;
    if (EPI == EPI_BF16) {
      bf16_t* C = (bf16_t*)Cout + (size_t)row * ldc + n0 + wc * 64 + fq * 8;
#pragma unroll
      for (int pq = 0; pq < 2; ++pq) { uint4 o; o.x = pk2(acc[m][2 * pq][0], acc[m][2 * pq][1]); o.y = pk2(acc[m][2 * pq][2], acc[m][2 * pq][3]);
        o.z = pk2(acc[m][2 * pq + 1][0], acc[m][2 * pq + 1][1]); o.w = pk2(acc[m][2 * pq + 1][2], acc[m][2 * pq + 1][3]); *(uint4*)(C + pq * 32) = o; }
    } else if (EPI == EPI_RESID) {
      float* C = (float*)Cout + (size_t)row * ldc + n0 + wc * 64 + fq * 4;
#pragma unroll
      for (int n = 0; n < 4; ++n) { const f32x4 x = *(const f32x4*)(C + n * 16); *(f32x4*)(C + n * 16) = x * ALPHA + acc[m][n]; }
    } else {
      bf16_t* C = (bf16_t*)Cout + (size_t)row * ldc + (n0 >> 1) + wc * 32 + fq * 8;
      const f32x4 g0 = acc[m][0], u0 = acc[m][1], g1 = acc[m][2], u1 = acc[m][3];
      uint4 o; o.x = pk2(siluf_(g0[0]) * u0[0], siluf_(g0[1]) * u0[1]); o.y = pk2(siluf_(g0[2]) * u0[2], siluf_(g0[3]) * u0[3]);
      o.z = pk2(siluf_(g1[0]) * u1[0], siluf_(g1[1]) * u1[1]); o.w = pk2(siluf_(g1[2]) * u1[2], siluf_(g1[3]) * u1[3]);
      *(uint4*)C = o;
    }
  }
}
template <int EPI>
__device__ __forceinline__ void gemm_phase(const bf16_t* A, int lda, const bf16_t* Bt, int ldb, int K, int ntn, void* C, int ldc, char* lds, int bid, int nb, const int tid) {
  constexpr int GM = 4, nM = MT / 128;
  const int ntiles = nM * ntn, nig = GM * ntn;
  const int pos = (EPI == EPI_BF16 && (nb & 7) == 0) ? (bid & 7) * (nb >> 3) + (bid >> 3) : bid;
  for (int L = pos; L < ntiles; L += nb) {
    int mt, nn;
    if (EPI != EPI_BF16) { mt = L / ntn; nn = L % ntn; }
    else { const int gid = L / nig, fm = gid * GM, gsz = min(nM - fm, GM), rem = L - gid * nig; mt = fm + rem % gsz; nn = rem / gsz; }
    gemm_tile<EPI>(A, lda, Bt, ldb, K, mt * 128, nn * 128, C, ldc, lds, tid);
  }
}

#define XB_TMO      128
#define XB_XCNT(j)  (256  + 64 * (j))
#define XB_XSUB(j)  (1280 + 64 * (j))
#define XB_XGEN(j)  (2304 + 64 * (j))
#define XB_TOP      3328
#define XB_TOPGEN   3392
#define XCD_BAR_WORDS 3456
#define XB_SPIN_CAP (1u << 22)
__device__ __forceinline__ unsigned xb_ld(unsigned* p) { return __hip_atomic_load(p, __ATOMIC_RELAXED, __HIP_MEMORY_SCOPE_AGENT); }
__device__ __forceinline__ unsigned xb_add(unsigned* p, unsigned v) { return __hip_atomic_fetch_add(p, v, __ATOMIC_RELAXED, __HIP_MEMORY_SCOPE_AGENT); }
__device__ __forceinline__ unsigned xb_xcc_id() { return (unsigned)__builtin_amdgcn_s_getreg((3 << 11) | 20) & 0xFu; }
#define XB_SPIN(cond, bar) do { unsigned _sp = 0; while (cond) { __builtin_amdgcn_s_sleep(1); \
    if ((++_sp & 255u) == 0u) { if (xb_ld(&(bar)[XB_TMO])) break; if (_sp > XB_SPIN_CAP) { atomicAdd(&(bar)[XB_TMO], 1u); break; } } } } while (0)
struct XcdBarrier { unsigned* bar; unsigned x; unsigned nloc, nx; };
__device__ __forceinline__ void xcd_barrier_complete(unsigned* bar, unsigned x, unsigned G, unsigned& nloc, unsigned& nx) {
  unsigned sum, cnt, mine, sp = 0u;
  for (;;) {
    sum = 0u; cnt = 0u; mine = 0u;
#pragma unroll
    for (unsigned j = 0; j < 16; ++j) { const unsigned c = xb_ld(&bar[XB_XCNT(j)]); sum += c; cnt += (c > 0u) ? 1u : 0u; mine = (j == x) ? c : mine; }
    if (sum == G) break;
    __builtin_amdgcn_s_sleep(1);
    if ((++sp & 255u) == 0u) { if (xb_ld(&bar[XB_TMO])) break; if (sp > XB_SPIN_CAP) { atomicAdd(&bar[XB_TMO], 1u); break; } }
  }
  nloc = mine > 0u ? mine : 1u; nx = cnt > 0u ? cnt : 1u;
}
__device__ __forceinline__ void xcd_barrier(XcdBarrier& b, const int tid, const unsigned G) {
  asm volatile("s_waitcnt vmcnt(0)" ::: "memory");
  __syncthreads();
  if (tid == 0) {
    unsigned* bar = b.bar;
    __builtin_amdgcn_s_waitcnt(0);
    if (b.nloc == 0u) xcd_barrier_complete(bar, b.x, G, b.nloc, b.nx);
    const unsigned nloc = b.nloc, nx = b.nx;
    const unsigned old = xb_add(&bar[XB_XSUB(b.x)], 1u);
    const unsigned gen = old / nloc;
    if (old + 1u == (gen + 1u) * nloc) {
      __builtin_amdgcn_fence(__ATOMIC_RELEASE, "agent");
      asm volatile("s_waitcnt vmcnt(0)" ::: "memory");
      const unsigned og = xb_add(&bar[XB_TOP], 1u);
      const unsigned tg = og / nx;
      if (og + 1u == (tg + 1u) * nx) xb_add(&bar[XB_TOPGEN], 1u);
      else XB_SPIN(xb_ld(&bar[XB_TOPGEN]) == tg, bar);
      __builtin_amdgcn_fence(__ATOMIC_ACQUIRE, "agent");
      xb_add(&bar[XB_XGEN(b.x)], 1u);
      asm volatile("s_waitcnt vmcnt(0)" ::: "memory");
    } else {
      XB_SPIN(xb_ld(&bar[XB_XGEN(b.x)]) == gen, bar);
      __builtin_amdgcn_fence(__ATOMIC_ACQUIRE, "agent");
      asm volatile("s_waitcnt vmcnt(0)" ::: "memory");
    }
  }
  __syncthreads();
}

template <int N, int RS>
__device__ __forceinline__ void convN(const bf16_t* rawb, const float* cwl, int tt, int off, float (&x)[N]) {
#pragma unroll
  for (int i = 0; i < N; ++i) x[i] = 0.f;
#pragma unroll
  for (int j = 0; j < 4; ++j) {
    float xv[N];
    if (N == 8) { const uint4 rv = *(const uint4*)(rawb + (tt + j) * RS + off); unpack8(rv, xv); }
    else if (N == 4) { const uint2 rv = *(const uint2*)(rawb + (tt + j) * RS + off); xv[0] = bflo(rv.x); xv[1] = bfhi(rv.x); xv[2 % N] = bflo(rv.y); xv[3 % N] = bfhi(rv.y); }
    else { const unsigned rv = *(const unsigned*)(rawb + (tt + j) * RS + off); xv[0] = bflo(rv); xv[1] = bfhi(rv); }
#pragma unroll
    for (int i = 0; i < N; ++i) x[i] += cwl[j * RS + off + i] * xv[i];
  }
#pragma unroll
  for (int i = 0; i < N; ++i) asm volatile("" : "+v"(x[i]));
#pragma unroll
  for (int i = 0; i < N; ++i) x[i] = siluf_(x[i]);
}

template <int MIX, int VN>
__device__ __forceinline__ void load_chunk_fn(const unsigned char* ws, const bf16_t* Pb, const int t, const int T, const int h, const int vcol, const int sub, const int posb,
                                              uint4& R0, uint4& R1, uint2& R2, uint4& R4, uint4& R5, unsigned& ex0, unsigned& ex1) {
  if (t < T) {
    const bf16_t* pr = Pb + (size_t)t * DINP;
    const int vbase = (MIX == 0) ? 512 : (MIX == 1) ? 1544 : (MIX == 2) ? 2312 : 3352;
    if (VN == 4) R2 = *(const uint2*)(pr + vbase + h * 64 + vcol);
    else R2.x = *(const unsigned*)(pr + vbase + h * 64 + vcol);
    if (MIX == 0) {
      R0 = *(const uint4*)(pr + 0 + h * 64 + sub * 8); R1 = *(const uint4*)(pr + 256 + h * 64 + sub * 8);
      ex0 = pr[768 + h]; ex1 = pr[772 + h];
    } else if (MIX == 1) {
      R0 = *(const uint4*)(pr + 1032 + h * 64 + sub * 8); R1 = *(const uint4*)(pr + 1288 + h * 64 + sub * 8);
    } else if (MIX == 2) {
      const uint2 q2 = *(const uint2*)(pr + 2056 + h * 32 + sub * 4), k2 = *(const uint2*)(pr + 2184 + h * 32 + sub * 4);
      R0 = make_uint4(q2.x, q2.y, k2.x, k2.y);
      R1 = *(const uint4*)(pr + 2568); R4 = *(const uint4*)(pr + 2576);
    } else {
      const uint2 ql = *(const uint2*)(pr + 2840 + h * 64 + sub * 4), qh = *(const uint2*)(pr + 2840 + h * 64 + 32 + sub * 4);
      const uint2 kl = *(const uint2*)(pr + 3096 + h * 64 + sub * 4), kh = *(const uint2*)(pr + 3096 + h * 64 + 32 + sub * 4);
      R0 = make_uint4(ql.x, ql.y, qh.x, qh.y); R1 = make_uint4(kl.x, kl.y, kh.x, kh.y);
      const uint4* cs = (const uint4*)(ws + OFF_CS + ((size_t)(posb + t) * 32 + sub * 4) * 8);
      R4 = cs[0]; R5 = cs[1];
    }
  }
}

__device__ __forceinline__ float dpp_hm(float x) {
  return __int_as_float(__builtin_amdgcn_update_dpp(0, __float_as_int(x), 0x141, 0xF, 0xF, true));
}
__device__ __forceinline__ float dpp_rm(float x) {
  return __int_as_float(__builtin_amdgcn_update_dpp(0, __float_as_int(x), 0x140, 0xF, 0xF, true));
}
__device__ __forceinline__ float red8d(float x) { x += dpp_x1(x); x += dpp_x2(x); x += dpp_hm(x); return x; }
template <int KG> __device__ __forceinline__ float redKG(float x) { x = red8d(x); if (KG == 16) x += dpp_rm(x); return x; }

template <int MIX, int KPL>
struct StepIn { float q[KPL], k[KPL], d[KPL]; float v, a, be, qk; };

template <int MIX, int KPL>
__device__ __forceinline__ void load_step(const float* qkdv, const float* scal, int t, int kg, int col, StepIn<MIX, KPL>& s) {
  const float* base = qkdv + t * 256;
#pragma unroll
  for (int i = 0; i < KPL; i += 4) {
    const f32x4 a = *(const f32x4*)(base + kg * KPL + i), b = *(const f32x4*)(base + 64 + kg * KPL + i);
    s.q[i] = a[0]; s.q[i + 1] = a[1]; s.q[i + 2] = a[2]; s.q[i + 3] = a[3];
    s.k[i] = b[0]; s.k[i + 1] = b[1]; s.k[i + 2] = b[2]; s.k[i + 3] = b[3];
    if (MIX == 1 || MIX == 2) { const f32x4 d = *(const f32x4*)(base + 128 + kg * KPL + i); s.d[i] = d[0]; s.d[i + 1] = d[1]; s.d[i + 2] = d[2]; s.d[i + 3] = d[3]; }
  }
  s.v = base[192 + col];
  if (MIX == 0) { const f32x4 c = *(const f32x4*)(scal + t * 4); s.a = c[0]; s.be = c[1]; s.qk = c[2]; }
}

template <int MIX, int KPL, int KG>
__device__ __forceinline__ float do_step(const StepIn<MIX, KPL>& s, float (&S)[KPL], const float gam) {
  if (MIX == 0) {
    float kS0 = 0.f, kS1 = 0.f, qS0 = 0.f, qS1 = 0.f;
#pragma unroll
    for (int i = 0; i < KPL; i += 2) { kS0 += s.k[i] * S[i]; kS1 += s.k[i + 1] * S[i + 1]; qS0 += s.q[i] * S[i]; qS1 += s.q[i + 1] * S[i + 1]; }
    const float kS = redKG<KG>(kS0 + kS1), qS = redKG<KG>(qS0 + qS1);
    const float w = s.be * (s.v - s.a * kS);
#pragma unroll
    for (int i = 0; i < KPL; ++i) S[i] = s.a * S[i] + s.k[i] * w;
    return s.a * qS + s.qk * w;
  } else {
    float o0 = 0.f, o1 = 0.f;
#pragma unroll
    for (int i = 0; i < KPL; i += 2) {
      const float d0 = (MIX == 3) ? gam : s.d[i], d1 = (MIX == 3) ? gam : s.d[i + 1];
      S[i] = d0 * S[i] + s.k[i] * s.v; S[i + 1] = d1 * S[i + 1] + s.k[i + 1] * s.v;
      o0 += s.q[i] * S[i]; o1 += s.q[i + 1] * S[i + 1];
    }
    return redKG<KG>(o0 + o1);
  }
}

template <int MIX>
__device__ __forceinline__ void scan_part(const Params& p, const int layer, const int smp, const int b0, const int bstep, const int bend, const int h, const int part, char* lds, const int tid) {
  constexpr int DK = (MIX == 2) ? 32 : 64;
  constexpr int NS = (MIX == 0) ? 4 : 2;
  constexpr int CW = 64 / NS;
  constexpr int CPW = CW / 4;
  constexpr int KG = 64 / CPW;
  constexpr int KPL = DK / KG;
  constexpr int VN = CW / 8;
  constexpr int RS = 128 + CW;
  float* qkdv = (float*)lds;
  float* obuf = (float*)(lds + 32768);
  float* scal = (float*)(lds + 36864);
  bf16_t* rawb = (bf16_t*)(lds + 37376);
  float* cwl = (float*)(lds + 48576);
  float* wgl = (float*)(lds + 37376);

  const int lane = tid & 63, wv = tid >> 6;
  const int tt = tid >> 3, sub = tid & 7;
  const int col = wv * CPW + lane / KG, kg = lane % KG;
  const int T = smp ? 4 : TPR;
  const int nBatch = smp ? NSB : NB;
  const int posb = smp ? 2064 : 0;
  const int vcol = part * CW + sub * VN;
  __syncthreads();
  float c8[8];
  float Aexp = 0.f, dtb = 0.f, gam = 0.f;
  if (MIX == 0) {
    Aexp = __expf(p.I(12)[layer * 4 + h]); dtb = p.I(13)[layer * 4 + h];
    for (int e = tid; e < 4 * RS; e += 256) { const int j = e / RS, r = e % RS;
      const int cc = (r < 64) ? (h * 64 + r) : (r < 128) ? (256 + h * 64 + r - 64) : (512 + h * 64 + part * CW + r - 128);
      cwl[e] = p.I(11)[(size_t)(layer * 4 + j) * 768 + cc]; }
  } else if (MIX == 1) {
#pragma unroll
    for (int i = 0; i < 8; ++i) {
      const int d = h * 64 + sub * 8 + i;
      c8[i] = (layer == 0) ? 1.0f : sigmoidf_(p.I(15)[d] - p.I(15)[256 + d]);
    }
  } else if (MIX == 2) {
    for (int e = tid; e < 512; e += 256) { const int r = e >> 5, j = e & 31; wgl[e] = p.I(17)[(size_t)(layer * 16 + r) * 128 + h * 32 + j]; }
#pragma unroll
    for (int i = 0; i < 4; ++i) c8[i] = p.I(18)[layer * 128 + h * 32 + sub * 4 + i];
  } else {
    gam = 1.0f - exp2f(-5.0f - (float)h);
  }
  for (int b = b0; b < bend; b += bstep) {
  const int row0 = smp ? MP + b * 4 : b * TPR;
  const bf16_t* Pb = (const bf16_t*)(p.W() + OFF_P) + (size_t)row0 * DINP;
  bf16_t* Ob = (bf16_t*)p.O() + (size_t)row0 * 1024 + MIX * 256 + h * 64 + part * CW;
  float* PS = (float*)((unsigned char*)p.O() + DOUT_PS) + (size_t)row0 * 128 + (MIX * 4 + h) * 8 + part * 2;
  uint4 R0 = make_uint4(0, 0, 0, 0), R1 = R0, R4 = R0, R5 = R0; uint2 R2 = make_uint2(0, 0); unsigned ex0 = 0, ex1 = 0;
  load_chunk_fn<MIX, VN>(p.W(), Pb, tt, T, h, vcol, sub, posb, R0, R1, R2, R4, R5, ex0, ex1);
  float S[KPL];
  if (smp) {
    const float* sin_ = p.I(3 + MIX) + ((size_t)(layer * NSB + b) * 4 + h) * DK * 64 + part * CW;
#pragma unroll
    for (int i = 0; i < KPL; ++i) S[i] = sin_[(kg * KPL + i) * 64 + col];
  } else {
#pragma unroll
    for (int i = 0; i < KPL; ++i) S[i] = 0.f;
  }
  if (MIX == 0) {
    for (int e = tid; e < 3 * RS; e += 256) { const int j = e / RS, r = e % RS;
      const int cc = (r < 64) ? (h * 64 + r) : (r < 128) ? (256 + h * 64 + r - 64) : (512 + h * 64 + part * CW + r - 128);
      float v = 0.f; if (smp) v = p.I(2)[((size_t)(layer * NSB + b) * 3 + j) * 768 + cc];
      rawb[e] = (bf16_t)f2bf(v); }
  }
  __syncthreads();

  int ntok_last = 0;
  for (int t0 = 0; t0 < T; t0 += 32) {
    const int ntok = min(32, T - t0);
    ntok_last = ntok;
    const bool valid = tt < ntok;
    float* dst = qkdv + tt * 256;
    if (MIX != 0 && valid) {
      if (VN == 4) *(f32x4*)(dst + 192 + sub * 4) = (f32x4){bflo(R2.x), bfhi(R2.x), bflo(R2.y), bfhi(R2.y)};
      else *(float2*)(dst + 192 + sub * 2) = make_float2(bflo(R2.x), bfhi(R2.x));
    }
    if (MIX == 0) {
      if (valid) {
        *(uint4*)(rawb + (3 + tt) * RS + 0 + sub * 8) = R0;
        *(uint4*)(rawb + (3 + tt) * RS + 64 + sub * 8) = R1;
        if (VN == 4) *(uint2*)(rawb + (3 + tt) * RS + 128 + sub * 4) = R2;
        else *(unsigned*)(rawb + (3 + tt) * RS + 128 + sub * 2) = R2.x;
      }
      __syncthreads();
      if (valid) {
        float xq[8], xk[8], xv[VN];
        convN<8, RS>(rawb, cwl, tt, sub * 8, xq);
        convN<8, RS>(rawb, cwl, tt, 64 + sub * 8, xk);
        convN<VN, RS>(rawb, cwl, tt, 128 + sub * VN, xv);
#pragma unroll
        for (int i = 0; i < VN; ++i) dst[192 + sub * VN + i] = xv[i];
        float ssq = 0.f, ssk = 0.f;
#pragma unroll
        for (int i = 0; i < 8; ++i) { ssq += xq[i] * xq[i]; ssk += xk[i] * xk[i]; }
        ssq = red8d(ssq); ssk = red8d(ssk);
        const float rq = rsqrtf(ssq + 1e-6f) * 0.125f, rk = rsqrtf(ssk + 1e-6f);
        float qk = 0.f;
#pragma unroll
        for (int i = 0; i < 8; ++i) { xq[i] *= rq; xk[i] *= rk; qk += xq[i] * xk[i]; }
        qk = red8d(qk);
        *(f32x4*)(dst + sub * 8) = (f32x4){xq[0], xq[1], xq[2], xq[3]}; *(f32x4*)(dst + sub * 8 + 4) = (f32x4){xq[4], xq[5], xq[6], xq[7]};
        *(f32x4*)(dst + 64 + sub * 8) = (f32x4){xk[0], xk[1], xk[2], xk[3]}; *(f32x4*)(dst + 64 + sub * 8 + 4) = (f32x4){xk[4], xk[5], xk[6], xk[7]};
        if (sub == 0) {
          const float be = sigmoidf_(bflo(ex0)), al = bflo(ex1);
          const float a = __expf(-Aexp * softplusf_(al + dtb));
          *(f32x4*)(scal + tt * 4) = (f32x4){a, be, qk, 0.f};
        }
      }
    } else if (MIX == 1) {
      if (valid) {
        float q[8], z[8]; unpack8(R0, q); unpack8(R1, z);
        float kk[8], dd[8];
#pragma unroll
        for (int i = 0; i < 8; ++i) { q[i] = siluf_(q[i]); kk[i] = c8[i] * sigmoidf_(-z[i]); dd[i] = 1.0f - fminf(kk[i], 1.0f - 1e-6f); }
        *(f32x4*)(dst + sub * 8) = (f32x4){q[0], q[1], q[2], q[3]}; *(f32x4*)(dst + sub * 8 + 4) = (f32x4){q[4], q[5], q[6], q[7]};
        *(f32x4*)(dst + 64 + sub * 8) = (f32x4){kk[0], kk[1], kk[2], kk[3]}; *(f32x4*)(dst + 64 + sub * 8 + 4) = (f32x4){kk[4], kk[5], kk[6], kk[7]};
        *(f32x4*)(dst + 128 + sub * 8) = (f32x4){dd[0], dd[1], dd[2], dd[3]}; *(f32x4*)(dst + 128 + sub * 8 + 4) = (f32x4){dd[4], dd[5], dd[6], dd[7]};
      }
    } else if (MIX == 2) {
      if (valid) {
        float lr[16]; unpack8(R1, lr); unpack8(R4, lr + 8);
        const float q0 = bflo(R0.x), q1 = bfhi(R0.x), q2 = bflo(R0.y), q3 = bfhi(R0.y);
        const float k0 = bflo(R0.z), k1 = bfhi(R0.z), k2 = bflo(R0.w), k3 = bfhi(R0.w);
        const float sc = 0.17677669529663687f;
        f32x4 xg = (f32x4){c8[0], c8[1], c8[2], c8[3]};
#pragma unroll
        for (int r = 0; r < 16; ++r) xg += lr[r] * *(const f32x4*)(wgl + r * 32 + sub * 4);
        f32x4 dd;
#pragma unroll
        for (int i = 0; i < 4; ++i) { const float ls = fminf(xg[i], 0.f) - __logf(1.0f + __expf(-fabsf(xg[i]))); dd[i] = __expf(ls * 0.0625f); }
        *(f32x4*)(dst + sub * 4) = (f32x4){q0 * sc, q1 * sc, q2 * sc, q3 * sc};
        *(f32x4*)(dst + 64 + sub * 4) = (f32x4){k0, k1, k2, k3};
        *(f32x4*)(dst + 128 + sub * 4) = dd;
      }
    } else {
      if (valid) {
        const float ql[4] = {bflo(R0.x), bfhi(R0.x), bflo(R0.y), bfhi(R0.y)}, qh[4] = {bflo(R0.z), bfhi(R0.z), bflo(R0.w), bfhi(R0.w)};
        const float kl[4] = {bflo(R1.x), bfhi(R1.x), bflo(R1.y), bfhi(R1.y)}, kh[4] = {bflo(R1.z), bfhi(R1.z), bflo(R1.w), bfhi(R1.w)};
        const float cc[4] = {__uint_as_float(R4.x), __uint_as_float(R4.z), __uint_as_float(R5.x), __uint_as_float(R5.z)};
        const float sn[4] = {__uint_as_float(R4.y), __uint_as_float(R4.w), __uint_as_float(R5.y), __uint_as_float(R5.w)};
        f32x4 qa, qb, ka, kb;
#pragma unroll
        for (int i = 0; i < 4; ++i) {
          qa[i] = ql[i] * cc[i] - qh[i] * sn[i]; qb[i] = ql[i] * sn[i] + qh[i] * cc[i];
          ka[i] = (kl[i] * cc[i] - kh[i] * sn[i]) * 0.125f; kb[i] = (kl[i] * sn[i] + kh[i] * cc[i]) * 0.125f;
        }
        *(f32x4*)(dst + sub * 4) = qa; *(f32x4*)(dst + 32 + sub * 4) = qb;
        *(f32x4*)(dst + 64 + sub * 4) = ka; *(f32x4*)(dst + 96 + sub * 4) = kb;
      }
    }
    __syncthreads();
    if (MIX == 0 && t0 + 32 < T) {
      if (tid < 3 * RS / 8) { const uint4 v = *(const uint4*)(rawb + 32 * RS + tid * 8); *(uint4*)(rawb + tid * 8) = v; }
    }
    if (t0 + 32 < T) load_chunk_fn<MIX, VN>(p.W(), Pb, t0 + 32 + tt, T, h, vcol, sub, posb, R0, R1, R2, R4, R5, ex0, ex1);
    {
      StepIn<MIX, KPL> sa, sb;
      float osave = 0.f;
      load_step<MIX, KPL>(qkdv, scal, 0, kg, col, sa);
      for (int t = 0; t < ntok; t += 2) {
        load_step<MIX, KPL>(qkdv, scal, t + 1, kg, col, sb);
        __builtin_amdgcn_sched_barrier(0);
        const float oa = do_step<MIX, KPL, KG>(sa, S, gam);
        osave = (kg == (t & (KG - 1))) ? oa : osave;
        load_step<MIX, KPL>(qkdv, scal, min(t + 2, ntok - 1), kg, col, sa);
        __builtin_amdgcn_sched_barrier(0);
        const float ob = do_step<MIX, KPL, KG>(sb, S, gam);
        osave = (kg == ((t + 1) & (KG - 1))) ? ob : osave;
        if (((t + 2) & (KG - 1)) == 0) obuf[(t + 2 - KG + kg) * CW + col] = osave;
      }
      const int remn = ntok & (KG - 1);
      if (remn != 0 && kg < remn) obuf[(ntok - remn + kg) * CW + col] = osave;
    }
    __syncthreads();
    if (valid) {
      float o[VN];
#pragma unroll
      for (int i = 0; i < VN; ++i) o[i] = obuf[tt * CW + sub * VN + i];
      float s1 = 0.f, s2 = 0.f;
#pragma unroll
      for (int i = 0; i < VN; ++i) { s1 += o[i]; s2 += o[i] * o[i]; }
      s1 = red8d(s1); s2 = red8d(s2);
      if (VN == 4) { uint2 o2; o2.x = pk2(o[0], o[1]); o2.y = pk2(o[2 % VN], o[3 % VN]); *(uint2*)(Ob + (size_t)(t0 + tt) * 1024 + sub * 4) = o2; }
      else *(unsigned*)(Ob + (size_t)(t0 + tt) * 1024 + sub * 2) = pk2(o[0], o[1]);
      if (sub == 0) *(float2*)(PS + (size_t)(t0 + tt) * 128) = make_float2(s1, s2);
    }
  }
  {
    const size_t obase = (MIX == 0) ? (smp ? O_DS : O_DP) : (MIX == 1) ? (smp ? O_HS : O_HP) : (MIX == 2) ? (smp ? O_GS : O_GP) : (smp ? O_RS : O_RP);
    float* so = p.O() + obase + ((size_t)(layer * nBatch + b) * 4 + h) * DK * 64 + part * CW;
#pragma unroll
    for (int i = 0; i < KPL; ++i) so[(kg * KPL + i) * 64 + col] = S[i];
  }
  if (MIX == 0) {
    float* co = p.O() + (smp ? O_CS : O_CP) + (size_t)(layer * nBatch + b) * 3 * 768;
    for (int e = tid; e < 3 * RS; e += 256) { const int j = e / RS, r = e % RS;
      const float v = bflo((unsigned)rawb[(ntok_last + j) * RS + r]);
      if (r < 128) { if (part == 0) co[j * 768 + ((r < 64) ? (h * 64 + r) : (256 + h * 64 + r - 64))] = v; }
      else co[j * 768 + 512 + h * 64 + part * CW + r - 128] = v; }
  }
  __syncthreads();
  }
}

constexpr int ITEMS_PER_SEQ = 40;
__device__ __forceinline__ void scan_dispatch(const Params& p, int layer, int smp, int type, int b0, int bstep, int bend, char* lds, const int tid) {
  const int r = type;
  if (r < 16) scan_part<0>(p, layer, smp, b0, bstep, bend, r >> 2, r & 3, lds, tid);
  else {
    const int r2 = r - 16, mh = 4 + (r2 >> 1), part = r2 & 1, mix = mh >> 2, h = mh & 3;
    if (mix == 1) scan_part<1>(p, layer, smp, b0, bstep, bend, h, part, lds, tid);
    else if (mix == 2) scan_part<2>(p, layer, smp, b0, bstep, bend, h, part, lds, tid);
    else scan_part<3>(p, layer, smp, b0, bstep, bend, h, part, lds, tid);
  }
}

__device__ __forceinline__ int long_item_type(int u, int& b) {
  int type;
  if (u < 64) { b = u >> 3; type = 24 + (u & 7); }
  else if (u < 192) { const int v = u - 64; b = v >> 4; type = v & 15; }
  else if (u < 256) { const int v = u - 192; b = v >> 3; type = 16 + (v & 7); }
  else { const int v = u - 256; b = v >> 3; type = 32 + (v & 7); }
  return type;
}
__device__ __forceinline__ void scan_phase(const Params& p, int layer, char* lds, int bid, int nb, const int tid, const int role, const int ci, const int nprim, const int nsec) {
  constexpr int NPI = NB * ITEMS_PER_SEQ;
  const bool paired = (nprim == 256 && nsec == 256);
  int j = -1, nbs = 1;
  if (paired) {
    int u = -1;
    if (role == 0) u = ci; else if (ci < NPI - 256) u = 256 + ci;
    if (u >= 0) { int b; const int type = long_item_type(u, b); scan_dispatch(p, layer, 0, type, b, 1, b + 1, lds, tid); }
    else { j = ci - (NPI - 256); nbs = 256 - (NPI - 256); }
  } else {
    for (int u = bid; u < NPI; u += nb) { int b; const int type = long_item_type(u, b); scan_dispatch(p, layer, 0, type, b, 1, b + 1, lds, tid); }
    nbs = (nb > NPI) ? nb - NPI : nb; j = (nb > NPI) ? bid - NPI : bid;
  }
  if (j >= 0) {
    const int nsl = (nbs + ITEMS_PER_SEQ - 1) / ITEMS_PER_SEQ;
    for (int jj = j; jj < ITEMS_PER_SEQ * nsl; jj += nbs) scan_dispatch(p, layer, 1, jj % ITEMS_PER_SEQ, jj / ITEMS_PER_SEQ, nsl, NSB, lds, tid);
    if (layer == 0) { __syncthreads(); convert_weights(p, lds, 3360 + j, 6720, nbs, tid); }
  }
}

__device__ __forceinline__ void norm_phase(const Params& p, int layer, int bid, int nb, const int tid) {
  bf16_t* O = (bf16_t*)p.O();
  const bf16_t* P = (const bf16_t*)(p.W() + OFF_P);
  const float* PS = (const float*)((const unsigned char*)p.O() + DOUT_PS);
  const int cg8 = tid & 127;
  const int mh = cg8 >> 3, mix = mh >> 2, h = mh & 3, j0 = (cg8 & 7) * 8;
  const int gcol = (mix == 0) ? 776 : (mix == 1) ? 1800 : (mix == 2) ? 2584 : 3608;
  const float* gsrc = (mix == 0) ? p.I(14) : (mix == 1) ? p.I(16) : (mix == 2) ? p.I(19) : p.I(20);
  float g8[8];
#pragma unroll
  for (int i = 0; i < 8; ++i) g8[i] = gsrc[layer * 256 + h * 64 + j0 + i];
  uint4 ovn, gvn; f32x4 psn, ps2n = (f32x4){0.f, 0.f, 0.f, 0.f};
  {
    const int r0 = min(bid * 2 + (tid >> 7), MT - 1);
    ovn = *(const uint4*)(O + (size_t)r0 * 1024 + cg8 * 8);
    gvn = *(const uint4*)(P + (size_t)r0 * DINP + gcol + h * 64 + j0);
    psn = *(const f32x4*)(PS + (size_t)r0 * 128 + mh * 8);
    if (mix == 0) ps2n = *(const f32x4*)(PS + (size_t)r0 * 128 + mh * 8 + 4);
  }
  for (int row = bid * 2 + (tid >> 7); row < MT; row += nb * 2) {
    const uint4 ov = ovn, gv = gvn; const f32x4 ps = psn, ps2 = ps2n;
    {
      const int rn = min(row + nb * 2, MT - 1);
      ovn = *(const uint4*)(O + (size_t)rn * 1024 + cg8 * 8);
      gvn = *(const uint4*)(P + (size_t)rn * DINP + gcol + h * 64 + j0);
      psn = *(const f32x4*)(PS + (size_t)rn * 128 + mh * 8);
      if (mix == 0) ps2n = *(const f32x4*)(PS + (size_t)rn * 128 + mh * 8 + 4);
    }
    float s1 = ps[0] + ps[2], s2 = ps[1] + ps[3];
    if (mix == 0) { s1 += ps2[0] + ps2[2]; s2 += ps2[1] + ps2[3]; }
    float o[8], gt[8]; unpack8(ov, o); unpack8(gv, gt);
    float mu = 0.f, rs;
    if (mix == 3) { mu = s1 * (1.0f / 64.0f); const float var = fmaxf(s2 * (1.0f / 64.0f) - mu * mu, 0.f); rs = rsqrtf(var + 1e-5f); }
    else rs = rsqrtf(s2 * (1.0f / 64.0f) + 1e-6f);
    float r[8];
#pragma unroll
    for (int i = 0; i < 8; ++i) r[i] = (o[i] - mu) * rs * g8[i] * siluf_(gt[i]);
    uint4 o4; o4.x = pk2(r[0], r[1]); o4.y = pk2(r[2], r[3]); o4.z = pk2(r[4], r[5]); o4.w = pk2(r[6], r[7]);
    *(uint4*)(O + (size_t)row * 1024 + cg8 * 8) = o4;
  }
}

constexpr int NPHASE = 17;
__global__ void __launch_bounds__(256, 2) hymba_fwd(Params p_, int ph_lo, int ph_hi) {
  __shared__ __attribute__((aligned(16))) char lds[65536];
  XcdBarrier xb; xb.bar = (unsigned*)(p_.ws + OFF_BAR); xb.x = xb_xcc_id(); xb.nloc = 0u; xb.nx = 0u;
  if (threadIdx.x == 0) (void)xb_add(&xb.bar[XB_XCNT(xb.x)], 1u);
  int role = 0, ci = 0;
  {
    const unsigned key = ((((unsigned)__builtin_amdgcn_s_getreg((31 << 11) | 4)) >> 8) & 0xFFu) | (xb.x << 8);
    if (threadIdx.x == 0) {
      const unsigned slot = xb_add(&xb.bar[CEN_TAB + key], 1u);
      unsigned r;
      if (slot == 0u) { r = xb_add(&xb.bar[CEN_CNT], 1u); __hip_atomic_store(&xb.bar[CEN_TAB2 + key], r + 1u, __ATOMIC_RELAXED, __HIP_MEMORY_SCOPE_AGENT); }
      else { (void)xb_add(&xb.bar[CEN_CNT + 1], 1u); r = 0u; }
      *(volatile unsigned*)(lds) = slot == 0u ? 0u : 1u; *(volatile unsigned*)(lds + 4) = r;
    }
    __syncthreads();
    role = (int)*(volatile unsigned*)(lds); ci = (int)*(volatile unsigned*)(lds + 4);
    __syncthreads();
    role = __builtin_amdgcn_readfirstlane(role); ci = __builtin_amdgcn_readfirstlane(ci);
    if (role != 0) ci = -1 - (int)key;
  }
  int nprim = 0, nsec = 0;
  if (ph_hi < 0) cg::this_grid().sync();
  for (int ph = ph_lo; ph < ph_hi; ++ph) {
    int tid = threadIdx.x, bid = blockIdx.x, nb = gridDim.x;
    asm volatile("" : "+v"(tid));
    asm volatile("" : "+s"(bid), "+s"(nb));
    if (ph > ph_lo) xcd_barrier(xb, tid, (unsigned)nb);
    if (ph == ph_lo + 1) {
      nprim = (int)xb_ld(&xb.bar[CEN_CNT]); nsec = (int)xb_ld(&xb.bar[CEN_CNT + 1]);
      if (role != 0) { const unsigned v = xb_ld(&xb.bar[CEN_TAB2 + (unsigned)(-1 - ci)]); ci = (v > 0u) ? (int)v - 1 : 0; }
      nprim = __builtin_amdgcn_readfirstlane(nprim); nsec = __builtin_amdgcn_readfirstlane(nsec); ci = __builtin_amdgcn_readfirstlane(ci);
    }
    const Params& p = p_;
    if (ph == 0) {
      convert_weights(p, lds, bid, 3360, nb, tid);
      embed_ln(p, bid, nb, tid);
      rope_table(p, bid, nb, tid);
    } else {
      const int l = (ph - 1) / 8, s = (ph - 1) % 8;
      const bf16_t* Xb = (const bf16_t*)p.O();
      bf16_t* X1b = (bf16_t*)(p.W() + OFF_X1B);
      bf16_t* Hb = (bf16_t*)(p.W() + OFF_H);
      float* X = (float*)(p.W() + OFF_X);
      if (s == 0) gemm_phase<EPI_BF16>(Xb, 1024, (const bf16_t*)(p.W() + OFF_WIN + l * SZ_WIN), 1024, 1024, DINP / 128, p.W() + OFF_P, DINP, lds, bid, nb, tid);
      else if (s == 1) scan_phase(p, l, lds, bid, nb, tid, role, ci, nprim, nsec);
      else if (s == 2) norm_phase(p, l, bid, nb, tid);
      else if (s == 3) gemm_phase<EPI_RESID>(Xb, 1024, (const bf16_t*)(p.W() + OFF_WOUT + l * SZ_WOUT), 1024, 1024, 8, X, 1024, lds, bid, nb, tid);
      else if (s == 4) ln_phase(p, p.I(22) + l * 1024, p.I(23) + l * 1024, X1b, 0, bid, nb, tid);
      else if (s == 5) gemm_phase<EPI_SWIGLU>(X1b, 1024, (const bf16_t*)(p.W() + OFF_WGU + l * SZ_WGU), 1024, 1024, 44, Hb, DFF, lds, bid, nb, tid);
      else if (s == 6) gemm_phase<EPI_RESID>(Hb, DFF, (const bf16_t*)(p.W() + OFF_WDN + l * SZ_WDN), DFF, DFF, 8, X, 1024, lds, bid, nb, tid);
      else ln_phase(p, p.I(27) + l * 1024, p.I(28) + l * 1024, (bf16_t*)p.O(), l == 1, bid, nb, tid);
    }
  }
}

extern "C" void kernel_launch(void* const* d_in, const int* in_sizes, int n_in, void* d_out, int out_size, void* d_ws, size_t ws_size,
                              hipStream_t stream) {
  (void)in_sizes; (void)out_size;
  if (n_in < 29 || ws_size < WS_NEED) { fprintf(stderr, "bad args: n_in %d ws %zu need %zu\n", n_in, ws_size, (size_t)WS_NEED); return; }
  Params p{};
  for (int i = 0; i < 29; ++i) p.in[i] = (const float*)d_in[i];
  p.out = (float*)d_out;
  p.ws = (unsigned char*)d_ws;
  static int grid_blocks = 0;
  if (!grid_blocks) {
    int dev = 0, cus = 0, per_cu = 0;
    (void)hipGetDevice(&dev);
    (void)hipDeviceGetAttribute(&cus, hipDeviceAttributeMultiprocessorCount, dev);
    (void)hipOccupancyMaxActiveBlocksPerMultiprocessor(&per_cu, hymba_fwd, 256, 0);
    if (per_cu > 2) per_cu = 2;
    if (per_cu < 1) per_cu = 1;
    grid_blocks = cus * per_cu;
  }
  (void)hipMemsetAsync((unsigned char*)d_ws + OFF_BAR, 0, BAR_BYTES, stream);
  int lo = 0, hi = NPHASE;
  void* args[] = {&p, &lo, &hi};
  hipError_t e = hipLaunchCooperativeKernel((void*)hymba_fwd, dim3(grid_blocks), dim3(256), args, 0, stream);
  if (e != hipSuccess) fprintf(stderr, "cooperative launch failed: %s (grid %d)\n", hipGetErrorString(e), grid_blocks);
}
```

```cpp
#include <hip/hip_runtime.h>
#include <hip/hip_cooperative_groups.h>
#include <cstdio>
#include <cstdint>
namespace cg = cooperative_groups;

#ifndef COOP
#define COOP 1
#endif

typedef unsigned short bf16_t;
typedef short bf16x8 __attribute__((ext_vector_type(8)));
typedef float f32x4 __attribute__((ext_vector_type(4)));

constexpr int DM = 1024, NB = 8, TPR = 2064, NSB = 128, TS = 4;
constexpr int MP = NB * TPR;
constexpr int MS = NSB * TS;
constexpr int MT = MP + MS;
constexpr int DIN = 3864, DINP = 3968, DFF = 2816;
constexpr float ALPHA = 1.41421356237309515f;

constexpr size_t SZ_WIN = (size_t)DINP * 1024 * 2, SZ_WOUT = (size_t)1024 * 1024 * 2, SZ_WGU = (size_t)5632 * 1024 * 2, SZ_WDN = (size_t)1024 * 2816 * 2;
constexpr size_t OFF_CS = 0;
constexpr size_t OFF_WIN = 532480;
constexpr size_t OFF_WOUT = OFF_WIN + 2 * SZ_WIN;
constexpr size_t OFF_WGU = OFF_WOUT + 2 * SZ_WOUT;
constexpr size_t OFF_WDN = OFF_WGU + 2 * SZ_WGU;
constexpr size_t OFF_X = OFF_WDN + 2 * SZ_WDN;
constexpr size_t OFF_P = OFF_X + (size_t)MT * 1024 * 4;
constexpr size_t OFF_X1B = OFF_P;
constexpr size_t OFF_H = OFF_P + (size_t)MT * 1024 * 2;
constexpr size_t OFF_BAR = OFF_P + (size_t)MT * DINP * 2;
constexpr int CEN_CNT = 3520, CEN_TAB = 4096, CEN_TAB2 = 8192;
constexpr size_t BAR_BYTES = 12288 * 4;
constexpr size_t WS_NEED = OFF_BAR + BAR_BYTES;
constexpr size_t DOUT_PS = 36000000;

constexpr size_t O_YP = 0, O_YS = 16777216, O_CP = 17301504, O_CS = 17338368, O_DP = 17928192, O_DS = 18190336,
                 O_HP = 22384640, O_HS = 22646784, O_GP = 26841088, O_GS = 26972160, O_RP = 29069312, O_RS = 29331456;

#define GAS __attribute__((address_space(1)))
struct Params {
  const float* in[29];
  float* out;
  unsigned char* ws;
  __device__ __forceinline__ const float* I(int i) const { return (const float*)(const GAS float*)in[i]; }
  __device__ __forceinline__ float* O() const { return (float*)(GAS float*)out; }
  __device__ __forceinline__ unsigned char* W() const { return (unsigned char*)(GAS unsigned char*)ws; }
};

__device__ __forceinline__ unsigned f2bf(float f) {
  unsigned u = __float_as_uint(f);
  u += 0x7fffu + ((u >> 16) & 1u);
  return u >> 16;
}
typedef float f32x2_t __attribute__((ext_vector_type(2)));
typedef __bf16 bf16x2_t __attribute__((ext_vector_type(2)));
__device__ __forceinline__ unsigned pk2(float lo, float hi) { const f32x2_t v = {lo, hi}; const bf16x2_t b = __builtin_convertvector(v, bf16x2_t); return __builtin_bit_cast(unsigned, b); }
__device__ __forceinline__ float bflo(unsigned u) { return __uint_as_float(u << 16); }
__device__ __forceinline__ float bfhi(unsigned u) { return __uint_as_float(u & 0xffff0000u); }
__device__ __forceinline__ void unpack8(const uint4& r, float* x) {
  x[0] = bflo(r.x); x[1] = bfhi(r.x); x[2] = bflo(r.y); x[3] = bfhi(r.y);
  x[4] = bflo(r.z); x[5] = bfhi(r.z); x[6] = bflo(r.w); x[7] = bfhi(r.w);
}
__device__ __forceinline__ float sigmoidf_(float x) { return __builtin_amdgcn_rcpf(1.0f + __expf(-x)); }
__device__ __forceinline__ float siluf_(float x) { return x * __builtin_amdgcn_rcpf(1.0f + __expf(-x)); }
__device__ __forceinline__ float softplusf_(float x) { return fmaxf(x, 0.f) + __logf(1.0f + __expf(-fabsf(x))); }
__device__ __forceinline__ float red8(float x) {
  x += __shfl_xor(x, 1); x += __shfl_xor(x, 2); x += __shfl_xor(x, 4); return x;
}
__device__ __forceinline__ float dpp_x1(float x) {
  return __int_as_float(__builtin_amdgcn_update_dpp(0, __float_as_int(x), 0xB1, 0xF, 0xF, true));
}
__device__ __forceinline__ float dpp_x2(float x) {
  return __int_as_float(__builtin_amdgcn_update_dpp(0, __float_as_int(x), 0x4E, 0xF, 0xF, true));
}
__device__ __forceinline__ float red4(float x) { x += dpp_x1(x); x += dpp_x2(x); return x; }
__device__ __forceinline__ float wave_sum(float x) {
#pragma unroll
  for (int o = 32; o >= 1; o >>= 1) x += __shfl_xor(x, o);
  return x;
}

__device__ __forceinline__ void convert_weights(const Params& p, char* lds, int w0, int w1, int wstep, const int tid) {
  float* tile = (float*)lds;
  for (int w = w0; w < w1; w += wstep) {
    const int l = w / 3360; int r = w % 3360;
    int mat, kt, rt;
    if (r < 992) { mat = 0; kt = r / 62; rt = r % 62; }
    else if (r < 1248) { r -= 992; mat = 1; kt = r / 16; rt = r % 16; }
    else if (r < 2656) { r -= 1248; mat = 2; kt = r / 88; rt = r % 88; }
    else { r -= 2656; mat = 3; kt = r / 16; rt = r % 16; }
    {
      const int r4 = (tid & 15) * 4, R = rt * 64 + r4, kq = tid >> 4;
      const float* src; int ns; bool valid = true;
      if (mat == 0) { const int rho = R & 31, scol = (R & ~31) + 8 * ((rho & 15) >> 2) + 4 * (rho >> 4) + (rho & 3);
        src = p.I(10) + (size_t)l * 1024 * DIN + scol; ns = DIN; valid = scol < DIN; }
      else if (mat == 1) { src = p.I(21) + (size_t)l * 1024 * 1024 + R; ns = 1024; }
      else if (mat == 2) { const int q = R & 63, f = q >> 4, i = q & 15, ty = f & 1, hid = (R >> 6) * 32 + 8 * (i >> 2) + 4 * (f >> 1) + (i & 3);
        src = (ty ? p.I(25) : p.I(24)) + (size_t)l * 1024 * DFF + hid; ns = DFF; }
      else { src = p.I(26) + (size_t)l * DFF * 1024 + R; ns = 1024; }
      f32x4 v[4];
#pragma unroll
      for (int i = 0; i < 4; ++i) v[i] = valid ? *(const f32x4*)(src + (size_t)(kt * 64 + kq + 16 * i) * ns) : (f32x4){0.f, 0.f, 0.f, 0.f};
#pragma unroll
      for (int i = 0; i < 4; ++i) {
        const int k = kq + 16 * i;
        tile[(r4 + 0) * 65 + k] = v[i][0]; tile[(r4 + 1) * 65 + k] = v[i][1]; tile[(r4 + 2) * 65 + k] = v[i][2]; tile[(r4 + 3) * 65 + k] = v[i][3];
      }
    }
    __syncthreads();
    {
      const int rr = tid >> 2, kc = (tid & 3) * 16;
      const int Kd = (mat == 3) ? DFF : 1024;
      bf16_t* base;
      if (mat == 0) base = (bf16_t*)(p.W() + OFF_WIN + l * SZ_WIN);
      else if (mat == 1) base = (bf16_t*)(p.W() + OFF_WOUT + l * SZ_WOUT);
      else if (mat == 2) base = (bf16_t*)(p.W() + OFF_WGU + l * SZ_WGU);
      else base = (bf16_t*)(p.W() + OFF_WDN + l * SZ_WDN);
      bf16_t* dst = base + (size_t)(rt * 64 + rr) * Kd + kt * 64 + kc;
      const float* s = tile + rr * 65 + kc;
      uint4 a, b;
      a.x = pk2(s[0], s[1]); a.y = pk2(s[2], s[3]); a.z = pk2(s[4], s[5]); a.w = pk2(s[6], s[7]);
      b.x = pk2(s[8], s[9]); b.y = pk2(s[10], s[11]); b.z = pk2(s[12], s[13]); b.w = pk2(s[14], s[15]);
      *(uint4*)dst = a; *(uint4*)(dst + 8) = b;
    }
    __syncthreads();
  }
}

__device__ __forceinline__ void ln_row_regs(f32x4 (&v)[4], const float* g, const float* bb, int lane) {
  float s = 0.f;
#pragma unroll
  for (int i = 0; i < 4; ++i) s += (v[i][0] + v[i][1]) + (v[i][2] + v[i][3]);
  const float mu = wave_sum(s) * (1.0f / 1024.0f);
  float q = 0.f;
#pragma unroll
  for (int i = 0; i < 4; ++i) { const f32x4 d = v[i] - mu; q += (d[0] * d[0] + d[1] * d[1]) + (d[2] * d[2] + d[3] * d[3]); }
  const float rs = rsqrtf(wave_sum(q) * (1.0f / 1024.0f) + 1e-5f);
#pragma unroll
  for (int i = 0; i < 4; ++i) {
    const f32x4 gg = *(const f32x4*)(g + lane * 4 + i * 256), b4 = *(const f32x4*)(bb + lane * 4 + i * 256);
    v[i] = (v[i] - mu) * rs * gg + b4;
  }
}

__device__ __forceinline__ void embed_ln(const Params& p, int bid, int nb, const int tid) {
  const int lane = tid & 63, wv = tid >> 6;
  float* X = (float*)(p.W() + OFF_X);
  bf16_t* Xb = (bf16_t*)p.O();
  for (int row = bid * 4 + wv; row < MT; row += nb * 4) {
    const float* src;
    if (row < MP) { const int b = row / TPR, t = row % TPR;
      src = (t < 16) ? p.I(7) + (size_t)t * 1024 : p.I(0) + ((size_t)b * 2048 + (t - 16)) * 1024; }
    else src = p.I(1) + (size_t)(row - MP) * 1024;
    f32x4 v[4];
#pragma unroll
    for (int i = 0; i < 4; ++i) v[i] = *(const f32x4*)(src + lane * 4 + i * 256);
    ln_row_regs(v, p.I(8), p.I(9), lane);
#pragma unroll
    for (int i = 0; i < 4; ++i) {
      *(f32x4*)(X + (size_t)row * 1024 + lane * 4 + i * 256) = v[i];
      uint2 o; o.x = pk2(v[i][0], v[i][1]); o.y = pk2(v[i][2], v[i][3]);
      *(uint2*)(Xb + (size_t)row * 1024 + lane * 4 + i * 256) = o;
    }
  }
}

__device__ __forceinline__ void rope_table(const Params& p, int bid, int nb, const int tid) {
  float2* cs = (float2*)(p.W() + OFF_CS);
  for (int e = bid * 256 + tid; e < 2068 * 32; e += nb * 256) {
    const int idx = e >> 5, i = e & 31;
    const double pos = (idx < 2064) ? (double)idx : (double)(16384 + idx - 2064);
    const double inv = exp(-((double)i / 31.0) * 9.210340371976184);
    const double ang = pos * inv;
    cs[e] = make_float2((float)cos(ang), (float)sin(ang));
  }
}

__device__ __forceinline__ void ln_phase(const Params& p, const float* g, const float* bb, bf16_t* xb, int final_, int bid, int nb, const int tid) {
  const int lane = tid & 63, wv = tid >> 6;
  float* X = (float*)(p.W() + OFF_X);
  f32x4 nx[4];
  {
    const int r0 = min(bid * 4 + wv, MT - 1);
#pragma unroll
    for (int i = 0; i < 4; ++i) nx[i] = *(const f32x4*)(X + (size_t)r0 * 1024 + lane * 4 + i * 256);
  }
  for (int row = bid * 4 + wv; row < MT; row += nb * 4) {
    f32x4 v[4];
#pragma unroll
    for (int i = 0; i < 4; ++i) v[i] = nx[i];
    {
      const int rn = min(row + nb * 4, MT - 1);
#pragma unroll
      for (int i = 0; i < 4; ++i) nx[i] = *(const f32x4*)(X + (size_t)rn * 1024 + lane * 4 + i * 256);
    }
    ln_row_regs(v, g, bb, lane);
    if (!final_) {
#pragma unroll
      for (int i = 0; i < 4; ++i) {
        *(f32x4*)(X + (size_t)row * 1024 + lane * 4 + i * 256) = v[i];
        uint2 o; o.x = pk2(v[i][0], v[i][1]); o.y = pk2(v[i][2], v[i][3]);
        *(uint2*)(xb + (size_t)row * 1024 + lane * 4 + i * 256) = o;
      }
    } else {
      float* dst = nullptr;
      if (row < MP) { const int b = row / TPR, t = row % TPR; if (t >= 16) dst = p.O() + O_YP + ((size_t)b * 2048 + (t - 16)) * 1024; }
      else dst = p.O() + O_YS + (size_t)(row - MP) * 1024;
      if (dst) {
#pragma unroll
        for (int i = 0; i < 4; ++i) *(f32x4*)(dst + lane * 4 + i * 256) = v[i];
      }
    }
  }
}

enum { EPI_BF16 = 0, EPI_RESID = 1, EPI_SWIGLU = 2 };

template <int EPI>
__device__ __forceinline__ void gemm_tile(const bf16_t* __restrict__ A, const int lda, const bf16_t* __restrict__ Bt, const int ldb,
                                          const int K, const int m0, const int n0, void* Cout, const int ldc, char* lds, const int tid) {
  const int wid = tid >> 6, lane = tid & 63, wr = wid >> 1, wc = wid & 1, fr = lane & 15, fq = lane >> 4;
  f32x4 acc[4][4];
#pragma unroll
  for (int m = 0; m < 4; ++m)
#pragma unroll
    for (int n = 0; n < 4; ++n) acc[m][n] = (f32x4){0.f, 0.f, 0.f, 0.f};
  const int nt = K >> 6;
  auto stage = [&](int kt, int buf) {
#pragma unroll
    for (int i = 0; i < 4; ++i) {
      const int off = tid * 16 + i * 4096;
      const int panel = off >> 13, rem = off & 8191, r = rem >> 6, c = (rem & 63) >> 1;
      const bf16_t* ga = A + (size_t)(m0 + r) * lda + kt * 64 + panel * 32 + c;
      const bf16_t* gb = Bt + (size_t)(n0 + r) * ldb + kt * 64 + panel * 32 + c;
      __builtin_amdgcn_global_load_lds((const unsigned*)ga, (__attribute__((address_space(3))) unsigned*)(lds + buf * 32768 + off), 16, 0, 0);
      __builtin_amdgcn_global_load_lds((const unsigned*)gb, (__attribute__((address_space(3))) unsigned*)(lds + buf * 32768 + 16384 + off), 16, 0, 0);
    }
  };
  stage(0, 0);
  for (int kt = 0; kt < nt; ++kt) {
    asm volatile("s_waitcnt vmcnt(0)" ::: "memory");
    __syncthreads();
    const char* sa = lds + (kt & 1) * 32768;
    const char* sb = sa + 16384;
    bf16x8 af[2][4], bfr[2][4];
#pragma unroll
    for (int ks = 0; ks < 2; ++ks) {
#pragma unroll
      for (int m = 0; m < 4; ++m) af[ks][m] = *(const bf16x8*)(sa + ks * 8192 + (wr * 64 + m * 16 + fr) * 64 + fq * 16);
#pragma unroll
      for (int n = 0; n < 4; ++n) bfr[ks][n] = *(const bf16x8*)(sb + ks * 8192 + (wc * 64 + n * 16 + fr) * 64 + fq * 16);
    }
    if (kt + 1 < nt) stage(kt + 1, (kt + 1) & 1);
#pragma unroll
    for (int ks = 0; ks < 2; ++ks)
#pragma unroll
      for (int m = 0; m < 4; ++m)
#pragma unroll
        for (int n = 0; n < 4; ++n) acc[m][n] = __builtin_amdgcn_mfma_f32_16x16x32_bf16(bfr[ks][n], af[ks][m], acc[m][n], 0, 0, 0);
  }
  if (EPI == EPI_RESID) {
    float* C0 = (float*)Cout + (size_t)(m0 + wr * 64 + fr) * ldc + n0 + wc * 64 + fq * 4;
    f32x4 xin[4][4];
#pragma unroll
    for (int m = 0; m < 4; ++m)
#pragma unroll
      for (int n = 0; n < 4; ++n) xin[m][n] = *(const f32x4*)(C0 + (size_t)m * 16 * ldc + n * 16);
#pragma unroll
    for (int m = 0; m < 4; ++m)
#pragma unroll
      for (int n = 0; n < 4; ++n) asm volatile("" : "+v"(xin[m][n]));
#pragma unroll
    for (int m = 0; m < 4; ++m)
#pragma unroll
      for (int n = 0; n < 4; ++n) *(f32x4*)(C0 + (size_t)m * 16 * ldc + n * 16) = xin[m][n] * ALPHA + acc[m][n];
    return;
  }
#pragma unroll
  for (int m = 0; m < 4; ++m) {
    const int row = m0 + wr * 64 + m * 16 + fr;
    if (EPI == EPI_BF16) {
      bf16_t* C = (bf16_t*)Cout + (size_t)row * ldc + n0 + wc * 64 + fq * 8;
#pragma unroll
      for (int pq = 0; pq < 2; ++pq) { uint4 o; o.x = pk2(acc[m][2 * pq][0], acc[m][2 * pq][1]); o.y = pk2(acc[m][2 * pq][2], acc[m][2 * pq][3]);
        o.z = pk2(acc[m][2 * pq + 1][0], acc[m][2 * pq + 1][1]); o.w = pk2(acc[m][2 * pq + 1][2], acc[m][2 * pq + 1][3]); *(uint4*)(C + pq * 32) = o; }
    } else if (EPI == EPI_RESID) {
      float* C = (float*)Cout + (size_t)row * ldc + n0 + wc * 64 + fq * 4;
#pragma unroll
      for (int n = 0; n < 4; ++n) { const f32x4 x = *(const f32x4*)(C + n * 16); *(f32x4*)(C + n * 16) = x * ALPHA + acc[m][n]; }
    } else {
      bf16_t* C = (bf16_t*)Cout + (size_t)row * ldc + (n0 >> 1) + wc * 32 + fq * 8;
      const f32x4 g0 = acc[m][0], u0 = acc[m][1], g1 = acc[m][2], u1 = acc[m][3];
      uint4 o; o.x = pk2(siluf_(g0[0]) * u0[0], siluf_(g0[1]) * u0[1]); o.y = pk2(siluf_(g0[2]) * u0[2], siluf_(g0[3]) * u0[3]);
      o.z = pk2(siluf_(g1[0]) * u1[0], siluf_(g1[1]) * u1[1]); o.w = pk2(siluf_(g1[2]) * u1[2], siluf_(g1[3]) * u1[3]);
      *(uint4*)C = o;
    }
  }
}
template <int EPI>
__device__ __forceinline__ void gemm_phase(const bf16_t* A, int lda, const bf16_t* Bt, int ldb, int K, int ntn, void* C, int ldc, char* lds, int bid, int nb, const int tid) {
  constexpr int GM = 4, nM = MT / 128;
  const int ntiles = nM * ntn, nig = GM * ntn;
  const int pos = (EPI == EPI_BF16 && (nb & 7) == 0) ? (bid & 7) * (nb >> 3) + (bid >> 3) : bid;
  for (int L = pos; L < ntiles; L += nb) {
    int mt, nn;
    if (EPI != EPI_BF16) { mt = L / ntn; nn = L % ntn; }
    else { const int gid = L / nig, fm = gid * GM, gsz = min(nM - fm, GM), rem = L - gid * nig; mt = fm + rem % gsz; nn = rem / gsz; }
    gemm_tile<EPI>(A, lda, Bt, ldb, K, mt * 128, nn * 128, C, ldc, lds, tid);
  }
}

#define XB_TMO      128
#define XB_XCNT(j)  (256  + 64 * (j))
#define XB_XSUB(j)  (1280 + 64 * (j))
#define XB_XGEN(j)  (2304 + 64 * (j))
#define XB_TOP      3328
#define XB_TOPGEN   3392
#define XCD_BAR_WORDS 3456
#define XB_SPIN_CAP (1u << 22)
__device__ __forceinline__ unsigned xb_ld(unsigned* p) { return __hip_atomic_load(p, __ATOMIC_RELAXED, __HIP_MEMORY_SCOPE_AGENT); }
__device__ __forceinline__ unsigned xb_add(unsigned* p, unsigned v) { return __hip_atomic_fetch_add(p, v, __ATOMIC_RELAXED, __HIP_MEMORY_SCOPE_AGENT); }
__device__ __forceinline__ unsigned xb_xcc_id() { return (unsigned)__builtin_amdgcn_s_getreg((3 << 11) | 20) & 0xFu; }
#define XB_SPIN(cond, bar) do { unsigned _sp = 0; while (cond) { __builtin_amdgcn_s_sleep(1); \
    if ((++_sp & 255u) == 0u) { if (xb_ld(&(bar)[XB_TMO])) break; if (_sp > XB_SPIN_CAP) { atomicAdd(&(bar)[XB_TMO], 1u); break; } } } } while (0)
struct XcdBarrier { unsigned* bar; unsigned x; unsigned nloc, nx; };
__device__ __forceinline__ void xcd_barrier_complete(unsigned* bar, unsigned x, unsigned G, unsigned& nloc, unsigned& nx) {
  unsigned sum, cnt, mine, sp = 0u;
  for (;;) {
    sum = 0u; cnt = 0u; mine = 0u;
#pragma unroll
    for (unsigned j = 0; j < 16; ++j) { const unsigned c = xb_ld(&bar[XB_XCNT(j)]); sum += c; cnt += (c > 0u) ? 1u : 0u; mine = (j == x) ? c : mine; }
    if (sum == G) break;
    __builtin_amdgcn_s_sleep(1);
    if ((++sp & 255u) == 0u) { if (xb_ld(&bar[XB_TMO])) break; if (sp > XB_SPIN_CAP) { atomicAdd(&bar[XB_TMO], 1u); break; } }
  }
  nloc = mine > 0u ? mine : 1u; nx = cnt > 0u ? cnt : 1u;
}
__device__ __forceinline__ void xcd_barrier(XcdBarrier& b, const int tid, const unsigned G) {
  asm volatile("s_waitcnt vmcnt(0)" ::: "memory");
  __syncthreads();
  if (tid == 0) {
    unsigned* bar = b.bar;
    __builtin_amdgcn_s_waitcnt(0);
    if (b.nloc == 0u) xcd_barrier_complete(bar, b.x, G, b.nloc, b.nx);
    const unsigned nloc = b.nloc, nx = b.nx;
    const unsigned old = xb_add(&bar[XB_XSUB(b.x)], 1u);
    const unsigned gen = old / nloc;
    if (old + 1u == (gen + 1u) * nloc) {
      __builtin_amdgcn_fence(__ATOMIC_RELEASE, "agent");
      asm volatile("s_waitcnt vmcnt(0)" ::: "memory");
      const unsigned og = xb_add(&bar[XB_TOP], 1u);
      const unsigned tg = og / nx;
      if (og + 1u == (tg + 1u) * nx) xb_add(&bar[XB_TOPGEN], 1u);
      else XB_SPIN(xb_ld(&bar[XB_TOPGEN]) == tg, bar);
      __builtin_amdgcn_fence(__ATOMIC_ACQUIRE, "agent");
      xb_add(&bar[XB_XGEN(b.x)], 1u);
      asm volatile("s_waitcnt vmcnt(0)" ::: "memory");
    } else {
      XB_SPIN(xb_ld(&bar[XB_XGEN(b.x)]) == gen, bar);
      __builtin_amdgcn_fence(__ATOMIC_ACQUIRE, "agent");
      asm volatile("s_waitcnt vmcnt(0)" ::: "memory");
    }
  }
  __syncthreads();
}

template <int N, int RS>
__device__ __forceinline__ void convN(const bf16_t* rawb, const float* cwl, int tt, int off, float (&x)[N]) {
#pragma unroll
  for (int i = 0; i < N; ++i) x[i] = 0.f;
#pragma unroll
  for (int j = 0; j < 4; ++j) {
    float xv[N];
    if (N == 8) { const uint4 rv = *(const uint4*)(rawb + (tt + j) * RS + off); unpack8(rv, xv); }
    else if (N == 4) { const uint2 rv = *(const uint2*)(rawb + (tt + j) * RS + off); xv[0] = bflo(rv.x); xv[1] = bfhi(rv.x); xv[2 % N] = bflo(rv.y); xv[3 % N] = bfhi(rv.y); }
    else { const unsigned rv = *(const unsigned*)(rawb + (tt + j) * RS + off); xv[0] = bflo(rv); xv[1] = bfhi(rv); }
#pragma unroll
    for (int i = 0; i < N; ++i) x[i] += cwl[j * RS + off + i] * xv[i];
  }
#pragma unroll
  for (int i = 0; i < N; ++i) asm volatile("" : "+v"(x[i]));
#pragma unroll
  for (int i = 0; i < N; ++i) x[i] = siluf_(x[i]);
}

template <int MIX, int VN>
__device__ __forceinline__ void load_chunk_fn(const unsigned char* ws, const bf16_t* Pb, const int t, const int T, const int h, const int vcol, const int sub, const int posb,
                                              uint4& R0, uint4& R1, uint2& R2, uint4& R4, uint4& R5, unsigned& ex0, unsigned& ex1) {
  if (t < T) {
    const bf16_t* pr = Pb + (size_t)t * DINP;
    const int vbase = (MIX == 0) ? 512 : (MIX == 1) ? 1544 : (MIX == 2) ? 2312 : 3352;
    if (VN == 4) R2 = *(const uint2*)(pr + vbase + h * 64 + vcol);
    else R2.x = *(const unsigned*)(pr + vbase + h * 64 + vcol);
    if (MIX == 0) {
      R0 = *(const uint4*)(pr + 0 + h * 64 + sub * 8); R1 = *(const uint4*)(pr + 256 + h * 64 + sub * 8);
      ex0 = pr[768 + h]; ex1 = pr[772 + h];
    } else if (MIX == 1) {
      R0 = *(const uint4*)(pr + 1032 + h * 64 + sub * 8); R1 = *(const uint4*)(pr + 1288 + h * 64 + sub * 8);
    } else if (MIX == 2) {
      const uint2 q2 = *(const uint2*)(pr + 2056 + h * 32 + sub * 4), k2 = *(const uint2*)(pr + 2184 + h * 32 + sub * 4);
      R0 = make_uint4(q2.x, q2.y, k2.x, k2.y);
      R1 = *(const uint4*)(pr + 2568); R4 = *(const uint4*)(pr + 2576);
    } else {
      const uint2 ql = *(const uint2*)(pr + 2840 + h * 64 + sub * 4), qh = *(const uint2*)(pr + 2840 + h * 64 + 32 + sub * 4);
      const uint2 kl = *(const uint2*)(pr + 3096 + h * 64 + sub * 4), kh = *(const uint2*)(pr + 3096 + h * 64 + 32 + sub * 4);
      R0 = make_uint4(ql.x, ql.y, qh.x, qh.y); R1 = make_uint4(kl.x, kl.y, kh.x, kh.y);
      const uint4* cs = (const uint4*)(ws + OFF_CS + ((size_t)(posb + t) * 32 + sub * 4) * 8);
      R4 = cs[0]; R5 = cs[1];
    }
  }
}

__device__ __forceinline__ float dpp_hm(float x) {
  return __int_as_float(__builtin_amdgcn_update_dpp(0, __float_as_int(x), 0x141, 0xF, 0xF, true));
}
__device__ __forceinline__ float dpp_rm(float x) {
  return __int_as_float(__builtin_amdgcn_update_dpp(0, __float_as_int(x), 0x140, 0xF, 0xF, true));
}
__device__ __forceinline__ float red8d(float x) { x += dpp_x1(x); x += dpp_x2(x); x += dpp_hm(x); return x; }
template <int KG> __device__ __forceinline__ float redKG(float x) { x = red8d(x); if (KG == 16) x += dpp_rm(x); return x; }

template <int MIX, int KPL>
struct StepIn { float q[KPL], k[KPL], d[KPL]; float v, a, be, qk; };

template <int MIX, int KPL>
__device__ __forceinline__ void load_step(const float* qkdv, const float* scal, int t, int kg, int col, StepIn<MIX, KPL>& s) {
  const float* base = qkdv + t * 256;
#pragma unroll
  for (int i = 0; i < KPL; i += 4) {
    const f32x4 a = *(const f32x4*)(base + kg * KPL + i), b = *(const f32x4*)(base + 64 + kg * KPL + i);
    s.q[i] = a[0]; s.q[i + 1] = a[1]; s.q[i + 2] = a[2]; s.q[i + 3] = a[3];
    s.k[i] = b[0]; s.k[i + 1] = b[1]; s.k[i + 2] = b[2]; s.k[i + 3] = b[3];
    if (MIX == 1 || MIX == 2) { const f32x4 d = *(const f32x4*)(base + 128 + kg * KPL + i); s.d[i] = d[0]; s.d[i + 1] = d[1]; s.d[i + 2] = d[2]; s.d[i + 3] = d[3]; }
  }
  s.v = base[192 + col];
  if (MIX == 0) { const f32x4 c = *(const f32x4*)(scal + t * 4); s.a = c[0]; s.be = c[1]; s.qk = c[2]; }
}

template <int MIX, int KPL, int KG>
__device__ __forceinline__ float do_step(const StepIn<MIX, KPL>& s, float (&S)[KPL], const float gam) {
  if (MIX == 0) {
    float kS0 = 0.f, kS1 = 0.f, qS0 = 0.f, qS1 = 0.f;
#pragma unroll
    for (int i = 0; i < KPL; i += 2) { kS0 += s.k[i] * S[i]; kS1 += s.k[i + 1] * S[i + 1]; qS0 += s.q[i] * S[i]; qS1 += s.q[i + 1] * S[i + 1]; }
    const float kS = redKG<KG>(kS0 + kS1), qS = redKG<KG>(qS0 + qS1);
    const float w = s.be * (s.v - s.a * kS);
#pragma unroll
    for (int i = 0; i < KPL; ++i) S[i] = s.a * S[i] + s.k[i] * w;
    return s.a * qS + s.qk * w;
  } else {
    float o0 = 0.f, o1 = 0.f;
#pragma unroll
    for (int i = 0; i < KPL; i += 2) {
      const float d0 = (MIX == 3) ? gam : s.d[i], d1 = (MIX == 3) ? gam : s.d[i + 1];
      S[i] = d0 * S[i] + s.k[i] * s.v; S[i + 1] = d1 * S[i + 1] + s.k[i + 1] * s.v;
      o0 += s.q[i] * S[i]; o1 += s.q[i + 1] * S[i + 1];
    }
    return redKG<KG>(o0 + o1);
  }
}

template <int MIX>
__device__ __forceinline__ void scan_part(const Params& p, const int layer, const int smp, const int b0, const int bstep, const int bend, const int h, const int part, char* lds, const int tid) {
  constexpr int DK = (MIX == 2) ? 32 : 64;
  constexpr int NS = (MIX == 0) ? 4 : 2;
  constexpr int CW = 64 / NS;
  constexpr int CPW = CW / 4;
  constexpr int KG = 64 / CPW;
  constexpr int KPL = DK / KG;
  constexpr int VN = CW / 8;
  constexpr int RS = 128 + CW;
  float* qkdv = (float*)lds;
  float* obuf = (float*)(lds + 32768);
  float* scal = (float*)(lds + 36864);
  bf16_t* rawb = (bf16_t*)(lds + 37376);
  float* cwl = (float*)(lds + 48576);
  float* wgl = (float*)(lds + 37376);

  const int lane = tid & 63, wv = tid >> 6;
  const int tt = tid >> 3, sub = tid & 7;
  const int col = wv * CPW + lane / KG, kg = lane % KG;
  const int T = smp ? 4 : TPR;
  const int nBatch = smp ? NSB : NB;
  const int posb = smp ? 2064 : 0;
  const int vcol = part * CW + sub * VN;
  __syncthreads();
  float c8[8];
  float Aexp = 0.f, dtb = 0.f, gam = 0.f;
  if (MIX == 0) {
    Aexp = __expf(p.I(12)[layer * 4 + h]); dtb = p.I(13)[layer * 4 + h];
    for (int e = tid; e < 4 * RS; e += 256) { const int j = e / RS, r = e % RS;
      const int cc = (r < 64) ? (h * 64 + r) : (r < 128) ? (256 + h * 64 + r - 64) : (512 + h * 64 + part * CW + r - 128);
      cwl[e] = p.I(11)[(size_t)(layer * 4 + j) * 768 + cc]; }
  } else if (MIX == 1) {
#pragma unroll
    for (int i = 0; i < 8; ++i) {
      const int d = h * 64 + sub * 8 + i;
      c8[i] = (layer == 0) ? 1.0f : sigmoidf_(p.I(15)[d] - p.I(15)[256 + d]);
    }
  } else if (MIX == 2) {
    for (int e = tid; e < 512; e += 256) { const int r = e >> 5, j = e & 31; wgl[e] = p.I(17)[(size_t)(layer * 16 + r) * 128 + h * 32 + j]; }
#pragma unroll
    for (int i = 0; i < 4; ++i) c8[i] = p.I(18)[layer * 128 + h * 32 + sub * 4 + i];
  } else {
    gam = 1.0f - exp2f(-5.0f - (float)h);
  }
  for (int b = b0; b < bend; b += bstep) {
  const int row0 = smp ? MP + b * 4 : b * TPR;
  const bf16_t* Pb = (const bf16_t*)(p.W() + OFF_P) + (size_t)row0 * DINP;
  bf16_t* Ob = (bf16_t*)p.O() + (size_t)row0 * 1024 + MIX * 256 + h * 64 + part * CW;
  float* PS = (float*)((unsigned char*)p.O() + DOUT_PS) + (size_t)row0 * 128 + (MIX * 4 + h) * 8 + part * 2;
  uint4 R0 = make_uint4(0, 0, 0, 0), R1 = R0, R4 = R0, R5 = R0; uint2 R2 = make_uint2(0, 0); unsigned ex0 = 0, ex1 = 0;
  load_chunk_fn<MIX, VN>(p.W(), Pb, tt, T, h, vcol, sub, posb, R0, R1, R2, R4, R5, ex0, ex1);
  float S[KPL];
  if (smp) {
    const float* sin_ = p.I(3 + MIX) + ((size_t)(layer * NSB + b) * 4 + h) * DK * 64 + part * CW;
#pragma unroll
    for (int i = 0; i < KPL; ++i) S[i] = sin_[(kg * KPL + i) * 64 + col];
  } else {
#pragma unroll
    for (int i = 0; i < KPL; ++i) S[i] = 0.f;
  }
  if (MIX == 0) {
    for (int e = tid; e < 3 * RS; e += 256) { const int j = e / RS, r = e % RS;
      const int cc = (r < 64) ? (h * 64 + r) : (r < 128) ? (256 + h * 64 + r - 64) : (512 + h * 64 + part * CW + r - 128);
      float v = 0.f; if (smp) v = p.I(2)[((size_t)(layer * NSB + b) * 3 + j) * 768 + cc];
      rawb[e] = (bf16_t)f2bf(v); }
  }
  __syncthreads();

  int ntok_last = 0;
  for (int t0 = 0; t0 < T; t0 += 32) {
    const int ntok = min(32, T - t0);
    ntok_last = ntok;
    const bool valid = tt < ntok;
    float* dst = qkdv + tt * 256;
    if (MIX != 0 && valid) {
      if (VN == 4) *(f32x4*)(dst + 192 + sub * 4) = (f32x4){bflo(R2.x), bfhi(R2.x), bflo(R2.y), bfhi(R2.y)};
      else *(float2*)(dst + 192 + sub * 2) = make_float2(bflo(R2.x), bfhi(R2.x));
    }
    if (MIX == 0) {
      if (valid) {
        *(uint4*)(rawb + (3 + tt) * RS + 0 + sub * 8) = R0;
        *(uint4*)(rawb + (3 + tt) * RS + 64 + sub * 8) = R1;
        if (VN == 4) *(uint2*)(rawb + (3 + tt) * RS + 128 + sub * 4) = R2;
        else *(unsigned*)(rawb + (3 + tt) * RS + 128 + sub * 2) = R2.x;
      }
      __syncthreads();
      if (valid) {
        float xq[8], xk[8], xv[VN];
        convN<8, RS>(rawb, cwl, tt, sub * 8, xq);
        convN<8, RS>(rawb, cwl, tt, 64 + sub * 8, xk);
        convN<VN, RS>(rawb, cwl, tt, 128 + sub * VN, xv);
#pragma unroll
        for (int i = 0; i < VN; ++i) dst[192 + sub * VN + i] = xv[i];
        float ssq = 0.f, ssk = 0.f;
#pragma unroll
        for (int i = 0; i < 8; ++i) { ssq += xq[i] * xq[i]; ssk += xk[i] * xk[i]; }
        ssq = red8d(ssq); ssk = red8d(ssk);
        const float rq = rsqrtf(ssq + 1e-6f) * 0.125f, rk = rsqrtf(ssk + 1e-6f);
        float qk = 0.f;
#pragma unroll
        for (int i = 0; i < 8; ++i) { xq[i] *= rq; xk[i] *= rk; qk += xq[i] * xk[i]; }
        qk = red8d(qk);
        *(f32x4*)(dst + sub * 8) = (f32x4){xq[0], xq[1], xq[2], xq[3]}; *(f32x4*)(dst + sub * 8 + 4) = (f32x4){xq[4], xq[5], xq[6], xq[7]};
        *(f32x4*)(dst + 64 + sub * 8) = (f32x4){xk[0], xk[1], xk[2], xk[3]}; *(f32x4*)(dst + 64 + sub * 8 + 4) = (f32x4){xk[4], xk[5], xk[6], xk[7]};
        if (sub == 0) {
          const float be = sigmoidf_(bflo(ex0)), al = bflo(ex1);
          const float a = __expf(-Aexp * softplusf_(al + dtb));
          *(f32x4*)(scal + tt * 4) = (f32x4){a, be, qk, 0.f};
        }
      }
    } else if (MIX == 1) {
      if (valid) {
        float q[8], z[8]; unpack8(R0, q); unpack8(R1, z);
        float kk[8], dd[8];
#pragma unroll
        for (int i = 0; i < 8; ++i) { q[i] = siluf_(q[i]); kk[i] = c8[i] * sigmoidf_(-z[i]); dd[i] = 1.0f - fminf(kk[i], 1.0f - 1e-6f); }
        *(f32x4*)(dst + sub * 8) = (f32x4){q[0], q[1], q[2], q[3]}; *(f32x4*)(dst + sub * 8 + 4) = (f32x4){q[4], q[5], q[6], q[7]};
        *(f32x4*)(dst + 64 + sub * 8) = (f32x4){kk[0], kk[1], kk[2], kk[3]}; *(f32x4*)(dst + 64 + sub * 8 + 4) = (f32x4){kk[4], kk[5], kk[6], kk[7]};
        *(f32x4*)(dst + 128 + sub * 8) = (f32x4){dd[0], dd[1], dd[2], dd[3]}; *(f32x4*)(dst + 128 + sub * 8 + 4) = (f32x4){dd[4], dd[5], dd[6], dd[7]};
      }
    } else if (MIX == 2) {
      if (valid) {
        float lr[16]; unpack8(R1, lr); unpack8(R4, lr + 8);
        const float q0 = bflo(R0.x), q1 = bfhi(R0.x), q2 = bflo(R0.y), q3 = bfhi(R0.y);
        const float k0 = bflo(R0.z), k1 = bfhi(R0.z), k2 = bflo(R0.w), k3 = bfhi(R0.w);
        const float sc = 0.17677669529663687f;
        f32x4 xg = (f32x4){c8[0], c8[1], c8[2], c8[3]};
#pragma unroll
        for (int r = 0; r < 16; ++r) xg += lr[r] * *(const f32x4*)(wgl + r * 32 + sub * 4);
        f32x4 dd;
#pragma unroll
        for (int i = 0; i < 4; ++i) { const float ls = fminf(xg[i], 0.f) - __logf(1.0f + __expf(-fabsf(xg[i]))); dd[i] = __expf(ls * 0.0625f); }
        *(f32x4*)(dst + sub * 4) = (f32x4){q0 * sc, q1 * sc, q2 * sc, q3 * sc};
        *(f32x4*)(dst + 64 + sub * 4) = (f32x4){k0, k1, k2, k3};
        *(f32x4*)(dst + 128 + sub * 4) = dd;
      }
    } else {
      if (valid) {
        const float ql[4] = {bflo(R0.x), bfhi(R0.x), bflo(R0.y), bfhi(R0.y)}, qh[4] = {bflo(R0.z), bfhi(R0.z), bflo(R0.w), bfhi(R0.w)};
        const float kl[4] = {bflo(R1.x), bfhi(R1.x), bflo(R1.y), bfhi(R1.y)}, kh[4] = {bflo(R1.z), bfhi(R1.z), bflo(R1.w), bfhi(R1.w)};
        const float cc[4] = {__uint_as_float(R4.x), __uint_as_float(R4.z), __uint_as_float(R5.x), __uint_as_float(R5.z)};
        const float sn[4] = {__uint_as_float(R4.y), __uint_as_float(R4.w), __uint_as_float(R5.y), __uint_as_float(R5.w)};
        f32x4 qa, qb, ka, kb;
#pragma unroll
        for (int i = 0; i < 4; ++i) {
          qa[i] = ql[i] * cc[i] - qh[i] * sn[i]; qb[i] = ql[i] * sn[i] + qh[i] * cc[i];
          ka[i] = (kl[i] * cc[i] - kh[i] * sn[i]) * 0.125f; kb[i] = (kl[i] * sn[i] + kh[i] * cc[i]) * 0.125f;
        }
        *(f32x4*)(dst + sub * 4) = qa; *(f32x4*)(dst + 32 + sub * 4) = qb;
        *(f32x4*)(dst + 64 + sub * 4) = ka; *(f32x4*)(dst + 96 + sub * 4) = kb;
      }
    }
    __syncthreads();
    if (MIX == 0 && t0 + 32 < T) {
      if (tid < 3 * RS / 8) { const uint4 v = *(const uint4*)(rawb + 32 * RS + tid * 8); *(uint4*)(rawb + tid * 8) = v; }
    }
    if (t0 + 32 < T) load_chunk_fn<MIX, VN>(p.W(), Pb, t0 + 32 + tt, T, h, vcol, sub, posb, R0, R1, R2, R4, R5, ex0, ex1);
    {
      StepIn<MIX, KPL> sa, sb;
      float osave = 0.f;
      load_step<MIX, KPL>(qkdv, scal, 0, kg, col, sa);
      for (int t = 0; t < ntok; t += 2) {
        load_step<MIX, KPL>(qkdv, scal, t + 1, kg, col, sb);
        __builtin_amdgcn_sched_barrier(0);
        const float oa = do_step<MIX, KPL, KG>(sa, S, gam);
        osave = (kg == (t & (KG - 1))) ? oa : osave;
        load_step<MIX, KPL>(qkdv, scal, min(t + 2, ntok - 1), kg, col, sa);
        __builtin_amdgcn_sched_barrier(0);
        const float ob = do_step<MIX, KPL, KG>(sb, S, gam);
        osave = (kg == ((t + 1) & (KG - 1))) ? ob : osave;
        if (((t + 2) & (KG - 1)) == 0) obuf[(t + 2 - KG + kg) * CW + col] = osave;
      }
      const int remn = ntok & (KG - 1);
      if (remn != 0 && kg < remn) obuf[(ntok - remn + kg) * CW + col] = osave;
    }
    __syncthreads();
    if (valid) {
      float o[VN];
#pragma unroll
      for (int i = 0; i < VN; ++i) o[i] = obuf[tt * CW + sub * VN + i];
      float s1 = 0.f, s2 = 0.f;
#pragma unroll
      for (int i = 0; i < VN; ++i) { s1 += o[i]; s2 += o[i] * o[i]; }
      s1 = red8d(s1); s2 = red8d(s2);
      if (VN == 4) { uint2 o2; o2.x = pk2(o[0], o[1]); o2.y = pk2(o[2 % VN], o[3 % VN]); *(uint2*)(Ob + (size_t)(t0 + tt) * 1024 + sub * 4) = o2; }
      else *(unsigned*)(Ob + (size_t)(t0 + tt) * 1024 + sub * 2) = pk2(o[0], o[1]);
      if (sub == 0) *(float2*)(PS + (size_t)(t0 + tt) * 128) = make_float2(s1, s2);
    }
  }
  {
    const size_t obase = (MIX == 0) ? (smp ? O_DS : O_DP) : (MIX == 1) ? (smp ? O_HS : O_HP) : (MIX == 2) ? (smp ? O_GS : O_GP) : (smp ? O_RS : O_RP);
    float* so = p.O() + obase + ((size_t)(layer * nBatch + b) * 4 + h) * DK * 64 + part * CW;
#pragma unroll
    for (int i = 0; i < KPL; ++i) so[(kg * KPL + i) * 64 + col] = S[i];
  }
  if (MIX == 0) {
    float* co = p.O() + (smp ? O_CS : O_CP) + (size_t)(layer * nBatch + b) * 3 * 768;
    for (int e = tid; e < 3 * RS; e += 256) { const int j = e / RS, r = e % RS;
      const float v = bflo((unsigned)rawb[(ntok_last + j) * RS + r]);
      if (r < 128) { if (part == 0) co[j * 768 + ((r < 64) ? (h * 64 + r) : (256 + h * 64 + r - 64))] = v; }
      else co[j * 768 + 512 + h * 64 + part * CW + r - 128] = v; }
  }
  __syncthreads();
  }
}

constexpr int ITEMS_PER_SEQ = 40;
__device__ __forceinline__ void scan_dispatch(const Params& p, int layer, int smp, int type, int b0, int bstep, int bend, char* lds, const int tid) {
  const int r = type;
  if (r < 16) scan_part<0>(p, layer, smp, b0, bstep, bend, r >> 2, r & 3, lds, tid);
  else {
    const int r2 = r - 16, mh = 4 + (r2 >> 1), part = r2 & 1, mix = mh >> 2, h = mh & 3;
    if (mix == 1) scan_part<1>(p, layer, smp, b0, bstep, bend, h, part, lds, tid);
    else if (mix == 2) scan_part<2>(p, layer, smp, b0, bstep, bend, h, part, lds, tid);
    else scan_part<3>(p, layer, smp, b0, bstep, bend, h, part, lds, tid);
  }
}

__device__ __forceinline__ int long_item_type(int u, int& b) {
  int type;
  if (u < 64) { b = u >> 3; type = 24 + (u & 7); }
  else if (u < 192) { const int v = u - 64; b = v >> 4; type = v & 15; }
  else if (u < 256) { const int v = u - 192; b = v >> 3; type = 16 + (v & 7); }
  else { const int v = u - 256; b = v >> 3; type = 32 + (v & 7); }
  return type;
}
__device__ __forceinline__ void scan_phase(const Params& p, int layer, char* lds, int bid, int nb, const int tid, const int role, const int ci, const int nprim, const int nsec) {
  constexpr int NPI = NB * ITEMS_PER_SEQ;
  const bool paired = (nprim == 256 && nsec == 256);
  int j = -1, nbs = 1;
  if (paired) {
    int u = -1;
    if (role == 0) u = ci; else if (ci < NPI - 256) u = 256 + ci;
    if (u >= 0) { int b; const int type = long_item_type(u, b); scan_dispatch(p, layer, 0, type, b, 1, b + 1, lds, tid); }
    else { j = ci - (NPI - 256); nbs = 256 - (NPI - 256); }
  } else {
    for (int u = bid; u < NPI; u += nb) { int b; const int type = long_item_type(u, b); scan_dispatch(p, layer, 0, type, b, 1, b + 1, lds, tid); }
    nbs = (nb > NPI) ? nb - NPI : nb; j = (nb > NPI) ? bid - NPI : bid;
  }
  if (j >= 0) {
    const int nsl = (nbs + ITEMS_PER_SEQ - 1) / ITEMS_PER_SEQ;
    for (int jj = j; jj < ITEMS_PER_SEQ * nsl; jj += nbs) scan_dispatch(p, layer, 1, jj % ITEMS_PER_SEQ, jj / ITEMS_PER_SEQ, nsl, NSB, lds, tid);
    if (layer == 0) { __syncthreads(); convert_weights(p, lds, 992 + j, 6720, nbs, tid); }
  }
}

__device__ __forceinline__ void norm_phase(const Params& p, int layer, int bid, int nb, const int tid) {
  bf16_t* O = (bf16_t*)p.O();
  const bf16_t* P = (const bf16_t*)(p.W() + OFF_P);
  const float* PS = (const float*)((const unsigned char*)p.O() + DOUT_PS);
  const int cg8 = tid & 127;
  const int mh = cg8 >> 3, mix = mh >> 2, h = mh & 3, j0 = (cg8 & 7) * 8;
  const int gcol = (mix == 0) ? 776 : (mix == 1) ? 1800 : (mix == 2) ? 2584 : 3608;
  const float* gsrc = (mix == 0) ? p.I(14) : (mix == 1) ? p.I(16) : (mix == 2) ? p.I(19) : p.I(20);
  float g8[8];
#pragma unroll
  for (int i = 0; i < 8; ++i) g8[i] = gsrc[layer * 256 + h * 64 + j0 + i];
  uint4 ovn, gvn; f32x4 psn, ps2n = (f32x4){0.f, 0.f, 0.f, 0.f};
  {
    const int r0 = min(bid * 2 + (tid >> 7), MT - 1);
    ovn = *(const uint4*)(O + (size_t)r0 * 1024 + cg8 * 8);
    gvn = *(const uint4*)(P + (size_t)r0 * DINP + gcol + h * 64 + j0);
    psn = *(const f32x4*)(PS + (size_t)r0 * 128 + mh * 8);
    if (mix == 0) ps2n = *(const f32x4*)(PS + (size_t)r0 * 128 + mh * 8 + 4);
  }
  for (int row = bid * 2 + (tid >> 7); row < MT; row += nb * 2) {
    const uint4 ov = ovn, gv = gvn; const f32x4 ps = psn, ps2 = ps2n;
    {
      const int rn = min(row + nb * 2, MT - 1);
      ovn = *(const uint4*)(O + (size_t)rn * 1024 + cg8 * 8);
      gvn = *(const uint4*)(P + (size_t)rn * DINP + gcol + h * 64 + j0);
      psn = *(const f32x4*)(PS + (size_t)rn * 128 + mh * 8);
      if (mix == 0) ps2n = *(const f32x4*)(PS + (size_t)rn * 128 + mh * 8 + 4);
    }
    float s1 = ps[0] + ps[2], s2 = ps[1] + ps[3];
    if (mix == 0) { s1 += ps2[0] + ps2[2]; s2 += ps2[1] + ps2[3]; }
    float o[8], gt[8]; unpack8(ov, o); unpack8(gv, gt);
    float mu = 0.f, rs;
    if (mix == 3) { mu = s1 * (1.0f / 64.0f); const float var = fmaxf(s2 * (1.0f / 64.0f) - mu * mu, 0.f); rs = rsqrtf(var + 1e-5f); }
    else rs = rsqrtf(s2 * (1.0f / 64.0f) + 1e-6f);
    float r[8];
#pragma unroll
    for (int i = 0; i < 8; ++i) r[i] = (o[i] - mu) * rs * g8[i] * siluf_(gt[i]);
    uint4 o4; o4.x = pk2(r[0], r[1]); o4.y = pk2(r[2], r[3]); o4.z = pk2(r[4], r[5]); o4.w = pk2(r[6], r[7]);
    *(uint4*)(O + (size_t)row * 1024 + cg8 * 8) = o4;
  }
}

constexpr int NPHASE = 17;
__global__ void __launch_bounds__(256, 2) hymba_fwd(Params p_, int ph_lo, int ph_hi) {
  __shared__ __attribute__((aligned(16))) char lds[65536];
  XcdBarrier xb; xb.bar = (unsigned*)(p_.ws + OFF_BAR); xb.x = xb_xcc_id(); xb.nloc = 0u; xb.nx = 0u;
  if (threadIdx.x == 0) (void)xb_add(&xb.bar[XB_XCNT(xb.x)], 1u);
  int role = 0, ci = 0;
  {
    const unsigned key = ((((unsigned)__builtin_amdgcn_s_getreg((31 << 11) | 4)) >> 8) & 0xFFu) | (xb.x << 8);
    if (threadIdx.x == 0) {
      const unsigned slot = xb_add(&xb.bar[CEN_TAB + key], 1u);
      unsigned r;
      if (slot == 0u) { r = xb_add(&xb.bar[CEN_CNT], 1u); __hip_atomic_store(&xb.bar[CEN_TAB2 + key], r + 1u, __ATOMIC_RELAXED, __HIP_MEMORY_SCOPE_AGENT); }
      else { (void)xb_add(&xb.bar[CEN_CNT + 1], 1u); r = 0u; }
      *(volatile unsigned*)(lds) = slot == 0u ? 0u : 1u; *(volatile unsigned*)(lds + 4) = r;
    }
    __syncthreads();
    role = (int)*(volatile unsigned*)(lds); ci = (int)*(volatile unsigned*)(lds + 4);
    __syncthreads();
    role = __builtin_amdgcn_readfirstlane(role); ci = __builtin_amdgcn_readfirstlane(ci);
    if (role != 0) ci = -1 - (int)key;
  }
  int nprim = 0, nsec = 0;
  if (ph_hi < 0) cg::this_grid().sync();
  for (int ph = ph_lo; ph < ph_hi; ++ph) {
    int tid = threadIdx.x, bid = blockIdx.x, nb = gridDim.x;
    asm volatile("" : "+v"(tid));
    asm volatile("" : "+s"(bid), "+s"(nb));
    if (ph > ph_lo) xcd_barrier(xb, tid, (unsigned)nb);
    if (ph == ph_lo + 1) {
      nprim = (int)xb_ld(&xb.bar[CEN_CNT]); nsec = (int)xb_ld(&xb.bar[CEN_CNT + 1]);
      if (role != 0) { const unsigned v = xb_ld(&xb.bar[CEN_TAB2 + (unsigned)(-1 - ci)]); ci = (v > 0u) ? (int)v - 1 : 0; }
      nprim = __builtin_amdgcn_readfirstlane(nprim); nsec = __builtin_amdgcn_readfirstlane(nsec); ci = __builtin_amdgcn_readfirstlane(ci);
    }
    const Params& p = p_;
    if (ph == 0) {
      convert_weights(p, lds, bid, 992, nb, tid);
      embed_ln(p, bid, nb, tid);
      rope_table(p, bid, nb, tid);
    } else {
      const int l = (ph - 1) / 8, s = (ph - 1) % 8;
      const bf16_t* Xb = (const bf16_t*)p.O();
      bf16_t* X1b = (bf16_t*)(p.W() + OFF_X1B);
      bf16_t* Hb = (bf16_t*)(p.W() + OFF_H);
      float* X = (float*)(p.W() + OFF_X);
      if (s == 0) gemm_phase<EPI_BF16>(Xb, 1024, (const bf16_t*)(p.W() + OFF_WIN + l * SZ_WIN), 1024, 1024, DINP / 128, p.W() + OFF_P, DINP, lds, bid, nb, tid);
      else if (s == 1) scan_phase(p, l, lds, bid, nb, tid, role, ci, nprim, nsec);
      else if (s == 2) norm_phase(p, l, bid, nb, tid);
      else if (s == 3) gemm_phase<EPI_RESID>(Xb, 1024, (const bf16_t*)(p.W() + OFF_WOUT + l * SZ_WOUT), 1024, 1024, 8, X, 1024, lds, bid, nb, tid);
      else if (s == 4) ln_phase(p, p.I(22) + l * 1024, p.I(23) + l * 1024, X1b, 0, bid, nb, tid);
      else if (s == 5) gemm_phase<EPI_SWIGLU>(X1b, 1024, (const bf16_t*)(p.W() + OFF_WGU + l * SZ_WGU), 1024, 1024, 44, Hb, DFF, lds, bid, nb, tid);
      else if (s == 6) gemm_phase<EPI_RESID>(Hb, DFF, (const bf16_t*)(p.W() + OFF_WDN + l * SZ_WDN), DFF, DFF, 8, X, 1024, lds, bid, nb, tid);
      else ln_phase(p, p.I(27) + l * 1024, p.I(28) + l * 1024, (bf16_t*)p.O(), l == 1, bid, nb, tid);
    }
  }
}

extern "C" void kernel_launch(void* const* d_in, const int* in_sizes, int n_in, void* d_out, int out_size, void* d_ws, size_t ws_size,
                              hipStream_t stream) {
  (void)in_sizes; (void)out_size;
  if (n_in < 29 || ws_size < WS_NEED) { fprintf(stderr, "bad args: n_in %d ws %zu need %zu\n", n_in, ws_size, (size_t)WS_NEED); return; }
  Params p{};
  for (int i = 0; i < 29; ++i) p.in[i] = (const float*)d_in[i];
  p.out = (float*)d_out;
  p.ws = (unsigned char*)d_ws;
  static int grid_blocks = 0;
  if (!grid_blocks) {
    int dev = 0, cus = 0, per_cu = 0;
    (void)hipGetDevice(&dev);
    (void)hipDeviceGetAttribute(&cus, hipDeviceAttributeMultiprocessorCount, dev);
    (void)hipOccupancyMaxActiveBlocksPerMultiprocessor(&per_cu, hymba_fwd, 256, 0);
    if (per_cu > 2) per_cu = 2;
    if (per_cu < 1) per_cu = 1;
    grid_blocks = cus * per_cu;
  }
  (void)hipMemsetAsync((unsigned char*)d_ws + OFF_BAR, 0, BAR_BYTES, stream);
  int lo = 0, hi = NPHASE;
  void* args[] = {&p, &lo, &hi};
  hipError_t e = hipLaunchCooperativeKernel((void*)hymba_fwd, dim3(grid_blocks), dim3(256), args, 0, stream);
  if (e != hipSuccess) fprintf(stderr, "cooperative launch failed: %s (grid %d)\n", hipGetErrorString(e), grid_blocks);
}
```

```cpp
#include <hip/hip_runtime.h>
#include <hip/hip_cooperative_groups.h>
#include <cstdio>
#include <cstdint>
namespace cg = cooperative_groups;

#ifndef COOP
#define COOP 1
#endif

typedef unsigned short bf16_t;
typedef short bf16x8 __attribute__((ext_vector_type(8)));
typedef float f32x4 __attribute__((ext_vector_type(4)));

constexpr int DM = 1024, NB = 8, TPR = 2064, NSB = 128, TS = 4;
constexpr int MP = NB * TPR;
constexpr int MS = NSB * TS;
constexpr int MT = MP + MS;
constexpr int DIN = 3864, DINP = 3968, DFF = 2816;
constexpr float ALPHA = 1.41421356237309515f;

constexpr size_t SZ_WIN = (size_t)DINP * 1024 * 2, SZ_WOUT = (size_t)1024 * 1024 * 2, SZ_WGU = (size_t)5632 * 1024 * 2, SZ_WDN = (size_t)1024 * 2816 * 2;
constexpr size_t OFF_CS = 0;
constexpr size_t OFF_WIN = 532480;
constexpr size_t OFF_WOUT = OFF_WIN + 2 * SZ_WIN;
constexpr size_t OFF_WGU = OFF_WOUT + 2 * SZ_WOUT;
constexpr size_t OFF_WDN = OFF_WGU + 2 * SZ_WGU;
constexpr size_t OFF_X = OFF_WDN + 2 * SZ_WDN;
constexpr size_t OFF_P = OFF_X + (size_t)MT * 1024 * 4;
constexpr size_t OFF_X1B = OFF_P;
constexpr size_t OFF_H = OFF_P + (size_t)MT * 1024 * 2;
constexpr size_t OFF_BAR = OFF_P + (size_t)MT * DINP * 2;
constexpr int CEN_CNT = 3520, CEN_TAB = 4096, CEN_TAB2 = 8192;
constexpr size_t BAR_BYTES = 12288 * 4;
constexpr size_t WS_NEED = OFF_BAR + BAR_BYTES;
constexpr size_t DOUT_PS = 36000000;

constexpr size_t O_YP = 0, O_YS = 16777216, O_CP = 17301504, O_CS = 17338368, O_DP = 17928192, O_DS = 18190336,
                 O_HP = 22384640, O_HS = 22646784, O_GP = 26841088, O_GS = 26972160, O_RP = 29069312, O_RS = 29331456;

#define GAS __attribute__((address_space(1)))
struct Params {
  const float* in[29];
  float* out;
  unsigned char* ws;
  __device__ __forceinline__ const float* I(int i) const { return (const float*)(const GAS float*)in[i]; }
  __device__ __forceinline__ float* O() const { return (float*)(GAS float*)out; }
  __device__ __forceinline__ unsigned char* W() const { return (unsigned char*)(GAS unsigned char*)ws; }
};

__device__ __forceinline__ unsigned f2bf(float f) {
  unsigned u = __float_as_uint(f);
  u += 0x7fffu + ((u >> 16) & 1u);
  return u >> 16;
}
typedef float f32x2_t __attribute__((ext_vector_type(2)));
typedef __bf16 bf16x2_t __attribute__((ext_vector_type(2)));
__device__ __forceinline__ unsigned pk2(float lo, float hi) { const f32x2_t v = {lo, hi}; const bf16x2_t b = __builtin_convertvector(v, bf16x2_t); return __builtin_bit_cast(unsigned, b); }
__device__ __forceinline__ float bflo(unsigned u) { return __uint_as_float(u << 16); }
__device__ __forceinline__ float bfhi(unsigned u) { return __uint_as_float(u & 0xffff0000u); }
__device__ __forceinline__ void unpack8(const uint4& r, float* x) {
  x[0] = bflo(r.x); x[1] = bfhi(r.x); x[2] = bflo(r.y); x[3] = bfhi(r.y);
  x[4] = bflo(r.z); x[5] = bfhi(r.z); x[6] = bflo(r.w); x[7] = bfhi(r.w);
}
__device__ __forceinline__ float sigmoidf_(float x) { return __builtin_amdgcn_rcpf(1.0f + __expf(-x)); }
__device__ __forceinline__ float siluf_(float x) { return x * __builtin_amdgcn_rcpf(1.0f + __expf(-x)); }
__device__ __forceinline__ float softplusf_(float x) { return fmaxf(x, 0.f) + __logf(1.0f + __expf(-fabsf(x))); }
__device__ __forceinline__ float red8(float x) {
  x += __shfl_xor(x, 1); x += __shfl_xor(x, 2); x += __shfl_xor(x, 4); return x;
}
__device__ __forceinline__ float dpp_x1(float x) {
  return __int_as_float(__builtin_amdgcn_update_dpp(0, __float_as_int(x), 0xB1, 0xF, 0xF, true));
}
__device__ __forceinline__ float dpp_x2(float x) {
  return __int_as_float(__builtin_amdgcn_update_dpp(0, __float_as_int(x), 0x4E, 0xF, 0xF, true));
}
__device__ __forceinline__ float red4(float x) { x += dpp_x1(x); x += dpp_x2(x); return x; }
__device__ __forceinline__ float wave_sum(float x) {
#pragma unroll
  for (int o = 32; o >= 1; o >>= 1) x += __shfl_xor(x, o);
  return x;
}

__device__ __forceinline__ void convert_weights(const Params& p, char* lds, int w0, int w1, int wstep, const int tid) {
  float* tile = (float*)lds;
  for (int w = w0; w < w1; w += wstep) {
    const int l = w / 3360; int r = w % 3360;
    int mat, kt, rt;
    if (r < 992) { mat = 0; kt = r / 62; rt = r % 62; }
    else if (r < 1248) { r -= 992; mat = 1; kt = r / 16; rt = r % 16; }
    else if (r < 2656) { r -= 1248; mat = 2; kt = r / 88; rt = r % 88; }
    else { r -= 2656; mat = 3; kt = r / 16; rt = r % 16; }
    {
      const int r4 = (tid & 15) * 4, R = rt * 64 + r4, kq = tid >> 4;
      const float* src; int ns; bool valid = true;
      if (mat == 0) { const int rho = R & 31, scol = (R & ~31) + 8 * ((rho & 15) >> 2) + 4 * (rho >> 4) + (rho & 3);
        src = p.I(10) + (size_t)l * 1024 * DIN + scol; ns = DIN; valid = scol < DIN; }
      else if (mat == 1) { src = p.I(21) + (size_t)l * 1024 * 1024 + R; ns = 1024; }
      else if (mat == 2) { const int q = R & 63, f = q >> 4, i = q & 15, ty = f & 1, hid = (R >> 6) * 32 + 8 * (i >> 2) + 4 * (f >> 1) + (i & 3);
        src = (ty ? p.I(25) : p.I(24)) + (size_t)l * 1024 * DFF + hid; ns = DFF; }
      else { src = p.I(26) + (size_t)l * DFF * 1024 + R; ns = 1024; }
      f32x4 v[4];
#pragma unroll
      for (int i = 0; i < 4; ++i) v[i] = valid ? *(const f32x4*)(src + (size_t)(kt * 64 + kq + 16 * i) * ns) : (f32x4){0.f, 0.f, 0.f, 0.f};
#pragma unroll
      for (int i = 0; i < 4; ++i) {
        const int k = kq + 16 * i;
        tile[(r4 + 0) * 65 + k] = v[i][0]; tile[(r4 + 1) * 65 + k] = v[i][1]; tile[(r4 + 2) * 65 + k] = v[i][2]; tile[(r4 + 3) * 65 + k] = v[i][3];
      }
    }
    __syncthreads();
    {
      const int rr = tid >> 2, kc = (tid & 3) * 16;
      const int Kd = (mat == 3) ? DFF : 1024;
      bf16_t* base;
      if (mat == 0) base = (bf16_t*)(p.W() + OFF_WIN + l * SZ_WIN);
      else if (mat == 1) base = (bf16_t*)(p.W() + OFF_WOUT + l * SZ_WOUT);
      else if (mat == 2) base = (bf16_t*)(p.W() + OFF_WGU + l * SZ_WGU);
      else base = (bf16_t*)(p.W() + OFF_WDN + l * SZ_WDN);
      bf16_t* dst = base + (size_t)(rt * 64 + rr) * Kd + kt * 64 + kc;
      const float* s = tile + rr * 65 + kc;
      uint4 a, b;
      a.x = pk2(s[0], s[1]); a.y = pk2(s[2], s[3]); a.z = pk2(s[4], s[5]); a.w = pk2(s[6], s[7]);
      b.x = pk2(s[8], s[9]); b.y = pk2(s[10], s[11]); b.z = pk2(s[12], s[13]); b.w = pk2(s[14], s[15]);
      *(uint4*)dst = a; *(uint4*)(dst + 8) = b;
    }
    __syncthreads();
  }
}

__device__ __forceinline__ void ln_row_regs(f32x4 (&v)[4], const float* g, const float* bb, int lane) {
  float s = 0.f;
#pragma unroll
  for (int i = 0; i < 4; ++i) s += (v[i][0] + v[i][1]) + (v[i][2] + v[i][3]);
  const float mu = wave_sum(s) * (1.0f / 1024.0f);
  float q = 0.f;
#pragma unroll
  for (int i = 0; i < 4; ++i) { const f32x4 d = v[i] - mu; q += (d[0] * d[0] + d[1] * d[1]) + (d[2] * d[2] + d[3] * d[3]); }
  const float rs = rsqrtf(wave_sum(q) * (1.0f / 1024.0f) + 1e-5f);
#pragma unroll
  for (int i = 0; i < 4; ++i) {
    const f32x4 gg = *(const f32x4*)(g + lane * 4 + i * 256), b4 = *(const f32x4*)(bb + lane * 4 + i * 256);
    v[i] = (v[i] - mu) * rs * gg + b4;
  }
}

__device__ __forceinline__ void embed_ln(const Params& p, int bid, int nb, const int tid) {
  const int lane = tid & 63, wv = tid >> 6;
  float* X = (float*)(p.W() + OFF_X);
  bf16_t* Xb = (bf16_t*)p.O();
  for (int row = bid * 4 + wv; row < MT; row += nb * 4) {
    const float* src;
    if (row < MP) { const int b = row / TPR, t = row % TPR;
      src = (t < 16) ? p.I(7) + (size_t)t * 1024 : p.I(0) + ((size_t)b * 2048 + (t - 16)) * 1024; }
    else src = p.I(1) + (size_t)(row - MP) * 1024;
    f32x4 v[4];
#pragma unroll
    for (int i = 0; i < 4; ++i) v[i] = *(const f32x4*)(src + lane * 4 + i * 256);
    ln_row_regs(v, p.I(8), p.I(9), lane);
#pragma unroll
    for (int i = 0; i < 4; ++i) {
      *(f32x4*)(X + (size_t)row * 1024 + lane * 4 + i * 256) = v[i];
      uint2 o; o.x = pk2(v[i][0], v[i][1]); o.y = pk2(v[i][2], v[i][3]);
      *(uint2*)(Xb + (size_t)row * 1024 + lane * 4 + i * 256) = o;
    }
  }
}

__device__ __forceinline__ void rope_table(const Params& p, int bid, int nb, const int tid) {
  float2* cs = (float2*)(p.W() + OFF_CS);
  for (int e = bid * 256 + tid; e < 2068 * 32; e += nb * 256) {
    const int idx = e >> 5, i = e & 31;
    const double pos = (idx < 2064) ? (double)idx : (double)(16384 + idx - 2064);
    const double inv = exp(-((double)i / 31.0) * 9.210340371976184);
    const double ang = pos * inv;
    cs[e] = make_float2((float)cos(ang), (float)sin(ang));
  }
}

__device__ __forceinline__ void ln_phase(const Params& p, const float* g, const float* bb, bf16_t* xb, int final_, int bid, int nb, const int tid) {
  const int lane = tid & 63, wv = tid >> 6;
  float* X = (float*)(p.W() + OFF_X);
  f32x4 nx[4];
  {
    const int r0 = min(bid * 4 + wv, MT - 1);
#pragma unroll
    for (int i = 0; i < 4; ++i) nx[i] = *(const f32x4*)(X + (size_t)r0 * 1024 + lane * 4 + i * 256);
  }
  for (int row = bid * 4 + wv; row < MT; row += nb * 4) {
    f32x4 v[4];
#pragma unroll
    for (int i = 0; i < 4; ++i) v[i] = nx[i];
    {
      const int rn = min(row + nb * 4, MT - 1);
#pragma unroll
      for (int i = 0; i < 4; ++i) nx[i] = *(const f32x4*)(X + (size_t)rn * 1024 + lane * 4 + i * 256);
    }
    ln_row_regs(v, g, bb, lane);
    if (!final_) {
#pragma unroll
      for (int i = 0; i < 4; ++i) {
        *(f32x4*)(X + (size_t)row * 1024 + lane * 4 + i * 256) = v[i];
        uint2 o; o.x = pk2(v[i][0], v[i][1]); o.y = pk2(v[i][2], v[i][3]);
        *(uint2*)(xb + (size_t)row * 1024 + lane * 4 + i * 256) = o;
      }
    } else {
      float* dst = nullptr;
      if (row < MP) { const int b = row / TPR, t = row % TPR; if (t >= 16) dst = p.O() + O_YP + ((size_t)b * 2048 + (t - 16)) * 1024; }
      else dst = p.O() + O_YS + (size_t)(row - MP) * 1024;
      if (dst) {
#pragma unroll
        for (int i = 0; i < 4; ++i) *(f32x4*)(dst + lane * 4 + i * 256) = v[i];
      }
    }
  }
}

enum { EPI_BF16 = 0, EPI_RESID = 1, EPI_SWIGLU = 2 };

template <int EPI>
__device__ __forceinline__ void gemm_tile(const bf16_t* __restrict__ A, const int lda, const bf16_t* __restrict__ Bt, const int ldb,
                                          const int K, const int m0, const int n0, void* Cout, const int ldc, char* lds, const int tid) {
  const int wid = tid >> 6, lane = tid & 63, wr = wid >> 1, wc = wid & 1, fr = lane & 15, fq = lane >> 4;
  f32x4 acc[4][4];
#pragma unroll
  for (int m = 0; m < 4; ++m)
#pragma unroll
    for (int n = 0; n < 4; ++n) acc[m][n] = (f32x4){0.f, 0.f, 0.f, 0.f};
  const int nt = K >> 6;
  auto stage = [&](int kt, int buf) {
#pragma unroll
    for (int i = 0; i < 4; ++i) {
      const int off = tid * 16 + i * 4096;
      const int panel = off >> 13, rem = off & 8191, r = rem >> 6, c = (rem & 63) >> 1;
      const bf16_t* ga = A + (size_t)(m0 + r) * lda + kt * 64 + panel * 32 + c;
      const bf16_t* gb = Bt + (size_t)(n0 + r) * ldb + kt * 64 + panel * 32 + c;
      __builtin_amdgcn_global_load_lds((const unsigned*)ga, (__attribute__((address_space(3))) unsigned*)(lds + buf * 32768 + off), 16, 0, 0);
      __builtin_amdgcn_global_load_lds((const unsigned*)gb, (__attribute__((address_space(3))) unsigned*)(lds + buf * 32768 + 16384 + off), 16, 0, 0);
    }
  };
  stage(0, 0);
  for (int kt = 0; kt < nt; ++kt) {
    asm volatile("s_waitcnt vmcnt(0)" ::: "memory");
    __syncthreads();
    const char* sa = lds + (kt & 1) * 32768;
    const char* sb = sa + 16384;
    bf16x8 af[2][4], bfr[2][4];
#pragma unroll
    for (int ks = 0; ks < 2; ++ks) {
#pragma unroll
      for (int m = 0; m < 4; ++m) af[ks][m] = *(const bf16x8*)(sa + ks * 8192 + (wr * 64 + m * 16 + fr) * 64 + fq * 16);
#pragma unroll
      for (int n = 0; n < 4; ++n) bfr[ks][n] = *(const bf16x8*)(sb + ks * 8192 + (wc * 64 + n * 16 + fr) * 64 + fq * 16);
    }
    if (kt + 1 < nt) stage(kt + 1, (kt + 1) & 1);
#pragma unroll
    for (int ks = 0; ks < 2; ++ks)
#pragma unroll
      for (int m = 0; m < 4; ++m)
#pragma unroll
        for (int n = 0; n < 4; ++n) acc[m][n] = __builtin_amdgcn_mfma_f32_16x16x32_bf16(bfr[ks][n], af[ks][m], acc[m][n], 0, 0, 0);
  }
  if (EPI == EPI_RESID) {
    float* C0 = (float*)Cout + (size_t)(m0 + wr * 64 + fr) * ldc + n0 + wc * 64 + fq * 4;
    f32x4 xin[4][4];
#pragma unroll
    for (int m = 0; m < 4; ++m)
#pragma unroll
      for (int n = 0; n < 4; ++n) xin[m][n] = *(const f32x4*)(C0 + (size_t)m * 16 * ldc + n * 16);
#pragma unroll
    for (int m = 0; m < 4; ++m)
#pragma unroll
      for (int n = 0; n < 4; ++n) asm volatile("" : "+v"(xin[m][n]));
#pragma unroll
    for (int m = 0; m < 4; ++m)
#pragma unroll
      for (int n = 0; n < 4; ++n) *(f32x4*)(C0 + (size_t)m * 16 * ldc + n * 16) = xin[m][n] * ALPHA + acc[m][n];
    return;
  }
#pragma unroll
  for (int m = 0; m < 4; ++m) {
    const int row = m0 + wr * 64 + m * 16 + fr;
    if (EPI == EPI_BF16) {
      bf16_t* C = (bf16_t*)Cout + (size_t)row * ldc + n0 + wc * 64 + fq * 8;
#pragma unroll
      for (int pq = 0; pq < 2; ++pq) { uint4 o; o.x = pk2(acc[m][2 * pq][0], acc[m][2 * pq][1]); o.y = pk2(acc[m][2 * pq][2], acc[m][2 * pq][3]);
        o.z = pk2(acc[m][2 * pq + 1][0], acc[m][2 * pq + 1][1]); o.w = pk2(acc[m][2 * pq + 1][2], acc[m][2 * pq + 1][3]); *(uint4*)(C + pq * 32) = o; }
    } else if (EPI == EPI_RESID) {
      float* C = (float*)Cout + (size_t)row * ldc + n0 + wc * 64 + fq * 4;
#pragma unroll
      for (int n = 0; n < 4; ++n) { const f32x4 x = *(const f32x4*)(C + n * 16); *(f32x4*)(C + n * 16) = x * ALPHA + acc[m][n]; }
    } else {
      bf16_t* C = (bf16_t*)Cout + (size_t)row * ldc + (n0 >> 1) + wc * 32 + fq * 8;
      const f32x4 g0 = acc[m][0], u0 = acc[m][1], g1 = acc[m][2], u1 = acc[m][3];
      uint4 o; o.x = pk2(siluf_(g0[0]) * u0[0], siluf_(g0[1]) * u0[1]); o.y = pk2(siluf_(g0[2]) * u0[2], siluf_(g0[3]) * u0[3]);
      o.z = pk2(siluf_(g1[0]) * u1[0], siluf_(g1[1]) * u1[1]); o.w = pk2(siluf_(g1[2]) * u1[2], siluf_(g1[3]) * u1[3]);
      *(uint4*)C = o;
    }
  }
}
template <int EPI>
__device__ __forceinline__ void gemm_phase(const bf16_t* A, int lda, const bf16_t* Bt, int ldb, int K, int ntn, void* C, int ldc, char* lds, int bid, int nb, const int tid) {
  constexpr int GM = 4, nM = MT / 128;
  const int ntiles = nM * ntn, nig = GM * ntn;
  const int pos = (EPI == EPI_BF16 && (nb & 7) == 0) ? (bid & 7) * (nb >> 3) + (bid >> 3) : bid;
  for (int L = pos; L < ntiles; L += nb) {
    int mt, nn;
    if (EPI != EPI_BF16) { mt = L / ntn; nn = L % ntn; }
    else { const int gid = L / nig, fm = gid * GM, gsz = min(nM - fm, GM), rem = L - gid * nig; mt = fm + rem % gsz; nn = rem / gsz; }
    gemm_tile<EPI>(A, lda, Bt, ldb, K, mt * 128, nn * 128, C, ldc, lds, tid);
  }
}

#define XB_TMO      128
#define XB_XCNT(j)  (256  + 64 * (j))
#define XB_XSUB(j)  (1280 + 64 * (j))
#define XB_XGEN(j)  (2304 + 64 * (j))
#define XB_TOP      3328
#define XB_TOPGEN   3392
#define XCD_BAR_WORDS 3456
#define XB_SPIN_CAP (1u << 22)
__device__ __forceinline__ unsigned xb_ld(unsigned* p) { return __hip_atomic_load(p, __ATOMIC_RELAXED, __HIP_MEMORY_SCOPE_AGENT); }
__device__ __forceinline__ unsigned xb_add(unsigned* p, unsigned v) { return __hip_atomic_fetch_add(p, v, __ATOMIC_RELAXED, __HIP_MEMORY_SCOPE_AGENT); }
__device__ __forceinline__ unsigned xb_xcc_id() { return (unsigned)__builtin_amdgcn_s_getreg((3 << 11) | 20) & 0xFu; }
#define XB_SPIN(cond, bar) do { unsigned _sp = 0; while (cond) { __builtin_amdgcn_s_sleep(1); \
    if ((++_sp & 255u) == 0u) { if (xb_ld(&(bar)[XB_TMO])) break; if (_sp > XB_SPIN_CAP) { atomicAdd(&(bar)[XB_TMO], 1u); break; } } } } while (0)
struct XcdBarrier { unsigned* bar; unsigned x; unsigned nloc, nx; };
__device__ __forceinline__ void xcd_barrier_complete(unsigned* bar, unsigned x, unsigned G, unsigned& nloc, unsigned& nx) {
  unsigned sum, cnt, mine, sp = 0u;
  for (;;) {
    sum = 0u; cnt = 0u; mine = 0u;
#pragma unroll
    for (unsigned j = 0; j < 16; ++j) { const unsigned c = xb_ld(&bar[XB_XCNT(j)]); sum += c; cnt += (c > 0u) ? 1u : 0u; mine = (j == x) ? c : mine; }
    if (sum == G) break;
    __builtin_amdgcn_s_sleep(1);
    if ((++sp & 255u) == 0u) { if (xb_ld(&bar[XB_TMO])) break; if (sp > XB_SPIN_CAP) { atomicAdd(&bar[XB_TMO], 1u); break; } }
  }
  nloc = mine > 0u ? mine : 1u; nx = cnt > 0u ? cnt : 1u;
}
__device__ __forceinline__ void xcd_barrier(XcdBarrier& b, const int tid, const unsigned G) {
  asm volatile("s_waitcnt vmcnt(0)" ::: "memory");
  __syncthreads();
  if (tid == 0) {
    unsigned* bar = b.bar;
    __builtin_amdgcn_s_waitcnt(0);
    if (b.nloc == 0u) xcd_barrier_complete(bar, b.x, G, b.nloc, b.nx);
    const unsigned nloc = b.nloc, nx = b.nx;
    const unsigned old = xb_add(&bar[XB_XSUB(b.x)], 1u);
    const unsigned gen = old / nloc;
    if (old + 1u == (gen + 1u) * nloc) {
      __builtin_amdgcn_fence(__ATOMIC_RELEASE, "agent");
      asm volatile("s_waitcnt vmcnt(0)" ::: "memory");
      const unsigned og = xb_add(&bar[XB_TOP], 1u);
      const unsigned tg = og / nx;
      if (og + 1u == (tg + 1u) * nx) xb_add(&bar[XB_TOPGEN], 1u);
      else XB_SPIN(xb_ld(&bar[XB_TOPGEN]) == tg, bar);
      __builtin_amdgcn_fence(__ATOMIC_ACQUIRE, "agent");
      xb_add(&bar[XB_XGEN(b.x)], 1u);
      asm volatile("s_waitcnt vmcnt(0)" ::: "memory");
    } else {
      XB_SPIN(xb_ld(&bar[XB_XGEN(b.x)]) == gen, bar);
      __builtin_amdgcn_fence(__ATOMIC_ACQUIRE, "agent");
      asm volatile("s_waitcnt vmcnt(0)" ::: "memory");
    }
  }
  __syncthreads();
}

template <int N, int RS>
__device__ __forceinline__ void convN(const bf16_t* rawb, const float* cwl, int tt, int off, float (&x)[N]) {
#pragma unroll
  for (int i = 0; i < N; ++i) x[i] = 0.f;
#pragma unroll
  for (int j = 0; j < 4; ++j) {
    float xv[N];
    if (N == 8) { const uint4 rv = *(const uint4*)(rawb + (tt + j) * RS + off); unpack8(rv, xv); }
    else if (N == 4) { const uint2 rv = *(const uint2*)(rawb + (tt + j) * RS + off); xv[0] = bflo(rv.x); xv[1] = bfhi(rv.x); xv[2 % N] = bflo(rv.y); xv[3 % N] = bfhi(rv.y); }
    else { const unsigned rv = *(const unsigned*)(rawb + (tt + j) * RS + off); xv[0] = bflo(rv); xv[1] = bfhi(rv); }
#pragma unroll
    for (int i = 0; i < N; ++i) x[i] += cwl[j * RS + off + i] * xv[i];
  }
#pragma unroll
  for (int i = 0; i < N; ++i) x[i] = siluf_(x[i]);
}

template <int MIX, int VN>
__device__ __forceinline__ void load_chunk_fn(const unsigned char* ws, const bf16_t* Pb, const int t, const int T, const int h, const int vcol, const int sub, const int posb,
                                              uint4& R0, uint4& R1, uint2& R2, uint4& R4, uint4& R5, unsigned& ex0, unsigned& ex1) {
  if (t < T) {
    const bf16_t* pr = Pb + (size_t)t * DINP;
    const int vbase = (MIX == 0) ? 512 : (MIX == 1) ? 1544 : (MIX == 2) ? 2312 : 3352;
    if (VN == 4) R2 = *(const uint2*)(pr + vbase + h * 64 + vcol);
    else R2.x = *(const unsigned*)(pr + vbase + h * 64 + vcol);
    if (MIX == 0) {
      R0 = *(const uint4*)(pr + 0 + h * 64 + sub * 8); R1 = *(const uint4*)(pr + 256 + h * 64 + sub * 8);
      ex0 = pr[768 + h]; ex1 = pr[772 + h];
    } else if (MIX == 1) {
      R0 = *(const uint4*)(pr + 1032 + h * 64 + sub * 8); R1 = *(const uint4*)(pr + 1288 + h * 64 + sub * 8);
    } else if (MIX == 2) {
      const uint2 q2 = *(const uint2*)(pr + 2056 + h * 32 + sub * 4), k2 = *(const uint2*)(pr + 2184 + h * 32 + sub * 4);
      R0 = make_uint4(q2.x, q2.y, k2.x, k2.y);
      R1 = *(const uint4*)(pr + 2568); R4 = *(const uint4*)(pr + 2576);
    } else {
      const uint2 ql = *(const uint2*)(pr + 2840 + h * 64 + sub * 4), qh = *(const uint2*)(pr + 2840 + h * 64 + 32 + sub * 4);
      const uint2 kl = *(const uint2*)(pr + 3096 + h * 64 + sub * 4), kh = *(const uint2*)(pr + 3096 + h * 64 + 32 + sub * 4);
      R0 = make_uint4(ql.x, ql.y, qh.x, qh.y); R1 = make_uint4(kl.x, kl.y, kh.x, kh.y);
      const uint4* cs = (const uint4*)(ws + OFF_CS + ((size_t)(posb + t) * 32 + sub * 4) * 8);
      R4 = cs[0]; R5 = cs[1];
    }
  }
}

__device__ __forceinline__ float dpp_hm(float x) {
  return __int_as_float(__builtin_amdgcn_update_dpp(0, __float_as_int(x), 0x141, 0xF, 0xF, true));
}
__device__ __forceinline__ float dpp_rm(float x) {
  return __int_as_float(__builtin_amdgcn_update_dpp(0, __float_as_int(x), 0x140, 0xF, 0xF, true));
}
__device__ __forceinline__ float red8d(float x) { x += dpp_x1(x); x += dpp_x2(x); x += dpp_hm(x); return x; }
template <int KG> __device__ __forceinline__ float redKG(float x) { x = red8d(x); if (KG == 16) x += dpp_rm(x); return x; }

template <int MIX, int KPL>
struct StepIn { float q[KPL], k[KPL], d[KPL]; float v, a, be, qk; };

template <int MIX, int KPL>
__device__ __forceinline__ void load_step(const float* qkdv, const float* scal, int t, int kg, int col, StepIn<MIX, KPL>& s) {
  const float* base = qkdv + t * 256;
#pragma unroll
  for (int i = 0; i < KPL; i += 4) {
    const f32x4 a = *(const f32x4*)(base + kg * KPL + i), b = *(const f32x4*)(base + 64 + kg * KPL + i);
    s.q[i] = a[0]; s.q[i + 1] = a[1]; s.q[i + 2] = a[2]; s.q[i + 3] = a[3];
    s.k[i] = b[0]; s.k[i + 1] = b[1]; s.k[i + 2] = b[2]; s.k[i + 3] = b[3];
    if (MIX == 1 || MIX == 2) { const f32x4 d = *(const f32x4*)(base + 128 + kg * KPL + i); s.d[i] = d[0]; s.d[i + 1] = d[1]; s.d[i + 2] = d[2]; s.d[i + 3] = d[3]; }
  }
  s.v = base[192 + col];
  if (MIX == 0) { const f32x4 c = *(const f32x4*)(scal + t * 4); s.a = c[0]; s.be = c[1]; s.qk = c[2]; }
}

template <int MIX, int KPL, int KG>
__device__ __forceinline__ float do_step(const StepIn<MIX, KPL>& s, float (&S)[KPL], const float gam) {
  if (MIX == 0) {
    float kS0 = 0.f, kS1 = 0.f, qS0 = 0.f, qS1 = 0.f;
#pragma unroll
    for (int i = 0; i < KPL; i += 2) { kS0 += s.k[i] * S[i]; kS1 += s.k[i + 1] * S[i + 1]; qS0 += s.q[i] * S[i]; qS1 += s.q[i + 1] * S[i + 1]; }
    const float kS = redKG<KG>(kS0 + kS1), qS = redKG<KG>(qS0 + qS1);
    const float w = s.be * (s.v - s.a * kS);
#pragma unroll
    for (int i = 0; i < KPL; ++i) S[i] = s.a * S[i] + s.k[i] * w;
    return s.a * qS + s.qk * w;
  } else {
    float o0 = 0.f, o1 = 0.f;
#pragma unroll
    for (int i = 0; i < KPL; i += 2) {
      const float d0 = (MIX == 3) ? gam : s.d[i], d1 = (MIX == 3) ? gam : s.d[i + 1];
      S[i] = d0 * S[i] + s.k[i] * s.v; S[i + 1] = d1 * S[i + 1] + s.k[i + 1] * s.v;
      o0 += s.q[i] * S[i]; o1 += s.q[i + 1] * S[i + 1];
    }
    return redKG<KG>(o0 + o1);
  }
}

template <int MIX>
__device__ __forceinline__ void scan_part(const Params& p, const int layer, const int smp, const int b0, const int bstep, const int bend, const int h, const int part, char* lds, const int tid) {
  constexpr int DK = (MIX == 2) ? 32 : 64;
  constexpr int NS = (MIX == 0) ? 4 : 2;
  constexpr int CW = 64 / NS;
  constexpr int CPW = CW / 4;
  constexpr int KG = 64 / CPW;
  constexpr int KPL = DK / KG;
  constexpr int VN = CW / 8;
  constexpr int RS = 128 + CW;
  float* qkdv = (float*)lds;
  float* obuf = (float*)(lds + 32768);
  float* scal = (float*)(lds + 36864);
  bf16_t* rawb = (bf16_t*)(lds + 37376);
  float* cwl = (float*)(lds + 48576);
  float* wgl = (float*)(lds + 37376);

  const int lane = tid & 63, wv = tid >> 6;
  const int tt = tid >> 3, sub = tid & 7;
  const int col = wv * CPW + lane / KG, kg = lane % KG;
  const int T = smp ? 4 : TPR;
  const int nBatch = smp ? NSB : NB;
  const int posb = smp ? 2064 : 0;
  const int vcol = part * CW + sub * VN;
  __syncthreads();
  float c8[8];
  float Aexp = 0.f, dtb = 0.f, gam = 0.f;
  if (MIX == 0) {
    Aexp = __expf(p.I(12)[layer * 4 + h]); dtb = p.I(13)[layer * 4 + h];
    for (int e = tid; e < 4 * RS; e += 256) { const int j = e / RS, r = e % RS;
      const int cc = (r < 64) ? (h * 64 + r) : (r < 128) ? (256 + h * 64 + r - 64) : (512 + h * 64 + part * CW + r - 128);
      cwl[e] = p.I(11)[(size_t)(layer * 4 + j) * 768 + cc]; }
  } else if (MIX == 1) {
#pragma unroll
    for (int i = 0; i < 8; ++i) {
      const int d = h * 64 + sub * 8 + i;
      c8[i] = (layer == 0) ? 1.0f : sigmoidf_(p.I(15)[d] - p.I(15)[256 + d]);
    }
  } else if (MIX == 2) {
    for (int e = tid; e < 512; e += 256) { const int r = e >> 5, j = e & 31; wgl[e] = p.I(17)[(size_t)(layer * 16 + r) * 128 + h * 32 + j]; }
#pragma unroll
    for (int i = 0; i < 4; ++i) c8[i] = p.I(18)[layer * 128 + h * 32 + sub * 4 + i];
  } else {
    gam = 1.0f - exp2f(-5.0f - (float)h);
  }
  for (int b = b0; b < bend; b += bstep) {
  const int row0 = smp ? MP + b * 4 : b * TPR;
  const bf16_t* Pb = (const bf16_t*)(p.W() + OFF_P) + (size_t)row0 * DINP;
  bf16_t* Ob = (bf16_t*)p.O() + (size_t)row0 * 1024 + MIX * 256 + h * 64 + part * CW;
  float* PS = (float*)((unsigned char*)p.O() + DOUT_PS) + (size_t)row0 * 128 + (MIX * 4 + h) * 8 + part * 2;
  uint4 R0 = make_uint4(0, 0, 0, 0), R1 = R0, R4 = R0, R5 = R0; uint2 R2 = make_uint2(0, 0); unsigned ex0 = 0, ex1 = 0;
  load_chunk_fn<MIX, VN>(p.W(), Pb, tt, T, h, vcol, sub, posb, R0, R1, R2, R4, R5, ex0, ex1);
  float S[KPL];
  if (smp) {
    const float* sin_ = p.I(3 + MIX) + ((size_t)(layer * NSB + b) * 4 + h) * DK * 64 + part * CW;
#pragma unroll
    for (int i = 0; i < KPL; ++i) S[i] = sin_[(kg * KPL + i) * 64 + col];
  } else {
#pragma unroll
    for (int i = 0; i < KPL; ++i) S[i] = 0.f;
  }
  if (MIX == 0) {
    for (int e = tid; e < 3 * RS; e += 256) { const int j = e / RS, r = e % RS;
      const int cc = (r < 64) ? (h * 64 + r) : (r < 128) ? (256 + h * 64 + r - 64) : (512 + h * 64 + part * CW + r - 128);
      float v = 0.f; if (smp) v = p.I(2)[((size_t)(layer * NSB + b) * 3 + j) * 768 + cc];
      rawb[e] = (bf16_t)f2bf(v); }
  }
  __syncthreads();

  int ntok_last = 0;
  for (int t0 = 0; t0 < T; t0 += 32) {
    const int ntok = min(32, T - t0);
    ntok_last = ntok;
    const bool valid = tt < ntok;
    float* dst = qkdv + tt * 256;
    if (MIX != 0 && valid) {
      if (VN == 4) *(f32x4*)(dst + 192 + sub * 4) = (f32x4){bflo(R2.x), bfhi(R2.x), bflo(R2.y), bfhi(R2.y)};
      else *(float2*)(dst + 192 + sub * 2) = make_float2(bflo(R2.x), bfhi(R2.x));
    }
    if (MIX == 0) {
      if (valid) {
        *(uint4*)(rawb + (3 + tt) * RS + 0 + sub * 8) = R0;
        *(uint4*)(rawb + (3 + tt) * RS + 64 + sub * 8) = R1;
        if (VN == 4) *(uint2*)(rawb + (3 + tt) * RS + 128 + sub * 4) = R2;
        else *(unsigned*)(rawb + (3 + tt) * RS + 128 + sub * 2) = R2.x;
      }
      __syncthreads();
      if (valid) {
        float xq[8], xk[8], xv[VN];
        convN<8, RS>(rawb, cwl, tt, sub * 8, xq);
        convN<8, RS>(rawb, cwl, tt, 64 + sub * 8, xk);
        convN<VN, RS>(rawb, cwl, tt, 128 + sub * VN, xv);
#pragma unroll
        for (int i = 0; i < VN; ++i) dst[192 + sub * VN + i] = xv[i];
        float ssq = 0.f, ssk = 0.f;
#pragma unroll
        for (int i = 0; i < 8; ++i) { ssq += xq[i] * xq[i]; ssk += xk[i] * xk[i]; }
        ssq = red8d(ssq); ssk = red8d(ssk);
        const float rq = rsqrtf(ssq + 1e-6f) * 0.125f, rk = rsqrtf(ssk + 1e-6f);
        float qk = 0.f;
#pragma unroll
        for (int i = 0; i < 8; ++i) { xq[i] *= rq; xk[i] *= rk; qk += xq[i] * xk[i]; }
        qk = red8d(qk);
        *(f32x4*)(dst + sub * 8) = (f32x4){xq[0], xq[1], xq[2], xq[3]}; *(f32x4*)(dst + sub * 8 + 4) = (f32x4){xq[4], xq[5], xq[6], xq[7]};
        *(f32x4*)(dst + 64 + sub * 8) = (f32x4){xk[0], xk[1], xk[2], xk[3]}; *(f32x4*)(dst + 64 + sub * 8 + 4) = (f32x4){xk[4], xk[5], xk[6], xk[7]};
        if (sub == 0) {
          const float be = sigmoidf_(bflo(ex0)), al = bflo(ex1);
          const float a = __expf(-Aexp * softplusf_(al + dtb));
          *(f32x4*)(scal + tt * 4) = (f32x4){a, be, qk, 0.f};
        }
      }
    } else if (MIX == 1) {
      if (valid) {
        float q[8], z[8]; unpack8(R0, q); unpack8(R1, z);
        float kk[8], dd[8];
#pragma unroll
        for (int i = 0; i < 8; ++i) { q[i] = siluf_(q[i]); kk[i] = c8[i] * sigmoidf_(-z[i]); dd[i] = 1.0f - fminf(kk[i], 1.0f - 1e-6f); }
        *(f32x4*)(dst + sub * 8) = (f32x4){q[0], q[1], q[2], q[3]}; *(f32x4*)(dst + sub * 8 + 4) = (f32x4){q[4], q[5], q[6], q[7]};
        *(f32x4*)(dst + 64 + sub * 8) = (f32x4){kk[0], kk[1], kk[2], kk[3]}; *(f32x4*)(dst + 64 + sub * 8 + 4) = (f32x4){kk[4], kk[5], kk[6], kk[7]};
        *(f32x4*)(dst + 128 + sub * 8) = (f32x4){dd[0], dd[1], dd[2], dd[3]}; *(f32x4*)(dst + 128 + sub * 8 + 4) = (f32x4){dd[4], dd[5], dd[6], dd[7]};
      }
    } else if (MIX == 2) {
      if (valid) {
        float lr[16]; unpack8(R1, lr); unpack8(R4, lr + 8);
        const float q0 = bflo(R0.x), q1 = bfhi(R0.x), q2 = bflo(R0.y), q3 = bfhi(R0.y);
        const float k0 = bflo(R0.z), k1 = bfhi(R0.z), k2 = bflo(R0.w), k3 = bfhi(R0.w);
        const float sc = 0.17677669529663687f;
        f32x4 xg = (f32x4){c8[0], c8[1], c8[2], c8[3]};
#pragma unroll
        for (int r = 0; r < 16; ++r) xg += lr[r] * *(const f32x4*)(wgl + r * 32 + sub * 4);
        f32x4 dd;
#pragma unroll
        for (int i = 0; i < 4; ++i) { const float ls = fminf(xg[i], 0.f) - __logf(1.0f + __expf(-fabsf(xg[i]))); dd[i] = __expf(ls * 0.0625f); }
        *(f32x4*)(dst + sub * 4) = (f32x4){q0 * sc, q1 * sc, q2 * sc, q3 * sc};
        *(f32x4*)(dst + 64 + sub * 4) = (f32x4){k0, k1, k2, k3};
        *(f32x4*)(dst + 128 + sub * 4) = dd;
      }
    } else {
      if (valid) {
        const float ql[4] = {bflo(R0.x), bfhi(R0.x), bflo(R0.y), bfhi(R0.y)}, qh[4] = {bflo(R0.z), bfhi(R0.z), bflo(R0.w), bfhi(R0.w)};
        const float kl[4] = {bflo(R1.x), bfhi(R1.x), bflo(R1.y), bfhi(R1.y)}, kh[4] = {bflo(R1.z), bfhi(R1.z), bflo(R1.w), bfhi(R1.w)};
        const float cc[4] = {__uint_as_float(R4.x), __uint_as_float(R4.z), __uint_as_float(R5.x), __uint_as_float(R5.z)};
        const float sn[4] = {__uint_as_float(R4.y), __uint_as_float(R4.w), __uint_as_float(R5.y), __uint_as_float(R5.w)};
        f32x4 qa, qb, ka, kb;
#pragma unroll
        for (int i = 0; i < 4; ++i) {
          qa[i] = ql[i] * cc[i] - qh[i] * sn[i]; qb[i] = ql[i] * sn[i] + qh[i] * cc[i];
          ka[i] = (kl[i] * cc[i] - kh[i] * sn[i]) * 0.125f; kb[i] = (kl[i] * sn[i] + kh[i] * cc[i]) * 0.125f;
        }
        *(f32x4*)(dst + sub * 4) = qa; *(f32x4*)(dst + 32 + sub * 4) = qb;
        *(f32x4*)(dst + 64 + sub * 4) = ka; *(f32x4*)(dst + 96 + sub * 4) = kb;
      }
    }
    __syncthreads();
    if (MIX == 0 && t0 + 32 < T) {
      if (tid < 3 * RS / 8) { const uint4 v = *(const uint4*)(rawb + 32 * RS + tid * 8); *(uint4*)(rawb + tid * 8) = v; }
    }
    if (t0 + 32 < T) load_chunk_fn<MIX, VN>(p.W(), Pb, t0 + 32 + tt, T, h, vcol, sub, posb, R0, R1, R2, R4, R5, ex0, ex1);
    {
      StepIn<MIX, KPL> sa, sb;
      float osave = 0.f;
      load_step<MIX, KPL>(qkdv, scal, 0, kg, col, sa);
      for (int t = 0; t < ntok; t += 2) {
        load_step<MIX, KPL>(qkdv, scal, t + 1, kg, col, sb);
        __builtin_amdgcn_sched_barrier(0);
        const float oa = do_step<MIX, KPL, KG>(sa, S, gam);
        osave = (kg == (t & (KG - 1))) ? oa : osave;
        load_step<MIX, KPL>(qkdv, scal, min(t + 2, ntok - 1), kg, col, sa);
        __builtin_amdgcn_sched_barrier(0);
        const float ob = do_step<MIX, KPL, KG>(sb, S, gam);
        osave = (kg == ((t + 1) & (KG - 1))) ? ob : osave;
        if (((t + 2) & (KG - 1)) == 0) obuf[(t + 2 - KG + kg) * CW + col] = osave;
      }
      const int remn = ntok & (KG - 1);
      if (remn != 0 && kg < remn) obuf[(ntok - remn + kg) * CW + col] = osave;
    }
    __syncthreads();
    if (valid) {
      float o[VN];
#pragma unroll
      for (int i = 0; i < VN; ++i) o[i] = obuf[tt * CW + sub * VN + i];
      float s1 = 0.f, s2 = 0.f;
#pragma unroll
      for (int i = 0; i < VN; ++i) { s1 += o[i]; s2 += o[i] * o[i]; }
      s1 = red8d(s1); s2 = red8d(s2);
      if (VN == 4) { uint2 o2; o2.x = pk2(o[0], o[1]); o2.y = pk2(o[2 % VN], o[3 % VN]); *(uint2*)(Ob + (size_t)(t0 + tt) * 1024 + sub * 4) = o2; }
      else *(unsigned*)(Ob + (size_t)(t0 + tt) * 1024 + sub * 2) = pk2(o[0], o[1]);
      if (sub == 0) *(float2*)(PS + (size_t)(t0 + tt) * 128) = make_float2(s1, s2);
    }
  }
  {
    const size_t obase = (MIX == 0) ? (smp ? O_DS : O_DP) : (MIX == 1) ? (smp ? O_HS : O_HP) : (MIX == 2) ? (smp ? O_GS : O_GP) : (smp ? O_RS : O_RP);
    float* so = p.O() + obase + ((size_t)(layer * nBatch + b) * 4 + h) * DK * 64 + part * CW;
#pragma unroll
    for (int i = 0; i < KPL; ++i) so[(kg * KPL + i) * 64 + col] = S[i];
  }
  if (MIX == 0) {
    float* co = p.O() + (smp ? O_CS : O_CP) + (size_t)(layer * nBatch + b) * 3 * 768;
    for (int e = tid; e < 3 * RS; e += 256) { const int j = e / RS, r = e % RS;
      const float v = bflo((unsigned)rawb[(ntok_last + j) * RS + r]);
      if (r < 128) { if (part == 0) co[j * 768 + ((r < 64) ? (h * 64 + r) : (256 + h * 64 + r - 64))] = v; }
      else co[j * 768 + 512 + h * 64 + part * CW + r - 128] = v; }
  }
  __syncthreads();
  }
}

constexpr int ITEMS_PER_SEQ = 40;
__device__ __forceinline__ void scan_dispatch(const Params& p, int layer, int smp, int type, int b0, int bstep, int bend, char* lds, const int tid) {
  const int r = type;
  if (r < 16) scan_part<0>(p, layer, smp, b0, bstep, bend, r >> 2, r & 3, lds, tid);
  else {
    const int r2 = r - 16, mh = 4 + (r2 >> 1), part = r2 & 1, mix = mh >> 2, h = mh & 3;
    if (mix == 1) scan_part<1>(p, layer, smp, b0, bstep, bend, h, part, lds, tid);
    else if (mix == 2) scan_part<2>(p, layer, smp, b0, bstep, bend, h, part, lds, tid);
    else scan_part<3>(p, layer, smp, b0, bstep, bend, h, part, lds, tid);
  }
}

__device__ __forceinline__ int long_item_type(int u, int& b) {
  int type;
  if (u < 64) { b = u >> 3; type = 24 + (u & 7); }
  else if (u < 192) { const int v = u - 64; b = v >> 4; type = v & 15; }
  else if (u < 256) { const int v = u - 192; b = v >> 3; type = 16 + (v & 7); }
  else { const int v = u - 256; b = v >> 3; type = 32 + (v & 7); }
  return type;
}
__device__ __forceinline__ void scan_phase(const Params& p, int layer, char* lds, int bid, int nb, const int tid, const int role, const int ci, const int nprim, const int nsec) {
  constexpr int NPI = NB * ITEMS_PER_SEQ;
  const bool paired = (nprim == 256 && nsec == 256);
  int j = -1, nbs = 1;
  if (paired) {
    int u = -1;
    if (role == 0) u = ci; else if (ci < NPI - 256) u = 256 + ci;
    if (u >= 0) { int b; const int type = long_item_type(u, b); scan_dispatch(p, layer, 0, type, b, 1, b + 1, lds, tid); }
    else { j = ci - (NPI - 256); nbs = 256 - (NPI - 256); }
  } else {
    for (int u = bid; u < NPI; u += nb) { int b; const int type = long_item_type(u, b); scan_dispatch(p, layer, 0, type, b, 1, b + 1, lds, tid); }
    nbs = (nb > NPI) ? nb - NPI : nb; j = (nb > NPI) ? bid - NPI : bid;
  }
  if (j >= 0) {
    const int nsl = (nbs + ITEMS_PER_SEQ - 1) / ITEMS_PER_SEQ;
    for (int jj = j; jj < ITEMS_PER_SEQ * nsl; jj += nbs) scan_dispatch(p, layer, 1, jj % ITEMS_PER_SEQ, jj / ITEMS_PER_SEQ, nsl, NSB, lds, tid);
    if (layer == 0) { __syncthreads(); convert_weights(p, lds, 992 + j, 6720, nbs, tid); }
  }
}

__device__ __forceinline__ void norm_phase(const Params& p, int layer, int bid, int nb, const int tid) {
  bf16_t* O = (bf16_t*)p.O();
  const bf16_t* P = (const bf16_t*)(p.W() + OFF_P);
  const float* PS = (const float*)((const unsigned char*)p.O() + DOUT_PS);
  const int cg8 = tid & 127;
  const int mh = cg8 >> 3, mix = mh >> 2, h = mh & 3, j0 = (cg8 & 7) * 8;
  const int gcol = (mix == 0) ? 776 : (mix == 1) ? 1800 : (mix == 2) ? 2584 : 3608;
  const float* gsrc = (mix == 0) ? p.I(14) : (mix == 1) ? p.I(16) : (mix == 2) ? p.I(19) : p.I(20);
  float g8[8];
#pragma unroll
  for (int i = 0; i < 8; ++i) g8[i] = gsrc[layer * 256 + h * 64 + j0 + i];
  uint4 ovn, gvn; f32x4 psn, ps2n = (f32x4){0.f, 0.f, 0.f, 0.f};
  {
    const int r0 = min(bid * 2 + (tid >> 7), MT - 1);
    ovn = *(const uint4*)(O + (size_t)r0 * 1024 + cg8 * 8);
    gvn = *(const uint4*)(P + (size_t)r0 * DINP + gcol + h * 64 + j0);
    psn = *(const f32x4*)(PS + (size_t)r0 * 128 + mh * 8);
    if (mix == 0) ps2n = *(const f32x4*)(PS + (size_t)r0 * 128 + mh * 8 + 4);
  }
  for (int row = bid * 2 + (tid >> 7); row < MT; row += nb * 2) {
    const uint4 ov = ovn, gv = gvn; const f32x4 ps = psn, ps2 = ps2n;
    {
      const int rn = min(row + nb * 2, MT - 1);
      ovn = *(const uint4*)(O + (size_t)rn * 1024 + cg8 * 8);
      gvn = *(const uint4*)(P + (size_t)rn * DINP + gcol + h * 64 + j0);
      psn = *(const f32x4*)(PS + (size_t)rn * 128 + mh * 8);
      if (mix == 0) ps2n = *(const f32x4*)(PS + (size_t)rn * 128 + mh * 8 + 4);
    }
    float s1 = ps[0] + ps[2], s2 = ps[1] + ps[3];
    if (mix == 0) { s1 += ps2[0] + ps2[2]; s2 += ps2[1] + ps2[3]; }
    float o[8], gt[8]; unpack8(ov, o); unpack8(gv, gt);
    float mu = 0.f, rs;
    if (mix == 3) { mu = s1 * (1.0f / 64.0f); const float var = fmaxf(s2 * (1.0f / 64.0f) - mu * mu, 0.f); rs = rsqrtf(var + 1e-5f); }
    else rs = rsqrtf(s2 * (1.0f / 64.0f) + 1e-6f);
    float r[8];
#pragma unroll
    for (int i = 0; i < 8; ++i) r[i] = (o[i] - mu) * rs * g8[i] * siluf_(gt[i]);
    uint4 o4; o4.x = pk2(r[0], r[1]); o4.y = pk2(r[2], r[3]); o4.z = pk2(r[4], r[5]); o4.w = pk2(r[6], r[7]);
    *(uint4*)(O + (size_t)row * 1024 + cg8 * 8) = o4;
  }
}

constexpr int NPHASE = 17;
__global__ void __launch_bounds__(256, 2) hymba_fwd(Params p_, int ph_lo, int ph_hi) {
  __shared__ __attribute__((aligned(16))) char lds[65536];
  XcdBarrier xb; xb.bar = (unsigned*)(p_.ws + OFF_BAR); xb.x = xb_xcc_id(); xb.nloc = 0u; xb.nx = 0u;
  if (threadIdx.x == 0) (void)xb_add(&xb.bar[XB_XCNT(xb.x)], 1u);
  int role = 0, ci = 0;
  {
    const unsigned key = ((((unsigned)__builtin_amdgcn_s_getreg((31 << 11) | 4)) >> 8) & 0xFFu) | (xb.x << 8);
    if (threadIdx.x == 0) {
      const unsigned slot = xb_add(&xb.bar[CEN_TAB + key], 1u);
      unsigned r;
      if (slot == 0u) { r = xb_add(&xb.bar[CEN_CNT], 1u); __hip_atomic_store(&xb.bar[CEN_TAB2 + key], r + 1u, __ATOMIC_RELAXED, __HIP_MEMORY_SCOPE_AGENT); }
      else { (void)xb_add(&xb.bar[CEN_CNT + 1], 1u); r = 0u; }
      *(volatile unsigned*)(lds) = slot == 0u ? 0u : 1u; *(volatile unsigned*)(lds + 4) = r;
    }
    __syncthreads();
    role = (int)*(volatile unsigned*)(lds); ci = (int)*(volatile unsigned*)(lds + 4);
    __syncthreads();
    role = __builtin_amdgcn_readfirstlane(role); ci = __builtin_amdgcn_readfirstlane(ci);
    if (role != 0) ci = -1 - (int)key;
  }
  int nprim = 0, nsec = 0;
  if (ph_hi < 0) cg::this_grid().sync();
  for (int ph = ph_lo; ph < ph_hi; ++ph) {
    int tid = threadIdx.x, bid = blockIdx.x, nb = gridDim.x;
    asm volatile("" : "+v"(tid));
    asm volatile("" : "+s"(bid), "+s"(nb));
    if (ph > ph_lo) xcd_barrier(xb, tid, (unsigned)nb);
    if (ph == ph_lo + 1) {
      nprim = (int)xb_ld(&xb.bar[CEN_CNT]); nsec = (int)xb_ld(&xb.bar[CEN_CNT + 1]);
      if (role != 0) { const unsigned v = xb_ld(&xb.bar[CEN_TAB2 + (unsigned)(-1 - ci)]); ci = (v > 0u) ? (int)v - 1 : 0; }
      nprim = __builtin_amdgcn_readfirstlane(nprim); nsec = __builtin_amdgcn_readfirstlane(nsec); ci = __builtin_amdgcn_readfirstlane(ci);
    }
    const Params& p = p_;
    if (ph == 0) {
      convert_weights(p, lds, bid, 992, nb, tid);
      embed_ln(p, bid, nb, tid);
      rope_table(p, bid, nb, tid);
    } else {
      const int l = (ph - 1) / 8, s = (ph - 1) % 8;
      const bf16_t* Xb = (const bf16_t*)p.O();
      bf16_t* X1b = (bf16_t*)(p.W() + OFF_X1B);
      bf16_t* Hb = (bf16_t*)(p.W() + OFF_H);
      float* X = (float*)(p.W() + OFF_X);
      if (s == 0) gemm_phase<EPI_BF16>(Xb, 1024, (const bf16_t*)(p.W() + OFF_WIN + l * SZ_WIN), 1024, 1024, DINP / 128, p.W() + OFF_P, DINP, lds, bid, nb, tid);
      else if (s == 1) scan_phase(p, l, lds, bid, nb, tid, role, ci, nprim, nsec);
      else if (s == 2) norm_phase(p, l, bid, nb, tid);
      else if (s == 3) gemm_phase<EPI_RESID>(Xb, 1024, (const bf16_t*)(p.W() + OFF_WOUT + l * SZ_WOUT), 1024, 1024, 8, X, 1024, lds, bid, nb, tid);
      else if (s == 4) ln_phase(p, p.I(22) + l * 1024, p.I(23) + l * 1024, X1b, 0, bid, nb, tid);
      else if (s == 5) gemm_phase<EPI_SWIGLU>(X1b, 1024, (const bf16_t*)(p.W() + OFF_WGU + l * SZ_WGU), 1024, 1024, 44, Hb, DFF, lds, bid, nb, tid);
      else if (s == 6) gemm_phase<EPI_RESID>(Hb, DFF, (const bf16_t*)(p.W() + OFF_WDN + l * SZ_WDN), DFF, DFF, 8, X, 1024, lds, bid, nb, tid);
      else ln_phase(p, p.I(27) + l * 1024, p.I(28) + l * 1024, (bf16_t*)p.O(), l == 1, bid, nb, tid);
    }
  }
}

extern "C" void kernel_launch(void* const* d_in, const int* in_sizes, int n_in, void* d_out, int out_size, void* d_ws, size_t ws_size,
                              hipStream_t stream) {
  (void)in_sizes; (void)out_size;
  if (n_in < 29 || ws_size < WS_NEED) { fprintf(stderr, "bad args: n_in %d ws %zu need %zu\n", n_in, ws_size, (size_t)WS_NEED); return; }
  Params p{};
  for (int i = 0; i < 29; ++i) p.in[i] = (const float*)d_in[i];
  p.out = (float*)d_out;
  p.ws = (unsigned char*)d_ws;
  static int grid_blocks = 0;
  if (!grid_blocks) {
    int dev = 0, cus = 0, per_cu = 0;
    (void)hipGetDevice(&dev);
    (void)hipDeviceGetAttribute(&cus, hipDeviceAttributeMultiprocessorCount, dev);
    (void)hipOccupancyMaxActiveBlocksPerMultiprocessor(&per_cu, hymba_fwd, 256, 0);
    if (per_cu > 2) per_cu = 2;
    if (per_cu < 1) per_cu = 1;
    grid_blocks = cus * per_cu;
  }
  (void)hipMemsetAsync((unsigned char*)d_ws + OFF_BAR, 0, BAR_BYTES, stream);
  int lo = 0, hi = NPHASE;
  void* args[] = {&p, &lo, &hi};
  hipError_t e = hipLaunchCooperativeKernel((void*)hymba_fwd, dim3(grid_blocks), dim3(256), args, 0, stream);
  if (e != hipSuccess) fprintf(stderr, "cooperative launch failed: %s (grid %d)\n", hipGetErrorString(e), grid_blocks);
}
```

```cpp
#include <hip/hip_runtime.h>
#include <hip/hip_cooperative_groups.h>
#include <cstdio>
#include <cstdint>
namespace cg = cooperative_groups;

#ifndef COOP
#define COOP 1
#endif

typedef unsigned short bf16_t;
typedef short bf16x8 __attribute__((ext_vector_type(8)));
typedef float f32x4 __attribute__((ext_vector_type(4)));

constexpr int DM = 1024, NB = 8, TPR = 2064, NSB = 128, TS = 4;
constexpr int MP = NB * TPR;
constexpr int MS = NSB * TS;
constexpr int MT = MP + MS;
constexpr int DIN = 3864, DINP = 3968, DFF = 2816;
constexpr float ALPHA = 1.41421356237309515f;

constexpr size_t SZ_WIN = (size_t)DINP * 1024 * 2, SZ_WOUT = (size_t)1024 * 1024 * 2, SZ_WGU = (size_t)5632 * 1024 * 2, SZ_WDN = (size_t)1024 * 2816 * 2;
constexpr size_t OFF_CS = 0;
constexpr size_t OFF_WIN = 532480;
constexpr size_t OFF_WOUT = OFF_WIN + 2 * SZ_WIN;
constexpr size_t OFF_WGU = OFF_WOUT + 2 * SZ_WOUT;
constexpr size_t OFF_WDN = OFF_WGU + 2 * SZ_WGU;
constexpr size_t OFF_X = OFF_WDN + 2 * SZ_WDN;
constexpr size_t OFF_P = OFF_X + (size_t)MT * 1024 * 4;
constexpr size_t OFF_X1B = OFF_P;
constexpr size_t OFF_H = OFF_P + (size_t)MT * 1024 * 2;
constexpr size_t OFF_BAR = OFF_P + (size_t)MT * DINP * 2;
constexpr int CEN_CNT = 3520, CEN_TAB = 4096, CEN_TAB2 = 8192;
constexpr size_t BAR_BYTES = 12288 * 4;
constexpr size_t WS_NEED = OFF_BAR + BAR_BYTES;
constexpr size_t DOUT_PS = 36000000;

constexpr size_t O_YP = 0, O_YS = 16777216, O_CP = 17301504, O_CS = 17338368, O_DP = 17928192, O_DS = 18190336,
                 O_HP = 22384640, O_HS = 22646784, O_GP = 26841088, O_GS = 26972160, O_RP = 29069312, O_RS = 29331456;

#define GAS __attribute__((address_space(1)))
struct Params {
  const float* in[29];
  float* out;
  unsigned char* ws;
  __device__ __forceinline__ const float* I(int i) const { return (const float*)(const GAS float*)in[i]; }
  __device__ __forceinline__ float* O() const { return (float*)(GAS float*)out; }
  __device__ __forceinline__ unsigned char* W() const { return (unsigned char*)(GAS unsigned char*)ws; }
};

__device__ __forceinline__ unsigned f2bf(float f) {
  unsigned u = __float_as_uint(f);
  u += 0x7fffu + ((u >> 16) & 1u);
  return u >> 16;
}
typedef float f32x2_t __attribute__((ext_vector_type(2)));
typedef __bf16 bf16x2_t __attribute__((ext_vector_type(2)));
__device__ __forceinline__ unsigned pk2(float lo, float hi) { const f32x2_t v = {lo, hi}; const bf16x2_t b = __builtin_convertvector(v, bf16x2_t); return __builtin_bit_cast(unsigned, b); }
__device__ __forceinline__ float bflo(unsigned u) { return __uint_as_float(u << 16); }
__device__ __forceinline__ float bfhi(unsigned u) { return __uint_as_float(u & 0xffff0000u); }
__device__ __forceinline__ void unpack8(const uint4& r, float* x) {
  x[0] = bflo(r.x); x[1] = bfhi(r.x); x[2] = bflo(r.y); x[3] = bfhi(r.y);
  x[4] = bflo(r.z); x[5] = bfhi(r.z); x[6] = bflo(r.w); x[7] = bfhi(r.w);
}
__device__ __forceinline__ float sigmoidf_(float x) { return __builtin_amdgcn_rcpf(1.0f + __expf(-x)); }
__device__ __forceinline__ float siluf_(float x) { return x * __builtin_amdgcn_rcpf(1.0f + __expf(-x)); }
__device__ __forceinline__ float softplusf_(float x) { return fmaxf(x, 0.f) + __logf(1.0f + __expf(-fabsf(x))); }
__device__ __forceinline__ float red8(float x) {
  x += __shfl_xor(x, 1); x += __shfl_xor(x, 2); x += __shfl_xor(x, 4); return x;
}
__device__ __forceinline__ float dpp_x1(float x) {
  return __int_as_float(__builtin_amdgcn_update_dpp(0, __float_as_int(x), 0xB1, 0xF, 0xF, true));
}
__device__ __forceinline__ float dpp_x2(float x) {
  return __int_as_float(__builtin_amdgcn_update_dpp(0, __float_as_int(x), 0x4E, 0xF, 0xF, true));
}
__device__ __forceinline__ float red4(float x) { x += dpp_x1(x); x += dpp_x2(x); return x; }
__device__ __forceinline__ float wave_sum(float x) {
#pragma unroll
  for (int o = 32; o >= 1; o >>= 1) x += __shfl_xor(x, o);
  return x;
}

__device__ __forceinline__ void convert_weights(const Params& p, char* lds, int w0, int w1, int wstep, const int tid) {
  float* tile = (float*)lds;
  for (int w = w0; w < w1; w += wstep) {
    const int l = w / 3360; int r = w % 3360;
    int mat, kt, rt;
    if (r < 992) { mat = 0; kt = r / 62; rt = r % 62; }
    else if (r < 1248) { r -= 992; mat = 1; kt = r / 16; rt = r % 16; }
    else if (r < 2656) { r -= 1248; mat = 2; kt = r / 88; rt = r % 88; }
    else { r -= 2656; mat = 3; kt = r / 16; rt = r % 16; }
    {
      const int r4 = (tid & 15) * 4, R = rt * 64 + r4, kq = tid >> 4;
      const float* src; int ns; bool valid = true;
      if (mat == 0) { const int rho = R & 31, scol = (R & ~31) + 8 * ((rho & 15) >> 2) + 4 * (rho >> 4) + (rho & 3);
        src = p.I(10) + (size_t)l * 1024 * DIN + scol; ns = DIN; valid = scol < DIN; }
      else if (mat == 1) { src = p.I(21) + (size_t)l * 1024 * 1024 + R; ns = 1024; }
      else if (mat == 2) { const int q = R & 63, f = q >> 4, i = q & 15, ty = f & 1, hid = (R >> 6) * 32 + 8 * (i >> 2) + 4 * (f >> 1) + (i & 3);
        src = (ty ? p.I(25) : p.I(24)) + (size_t)l * 1024 * DFF + hid; ns = DFF; }
      else { src = p.I(26) + (size_t)l * DFF * 1024 + R; ns = 1024; }
      f32x4 v[4];
#pragma unroll
      for (int i = 0; i < 4; ++i) v[i] = valid ? *(const f32x4*)(src + (size_t)(kt * 64 + kq + 16 * i) * ns) : (f32x4){0.f, 0.f, 0.f, 0.f};
#pragma unroll
      for (int i = 0; i < 4; ++i) {
        const int k = kq + 16 * i;
        tile[(r4 + 0) * 65 + k] = v[i][0]; tile[(r4 + 1) * 65 + k] = v[i][1]; tile[(r4 + 2) * 65 + k] = v[i][2]; tile[(r4 + 3) * 65 + k] = v[i][3];
      }
    }
    __syncthreads();
    {
      const int rr = tid >> 2, kc = (tid & 3) * 16;
      const int Kd = (mat == 3) ? DFF : 1024;
      bf16_t* base;
      if (mat == 0) base = (bf16_t*)(p.W() + OFF_WIN + l * SZ_WIN);
      else if (mat == 1) base = (bf16_t*)(p.W() + OFF_WOUT + l * SZ_WOUT);
      else if (mat == 2) base = (bf16_t*)(p.W() + OFF_WGU + l * SZ_WGU);
      else base = (bf16_t*)(p.W() + OFF_WDN + l * SZ_WDN);
      bf16_t* dst = base + (size_t)(rt * 64 + rr) * Kd + kt * 64 + kc;
      const float* s = tile + rr * 65 + kc;
      uint4 a, b;
      a.x = pk2(s[0], s[1]); a.y = pk2(s[2], s[3]); a.z = pk2(s[4], s[5]); a.w = pk2(s[6], s[7]);
      b.x = pk2(s[8], s[9]); b.y = pk2(s[10], s[11]); b.z = pk2(s[12], s[13]); b.w = pk2(s[14], s[15]);
      *(uint4*)dst = a; *(uint4*)(dst + 8) = b;
    }
    __syncthreads();
  }
}

__device__ __forceinline__ void ln_row_regs(f32x4 (&v)[4], const float* g, const float* bb, int lane) {
  float s = 0.f;
#pragma unroll
  for (int i = 0; i < 4; ++i) s += (v[i][0] + v[i][1]) + (v[i][2] + v[i][3]);
  const float mu = wave_sum(s) * (1.0f / 1024.0f);
  float q = 0.f;
#pragma unroll
  for (int i = 0; i < 4; ++i) { const f32x4 d = v[i] - mu; q += (d[0] * d[0] + d[1] * d[1]) + (d[2] * d[2] + d[3] * d[3]); }
  const float rs = rsqrtf(wave_sum(q) * (1.0f / 1024.0f) + 1e-5f);
#pragma unroll
  for (int i = 0; i < 4; ++i) {
    const f32x4 gg = *(const f32x4*)(g + lane * 4 + i * 256), b4 = *(const f32x4*)(bb + lane * 4 + i * 256);
    v[i] = (v[i] - mu) * rs * gg + b4;
  }
}

__device__ __forceinline__ void embed_ln(const Params& p, int bid, int nb, const int tid) {
  const int lane = tid & 63, wv = tid >> 6;
  float* X = (float*)(p.W() + OFF_X);
  bf16_t* Xb = (bf16_t*)p.O();
  for (int row = bid * 4 + wv; row < MT; row += nb * 4) {
    const float* src;
    if (row < MP) { const int b = row / TPR, t = row % TPR;
      src = (t < 16) ? p.I(7) + (size_t)t * 1024 : p.I(0) + ((size_t)b * 2048 + (t - 16)) * 1024; }
    else src = p.I(1) + (size_t)(row - MP) * 1024;
    f32x4 v[4];
#pragma unroll
    for (int i = 0; i < 4; ++i) v[i] = *(const f32x4*)(src + lane * 4 + i * 256);
    ln_row_regs(v, p.I(8), p.I(9), lane);
#pragma unroll
    for (int i = 0; i < 4; ++i) {
      *(f32x4*)(X + (size_t)row * 1024 + lane * 4 + i * 256) = v[i];
      uint2 o; o.x = pk2(v[i][0], v[i][1]); o.y = pk2(v[i][2], v[i][3]);
      *(uint2*)(Xb + (size_t)row * 1024 + lane * 4 + i * 256) = o;
    }
  }
}

__device__ __forceinline__ void rope_table(const Params& p, int bid, int nb, const int tid) {
  float2* cs = (float2*)(p.W() + OFF_CS);
  for (int e = bid * 256 + tid; e < 2068 * 32; e += nb * 256) {
    const int idx = e >> 5, i = e & 31;
    const double pos = (idx < 2064) ? (double)idx : (double)(16384 + idx - 2064);
    const double inv = exp(-((double)i / 31.0) * 9.210340371976184);
    const double ang = pos * inv;
    cs[e] = make_float2((float)cos(ang), (float)sin(ang));
  }
}

__device__ __forceinline__ void ln_phase(const Params& p, const float* g, const float* bb, bf16_t* xb, int final_, int bid, int nb, const int tid) {
  const int lane = tid & 63, wv = tid >> 6;
  float* X = (float*)(p.W() + OFF_X);
  f32x4 nx[4];
  {
    const int r0 = min(bid * 4 + wv, MT - 1);
#pragma unroll
    for (int i = 0; i < 4; ++i) nx[i] = *(const f32x4*)(X + (size_t)r0 * 1024 + lane * 4 + i * 256);
  }
  for (int row = bid * 4 + wv; row < MT; row += nb * 4) {
    f32x4 v[4];
#pragma unroll
    for (int i = 0; i < 4; ++i) v[i] = nx[i];
    {
      const int rn = min(row + nb * 4, MT - 1);
#pragma unroll
      for (int i = 0; i < 4; ++i) nx[i] = *(const f32x4*)(X + (size_t)rn * 1024 + lane * 4 + i * 256);
    }
    ln_row_regs(v, g, bb, lane);
    if (!final_) {
#pragma unroll
      for (int i = 0; i < 4; ++i) {
        *(f32x4*)(X + (size_t)row * 1024 + lane * 4 + i * 256) = v[i];
        uint2 o; o.x = pk2(v[i][0], v[i][1]); o.y = pk2(v[i][2], v[i][3]);
        *(uint2*)(xb + (size_t)row * 1024 + lane * 4 + i * 256) = o;
      }
    } else {
      float* dst = nullptr;
      if (row < MP) { const int b = row / TPR, t = row % TPR; if (t >= 16) dst = p.O() + O_YP + ((size_t)b * 2048 + (t - 16)) * 1024; }
      else dst = p.O() + O_YS + (size_t)(row - MP) * 1024;
      if (dst) {
#pragma unroll
        for (int i = 0; i < 4; ++i) *(f32x4*)(dst + lane * 4 + i * 256) = v[i];
      }
    }
  }
}

enum { EPI_BF16 = 0, EPI_RESID = 1, EPI_SWIGLU = 2 };

template <int EPI>
__device__ __forceinline__ void gemm_tile(const bf16_t* __restrict__ A, const int lda, const bf16_t* __restrict__ Bt, const int ldb,
                                          const int K, const int m0, const int n0, void* Cout, const int ldc, char* lds, const int tid) {
  const int wid = tid >> 6, lane = tid & 63, wr = wid >> 1, wc = wid & 1, fr = lane & 15, fq = lane >> 4;
  f32x4 acc[4][4];
#pragma unroll
  for (int m = 0; m < 4; ++m)
#pragma unroll
    for (int n = 0; n < 4; ++n) acc[m][n] = (f32x4){0.f, 0.f, 0.f, 0.f};
  const int nt = K >> 6;
  auto stage = [&](int kt, int buf) {
#pragma unroll
    for (int i = 0; i < 4; ++i) {
      const int off = tid * 16 + i * 4096;
      const int panel = off >> 13, rem = off & 8191, r = rem >> 6, c = (rem & 63) >> 1;
      const bf16_t* ga = A + (size_t)(m0 + r) * lda + kt * 64 + panel * 32 + c;
      const bf16_t* gb = Bt + (size_t)(n0 + r) * ldb + kt * 64 + panel * 32 + c;
      __builtin_amdgcn_global_load_lds((const unsigned*)ga, (__attribute__((address_space(3))) unsigned*)(lds + buf * 32768 + off), 16, 0, 0);
      __builtin_amdgcn_global_load_lds((const unsigned*)gb, (__attribute__((address_space(3))) unsigned*)(lds + buf * 32768 + 16384 + off), 16, 0, 0);
    }
  };
  stage(0, 0);
  for (int kt = 0; kt < nt; ++kt) {
    asm volatile("s_waitcnt vmcnt(0)" ::: "memory");
    __syncthreads();
    const char* sa = lds + (kt & 1) * 32768;
    const char* sb = sa + 16384;
    bf16x8 af[2][4], bfr[2][4];
#pragma unroll
    for (int ks = 0; ks < 2; ++ks) {
#pragma unroll
      for (int m = 0; m < 4; ++m) af[ks][m] = *(const bf16x8*)(sa + ks * 8192 + (wr * 64 + m * 16 + fr) * 64 + fq * 16);
#pragma unroll
      for (int n = 0; n < 4; ++n) bfr[ks][n] = *(const bf16x8*)(sb + ks * 8192 + (wc * 64 + n * 16 + fr) * 64 + fq * 16);
    }
    if (kt + 1 < nt) stage(kt + 1, (kt + 1) & 1);
#pragma unroll
    for (int ks = 0; ks < 2; ++ks)
#pragma unroll
      for (int m = 0; m < 4; ++m)
#pragma unroll
        for (int n = 0; n < 4; ++n) acc[m][n] = __builtin_amdgcn_mfma_f32_16x16x32_bf16(bfr[ks][n], af[ks][m], acc[m][n], 0, 0, 0);
  }
  if (EPI == EPI_RESID) {
    float* C0 = (float*)Cout + (size_t)(m0 + wr * 64 + fr) * ldc + n0 + wc * 64 + fq * 4;
#pragma unroll
    for (int mh = 0; mh < 2; ++mh) {
      f32x4 xin[2][4];
#pragma unroll
      for (int m = 0; m < 2; ++m)
#pragma unroll
        for (int n = 0; n < 4; ++n) xin[m][n] = *(const f32x4*)(C0 + (size_t)(mh * 2 + m) * 16 * ldc + n * 16);
#pragma unroll
      for (int m = 0; m < 2; ++m)
#pragma unroll
        for (int n = 0; n < 4; ++n) asm volatile("" : "+v"(xin[m][n]));
#pragma unroll
      for (int m = 0; m < 2; ++m)
#pragma unroll
        for (int n = 0; n < 4; ++n) *(f32x4*)(C0 + (size_t)(mh * 2 + m) * 16 * ldc + n * 16) = xin[m][n] * ALPHA + acc[mh * 2 + m][n];
    }
    return;
  }
#pragma unroll
  for (int m = 0; m < 4; ++m) {
    const int row = m0 + wr * 64 + m * 16 + fr;
    if (EPI == EPI_BF16) {
      bf16_t* C = (bf16_t*)Cout + (size_t)row * ldc + n0 + wc * 64 + fq * 8;
#pragma unroll
      for (int pq = 0; pq < 2; ++pq) { uint4 o; o.x = pk2(acc[m][2 * pq][0], acc[m][2 * pq][1]); o.y = pk2(acc[m][2 * pq][2], acc[m][2 * pq][3]);
        o.z = pk2(acc[m][2 * pq + 1][0], acc[m][2 * pq + 1][1]); o.w = pk2(acc[m][2 * pq + 1][2], acc[m][2 * pq + 1][3]); *(uint4*)(C + pq * 32) = o; }
    } else if (EPI == EPI_RESID) {
      float* C = (float*)Cout + (size_t)row * ldc + n0 + wc * 64 + fq * 4;
#pragma unroll
      for (int n = 0; n < 4; ++n) { const f32x4 x = *(const f32x4*)(C + n * 16); *(f32x4*)(C + n * 16) = x * ALPHA + acc[m][n]; }
    } else {
      bf16_t* C = (bf16_t*)Cout + (size_t)row * ldc + (n0 >> 1) + wc * 32 + fq * 8;
      const f32x4 g0 = acc[m][0], u0 = acc[m][1], g1 = acc[m][2], u1 = acc[m][3];
      uint4 o; o.x = pk2(siluf_(g0[0]) * u0[0], siluf_(g0[1]) * u0[1]); o.y = pk2(siluf_(g0[2]) * u0[2], siluf_(g0[3]) * u0[3]);
      o.z = pk2(siluf_(g1[0]) * u1[0], siluf_(g1[1]) * u1[1]); o.w = pk2(siluf_(g1[2]) * u1[2], siluf_(g1[3]) * u1[3]);
      *(uint4*)C = o;
    }
  }
}
template <int EPI>
__device__ __forceinline__ void gemm_phase(const bf16_t* A, int lda, const bf16_t* Bt, int ldb, int K, int ntn, void* C, int ldc, char* lds, int bid, int nb, const int tid) {
  constexpr int GM = 4, nM = MT / 128;
  const int ntiles = nM * ntn, nig = GM * ntn;
  const int pos = (EPI == EPI_BF16 && (nb & 7) == 0) ? (bid & 7) * (nb >> 3) + (bid >> 3) : bid;
  for (int L = pos; L < ntiles; L += nb) {
    int mt, nn;
    if (EPI != EPI_BF16) { mt = L / ntn; nn = L % ntn; }
    else { const int gid = L / nig, fm = gid * GM, gsz = min(nM - fm, GM), rem = L - gid * nig; mt = fm + rem % gsz; nn = rem / gsz; }
    gemm_tile<EPI>(A, lda, Bt, ldb, K, mt * 128, nn * 128, C, ldc, lds, tid);
  }
}

#define XB_TMO      128
#define XB_XCNT(j)  (256  + 64 * (j))
#define XB_XSUB(j)  (1280 + 64 * (j))
#define XB_XGEN(j)  (2304 + 64 * (j))
#define XB_TOP      3328
#define XB_TOPGEN   3392
#define XCD_BAR_WORDS 3456
#define XB_SPIN_CAP (1u << 22)
__device__ __forceinline__ unsigned xb_ld(unsigned* p) { return __hip_atomic_load(p, __ATOMIC_RELAXED, __HIP_MEMORY_SCOPE_AGENT); }
__device__ __forceinline__ unsigned xb_add(unsigned* p, unsigned v) { return __hip_atomic_fetch_add(p, v, __ATOMIC_RELAXED, __HIP_MEMORY_SCOPE_AGENT); }
__device__ __forceinline__ unsigned xb_xcc_id() { return (unsigned)__builtin_amdgcn_s_getreg((3 << 11) | 20) & 0xFu; }
#define XB_SPIN(cond, bar) do { unsigned _sp = 0; while (cond) { __builtin_amdgcn_s_sleep(1); \
    if ((++_sp & 255u) == 0u) { if (xb_ld(&(bar)[XB_TMO])) break; if (_sp > XB_SPIN_CAP) { atomicAdd(&(bar)[XB_TMO], 1u); break; } } } } while (0)
struct XcdBarrier { unsigned* bar; unsigned x; unsigned nloc, nx; };
__device__ __forceinline__ void xcd_barrier_complete(unsigned* bar, unsigned x, unsigned G, unsigned& nloc, unsigned& nx) {
  unsigned sum, cnt, mine, sp = 0u;
  for (;;) {
    sum = 0u; cnt = 0u; mine = 0u;
#pragma unroll
    for (unsigned j = 0; j < 16; ++j) { const unsigned c = xb_ld(&bar[XB_XCNT(j)]); sum += c; cnt += (c > 0u) ? 1u : 0u; mine = (j == x) ? c : mine; }
    if (sum == G) break;
    __builtin_amdgcn_s_sleep(1);
    if ((++sp & 255u) == 0u) { if (xb_ld(&bar[XB_TMO])) break; if (sp > XB_SPIN_CAP) { atomicAdd(&bar[XB_TMO], 1u); break; } }
  }
  nloc = mine > 0u ? mine : 1u; nx = cnt > 0u ? cnt : 1u;
}
__device__ __forceinline__ void xcd_barrier(XcdBarrier& b, const int tid, const unsigned G) {
  asm volatile("s_waitcnt vmcnt(0)" ::: "memory");
  __syncthreads();
  if (tid == 0) {
    unsigned* bar = b.bar;
    __builtin_amdgcn_s_waitcnt(0);
    if (b.nloc == 0u) xcd_barrier_complete(bar, b.x, G, b.nloc, b.nx);
    const unsigned nloc = b.nloc, nx = b.nx;
    const unsigned old = xb_add(&bar[XB_XSUB(b.x)], 1u);
    const unsigned gen = old / nloc;
    if (old + 1u == (gen + 1u) * nloc) {
      __builtin_amdgcn_fence(__ATOMIC_RELEASE, "agent");
      asm volatile("s_waitcnt vmcnt(0)" ::: "memory");
      const unsigned og = xb_add(&bar[XB_TOP], 1u);
      const unsigned tg = og / nx;
      if (og + 1u == (tg + 1u) * nx) xb_add(&bar[XB_TOPGEN], 1u);
      else XB_SPIN(xb_ld(&bar[XB_TOPGEN]) == tg, bar);
      __builtin_amdgcn_fence(__ATOMIC_ACQUIRE, "agent");
      xb_add(&bar[XB_XGEN(b.x)], 1u);
      asm volatile("s_waitcnt vmcnt(0)" ::: "memory");
    } else {
      XB_SPIN(xb_ld(&bar[XB_XGEN(b.x)]) == gen, bar);
      __builtin_amdgcn_fence(__ATOMIC_ACQUIRE, "agent");
      asm volatile("s_waitcnt vmcnt(0)" ::: "memory");
    }
  }
  __syncthreads();
}

template <int N, int RS>
__device__ __forceinline__ void convN(const bf16_t* rawb, const float (&w)[4][N], int tt, int off, float (&x)[N]) {
#pragma unroll
  for (int i = 0; i < N; ++i) x[i] = 0.f;
#pragma unroll
  for (int j = 0; j < 4; ++j) {
    float xv[N];
    if (N == 8) { const uint4 rv = *(const uint4*)(rawb + (tt + j) * RS + off); unpack8(rv, xv); }
    else if (N == 4) { const uint2 rv = *(const uint2*)(rawb + (tt + j) * RS + off); xv[0] = bflo(rv.x); xv[1] = bfhi(rv.x); xv[2 % N] = bflo(rv.y); xv[3 % N] = bfhi(rv.y); }
    else { const unsigned rv = *(const unsigned*)(rawb + (tt + j) * RS + off); xv[0] = bflo(rv); xv[1] = bfhi(rv); }
#pragma unroll
    for (int i = 0; i < N; ++i) x[i] += w[j][i] * xv[i];
  }
  if (N == 2) {
#pragma unroll
    for (int i = 0; i < N; ++i) asm volatile("" : "+v"(x[i]));
  }
#pragma unroll
  for (int i = 0; i < N; ++i) x[i] = siluf_(x[i]);
}

template <int MIX, int VN>
__device__ __forceinline__ void load_chunk_fn(const unsigned char* ws, const bf16_t* Pb, const int t, const int T, const int h, const int vcol, const int sub, const int posb,
                                              uint4& R0, uint4& R1, uint2& R2, uint4& R4, uint4& R5, unsigned& ex0, unsigned& ex1) {
  if (t < T) {
    const bf16_t* pr = Pb + (size_t)t * DINP;
    const int vbase = (MIX == 0) ? 512 : (MIX == 1) ? 1544 : (MIX == 2) ? 2312 : 3352;
    if (VN == 4) R2 = *(const uint2*)(pr + vbase + h * 64 + vcol);
    else R2.x = *(const unsigned*)(pr + vbase + h * 64 + vcol);
    if (MIX == 0) {
      R0 = *(const uint4*)(pr + 0 + h * 64 + sub * 8); R1 = *(const uint4*)(pr + 256 + h * 64 + sub * 8);
      ex0 = pr[768 + h]; ex1 = pr[772 + h];
    } else if (MIX == 1) {
      R0 = *(const uint4*)(pr + 1032 + h * 64 + sub * 8); R1 = *(const uint4*)(pr + 1288 + h * 64 + sub * 8);
    } else if (MIX == 2) {
      const uint2 q2 = *(const uint2*)(pr + 2056 + h * 32 + sub * 4), k2 = *(const uint2*)(pr + 2184 + h * 32 + sub * 4);
      R0 = make_uint4(q2.x, q2.y, k2.x, k2.y);
      R1 = *(const uint4*)(pr + 2568); R4 = *(const uint4*)(pr + 2576);
    } else {
      const uint2 ql = *(const uint2*)(pr + 2840 + h * 64 + sub * 4), qh = *(const uint2*)(pr + 2840 + h * 64 + 32 + sub * 4);
      const uint2 kl = *(const uint2*)(pr + 3096 + h * 64 + sub * 4), kh = *(const uint2*)(pr + 3096 + h * 64 + 32 + sub * 4);
      R0 = make_uint4(ql.x, ql.y, qh.x, qh.y); R1 = make_uint4(kl.x, kl.y, kh.x, kh.y);
      const uint4* cs = (const uint4*)(ws + OFF_CS + ((size_t)(posb + t) * 32 + sub * 4) * 8);
      R4 = cs[0]; R5 = cs[1];
    }
  }
}

__device__ __forceinline__ float dpp_hm(float x) {
  return __int_as_float(__builtin_amdgcn_update_dpp(0, __float_as_int(x), 0x141, 0xF, 0xF, true));
}
__device__ __forceinline__ float dpp_rm(float x) {
  return __int_as_float(__builtin_amdgcn_update_dpp(0, __float_as_int(x), 0x140, 0xF, 0xF, true));
}
__device__ __forceinline__ float red8d(float x) { x += dpp_x1(x); x += dpp_x2(x); x += dpp_hm(x); return x; }
template <int KG> __device__ __forceinline__ float redKG(float x) { x = red8d(x); if (KG == 16) x += dpp_rm(x); return x; }

template <int MIX, int KPL>
struct StepIn { float q[KPL], k[KPL], d[KPL]; float v, a, be, qk; };

template <int MIX, int KPL>
__device__ __forceinline__ void load_step(const float* qkdv, const float* scal, int t, int kg, int col, StepIn<MIX, KPL>& s) {
  const float* base = qkdv + t * 256;
#pragma unroll
  for (int i = 0; i < KPL; i += 4) {
    const f32x4 a = *(const f32x4*)(base + kg * KPL + i), b = *(const f32x4*)(base + 64 + kg * KPL + i);
    s.q[i] = a[0]; s.q[i + 1] = a[1]; s.q[i + 2] = a[2]; s.q[i + 3] = a[3];
    s.k[i] = b[0]; s.k[i + 1] = b[1]; s.k[i + 2] = b[2]; s.k[i + 3] = b[3];
    if (MIX == 1 || MIX == 2) { const f32x4 d = *(const f32x4*)(base + 128 + kg * KPL + i); s.d[i] = d[0]; s.d[i + 1] = d[1]; s.d[i + 2] = d[2]; s.d[i + 3] = d[3]; }
  }
  s.v = base[192 + col];
  if (MIX == 0) { const f32x4 c = *(const f32x4*)(scal + t * 4); s.a = c[0]; s.be = c[1]; s.qk = c[2]; }
}

template <int MIX, int KPL, int KG>
__device__ __forceinline__ float do_step(const StepIn<MIX, KPL>& s, float (&S)[KPL], const float gam) {
  if (MIX == 0) {
    float kS0 = 0.f, kS1 = 0.f, qS0 = 0.f, qS1 = 0.f;
#pragma unroll
    for (int i = 0; i < KPL; i += 2) { kS0 += s.k[i] * S[i]; kS1 += s.k[i + 1] * S[i + 1]; qS0 += s.q[i] * S[i]; qS1 += s.q[i + 1] * S[i + 1]; }
    const float kS = redKG<KG>(kS0 + kS1), qS = redKG<KG>(qS0 + qS1);
    const float w = s.be * (s.v - s.a * kS);
#pragma unroll
    for (int i = 0; i < KPL; ++i) S[i] = s.a * S[i] + s.k[i] * w;
    return s.a * qS + s.qk * w;
  } else {
    float o0 = 0.f, o1 = 0.f;
#pragma unroll
    for (int i = 0; i < KPL; i += 2) {
      const float d0 = (MIX == 3) ? gam : s.d[i], d1 = (MIX == 3) ? gam : s.d[i + 1];
      S[i] = d0 * S[i] + s.k[i] * s.v; S[i + 1] = d1 * S[i + 1] + s.k[i + 1] * s.v;
      o0 += s.q[i] * S[i]; o1 += s.q[i + 1] * S[i + 1];
    }
    return redKG<KG>(o0 + o1);
  }
}

template <int MIX>
__device__ __forceinline__ void scan_part(const Params& p, const int layer, const int smp, const int b0, const int bstep, const int bend, const int h, const int part, char* lds, const int tid) {
  constexpr int DK = (MIX == 2) ? 32 : 64;
  constexpr int NS = (MIX == 0) ? 4 : 2;
  constexpr int CW = 64 / NS;
  constexpr int CPW = CW / 4;
  constexpr int KG = 64 / CPW;
  constexpr int KPL = DK / KG;
  constexpr int VN = CW / 8;
  constexpr int RS = 128 + CW;
  float* qkdv = (float*)lds;
  float* obuf = (float*)(lds + 32768);
  float* scal = (float*)(lds + 36864);
  bf16_t* rawb = (bf16_t*)(lds + 37376);
  float* cwl = (float*)(lds + 48576);
  float* wgl = (float*)(lds + 37376);

  const int lane = tid & 63, wv = tid >> 6;
  const int tt = tid >> 3, sub = tid & 7;
  const int col = wv * CPW + lane / KG, kg = lane % KG;
  const int T = smp ? 4 : TPR;
  const int nBatch = smp ? NSB : NB;
  const int posb = smp ? 2064 : 0;
  const int vcol = part * CW + sub * VN;
  __syncthreads();
  float c8[8];
  float Aexp = 0.f, dtb = 0.f, gam = 0.f;
  float cwq[4][8], cwk[4][8];
  if (MIX == 0) {
    Aexp = __expf(p.I(12)[layer * 4 + h]); dtb = p.I(13)[layer * 4 + h];
#pragma unroll
    for (int j = 0; j < 4; ++j) {
      const float* cwp = p.I(11) + (size_t)(layer * 4 + j) * 768;
#pragma unroll
      for (int i = 0; i < 8; ++i) { cwq[j][i] = cwp[h * 64 + sub * 8 + i]; cwk[j][i] = cwp[256 + h * 64 + sub * 8 + i]; }
    }
    for (int e = tid; e < 4 * CW; e += 256) { const int j = e / CW, r = e % CW; cwl[j * RS + 128 + r] = p.I(11)[(size_t)(layer * 4 + j) * 768 + 512 + h * 64 + part * CW + r]; }
  } else if (MIX == 1) {
#pragma unroll
    for (int i = 0; i < 8; ++i) {
      const int d = h * 64 + sub * 8 + i;
      c8[i] = (layer == 0) ? 1.0f : sigmoidf_(p.I(15)[d] - p.I(15)[256 + d]);
    }
  } else if (MIX == 2) {
    for (int e = tid; e < 512; e += 256) { const int r = e >> 5, j = e & 31; wgl[e] = p.I(17)[(size_t)(layer * 16 + r) * 128 + h * 32 + j]; }
#pragma unroll
    for (int i = 0; i < 4; ++i) c8[i] = p.I(18)[layer * 128 + h * 32 + sub * 4 + i];
  } else {
    gam = 1.0f - exp2f(-5.0f - (float)h);
  }
  for (int b = b0; b < bend; b += bstep) {
  const int row0 = smp ? MP + b * 4 : b * TPR;
  const bf16_t* Pb = (const bf16_t*)(p.W() + OFF_P) + (size_t)row0 * DINP;
  bf16_t* Ob = (bf16_t*)p.O() + (size_t)row0 * 1024 + MIX * 256 + h * 64 + part * CW;
  float* PS = (float*)((unsigned char*)p.O() + DOUT_PS) + (size_t)row0 * 128 + (MIX * 4 + h) * 8 + part * 2;
  uint4 R0 = make_uint4(0, 0, 0, 0), R1 = R0, R4 = R0, R5 = R0; uint2 R2 = make_uint2(0, 0); unsigned ex0 = 0, ex1 = 0;
  load_chunk_fn<MIX, VN>(p.W(), Pb, tt, T, h, vcol, sub, posb, R0, R1, R2, R4, R5, ex0, ex1);
  float S[KPL];
  if (smp) {
    const float* sin_ = p.I(3 + MIX) + ((size_t)(layer * NSB + b) * 4 + h) * DK * 64 + part * CW;
#pragma unroll
    for (int i = 0; i < KPL; ++i) S[i] = sin_[(kg * KPL + i) * 64 + col];
  } else {
#pragma unroll
    for (int i = 0; i < KPL; ++i) S[i] = 0.f;
  }
  if (MIX == 0) {
    for (int e = tid; e < 3 * RS; e += 256) { const int j = e / RS, r = e % RS;
      const int cc = (r < 64) ? (h * 64 + r) : (r < 128) ? (256 + h * 64 + r - 64) : (512 + h * 64 + part * CW + r - 128);
      float v = 0.f; if (smp) v = p.I(2)[((size_t)(layer * NSB + b) * 3 + j) * 768 + cc];
      rawb[e] = (bf16_t)f2bf(v); }
  }
  __syncthreads();

  int ntok_last = 0;
  for (int t0 = 0; t0 < T; t0 += 32) {
    const int ntok = min(32, T - t0);
    ntok_last = ntok;
    const bool valid = tt < ntok;
    float* dst = qkdv + tt * 256;
    if (MIX != 0 && valid) {
      if (VN == 4) *(f32x4*)(dst + 192 + sub * 4) = (f32x4){bflo(R2.x), bfhi(R2.x), bflo(R2.y), bfhi(R2.y)};
      else *(float2*)(dst + 192 + sub * 2) = make_float2(bflo(R2.x), bfhi(R2.x));
    }
    if (MIX == 0) {
      if (valid) {
        *(uint4*)(rawb + (3 + tt) * RS + 0 + sub * 8) = R0;
        *(uint4*)(rawb + (3 + tt) * RS + 64 + sub * 8) = R1;
        if (VN == 4) *(uint2*)(rawb + (3 + tt) * RS + 128 + sub * 4) = R2;
        else *(unsigned*)(rawb + (3 + tt) * RS + 128 + sub * 2) = R2.x;
      }
      __syncthreads();
      if (valid) {
        float xq[8], xk[8], xv[VN];
        { float cwv[4][VN];
#pragma unroll
          for (int j = 0; j < 4; ++j)
#pragma unroll
            for (int i = 0; i < VN; ++i) cwv[j][i] = cwl[j * RS + 128 + sub * VN + i];
          convN<VN, RS>(rawb, cwv, tt, 128 + sub * VN, xv); }
        convN<8, RS>(rawb, cwq, tt, sub * 8, xq);
        convN<8, RS>(rawb, cwk, tt, 64 + sub * 8, xk);
#pragma unroll
        for (int i = 0; i < VN; ++i) dst[192 + sub * VN + i] = xv[i];
        float ssq = 0.f, ssk = 0.f;
#pragma unroll
        for (int i = 0; i < 8; ++i) { ssq += xq[i] * xq[i]; ssk += xk[i] * xk[i]; }
        ssq = red8d(ssq); ssk = red8d(ssk);
        const float rq = rsqrtf(ssq + 1e-6f) * 0.125f, rk = rsqrtf(ssk + 1e-6f);
        float qk = 0.f;
#pragma unroll
        for (int i = 0; i < 8; ++i) { xq[i] *= rq; xk[i] *= rk; qk += xq[i] * xk[i]; }
        qk = red8d(qk);
        *(f32x4*)(dst + sub * 8) = (f32x4){xq[0], xq[1], xq[2], xq[3]}; *(f32x4*)(dst + sub * 8 + 4) = (f32x4){xq[4], xq[5], xq[6], xq[7]};
        *(f32x4*)(dst + 64 + sub * 8) = (f32x4){xk[0], xk[1], xk[2], xk[3]}; *(f32x4*)(dst + 64 + sub * 8 + 4) = (f32x4){xk[4], xk[5], xk[6], xk[7]};
        if (sub == 0) {
          const float be = sigmoidf_(bflo(ex0)), al = bflo(ex1);
          const float a = __expf(-Aexp * softplusf_(al + dtb));
          *(f32x4*)(scal + tt * 4) = (f32x4){a, be, qk, 0.f};
        }
      }
    } else if (MIX == 1) {
      if (valid) {
        float q[8], z[8]; unpack8(R0, q); unpack8(R1, z);
        float kk[8], dd[8];
#pragma unroll
        for (int i = 0; i < 8; ++i) { q[i] = siluf_(q[i]); kk[i] = c8[i] * sigmoidf_(-z[i]); dd[i] = 1.0f - fminf(kk[i], 1.0f - 1e-6f); }
        *(f32x4*)(dst + sub * 8) = (f32x4){q[0], q[1], q[2], q[3]}; *(f32x4*)(dst + sub * 8 + 4) = (f32x4){q[4], q[5], q[6], q[7]};
        *(f32x4*)(dst + 64 + sub * 8) = (f32x4){kk[0], kk[1], kk[2], kk[3]}; *(f32x4*)(dst + 64 + sub * 8 + 4) = (f32x4){kk[4], kk[5], kk[6], kk[7]};
        *(f32x4*)(dst + 128 + sub * 8) = (f32x4){dd[0], dd[1], dd[2], dd[3]}; *(f32x4*)(dst + 128 + sub * 8 + 4) = (f32x4){dd[4], dd[5], dd[6], dd[7]};
      }
    } else if (MIX == 2) {
      if (valid) {
        float lr[16]; unpack8(R1, lr); unpack8(R4, lr + 8);
        const float q0 = bflo(R0.x), q1 = bfhi(R0.x), q2 = bflo(R0.y), q3 = bfhi(R0.y);
        const float k0 = bflo(R0.z), k1 = bfhi(R0.z), k2 = bflo(R0.w), k3 = bfhi(R0.w);
        const float sc = 0.17677669529663687f;
        f32x4 xg = (f32x4){c8[0], c8[1], c8[2], c8[3]};
#pragma unroll
        for (int r = 0; r < 16; ++r) xg += lr[r] * *(const f32x4*)(wgl + r * 32 + sub * 4);
        f32x4 dd;
#pragma unroll
        for (int i = 0; i < 4; ++i) { const float ls = fminf(xg[i], 0.f) - __logf(1.0f + __expf(-fabsf(xg[i]))); dd[i] = __expf(ls * 0.0625f); }
        *(f32x4*)(dst + sub * 4) = (f32x4){q0 * sc, q1 * sc, q2 * sc, q3 * sc};
        *(f32x4*)(dst + 64 + sub * 4) = (f32x4){k0, k1, k2, k3};
        *(f32x4*)(dst + 128 + sub * 4) = dd;
      }
    } else {
      if (valid) {
        const float ql[4] = {bflo(R0.x), bfhi(R0.x), bflo(R0.y), bfhi(R0.y)}, qh[4] = {bflo(R0.z), bfhi(R0.z), bflo(R0.w), bfhi(R0.w)};
        const float kl[4] = {bflo(R1.x), bfhi(R1.x), bflo(R1.y), bfhi(R1.y)}, kh[4] = {bflo(R1.z), bfhi(R1.z), bflo(R1.w), bfhi(R1.w)};
        const float cc[4] = {__uint_as_float(R4.x), __uint_as_float(R4.z), __uint_as_float(R5.x), __uint_as_float(R5.z)};
        const float sn[4] = {__uint_as_float(R4.y), __uint_as_float(R4.w), __uint_as_float(R5.y), __uint_as_float(R5.w)};
        f32x4 qa, qb, ka, kb;
#pragma unroll
        for (int i = 0; i < 4; ++i) {
          qa[i] = ql[i] * cc[i] - qh[i] * sn[i]; qb[i] = ql[i] * sn[i] + qh[i] * cc[i];
          ka[i] = (kl[i] * cc[i] - kh[i] * sn[i]) * 0.125f; kb[i] = (kl[i] * sn[i] + kh[i] * cc[i]) * 0.125f;
        }
        *(f32x4*)(dst + sub * 4) = qa; *(f32x4*)(dst + 32 + sub * 4) = qb;
        *(f32x4*)(dst + 64 + sub * 4) = ka; *(f32x4*)(dst + 96 + sub * 4) = kb;
      }
    }
    __syncthreads();
    if (MIX == 0 && t0 + 32 < T) {
      if (tid < 3 * RS / 8) { const uint4 v = *(const uint4*)(rawb + 32 * RS + tid * 8); *(uint4*)(rawb + tid * 8) = v; }
    }
    if (t0 + 32 < T) load_chunk_fn<MIX, VN>(p.W(), Pb, t0 + 32 + tt, T, h, vcol, sub, posb, R0, R1, R2, R4, R5, ex0, ex1);
    {
      StepIn<MIX, KPL> sa, sb;
      float osave = 0.f;
      load_step<MIX, KPL>(qkdv, scal, 0, kg, col, sa);
      for (int t = 0; t < ntok; t += 2) {
        load_step<MIX, KPL>(qkdv, scal, t + 1, kg, col, sb);
        __builtin_amdgcn_sched_barrier(0);
        const float oa = do_step<MIX, KPL, KG>(sa, S, gam);
        osave = (kg == (t & (KG - 1))) ? oa : osave;
        load_step<MIX, KPL>(qkdv, scal, min(t + 2, ntok - 1), kg, col, sa);
        __builtin_amdgcn_sched_barrier(0);
        const float ob = do_step<MIX, KPL, KG>(sb, S, gam);
        osave = (kg == ((t + 1) & (KG - 1))) ? ob : osave;
        if (((t + 2) & (KG - 1)) == 0) obuf[(t + 2 - KG + kg) * CW + col] = osave;
      }
      const int remn = ntok & (KG - 1);
      if (remn != 0 && kg < remn) obuf[(ntok - remn + kg) * CW + col] = osave;
    }
    __syncthreads();
    if (valid) {
      float o[VN];
#pragma unroll
      for (int i = 0; i < VN; ++i) o[i] = obuf[tt * CW + sub * VN + i];
      float s1 = 0.f, s2 = 0.f;
#pragma unroll
      for (int i = 0; i < VN; ++i) { s1 += o[i]; s2 += o[i] * o[i]; }
      s1 = red8d(s1); s2 = red8d(s2);
      if (VN == 4) { uint2 o2; o2.x = pk2(o[0], o[1]); o2.y = pk2(o[2 % VN], o[3 % VN]); *(uint2*)(Ob + (size_t)(t0 + tt) * 1024 + sub * 4) = o2; }
      else *(unsigned*)(Ob + (size_t)(t0 + tt) * 1024 + sub * 2) = pk2(o[0], o[1]);
      if (sub == 0) *(float2*)(PS + (size_t)(t0 + tt) * 128) = make_float2(s1, s2);
    }
  }
  {
    const size_t obase = (MIX == 0) ? (smp ? O_DS : O_DP) : (MIX == 1) ? (smp ? O_HS : O_HP) : (MIX == 2) ? (smp ? O_GS : O_GP) : (smp ? O_RS : O_RP);
    float* so = p.O() + obase + ((size_t)(layer * nBatch + b) * 4 + h) * DK * 64 + part * CW;
#pragma unroll
    for (int i = 0; i < KPL; ++i) so[(kg * KPL + i) * 64 + col] = S[i];
  }
  if (MIX == 0) {
    float* co = p.O() + (smp ? O_CS : O_CP) + (size_t)(layer * nBatch + b) * 3 * 768;
    for (int e = tid; e < 3 * RS; e += 256) { const int j = e / RS, r = e % RS;
      const float v = bflo((unsigned)rawb[(ntok_last + j) * RS + r]);
      if (r < 128) { if (part == 0) co[j * 768 + ((r < 64) ? (h * 64 + r) : (256 + h * 64 + r - 64))] = v; }
      else co[j * 768 + 512 + h * 64 + part * CW + r - 128] = v; }
  }
  __syncthreads();
  }
}

constexpr int ITEMS_PER_SEQ = 40;
__device__ __forceinline__ void scan_dispatch(const Params& p, int layer, int smp, int type, int b0, int bstep, int bend, char* lds, const int tid) {
  const int r = type;
  if (r < 16) scan_part<0>(p, layer, smp, b0, bstep, bend, r >> 2, r & 3, lds, tid);
  else {
    const int r2 = r - 16, mh = 4 + (r2 >> 1), part = r2 & 1, mix = mh >> 2, h = mh & 3;
    if (mix == 1) scan_part<1>(p, layer, smp, b0, bstep, bend, h, part, lds, tid);
    else if (mix == 2) scan_part<2>(p, layer, smp, b0, bstep, bend, h, part, lds, tid);
    else scan_part<3>(p, layer, smp, b0, bstep, bend, h, part, lds, tid);
  }
}

__device__ __forceinline__ int long_item_type(int u, int& b) {
  int type;
  if (u < 64) { b = u >> 3; type = 24 + (u & 7); }
  else if (u < 192) { const int v = u - 64; b = v >> 4; type = v & 15; }
  else if (u < 256) { const int v = u - 192; b = v >> 3; type = 16 + (v & 7); }
  else { const int v = u - 256; b = v >> 3; type = 32 + (v & 7); }
  return type;
}
__device__ __forceinline__ void scan_phase(const Params& p, int layer, char* lds, int bid, int nb, const int tid, const int role, const int ci, const int nprim, const int nsec) {
  constexpr int NPI = NB * ITEMS_PER_SEQ;
  const bool paired = (nprim == 256 && nsec == 256);
  int j = -1, nbs = 1;
  if (paired) {
    int u = -1;
    if (role == 0) u = ci; else if (ci < NPI - 256) u = 256 + ci;
    if (u >= 0) { int b; const int type = long_item_type(u, b); scan_dispatch(p, layer, 0, type, b, 1, b + 1, lds, tid); }
    else { j = ci - (NPI - 256); nbs = 256 - (NPI - 256); }
  } else {
    for (int u = bid; u < NPI; u += nb) { int b; const int type = long_item_type(u, b); scan_dispatch(p, layer, 0, type, b, 1, b + 1, lds, tid); }
    nbs = (nb > NPI) ? nb - NPI : nb; j = (nb > NPI) ? bid - NPI : bid;
  }
  if (j >= 0) {
    const int nsl = (nbs + ITEMS_PER_SEQ - 1) / ITEMS_PER_SEQ;
    for (int jj = j; jj < ITEMS_PER_SEQ * nsl; jj += nbs) scan_dispatch(p, layer, 1, jj % ITEMS_PER_SEQ, jj / ITEMS_PER_SEQ, nsl, NSB, lds, tid);
    if (layer == 0) { __syncthreads(); convert_weights(p, lds, 992 + j, 6720, nbs, tid); }
  }
}

__device__ __forceinline__ void norm_phase(const Params& p, int layer, int bid, int nb, const int tid) {
  bf16_t* O = (bf16_t*)p.O();
  const bf16_t* P = (const bf16_t*)(p.W() + OFF_P);
  const float* PS = (const float*)((const unsigned char*)p.O() + DOUT_PS);
  const int cg8 = tid & 127;
  const int mh = cg8 >> 3, mix = mh >> 2, h = mh & 3, j0 = (cg8 & 7) * 8;
  const int gcol = (mix == 0) ? 776 : (mix == 1) ? 1800 : (mix == 2) ? 2584 : 3608;
  const float* gsrc = (mix == 0) ? p.I(14) : (mix == 1) ? p.I(16) : (mix == 2) ? p.I(19) : p.I(20);
  float g8[8];
#pragma unroll
  for (int i = 0; i < 8; ++i) g8[i] = gsrc[layer * 256 + h * 64 + j0 + i];
  uint4 ovn, gvn; f32x4 psn, ps2n = (f32x4){0.f, 0.f, 0.f, 0.f};
  {
    const int r0 = min(bid * 2 + (tid >> 7), MT - 1);
    ovn = *(const uint4*)(O + (size_t)r0 * 1024 + cg8 * 8);
    gvn = *(const uint4*)(P + (size_t)r0 * DINP + gcol + h * 64 + j0);
    psn = *(const f32x4*)(PS + (size_t)r0 * 128 + mh * 8);
    if (mix == 0) ps2n = *(const f32x4*)(PS + (size_t)r0 * 128 + mh * 8 + 4);
  }
  for (int row = bid * 2 + (tid >> 7); row < MT; row += nb * 2) {
    const uint4 ov = ovn, gv = gvn; const f32x4 ps = psn, ps2 = ps2n;
    {
      const int rn = min(row + nb * 2, MT - 1);
      ovn = *(const uint4*)(O + (size_t)rn * 1024 + cg8 * 8);
      gvn = *(const uint4*)(P + (size_t)rn * DINP + gcol + h * 64 + j0);
      psn = *(const f32x4*)(PS + (size_t)rn * 128 + mh * 8);
      if (mix == 0) ps2n = *(const f32x4*)(PS + (size_t)rn * 128 + mh * 8 + 4);
    }
    float s1 = ps[0] + ps[2], s2 = ps[1] + ps[3];
    if (mix == 0) { s1 += ps2[0] + ps2[2]; s2 += ps2[1] + ps2[3]; }
    float o[8], gt[8]; unpack8(ov, o); unpack8(gv, gt);
    float mu = 0.f, rs;
    if (mix == 3) { mu = s1 * (1.0f / 64.0f); const float var = fmaxf(s2 * (1.0f / 64.0f) - mu * mu, 0.f); rs = rsqrtf(var + 1e-5f); }
    else rs = rsqrtf(s2 * (1.0f / 64.0f) + 1e-6f);
    float r[8];
#pragma unroll
    for (int i = 0; i < 8; ++i) r[i] = (o[i] - mu) * rs * g8[i] * siluf_(gt[i]);
    uint4 o4; o4.x = pk2(r[0], r[1]); o4.y = pk2(r[2], r[3]); o4.z = pk2(r[4], r[5]); o4.w = pk2(r[6], r[7]);
    *(uint4*)(O + (size_t)row * 1024 + cg8 * 8) = o4;
  }
}

constexpr int NPHASE = 17;
__global__ void __launch_bounds__(256, 2) hymba_fwd(Params p_, int ph_lo, int ph_hi) {
  __shared__ __attribute__((aligned(16))) char lds[65536];
  XcdBarrier xb; xb.bar = (unsigned*)(p_.ws + OFF_BAR); xb.x = xb_xcc_id(); xb.nloc = 0u; xb.nx = 0u;
  if (threadIdx.x == 0) (void)xb_add(&xb.bar[XB_XCNT(xb.x)], 1u);
  int role = 0, ci = 0;
  {
    const unsigned key = ((((unsigned)__builtin_amdgcn_s_getreg((31 << 11) | 4)) >> 8) & 0xFFu) | (xb.x << 8);
    if (threadIdx.x == 0) {
      const unsigned slot = xb_add(&xb.bar[CEN_TAB + key], 1u);
      unsigned r;
      if (slot == 0u) { r = xb_add(&xb.bar[CEN_CNT], 1u); __hip_atomic_store(&xb.bar[CEN_TAB2 + key], r + 1u, __ATOMIC_RELAXED, __HIP_MEMORY_SCOPE_AGENT); }
      else { (void)xb_add(&xb.bar[CEN_CNT + 1], 1u); r = 0u; }
      *(volatile unsigned*)(lds) = slot == 0u ? 0u : 1u; *(volatile unsigned*)(lds + 4) = r;
    }
    __syncthreads();
    role = (int)*(volatile unsigned*)(lds); ci = (int)*(volatile unsigned*)(lds + 4);
    __syncthreads();
    role = __builtin_amdgcn_readfirstlane(role); ci = __builtin_amdgcn_readfirstlane(ci);
    if (role != 0) ci = -1 - (int)key;
  }
  int nprim = 0, nsec = 0;
  if (ph_hi < 0) cg::this_grid().sync();
  for (int ph = ph_lo; ph < ph_hi; ++ph) {
    int tid = threadIdx.x, bid = blockIdx.x, nb = gridDim.x;
    asm volatile("" : "+v"(tid));
    asm volatile("" : "+s"(bid), "+s"(nb));
    if (ph > ph_lo) xcd_barrier(xb, tid, (unsigned)nb);
    if (ph == ph_lo + 1) {
      nprim = (int)xb_ld(&xb.bar[CEN_CNT]); nsec = (int)xb_ld(&xb.bar[CEN_CNT + 1]);
      if (role != 0) { const unsigned v = xb_ld(&xb.bar[CEN_TAB2 + (unsigned)(-1 - ci)]); ci = (v > 0u) ? (int)v - 1 : 0; }
      nprim = __builtin_amdgcn_readfirstlane(nprim); nsec = __builtin_amdgcn_readfirstlane(nsec); ci = __builtin_amdgcn_readfirstlane(ci);
    }
    const Params& p = p_;
    if (ph == 0) {
      convert_weights(p, lds, bid, 992, nb, tid);
      embed_ln(p, bid, nb, tid);
      rope_table(p, bid, nb, tid);
    } else {
      const int l = (ph - 1) / 8, s = (ph - 1) % 8;
      const bf16_t* Xb = (const bf16_t*)p.O();
      bf16_t* X1b = (bf16_t*)(p.W() + OFF_X1B);
      bf16_t* Hb = (bf16_t*)(p.W() + OFF_H);
      float* X = (float*)(p.W() + OFF_X);
      if (s == 0) gemm_phase<EPI_BF16>(Xb, 1024, (const bf16_t*)(p.W() + OFF_WIN + l * SZ_WIN), 1024, 1024, DINP / 128, p.W() + OFF_P, DINP, lds, bid, nb, tid);
      else if (s == 1) scan_phase(p, l, lds, bid, nb, tid, role, ci, nprim, nsec);
      else if (s == 2) norm_phase(p, l, bid, nb, tid);
      else if (s == 3) gemm_phase<EPI_RESID>(Xb, 1024, (const bf16_t*)(p.W() + OFF_WOUT + l * SZ_WOUT), 1024, 1024, 8, X, 1024, lds, bid, nb, tid);
      else if (s == 4) ln_phase(p, p.I(22) + l * 1024, p.I(23) + l * 1024, X1b, 0, bid, nb, tid);
      else if (s == 5) gemm_phase<EPI_SWIGLU>(X1b, 1024, (const bf16_t*)(p.W() + OFF_WGU + l * SZ_WGU), 1024, 1024, 44, Hb, DFF, lds, bid, nb, tid);
      else if (s == 6) gemm_phase<EPI_RESID>(Hb, DFF, (const bf16_t*)(p.W() + OFF_WDN + l * SZ_WDN), DFF, DFF, 8, X, 1024, lds, bid, nb, tid);
      else ln_phase(p, p.I(27) + l * 1024, p.I(28) + l * 1024, (bf16_t*)p.O(), l == 1, bid, nb, tid);
    }
  }
}

extern "C" void kernel_launch(void* const* d_in, const int* in_sizes, int n_in, void* d_out, int out_size, void* d_ws, size_t ws_size,
                              hipStream_t stream) {
  (void)in_sizes; (void)out_size;
  if (n_in < 29 || ws_size < WS_NEED) { fprintf(stderr, "bad args: n_in %d ws %zu need %zu\n", n_in, ws_size, (size_t)WS_NEED); return; }
  Params p{};
  for (int i = 0; i < 29; ++i) p.in[i] = (const float*)d_in[i];
  p.out = (float*)d_out;
  p.ws = (unsigned char*)d_ws;
  static int grid_blocks = 0;
  if (!grid_blocks) {
    int dev = 0, cus = 0, per_cu = 0;
    (void)hipGetDevice(&dev);
    (void)hipDeviceGetAttribute(&cus, hipDeviceAttributeMultiprocessorCount, dev);
    (void)hipOccupancyMaxActiveBlocksPerMultiprocessor(&per_cu, hymba_fwd, 256, 0);
    if (per_cu > 2) per_cu = 2;
    if (per_cu < 1) per_cu = 1;
    grid_blocks = cus * per_cu;
  }
  (void)hipMemsetAsync((unsigned char*)d_ws + OFF_BAR, 0, BAR_BYTES, stream);
  int lo = 0, hi = NPHASE;
  void* args[] = {&p, &lo, &hi};
  hipError_t e = hipLaunchCooperativeKernel((void*)hymba_fwd, dim3(grid_blocks), dim3(256), args, 0, stream);
  if (e != hipSuccess) fprintf(stderr, "cooperative launch failed: %s (grid %d)\n", hipGetErrorString(e), grid_blocks);
}
```

```cpp
#include <hip/hip_runtime.h>
#include <hip/hip_cooperative_groups.h>
#include <cstdio>
#include <cstdint>
namespace cg = cooperative_groups;

#ifndef COOP
#define COOP 1
#endif

typedef unsigned short bf16_t;
typedef short bf16x8 __attribute__((ext_vector_type(8)));
typedef float f32x4 __attribute__((ext_vector_type(4)));

constexpr int DM = 1024, NB = 8, TPR = 2064, NSB = 128, TS = 4;
constexpr int MP = NB * TPR;
constexpr int MS = NSB * TS;
constexpr int MT = MP + MS;
constexpr int DIN = 3864, DINP = 3968, DFF = 2816;
constexpr float ALPHA = 1.41421356237309515f;

constexpr size_t SZ_WIN = (size_t)DINP * 1024 * 2, SZ_WOUT = (size_t)1024 * 1024 * 2, SZ_WGU = (size_t)5632 * 1024 * 2, SZ_WDN = (size_t)1024 * 2816 * 2;
constexpr size_t OFF_CS = 0;
constexpr size_t OFF_WIN = 532480;
constexpr size_t OFF_WOUT = OFF_WIN + 2 * SZ_WIN;
constexpr size_t OFF_WGU = OFF_WOUT + 2 * SZ_WOUT;
constexpr size_t OFF_WDN = OFF_WGU + 2 * SZ_WGU;
constexpr size_t OFF_X = OFF_WDN + 2 * SZ_WDN;
constexpr size_t OFF_P = OFF_X + (size_t)MT * 1024 * 4;
constexpr size_t OFF_X1B = OFF_P;
constexpr size_t OFF_H = OFF_P + (size_t)MT * 1024 * 2;
constexpr size_t OFF_BAR = OFF_P + (size_t)MT * DINP * 2;
constexpr int CEN_CNT = 3520, CEN_TAB = 4096, CEN_TAB2 = 8192;
constexpr size_t BAR_BYTES = 12288 * 4;
constexpr size_t WS_NEED = OFF_BAR + BAR_BYTES;
constexpr size_t DOUT_PS = 36000000;

constexpr size_t O_YP = 0, O_YS = 16777216, O_CP = 17301504, O_CS = 17338368, O_DP = 17928192, O_DS = 18190336,
                 O_HP = 22384640, O_HS = 22646784, O_GP = 26841088, O_GS = 26972160, O_RP = 29069312, O_RS = 29331456;

#define GAS __attribute__((address_space(1)))
struct Params {
  const float* in[29];
  float* out;
  unsigned char* ws;
  __device__ __forceinline__ const float* I(int i) const { return (const float*)(const GAS float*)in[i]; }
  __device__ __forceinline__ float* O() const { return (float*)(GAS float*)out; }
  __device__ __forceinline__ unsigned char* W() const { return (unsigned char*)(GAS unsigned char*)ws; }
};

__device__ __forceinline__ unsigned f2bf(float f) {
  unsigned u = __float_as_uint(f);
  u += 0x7fffu + ((u >> 16) & 1u);
  return u >> 16;
}
typedef float f32x2_t __attribute__((ext_vector_type(2)));
typedef __bf16 bf16x2_t __attribute__((ext_vector_type(2)));
__device__ __forceinline__ unsigned pk2(float lo, float hi) { const f32x2_t v = {lo, hi}; const bf16x2_t b = __builtin_convertvector(v, bf16x2_t); return __builtin_bit_cast(unsigned, b); }
__device__ __forceinline__ float bflo(unsigned u) { return __uint_as_float(u << 16); }
__device__ __forceinline__ float bfhi(unsigned u) { return __uint_as_float(u & 0xffff0000u); }
__device__ __forceinline__ void unpack8(const uint4& r, float* x) {
  x[0] = bflo(r.x); x[1] = bfhi(r.x); x[2] = bflo(r.y); x[3] = bfhi(r.y);
  x[4] = bflo(r.z); x[5] = bfhi(r.z); x[6] = bflo(r.w); x[7] = bfhi(r.w);
}
__device__ __forceinline__ float sigmoidf_(float x) { return __builtin_amdgcn_rcpf(1.0f + __expf(-x)); }
__device__ __forceinline__ float siluf_(float x) { return x * __builtin_amdgcn_rcpf(1.0f + __expf(-x)); }
__device__ __forceinline__ float softplusf_(float x) { return fmaxf(x, 0.f) + __logf(1.0f + __expf(-fabsf(x))); }
__device__ __forceinline__ float red8(float x) {
  x += __shfl_xor(x, 1); x += __shfl_xor(x, 2); x += __shfl_xor(x, 4); return x;
}
__device__ __forceinline__ float dpp_x1(float x) {
  return __int_as_float(__builtin_amdgcn_update_dpp(0, __float_as_int(x), 0xB1, 0xF, 0xF, true));
}
__device__ __forceinline__ float dpp_x2(float x) {
  return __int_as_float(__builtin_amdgcn_update_dpp(0, __float_as_int(x), 0x4E, 0xF, 0xF, true));
}
__device__ __forceinline__ float red4(float x) { x += dpp_x1(x); x += dpp_x2(x); return x; }
__device__ __forceinline__ float wave_sum(float x) {
#pragma unroll
  for (int o = 32; o >= 1; o >>= 1) x += __shfl_xor(x, o);
  return x;
}

__device__ __forceinline__ void convert_weights(const Params& p, char* lds, int w0, int w1, int wstep, const int tid) {
  float* tile = (float*)lds;
  for (int w = w0; w < w1; w += wstep) {
    const int l = w / 3360; int r = w % 3360;
    int mat, kt, rt;
    if (r < 992) { mat = 0; kt = r / 62; rt = r % 62; }
    else if (r < 1248) { r -= 992; mat = 1; kt = r / 16; rt = r % 16; }
    else if (r < 2656) { r -= 1248; mat = 2; kt = r / 88; rt = r % 88; }
    else { r -= 2656; mat = 3; kt = r / 16; rt = r % 16; }
    {
      const int r4 = (tid & 15) * 4, R = rt * 64 + r4, kq = tid >> 4;
      const float* src; int ns; bool valid = true;
      if (mat == 0) { const int rho = R & 31, scol = (R & ~31) + 8 * ((rho & 15) >> 2) + 4 * (rho >> 4) + (rho & 3);
        src = p.I(10) + (size_t)l * 1024 * DIN + scol; ns = DIN; valid = scol < DIN; }
      else if (mat == 1) { src = p.I(21) + (size_t)l * 1024 * 1024 + R; ns = 1024; }
      else if (mat == 2) { const int q = R & 63, f = q >> 4, i = q & 15, ty = f & 1, hid = (R >> 6) * 32 + 8 * (i >> 2) + 4 * (f >> 1) + (i & 3);
        src = (ty ? p.I(25) : p.I(24)) + (size_t)l * 1024 * DFF + hid; ns = DFF; }
      else { src = p.I(26) + (size_t)l * DFF * 1024 + R; ns = 1024; }
      f32x4 v[4];
#pragma unroll
      for (int i = 0; i < 4; ++i) v[i] = valid ? *(const f32x4*)(src + (size_t)(kt * 64 + kq + 16 * i) * ns) : (f32x4){0.f, 0.f, 0.f, 0.f};
#pragma unroll
      for (int i = 0; i < 4; ++i) {
        const int k = kq + 16 * i;
        tile[(r4 + 0) * 65 + k] = v[i][0]; tile[(r4 + 1) * 65 + k] = v[i][1]; tile[(r4 + 2) * 65 + k] = v[i][2]; tile[(r4 + 3) * 65 + k] = v[i][3];
      }
    }
    __syncthreads();
    {
      const int rr = tid >> 2, kc = (tid & 3) * 16;
      const int Kd = (mat == 3) ? DFF : 1024;
      bf16_t* base;
      if (mat == 0) base = (bf16_t*)(p.W() + OFF_WIN + l * SZ_WIN);
      else if (mat == 1) base = (bf16_t*)(p.W() + OFF_WOUT + l * SZ_WOUT);
      else if (mat == 2) base = (bf16_t*)(p.W() + OFF_WGU + l * SZ_WGU);
      else base = (bf16_t*)(p.W() + OFF_WDN + l * SZ_WDN);
      bf16_t* dst = base + (size_t)(rt * 64 + rr) * Kd + kt * 64 + kc;
      const float* s = tile + rr * 65 + kc;
      uint4 a, b;
      a.x = pk2(s[0], s[1]); a.y = pk2(s[2], s[3]); a.z = pk2(s[4], s[5]); a.w = pk2(s[6], s[7]);
      b.x = pk2(s[8], s[9]); b.y = pk2(s[10], s[11]); b.z = pk2(s[12], s[13]); b.w = pk2(s[14], s[15]);
      *(uint4*)dst = a; *(uint4*)(dst + 8) = b;
    }
    __syncthreads();
  }
}

__device__ __forceinline__ void ln_row_regs(f32x4 (&v)[4], const float* g, const float* bb, int lane) {
  float s = 0.f;
#pragma unroll
  for (int i = 0; i < 4; ++i) s += (v[i][0] + v[i][1]) + (v[i][2] + v[i][3]);
  const float mu = wave_sum(s) * (1.0f / 1024.0f);
  float q = 0.f;
#pragma unroll
  for (int i = 0; i < 4; ++i) { const f32x4 d = v[i] - mu; q += (d[0] * d[0] + d[1] * d[1]) + (d[2] * d[2] + d[3] * d[3]); }
  const float rs = rsqrtf(wave_sum(q) * (1.0f / 1024.0f) + 1e-5f);
#pragma unroll
  for (int i = 0; i < 4; ++i) {
    const f32x4 gg = *(const f32x4*)(g + lane * 4 + i * 256), b4 = *(const f32x4*)(bb + lane * 4 + i * 256);
    v[i] = (v[i] - mu) * rs * gg + b4;
  }
}

__device__ __forceinline__ void embed_ln(const Params& p, int bid, int nb, const int tid) {
  const int lane = tid & 63, wv = tid >> 6;
  float* X = (float*)(p.W() + OFF_X);
  bf16_t* Xb = (bf16_t*)p.O();
  for (int row = bid * 4 + wv; row < MT; row += nb * 4) {
    const float* src;
    if (row < MP) { const int b = row / TPR, t = row % TPR;
      src = (t < 16) ? p.I(7) + (size_t)t * 1024 : p.I(0) + ((size_t)b * 2048 + (t - 16)) * 1024; }
    else src = p.I(1) + (size_t)(row - MP) * 1024;
    f32x4 v[4];
#pragma unroll
    for (int i = 0; i < 4; ++i) v[i] = *(const f32x4*)(src + lane * 4 + i * 256);
    ln_row_regs(v, p.I(8), p.I(9), lane);
#pragma unroll
    for (int i = 0; i < 4; ++i) {
      *(f32x4*)(X + (size_t)row * 1024 + lane * 4 + i * 256) = v[i];
      uint2 o; o.x = pk2(v[i][0], v[i][1]); o.y = pk2(v[i][2], v[i][3]);
      *(uint2*)(Xb + (size_t)row * 1024 + lane * 4 + i * 256) = o;
    }
  }
}

__device__ __forceinline__ void rope_table(const Params& p, int bid, int nb, const int tid) {
  float2* cs = (float2*)(p.W() + OFF_CS);
  for (int e = bid * 256 + tid; e < 2068 * 32; e += nb * 256) {
    const int idx = e >> 5, i = e & 31;
    const double pos = (idx < 2064) ? (double)idx : (double)(16384 + idx - 2064);
    const double inv = exp(-((double)i / 31.0) * 9.210340371976184);
    const double ang = pos * inv;
    cs[e] = make_float2((float)cos(ang), (float)sin(ang));
  }
}

__device__ __forceinline__ void ln_phase(const Params& p, const float* g, const float* bb, bf16_t* xb, int final_, int bid, int nb, const int tid) {
  const int lane = tid & 63, wv = tid >> 6;
  float* X = (float*)(p.W() + OFF_X);
  f32x4 nx[4];
  {
    const int r0 = min(bid * 4 + wv, MT - 1);
#pragma unroll
    for (int i = 0; i < 4; ++i) nx[i] = *(const f32x4*)(X + (size_t)r0 * 1024 + lane * 4 + i * 256);
  }
  for (int row = bid * 4 + wv; row < MT; row += nb * 4) {
    f32x4 v[4];
#pragma unroll
    for (int i = 0; i < 4; ++i) v[i] = nx[i];
    {
      const int rn = min(row + nb * 4, MT - 1);
#pragma unroll
      for (int i = 0; i < 4; ++i) nx[i] = *(const f32x4*)(X + (size_t)rn * 1024 + lane * 4 + i * 256);
    }
    ln_row_regs(v, g, bb, lane);
    if (!final_) {
#pragma unroll
      for (int i = 0; i < 4; ++i) {
        *(f32x4*)(X + (size_t)row * 1024 + lane * 4 + i * 256) = v[i];
        uint2 o; o.x = pk2(v[i][0], v[i][1]); o.y = pk2(v[i][2], v[i][3]);
        *(uint2*)(xb + (size_t)row * 1024 + lane * 4 + i * 256) = o;
      }
    } else {
      float* dst = nullptr;
      if (row < MP) { const int b = row / TPR, t = row % TPR; if (t >= 16) dst = p.O() + O_YP + ((size_t)b * 2048 + (t - 16)) * 1024; }
      else dst = p.O() + O_YS + (size_t)(row - MP) * 1024;
      if (dst) {
#pragma unroll
        for (int i = 0; i < 4; ++i) *(f32x4*)(dst + lane * 4 + i * 256) = v[i];
      }
    }
  }
}

enum { EPI_BF16 = 0, EPI_RESID = 1, EPI_SWIGLU = 2 };

template <int EPI>
__device__ __forceinline__ void gemm_tile(const bf16_t* __restrict__ A, const int lda, const bf16_t* __restrict__ Bt, const int ldb,
                                          const int K, const int m0, const int n0, void* Cout, const int ldc, char* lds, const int tid) {
  const int wid = tid >> 6, lane = tid & 63, wr = wid >> 1, wc = wid & 1, fr = lane & 15, fq = lane >> 4;
  f32x4 acc[4][4];
#pragma unroll
  for (int m = 0; m < 4; ++m)
#pragma unroll
    for (int n = 0; n < 4; ++n) acc[m][n] = (f32x4){0.f, 0.f, 0.f, 0.f};
  const int nt = K >> 6;
  const int st_row = tid >> 3, st_c = (tid & 7) ^ ((((tid >> 4) & 1) << 2) | ((tid >> 5) & 3));
  auto stage = [&](int kt, int buf) {
#pragma unroll
    for (int i = 0; i < 4; ++i) {
      const int off = tid * 16 + i * 4096, r = st_row + i * 32;
      const bf16_t* ga = A + (size_t)(m0 + r) * lda + kt * 64 + st_c * 8;
      const bf16_t* gb = Bt + (size_t)(n0 + r) * ldb + kt * 64 + st_c * 8;
      __builtin_amdgcn_global_load_lds((const unsigned*)ga, (__attribute__((address_space(3))) unsigned*)(lds + buf * 32768 + off), 16, 0, 0);
      __builtin_amdgcn_global_load_lds((const unsigned*)gb, (__attribute__((address_space(3))) unsigned*)(lds + buf * 32768 + 16384 + off), 16, 0, 0);
    }
  };
  const int fsw = (((fr >> 1) & 1) << 2) | ((fr >> 2) & 3);
  const int xk0 = (fq ^ fsw) << 4, xk1 = ((4 + fq) ^ fsw) << 4;
  stage(0, 0);
  for (int kt = 0; kt < nt; ++kt) {
    asm volatile("s_waitcnt vmcnt(0)" ::: "memory");
    __syncthreads();
    const char* sa = lds + (kt & 1) * 32768;
    const char* sb = sa + 16384;
    bf16x8 af[2][4], bfr[2][4];
#pragma unroll
    for (int ks = 0; ks < 2; ++ks) {
#pragma unroll
      for (int m = 0; m < 4; ++m) af[ks][m] = *(const bf16x8*)(sa + (wr * 64 + m * 16 + fr) * 128 + (ks ? xk1 : xk0));
#pragma unroll
      for (int n = 0; n < 4; ++n) bfr[ks][n] = *(const bf16x8*)(sb + (wc * 64 + n * 16 + fr) * 128 + (ks ? xk1 : xk0));
    }
    if (kt + 1 < nt) stage(kt + 1, (kt + 1) & 1);
#pragma unroll
    for (int ks = 0; ks < 2; ++ks)
#pragma unroll
      for (int m = 0; m < 4; ++m)
#pragma unroll
        for (int n = 0; n < 4; ++n) acc[m][n] = __builtin_amdgcn_mfma_f32_16x16x32_bf16(bfr[ks][n], af[ks][m], acc[m][n], 0, 0, 0);
  }
  if (EPI == EPI_RESID) {
    float* C0 = (float*)Cout + (size_t)(m0 + wr * 64 + fr) * ldc + n0 + wc * 64 + fq * 4;
#pragma unroll
    for (int mh = 0; mh < 2; ++mh) {
      f32x4 xin[2][4];
#pragma unroll
      for (int m = 0; m < 2; ++m)
#pragma unroll
        for (int n = 0; n < 4; ++n) xin[m][n] = *(const f32x4*)(C0 + (size_t)(mh * 2 + m) * 16 * ldc + n * 16);
#pragma unroll
      for (int m = 0; m < 2; ++m)
#pragma unroll
        for (int n = 0; n < 4; ++n) asm volatile("" : "+v"(xin[m][n]));
#pragma unroll
      for (int m = 0; m < 2; ++m)
#pragma unroll
        for (int n = 0; n < 4; ++n) *(f32x4*)(C0 + (size_t)(mh * 2 + m) * 16 * ldc + n * 16) = xin[m][n] * ALPHA + acc[mh * 2 + m][n];
    }
    return;
  }
#pragma unroll
  for (int m = 0; m < 4; ++m) {
    const int row = m0 + wr * 64 + m * 16 + fr;
    if (EPI == EPI_BF16) {
      bf16_t* C = (bf16_t*)Cout + (size_t)row * ldc + n0 + wc * 64 + fq * 8;
#pragma unroll
      for (int pq = 0; pq < 2; ++pq) { uint4 o; o.x = pk2(acc[m][2 * pq][0], acc[m][2 * pq][1]); o.y = pk2(acc[m][2 * pq][2], acc[m][2 * pq][3]);
        o.z = pk2(acc[m][2 * pq + 1][0], acc[m][2 * pq + 1][1]); o.w = pk2(acc[m][2 * pq + 1][2], acc[m][2 * pq + 1][3]); *(uint4*)(C + pq * 32) = o; }
    } else if (EPI == EPI_RESID) {
      float* C = (float*)Cout + (size_t)row * ldc + n0 + wc * 64 + fq * 4;
#pragma unroll
      for (int n = 0; n < 4; ++n) { const f32x4 x = *(const f32x4*)(C + n * 16); *(f32x4*)(C + n * 16) = x * ALPHA + acc[m][n]; }
    } else {
      bf16_t* C = (bf16_t*)Cout + (size_t)row * ldc + (n0 >> 1) + wc * 32 + fq * 8;
      const f32x4 g0 = acc[m][0], u0 = acc[m][1], g1 = acc[m][2], u1 = acc[m][3];
      uint4 o; o.x = pk2(siluf_(g0[0]) * u0[0], siluf_(g0[1]) * u0[1]); o.y = pk2(siluf_(g0[2]) * u0[2], siluf_(g0[3]) * u0[3]);
      o.z = pk2(siluf_(g1[0]) * u1[0], siluf_(g1[1]) * u1[1]); o.w = pk2(siluf_(g1[2]) * u1[2], siluf_(g1[3]) * u1[3]);
      *(uint4*)C = o;
    }
  }
}
template <int EPI>
__device__ __forceinline__ void gemm_phase(const bf16_t* A, int lda, const bf16_t* Bt, int ldb, int K, int ntn, void* C, int ldc, char* lds, int bid, int nb, const int tid) {
  constexpr int GM = 4, nM = MT / 128;
  const int ntiles = nM * ntn, nig = GM * ntn;
  const int pos = (EPI == EPI_BF16 && (nb & 7) == 0) ? (bid & 7) * (nb >> 3) + (bid >> 3) : bid;
  for (int L = pos; L < ntiles; L += nb) {
    int mt, nn;
    if (EPI != EPI_BF16) { mt = L / ntn; nn = L % ntn; }
    else { const int gid = L / nig, fm = gid * GM, gsz = min(nM - fm, GM), rem = L - gid * nig; mt = fm + rem % gsz; nn = rem / gsz; }
    gemm_tile<EPI>(A, lda, Bt, ldb, K, mt * 128, nn * 128, C, ldc, lds, tid);
  }
}

#define XB_TMO      128
#define XB_XCNT(j)  (256  + 64 * (j))
#define XB_XSUB(j)  (1280 + 64 * (j))
#define XB_XGEN(j)  (2304 + 64 * (j))
#define XB_TOP      3328
#define XB_TOPGEN   3392
#define XCD_BAR_WORDS 3456
#define XB_SPIN_CAP (1u << 22)
__device__ __forceinline__ unsigned xb_ld(unsigned* p) { return __hip_atomic_load(p, __ATOMIC_RELAXED, __HIP_MEMORY_SCOPE_AGENT); }
__device__ __forceinline__ unsigned xb_add(unsigned* p, unsigned v) { return __hip_atomic_fetch_add(p, v, __ATOMIC_RELAXED, __HIP_MEMORY_SCOPE_AGENT); }
__device__ __forceinline__ unsigned xb_xcc_id() { return (unsigned)__builtin_amdgcn_s_getreg((3 << 11) | 20) & 0xFu; }
#define XB_SPIN(cond, bar) do { unsigned _sp = 0; while (cond) { __builtin_amdgcn_s_sleep(1); \
    if ((++_sp & 255u) == 0u) { if (xb_ld(&(bar)[XB_TMO])) break; if (_sp > XB_SPIN_CAP) { atomicAdd(&(bar)[XB_TMO], 1u); break; } } } } while (0)
struct XcdBarrier { unsigned* bar; unsigned x; unsigned nloc, nx; };
__device__ __forceinline__ void xcd_barrier_complete(unsigned* bar, unsigned x, unsigned G, unsigned& nloc, unsigned& nx) {
  unsigned sum, cnt, mine, sp = 0u;
  for (;;) {
    sum = 0u; cnt = 0u; mine = 0u;
#pragma unroll
    for (unsigned j = 0; j < 16; ++j) { const unsigned c = xb_ld(&bar[XB_XCNT(j)]); sum += c; cnt += (c > 0u) ? 1u : 0u; mine = (j == x) ? c : mine; }
    if (sum == G) break;
    __builtin_amdgcn_s_sleep(1);
    if ((++sp & 255u) == 0u) { if (xb_ld(&bar[XB_TMO])) break; if (sp > XB_SPIN_CAP) { atomicAdd(&bar[XB_TMO], 1u); break; } }
  }
  nloc = mine > 0u ? mine : 1u; nx = cnt > 0u ? cnt : 1u;
}
__device__ __forceinline__ void xcd_barrier(XcdBarrier& b, const int tid, const unsigned G) {
  asm volatile("s_waitcnt vmcnt(0)" ::: "memory");
  __syncthreads();
  if (tid == 0) {
    unsigned* bar = b.bar;
    __builtin_amdgcn_s_waitcnt(0);
    if (b.nloc == 0u) xcd_barrier_complete(bar, b.x, G, b.nloc, b.nx);
    const unsigned nloc = b.nloc, nx = b.nx;
    const unsigned old = xb_add(&bar[XB_XSUB(b.x)], 1u);
    const unsigned gen = old / nloc;
    if (old + 1u == (gen + 1u) * nloc) {
      __builtin_amdgcn_fence(__ATOMIC_RELEASE, "agent");
      asm volatile("s_waitcnt vmcnt(0)" ::: "memory");
      const unsigned og = xb_add(&bar[XB_TOP], 1u);
      const unsigned tg = og / nx;
      if (og + 1u == (tg + 1u) * nx) xb_add(&bar[XB_TOPGEN], 1u);
      else XB_SPIN(xb_ld(&bar[XB_TOPGEN]) == tg, bar);
      __builtin_amdgcn_fence(__ATOMIC_ACQUIRE, "agent");
      xb_add(&bar[XB_XGEN(b.x)], 1u);
      asm volatile("s_waitcnt vmcnt(0)" ::: "memory");
    } else {
      XB_SPIN(xb_ld(&bar[XB_XGEN(b.x)]) == gen, bar);
      __builtin_amdgcn_fence(__ATOMIC_ACQUIRE, "agent");
      asm volatile("s_waitcnt vmcnt(0)" ::: "memory");
    }
  }
  __syncthreads();
}

template <int N, int RS>
__device__ __forceinline__ void convN(const bf16_t* rawb, const float (&w)[4][N], int tt, int off, float (&x)[N]) {
#pragma unroll
  for (int i = 0; i < N; ++i) x[i] = 0.f;
#pragma unroll
  for (int j = 0; j < 4; ++j) {
    float xv[N];
    if (N == 8) { const uint4 rv = *(const uint4*)(rawb + (tt + j) * RS + off); unpack8(rv, xv); }
    else if (N == 4) { const uint2 rv = *(const uint2*)(rawb + (tt + j) * RS + off); xv[0] = bflo(rv.x); xv[1] = bfhi(rv.x); xv[2 % N] = bflo(rv.y); xv[3 % N] = bfhi(rv.y); }
    else { const unsigned rv = *(const unsigned*)(rawb + (tt + j) * RS + off); xv[0] = bflo(rv); xv[1] = bfhi(rv); }
#pragma unroll
    for (int i = 0; i < N; ++i) x[i] += w[j][i] * xv[i];
  }
  if (N == 2) {
#pragma unroll
    for (int i = 0; i < N; ++i) asm volatile("" : "+v"(x[i]));
  }
#pragma unroll
  for (int i = 0; i < N; ++i) x[i] = siluf_(x[i]);
}

template <int MIX, int VN>
__device__ __forceinline__ void load_chunk_fn(const unsigned char* ws, const bf16_t* Pb, const int t, const int T, const int h, const int vcol, const int sub, const int posb,
                                              uint4& R0, uint4& R1, uint2& R2, uint4& R4, uint4& R5, unsigned& ex0, unsigned& ex1) {
  if (t < T) {
    const bf16_t* pr = Pb + (size_t)t * DINP;
    const int vbase = (MIX == 0) ? 512 : (MIX == 1) ? 1544 : (MIX == 2) ? 2312 : 3352;
    if (VN == 4) R2 = *(const uint2*)(pr + vbase + h * 64 + vcol);
    else R2.x = *(const unsigned*)(pr + vbase + h * 64 + vcol);
    if (MIX == 0) {
      R0 = *(const uint4*)(pr + 0 + h * 64 + sub * 8); R1 = *(const uint4*)(pr + 256 + h * 64 + sub * 8);
      ex0 = pr[768 + h]; ex1 = pr[772 + h];
    } else if (MIX == 1) {
      R0 = *(const uint4*)(pr + 1032 + h * 64 + sub * 8); R1 = *(const uint4*)(pr + 1288 + h * 64 + sub * 8);
    } else if (MIX == 2) {
      const uint2 q2 = *(const uint2*)(pr + 2056 + h * 32 + sub * 4), k2 = *(const uint2*)(pr + 2184 + h * 32 + sub * 4);
      R0 = make_uint4(q2.x, q2.y, k2.x, k2.y);
      R1 = *(const uint4*)(pr + 2568); R4 = *(const uint4*)(pr + 2576);
    } else {
      const uint2 ql = *(const uint2*)(pr + 2840 + h * 64 + sub * 4), qh = *(const uint2*)(pr + 2840 + h * 64 + 32 + sub * 4);
      const uint2 kl = *(const uint2*)(pr + 3096 + h * 64 + sub * 4), kh = *(const uint2*)(pr + 3096 + h * 64 + 32 + sub * 4);
      R0 = make_uint4(ql.x, ql.y, qh.x, qh.y); R1 = make_uint4(kl.x, kl.y, kh.x, kh.y);
      const uint4* cs = (const uint4*)(ws + OFF_CS + ((size_t)(posb + t) * 32 + sub * 4) * 8);
      R4 = cs[0]; R5 = cs[1];
    }
  }
}

__device__ __forceinline__ float dpp_hm(float x) {
  return __int_as_float(__builtin_amdgcn_update_dpp(0, __float_as_int(x), 0x141, 0xF, 0xF, true));
}
__device__ __forceinline__ float dpp_rm(float x) {
  return __int_as_float(__builtin_amdgcn_update_dpp(0, __float_as_int(x), 0x140, 0xF, 0xF, true));
}
__device__ __forceinline__ float red8d(float x) { x += dpp_x1(x); x += dpp_x2(x); x += dpp_hm(x); return x; }
template <int KG> __device__ __forceinline__ float redKG(float x) { x = red8d(x); if (KG == 16) x += dpp_rm(x); return x; }

template <int MIX, int KPL>
struct StepIn { float q[KPL], k[KPL], d[KPL]; float v, a, be, qk; };

template <int MIX, int KPL>
__device__ __forceinline__ void load_step(const float* qkdv, const float* scal, int t, int kg, int col, StepIn<MIX, KPL>& s) {
  const float* base = qkdv + t * 256;
#pragma unroll
  for (int i = 0; i < KPL; i += 4) {
    const f32x4 a = *(const f32x4*)(base + kg * KPL + i), b = *(const f32x4*)(base + 64 + kg * KPL + i);
    s.q[i] = a[0]; s.q[i + 1] = a[1]; s.q[i + 2] = a[2]; s.q[i + 3] = a[3];
    s.k[i] = b[0]; s.k[i + 1] = b[1]; s.k[i + 2] = b[2]; s.k[i + 3] = b[3];
    if (MIX == 1 || MIX == 2) { const f32x4 d = *(const f32x4*)(base + 128 + kg * KPL + i); s.d[i] = d[0]; s.d[i + 1] = d[1]; s.d[i + 2] = d[2]; s.d[i + 3] = d[3]; }
  }
  s.v = base[192 + col];
  if (MIX == 0) { const f32x4 c = *(const f32x4*)(scal + t * 4); s.a = c[0]; s.be = c[1]; s.qk = c[2]; }
}

template <int MIX, int KPL, int KG>
__device__ __forceinline__ float do_step(const StepIn<MIX, KPL>& s, float (&S)[KPL], const float gam) {
  if (MIX == 0) {
    float kS0 = 0.f, kS1 = 0.f, qS0 = 0.f, qS1 = 0.f;
#pragma unroll
    for (int i = 0; i < KPL; i += 2) { kS0 += s.k[i] * S[i]; kS1 += s.k[i + 1] * S[i + 1]; qS0 += s.q[i] * S[i]; qS1 += s.q[i + 1] * S[i + 1]; }
    const float kS = redKG<KG>(kS0 + kS1), qS = redKG<KG>(qS0 + qS1);
    const float w = s.be * (s.v - s.a * kS);
#pragma unroll
    for (int i = 0; i < KPL; ++i) S[i] = s.a * S[i] + s.k[i] * w;
    return s.a * qS + s.qk * w;
  } else {
    float o0 = 0.f, o1 = 0.f;
#pragma unroll
    for (int i = 0; i < KPL; i += 2) {
      const float d0 = (MIX == 3) ? gam : s.d[i], d1 = (MIX == 3) ? gam : s.d[i + 1];
      S[i] = d0 * S[i] + s.k[i] * s.v; S[i + 1] = d1 * S[i + 1] + s.k[i + 1] * s.v;
      o0 += s.q[i] * S[i]; o1 += s.q[i + 1] * S[i + 1];
    }
    return redKG<KG>(o0 + o1);
  }
}

template <int MIX>
__device__ __forceinline__ void scan_part(const Params& p, const int layer, const int smp, const int b0, const int bstep, const int bend, const int h, const int part, char* lds, const int tid) {
  constexpr int DK = (MIX == 2) ? 32 : 64;
  constexpr int NS = (MIX == 0) ? 4 : 2;
  constexpr int CW = 64 / NS;
  constexpr int CPW = CW / 4;
  constexpr int KG = 64 / CPW;
  constexpr int KPL = DK / KG;
  constexpr int VN = CW / 8;
  constexpr int RS = 128 + CW;
  float* qkdv = (float*)lds;
  float* obuf = (float*)(lds + 32768);
  float* scal = (float*)(lds + 36864);
  bf16_t* rawb = (bf16_t*)(lds + 37376);
  float* cwl = (float*)(lds + 48576);
  float* wgl = (float*)(lds + 37376);

  const int lane = tid & 63, wv = tid >> 6;
  const int tt = tid >> 3, sub = tid & 7;
  const int col = wv * CPW + lane / KG, kg = lane % KG;
  const int T = smp ? 4 : TPR;
  const int nBatch = smp ? NSB : NB;
  const int posb = smp ? 2064 : 0;
  const int vcol = part * CW + sub * VN;
  __syncthreads();
  float c8[8];
  float Aexp = 0.f, dtb = 0.f, gam = 0.f;
  float cwq[4][8], cwk[4][8];
  if (MIX == 0) {
    Aexp = __expf(p.I(12)[layer * 4 + h]); dtb = p.I(13)[layer * 4 + h];
#pragma unroll
    for (int j = 0; j < 4; ++j) {
      const float* cwp = p.I(11) + (size_t)(layer * 4 + j) * 768;
#pragma unroll
      for (int i = 0; i < 8; ++i) { cwq[j][i] = cwp[h * 64 + sub * 8 + i]; cwk[j][i] = cwp[256 + h * 64 + sub * 8 + i]; }
    }
    for (int e = tid; e < 4 * CW; e += 256) { const int j = e / CW, r = e % CW; cwl[j * RS + 128 + r] = p.I(11)[(size_t)(layer * 4 + j) * 768 + 512 + h * 64 + part * CW + r]; }
  } else if (MIX == 1) {
#pragma unroll
    for (int i = 0; i < 8; ++i) {
      const int d = h * 64 + sub * 8 + i;
      c8[i] = (layer == 0) ? 1.0f : sigmoidf_(p.I(15)[d] - p.I(15)[256 + d]);
    }
  } else if (MIX == 2) {
    for (int e = tid; e < 512; e += 256) { const int r = e >> 5, j = e & 31; wgl[e] = p.I(17)[(size_t)(layer * 16 + r) * 128 + h * 32 + j]; }
#pragma unroll
    for (int i = 0; i < 4; ++i) c8[i] = p.I(18)[layer * 128 + h * 32 + sub * 4 + i];
  } else {
    gam = 1.0f - exp2f(-5.0f - (float)h);
  }
  for (int b = b0; b < bend; b += bstep) {
  const int row0 = smp ? MP + b * 4 : b * TPR;
  const bf16_t* Pb = (const bf16_t*)(p.W() + OFF_P) + (size_t)row0 * DINP;
  bf16_t* Ob = (bf16_t*)p.O() + (size_t)row0 * 1024 + MIX * 256 + h * 64 + part * CW;
  float* PS = (float*)((unsigned char*)p.O() + DOUT_PS) + (size_t)row0 * 128 + (MIX * 4 + h) * 8 + part * 2;
  uint4 R0 = make_uint4(0, 0, 0, 0), R1 = R0, R4 = R0, R5 = R0; uint2 R2 = make_uint2(0, 0); unsigned ex0 = 0, ex1 = 0;
  load_chunk_fn<MIX, VN>(p.W(), Pb, tt, T, h, vcol, sub, posb, R0, R1, R2, R4, R5, ex0, ex1);
  float S[KPL];
  if (smp) {
    const float* sin_ = p.I(3 + MIX) + ((size_t)(layer * NSB + b) * 4 + h) * DK * 64 + part * CW;
#pragma unroll
    for (int i = 0; i < KPL; ++i) S[i] = sin_[(kg * KPL + i) * 64 + col];
  } else {
#pragma unroll
    for (int i = 0; i < KPL; ++i) S[i] = 0.f;
  }
  if (MIX == 0) {
    for (int e = tid; e < 3 * RS; e += 256) { const int j = e / RS, r = e % RS;
      const int cc = (r < 64) ? (h * 64 + r) : (r < 128) ? (256 + h * 64 + r - 64) : (512 + h * 64 + part * CW + r - 128);
      float v = 0.f; if (smp) v = p.I(2)[((size_t)(layer * NSB + b) * 3 + j) * 768 + cc];
      rawb[e] = (bf16_t)f2bf(v); }
  }
  __syncthreads();

  int ntok_last = 0;
  for (int t0 = 0; t0 < T; t0 += 32) {
    const int ntok = min(32, T - t0);
    ntok_last = ntok;
    const bool valid = tt < ntok;
    float* dst = qkdv + tt * 256;
    if (MIX != 0 && valid) {
      if (VN == 4) *(f32x4*)(dst + 192 + sub * 4) = (f32x4){bflo(R2.x), bfhi(R2.x), bflo(R2.y), bfhi(R2.y)};
      else *(float2*)(dst + 192 + sub * 2) = make_float2(bflo(R2.x), bfhi(R2.x));
    }
    if (MIX == 0) {
      if (valid) {
        *(uint4*)(rawb + (3 + tt) * RS + 0 + sub * 8) = R0;
        *(uint4*)(rawb + (3 + tt) * RS + 64 + sub * 8) = R1;
        if (VN == 4) *(uint2*)(rawb + (3 + tt) * RS + 128 + sub * 4) = R2;
        else *(unsigned*)(rawb + (3 + tt) * RS + 128 + sub * 2) = R2.x;
      }
      __syncthreads();
      if (valid) {
        float xq[8], xk[8], xv[VN];
        { float cwv[4][VN];
#pragma unroll
          for (int j = 0; j < 4; ++j)
#pragma unroll
            for (int i = 0; i < VN; ++i) cwv[j][i] = cwl[j * RS + 128 + sub * VN + i];
          convN<VN, RS>(rawb, cwv, tt, 128 + sub * VN, xv); }
        convN<8, RS>(rawb, cwq, tt, sub * 8, xq);
        convN<8, RS>(rawb, cwk, tt, 64 + sub * 8, xk);
#pragma unroll
        for (int i = 0; i < VN; ++i) dst[192 + sub * VN + i] = xv[i];
        float ssq = 0.f, ssk = 0.f;
#pragma unroll
        for (int i = 0; i < 8; ++i) { ssq += xq[i] * xq[i]; ssk += xk[i] * xk[i]; }
        ssq = red8d(ssq); ssk = red8d(ssk);
        const float rq = rsqrtf(ssq + 1e-6f) * 0.125f, rk = rsqrtf(ssk + 1e-6f);
        float qk = 0.f;
#pragma unroll
        for (int i = 0; i < 8; ++i) { xq[i] *= rq; xk[i] *= rk; qk += xq[i] * xk[i]; }
        qk = red8d(qk);
        *(f32x4*)(dst + sub * 8) = (f32x4){xq[0], xq[1], xq[2], xq[3]}; *(f32x4*)(dst + sub * 8 + 4) = (f32x4){xq[4], xq[5], xq[6], xq[7]};
        *(f32x4*)(dst + 64 + sub * 8) = (f32x4){xk[0], xk[1], xk[2], xk[3]}; *(f32x4*)(dst + 64 + sub * 8 + 4) = (f32x4){xk[4], xk[5], xk[6], xk[7]};
        if (sub == 0) {
          const float be = sigmoidf_(bflo(ex0)), al = bflo(ex1);
          const float a = __expf(-Aexp * softplusf_(al + dtb));
          *(f32x4*)(scal + tt * 4) = (f32x4){a, be, qk, 0.f};
        }
      }
    } else if (MIX == 1) {
      if (valid) {
        float q[8], z[8]; unpack8(R0, q); unpack8(R1, z);
        float kk[8], dd[8];
#pragma unroll
        for (int i = 0; i < 8; ++i) { q[i] = siluf_(q[i]); kk[i] = c8[i] * sigmoidf_(-z[i]); dd[i] = 1.0f - fminf(kk[i], 1.0f - 1e-6f); }
        *(f32x4*)(dst + sub * 8) = (f32x4){q[0], q[1], q[2], q[3]}; *(f32x4*)(dst + sub * 8 + 4) = (f32x4){q[4], q[5], q[6], q[7]};
        *(f32x4*)(dst + 64 + sub * 8) = (f32x4){kk[0], kk[1], kk[2], kk[3]}; *(f32x4*)(dst + 64 + sub * 8 + 4) = (f32x4){kk[4], kk[5], kk[6], kk[7]};
        *(f32x4*)(dst + 128 + sub * 8) = (f32x4){dd[0], dd[1], dd[2], dd[3]}; *(f32x4*)(dst + 128 + sub * 8 + 4) = (f32x4){dd[4], dd[5], dd[6], dd[7]};
      }
    } else if (MIX == 2) {
      if (valid) {
        float lr[16]; unpack8(R1, lr); unpack8(R4, lr + 8);
        const float q0 = bflo(R0.x), q1 = bfhi(R0.x), q2 = bflo(R0.y), q3 = bfhi(R0.y);
        const float k0 = bflo(R0.z), k1 = bfhi(R0.z), k2 = bflo(R0.w), k3 = bfhi(R0.w);
        const float sc = 0.17677669529663687f;
        f32x4 xg = (f32x4){c8[0], c8[1], c8[2], c8[3]};
#pragma unroll
        for (int r = 0; r < 16; ++r) xg += lr[r] * *(const f32x4*)(wgl + r * 32 + sub * 4);
        f32x4 dd;
#pragma unroll
        for (int i = 0; i < 4; ++i) { const float ls = fminf(xg[i], 0.f) - __logf(1.0f + __expf(-fabsf(xg[i]))); dd[i] = __expf(ls * 0.0625f); }
        *(f32x4*)(dst + sub * 4) = (f32x4){q0 * sc, q1 * sc, q2 * sc, q3 * sc};
        *(f32x4*)(dst + 64 + sub * 4) = (f32x4){k0, k1, k2, k3};
        *(f32x4*)(dst + 128 + sub * 4) = dd;
      }
    } else {
      if (valid) {
        const float ql[4] = {bflo(R0.x), bfhi(R0.x), bflo(R0.y), bfhi(R0.y)}, qh[4] = {bflo(R0.z), bfhi(R0.z), bflo(R0.w), bfhi(R0.w)};
        const float kl[4] = {bflo(R1.x), bfhi(R1.x), bflo(R1.y), bfhi(R1.y)}, kh[4] = {bflo(R1.z), bfhi(R1.z), bflo(R1.w), bfhi(R1.w)};
        const float cc[4] = {__uint_as_float(R4.x), __uint_as_float(R4.z), __uint_as_float(R5.x), __uint_as_float(R5.z)};
        const float sn[4] = {__uint_as_float(R4.y), __uint_as_float(R4.w), __uint_as_float(R5.y), __uint_as_float(R5.w)};
        f32x4 qa, qb, ka, kb;
#pragma unroll
        for (int i = 0; i < 4; ++i) {
          qa[i] = ql[i] * cc[i] - qh[i] * sn[i]; qb[i] = ql[i] * sn[i] + qh[i] * cc[i];
          ka[i] = (kl[i] * cc[i] - kh[i] * sn[i]) * 0.125f; kb[i] = (kl[i] * sn[i] + kh[i] * cc[i]) * 0.125f;
        }
        *(f32x4*)(dst + sub * 4) = qa; *(f32x4*)(dst + 32 + sub * 4) = qb;
        *(f32x4*)(dst + 64 + sub * 4) = ka; *(f32x4*)(dst + 96 + sub * 4) = kb;
      }
    }
    __syncthreads();
    if (MIX == 0 && t0 + 32 < T) {
      if (tid < 3 * RS / 8) { const uint4 v = *(const uint4*)(rawb + 32 * RS + tid * 8); *(uint4*)(rawb + tid * 8) = v; }
    }
    if (t0 + 32 < T) load_chunk_fn<MIX, VN>(p.W(), Pb, t0 + 32 + tt, T, h, vcol, sub, posb, R0, R1, R2, R4, R5, ex0, ex1);
    {
      StepIn<MIX, KPL> sa, sb;
      float osave = 0.f;
      load_step<MIX, KPL>(qkdv, scal, 0, kg, col, sa);
      for (int t = 0; t < ntok; t += 2) {
        load_step<MIX, KPL>(qkdv, scal, t + 1, kg, col, sb);
        __builtin_amdgcn_sched_barrier(0);
        const float oa = do_step<MIX, KPL, KG>(sa, S, gam);
        osave = (kg == (t & (KG - 1))) ? oa : osave;
        load_step<MIX, KPL>(qkdv, scal, min(t + 2, ntok - 1), kg, col, sa);
        __builtin_amdgcn_sched_barrier(0);
        const float ob = do_step<MIX, KPL, KG>(sb, S, gam);
        osave = (kg == ((t + 1) & (KG - 1))) ? ob : osave;
        if (((t + 2) & (KG - 1)) == 0) obuf[(t + 2 - KG + kg) * CW + col] = osave;
      }
      const int remn = ntok & (KG - 1);
      if (remn != 0 && kg < remn) obuf[(ntok - remn + kg) * CW + col] = osave;
    }
    __syncthreads();
    if (valid) {
      float o[VN];
#pragma unroll
      for (int i = 0; i < VN; ++i) o[i] = obuf[tt * CW + sub * VN + i];
      float s1 = 0.f, s2 = 0.f;
#pragma unroll
      for (int i = 0; i < VN; ++i) { s1 += o[i]; s2 += o[i] * o[i]; }
      s1 = red8d(s1); s2 = red8d(s2);
      if (VN == 4) { uint2 o2; o2.x = pk2(o[0], o[1]); o2.y = pk2(o[2 % VN], o[3 % VN]); *(uint2*)(Ob + (size_t)(t0 + tt) * 1024 + sub * 4) = o2; }
      else *(unsigned*)(Ob + (size_t)(t0 + tt) * 1024 + sub * 2) = pk2(o[0], o[1]);
      if (sub == 0) *(float2*)(PS + (size_t)(t0 + tt) * 128) = make_float2(s1, s2);
    }
  }
  {
    const size_t obase = (MIX == 0) ? (smp ? O_DS : O_DP) : (MIX == 1) ? (smp ? O_HS : O_HP) : (MIX == 2) ? (smp ? O_GS : O_GP) : (smp ? O_RS : O_RP);
    float* so = p.O() + obase + ((size_t)(layer * nBatch + b) * 4 + h) * DK * 64 + part * CW;
#pragma unroll
    for (int i = 0; i < KPL; ++i) so[(kg * KPL + i) * 64 + col] = S[i];
  }
  if (MIX == 0) {
    float* co = p.O() + (smp ? O_CS : O_CP) + (size_t)(layer * nBatch + b) * 3 * 768;
    for (int e = tid; e < 3 * RS; e += 256) { const int j = e / RS, r = e % RS;
      const float v = bflo((unsigned)rawb[(ntok_last + j) * RS + r]);
      if (r < 128) { if (part == 0) co[j * 768 + ((r < 64) ? (h * 64 + r) : (256 + h * 64 + r - 64))] = v; }
      else co[j * 768 + 512 + h * 64 + part * CW + r - 128] = v; }
  }
  __syncthreads();
  }
}

constexpr int ITEMS_PER_SEQ = 40;
__device__ __forceinline__ void scan_dispatch(const Params& p, int layer, int smp, int type, int b0, int bstep, int bend, char* lds, const int tid) {
  const int r = type;
  if (r < 16) scan_part<0>(p, layer, smp, b0, bstep, bend, r >> 2, r & 3, lds, tid);
  else {
    const int r2 = r - 16, mh = 4 + (r2 >> 1), part = r2 & 1, mix = mh >> 2, h = mh & 3;
    if (mix == 1) scan_part<1>(p, layer, smp, b0, bstep, bend, h, part, lds, tid);
    else if (mix == 2) scan_part<2>(p, layer, smp, b0, bstep, bend, h, part, lds, tid);
    else scan_part<3>(p, layer, smp, b0, bstep, bend, h, part, lds, tid);
  }
}

__device__ __forceinline__ int long_item_type(int u, int& b) {
  int type;
  if (u < 64) { b = u >> 3; type = 24 + (u & 7); }
  else if (u < 192) { const int v = u - 64; b = v >> 4; type = v & 15; }
  else if (u < 256) { const int v = u - 192; b = v >> 3; type = 16 + (v & 7); }
  else { const int v = u - 256; b = v >> 3; type = 32 + (v & 7); }
  return type;
}
__device__ __forceinline__ void scan_phase(const Params& p, int layer, char* lds, int bid, int nb, const int tid, const int role, const int ci, const int nprim, const int nsec) {
  constexpr int NPI = NB * ITEMS_PER_SEQ;
  const bool paired = (nprim == 256 && nsec == 256);
  int j = -1, nbs = 1;
  if (paired) {
    int u = -1;
    if (role == 0) u = ci; else if (ci < NPI - 256) u = 256 + ci;
    if (u >= 0) { int b; const int type = long_item_type(u, b); scan_dispatch(p, layer, 0, type, b, 1, b + 1, lds, tid); }
    else { j = ci - (NPI - 256); nbs = 256 - (NPI - 256); }
  } else {
    for (int u = bid; u < NPI; u += nb) { int b; const int type = long_item_type(u, b); scan_dispatch(p, layer, 0, type, b, 1, b + 1, lds, tid); }
    nbs = (nb > NPI) ? nb - NPI : nb; j = (nb > NPI) ? bid - NPI : bid;
  }
  if (j >= 0) {
    const int nsl = (nbs + ITEMS_PER_SEQ - 1) / ITEMS_PER_SEQ;
    for (int jj = j; jj < ITEMS_PER_SEQ * nsl; jj += nbs) scan_dispatch(p, layer, 1, jj % ITEMS_PER_SEQ, jj / ITEMS_PER_SEQ, nsl, NSB, lds, tid);
    if (layer == 0) { __syncthreads(); convert_weights(p, lds, 992 + j, 6720, nbs, tid); }
  }
}

__device__ __forceinline__ void norm_phase(const Params& p, int layer, int bid, int nb, const int tid) {
  bf16_t* O = (bf16_t*)p.O();
  const bf16_t* P = (const bf16_t*)(p.W() + OFF_P);
  const float* PS = (const float*)((const unsigned char*)p.O() + DOUT_PS);
  const int cg8 = tid & 127;
  const int mh = cg8 >> 3, mix = mh >> 2, h = mh & 3, j0 = (cg8 & 7) * 8;
  const int gcol = (mix == 0) ? 776 : (mix == 1) ? 1800 : (mix == 2) ? 2584 : 3608;
  const float* gsrc = (mix == 0) ? p.I(14) : (mix == 1) ? p.I(16) : (mix == 2) ? p.I(19) : p.I(20);
  float g8[8];
#pragma unroll
  for (int i = 0; i < 8; ++i) g8[i] = gsrc[layer * 256 + h * 64 + j0 + i];
  uint4 ovn, gvn; f32x4 psn, ps2n = (f32x4){0.f, 0.f, 0.f, 0.f};
  {
    const int r0 = min(bid * 2 + (tid >> 7), MT - 1);
    ovn = *(const uint4*)(O + (size_t)r0 * 1024 + cg8 * 8);
    gvn = *(const uint4*)(P + (size_t)r0 * DINP + gcol + h * 64 + j0);
    psn = *(const f32x4*)(PS + (size_t)r0 * 128 + mh * 8);
    if (mix == 0) ps2n = *(const f32x4*)(PS + (size_t)r0 * 128 + mh * 8 + 4);
  }
  for (int row = bid * 2 + (tid >> 7); row < MT; row += nb * 2) {
    const uint4 ov = ovn, gv = gvn; const f32x4 ps = psn, ps2 = ps2n;
    {
      const int rn = min(row + nb * 2, MT - 1);
      ovn = *(const uint4*)(O + (size_t)rn * 1024 + cg8 * 8);
      gvn = *(const uint4*)(P + (size_t)rn * DINP + gcol + h * 64 + j0);
      psn = *(const f32x4*)(PS + (size_t)rn * 128 + mh * 8);
      if (mix == 0) ps2n = *(const f32x4*)(PS + (size_t)rn * 128 + mh * 8 + 4);
    }
    float s1 = ps[0] + ps[2], s2 = ps[1] + ps[3];
    if (mix == 0) { s1 += ps2[0] + ps2[2]; s2 += ps2[1] + ps2[3]; }
    float o[8], gt[8]; unpack8(ov, o); unpack8(gv, gt);
    float mu = 0.f, rs;
    if (mix == 3) { mu = s1 * (1.0f / 64.0f); const float var = fmaxf(s2 * (1.0f / 64.0f) - mu * mu, 0.f); rs = rsqrtf(var + 1e-5f); }
    else rs = rsqrtf(s2 * (1.0f / 64.0f) + 1e-6f);
    float r[8];
#pragma unroll
    for (int i = 0; i < 8; ++i) r[i] = (o[i] - mu) * rs * g8[i] * siluf_(gt[i]);
    uint4 o4; o4.x = pk2(r[0], r[1]); o4.y = pk2(r[2], r[3]); o4.z = pk2(r[4], r[5]); o4.w = pk2(r[6], r[7]);
    *(uint4*)(O + (size_t)row * 1024 + cg8 * 8) = o4;
  }
}

constexpr int NPHASE = 17;
__global__ void __launch_bounds__(256, 2) hymba_fwd(Params p_, int ph_lo, int ph_hi) {
  __shared__ __attribute__((aligned(16))) char lds[65536];
  XcdBarrier xb; xb.bar = (unsigned*)(p_.ws + OFF_BAR); xb.x = xb_xcc_id(); xb.nloc = 0u; xb.nx = 0u;
  if (threadIdx.x == 0) (void)xb_add(&xb.bar[XB_XCNT(xb.x)], 1u);
  int role = 0, ci = 0;
  {
    const unsigned key = ((((unsigned)__builtin_amdgcn_s_getreg((31 << 11) | 4)) >> 8) & 0xFFu) | (xb.x << 8);
    if (threadIdx.x == 0) {
      const unsigned slot = xb_add(&xb.bar[CEN_TAB + key], 1u);
      unsigned r;
      if (slot == 0u) { r = xb_add(&xb.bar[CEN_CNT], 1u); __hip_atomic_store(&xb.bar[CEN_TAB2 + key], r + 1u, __ATOMIC_RELAXED, __HIP_MEMORY_SCOPE_AGENT); }
      else { (void)xb_add(&xb.bar[CEN_CNT + 1], 1u); r = 0u; }
      *(volatile unsigned*)(lds) = slot == 0u ? 0u : 1u; *(volatile unsigned*)(lds + 4) = r;
    }
    __syncthreads();
    role = (int)*(volatile unsigned*)(lds); ci = (int)*(volatile unsigned*)(lds + 4);
    __syncthreads();
    role = __builtin_amdgcn_readfirstlane(role); ci = __builtin_amdgcn_readfirstlane(ci);
    if (role != 0) ci = -1 - (int)key;
  }
  int nprim = 0, nsec = 0;
  if (ph_hi < 0) cg::this_grid().sync();
  for (int ph = ph_lo; ph < ph_hi; ++ph) {
    int tid = threadIdx.x, bid = blockIdx.x, nb = gridDim.x;
    asm volatile("" : "+v"(tid));
    asm volatile("" : "+s"(bid), "+s"(nb));
    if (ph > ph_lo) xcd_barrier(xb, tid, (unsigned)nb);
    if (ph == ph_lo + 1) {
      nprim = (int)xb_ld(&xb.bar[CEN_CNT]); nsec = (int)xb_ld(&xb.bar[CEN_CNT + 1]);
      if (role != 0) { const unsigned v = xb_ld(&xb.bar[CEN_TAB2 + (unsigned)(-1 - ci)]); ci = (v > 0u) ? (int)v - 1 : 0; }
      nprim = __builtin_amdgcn_readfirstlane(nprim); nsec = __builtin_amdgcn_readfirstlane(nsec); ci = __builtin_amdgcn_readfirstlane(ci);
    }
    const Params& p = p_;
    if (ph == 0) {
      convert_weights(p, lds, bid, 992, nb, tid);
      embed_ln(p, bid, nb, tid);
      rope_table(p, bid, nb, tid);
    } else {
      const int l = (ph - 1) / 8, s = (ph - 1) % 8;
      const bf16_t* Xb = (const bf16_t*)p.O();
      bf16_t* X1b = (bf16_t*)(p.W() + OFF_X1B);
      bf16_t* Hb = (bf16_t*)(p.W() + OFF_H);
      float* X = (float*)(p.W() + OFF_X);
      if (s == 0) gemm_phase<EPI_BF16>(Xb, 1024, (const bf16_t*)(p.W() + OFF_WIN + l * SZ_WIN), 1024, 1024, DINP / 128, p.W() + OFF_P, DINP, lds, bid, nb, tid);
      else if (s == 1) scan_phase(p, l, lds, bid, nb, tid, role, ci, nprim, nsec);
      else if (s == 2) norm_phase(p, l, bid, nb, tid);
      else if (s == 3) gemm_phase<EPI_RESID>(Xb, 1024, (const bf16_t*)(p.W() + OFF_WOUT + l * SZ_WOUT), 1024, 1024, 8, X, 1024, lds, bid, nb, tid);
      else if (s == 4) ln_phase(p, p.I(22) + l * 1024, p.I(23) + l * 1024, X1b, 0, bid, nb, tid);
      else if (s == 5) gemm_phase<EPI_SWIGLU>(X1b, 1024, (const bf16_t*)(p.W() + OFF_WGU + l * SZ_WGU), 1024, 1024, 44, Hb, DFF, lds, bid, nb, tid);
      else if (s == 6) gemm_phase<EPI_RESID>(Hb, DFF, (const bf16_t*)(p.W() + OFF_WDN + l * SZ_WDN), DFF, DFF, 8, X, 1024, lds, bid, nb, tid);
      else ln_phase(p, p.I(27) + l * 1024, p.I(28) + l * 1024, (bf16_t*)p.O(), l == 1, bid, nb, tid);
    }
  }
}

extern "C" void kernel_launch(void* const* d_in, const int* in_sizes, int n_in, void* d_out, int out_size, void* d_ws, size_t ws_size,
                              hipStream_t stream) {
  (void)in_sizes; (void)out_size;
  if (n_in < 29 || ws_size < WS_NEED) { fprintf(stderr, "bad args: n_in %d ws %zu need %zu\n", n_in, ws_size, (size_t)WS_NEED); return; }
  Params p{};
  for (int i = 0; i < 29; ++i) p.in[i] = (const float*)d_in[i];
  p.out = (float*)d_out;
  p.ws = (unsigned char*)d_ws;
  static int grid_blocks = 0;
  if (!grid_blocks) {
    int dev = 0, cus = 0, per_cu = 0;
    (void)hipGetDevice(&dev);
    (void)hipDeviceGetAttribute(&cus, hipDeviceAttributeMultiprocessorCount, dev);
    (void)hipOccupancyMaxActiveBlocksPerMultiprocessor(&per_cu, hymba_fwd, 256, 0);
    if (per_cu > 2) per_cu = 2;
    if (per_cu < 1) per_cu = 1;
    grid_blocks = cus * per_cu;
  }
  (void)hipMemsetAsync((unsigned char*)d_ws + OFF_BAR, 0, BAR_BYTES, stream);
  int lo = 0, hi = NPHASE;
  void* args[] = {&p, &lo, &hi};
  hipError_t e = hipLaunchCooperativeKernel((void*)hymba_fwd, dim3(grid_blocks), dim3(256), args, 0, stream);
  if (e != hipSuccess) fprintf(stderr, "cooperative launch failed: %s (grid %d)\n", hipGetErrorString(e), grid_blocks);
}
```

```cpp
#include <hip/hip_runtime.h>
#include <hip/hip_cooperative_groups.h>
#include <cstdio>
#include <cstdint>
namespace cg = cooperative_groups;

#ifndef COOP
#define COOP 1
#endif

typedef unsigned short bf16_t;
typedef short bf16x8 __attribute__((ext_vector_type(8)));
typedef float f32x4 __attribute__((ext_vector_type(4)));

constexpr int DM = 1024, NB = 8, TPR = 2064, NSB = 128, TS = 4;
constexpr int MP = NB * TPR;
constexpr int MS = NSB * TS;
constexpr int MT = MP + MS;
constexpr int DIN = 3864, DINP = 3968, DFF = 2816;
constexpr float ALPHA = 1.41421356237309515f;

constexpr size_t SZ_WIN = (size_t)DINP * 1024 * 2, SZ_WOUT = (size_t)1024 * 1024 * 2, SZ_WGU = (size_t)5632 * 1024 * 2, SZ_WDN = (size_t)1024 * 2816 * 2;
constexpr size_t OFF_CS = 0;
constexpr size_t OFF_WIN = 532480;
constexpr size_t OFF_WOUT = OFF_WIN + 2 * SZ_WIN;
constexpr size_t OFF_WGU = OFF_WOUT + 2 * SZ_WOUT;
constexpr size_t OFF_WDN = OFF_WGU + 2 * SZ_WGU;
constexpr size_t OFF_X = OFF_WDN + 2 * SZ_WDN;
constexpr size_t OFF_P = OFF_X + (size_t)MT * 1024 * 4;
constexpr size_t OFF_X1B = OFF_P;
constexpr size_t OFF_H = OFF_P + (size_t)MT * 1024 * 2;
constexpr size_t OFF_BAR = OFF_P + (size_t)MT * DINP * 2;
constexpr int CEN_CNT = 3520, CEN_TAB = 4096, CEN_TAB2 = 8192;
constexpr size_t BAR_BYTES = 12288 * 4;
constexpr size_t WS_NEED = OFF_BAR + BAR_BYTES;
constexpr size_t DOUT_PS = 36000000;

constexpr size_t O_YP = 0, O_YS = 16777216, O_CP = 17301504, O_CS = 17338368, O_DP = 17928192, O_DS = 18190336,
                 O_HP = 22384640, O_HS = 22646784, O_GP = 26841088, O_GS = 26972160, O_RP = 29069312, O_RS = 29331456;

#define GAS __attribute__((address_space(1)))
struct Params {
  const float* in[29];
  float* out;
  unsigned char* ws;
  __device__ __forceinline__ const float* I(int i) const { return (const float*)(const GAS float*)in[i]; }
  __device__ __forceinline__ float* O() const { return (float*)(GAS float*)out; }
  __device__ __forceinline__ unsigned char* W() const { return (unsigned char*)(GAS unsigned char*)ws; }
};

__device__ __forceinline__ unsigned f2bf(float f) {
  unsigned u = __float_as_uint(f);
  u += 0x7fffu + ((u >> 16) & 1u);
  return u >> 16;
}
typedef float f32x2_t __attribute__((ext_vector_type(2)));
typedef __bf16 bf16x2_t __attribute__((ext_vector_type(2)));
__device__ __forceinline__ unsigned pk2(float lo, float hi) { const f32x2_t v = {lo, hi}; const bf16x2_t b = __builtin_convertvector(v, bf16x2_t); return __builtin_bit_cast(unsigned, b); }
__device__ __forceinline__ float bflo(unsigned u) { return __uint_as_float(u << 16); }
__device__ __forceinline__ float bfhi(unsigned u) { return __uint_as_float(u & 0xffff0000u); }
__device__ __forceinline__ void unpack8(const uint4& r, float* x) {
  x[0] = bflo(r.x); x[1] = bfhi(r.x); x[2] = bflo(r.y); x[3] = bfhi(r.y);
  x[4] = bflo(r.z); x[5] = bfhi(r.z); x[6] = bflo(r.w); x[7] = bfhi(r.w);
}
__device__ __forceinline__ float sigmoidf_(float x) { return __builtin_amdgcn_rcpf(1.0f + __expf(-x)); }
__device__ __forceinline__ float siluf_(float x) { return x * __builtin_amdgcn_rcpf(1.0f + __expf(-x)); }
__device__ __forceinline__ float softplusf_(float x) { return fmaxf(x, 0.f) + __logf(1.0f + __expf(-fabsf(x))); }
__device__ __forceinline__ float red8(float x) {
  x += __shfl_xor(x, 1); x += __shfl_xor(x, 2); x += __shfl_xor(x, 4); return x;
}
__device__ __forceinline__ float dpp_x1(float x) {
  return __int_as_float(__builtin_amdgcn_update_dpp(0, __float_as_int(x), 0xB1, 0xF, 0xF, true));
}
__device__ __forceinline__ float dpp_x2(float x) {
  return __int_as_float(__builtin_amdgcn_update_dpp(0, __float_as_int(x), 0x4E, 0xF, 0xF, true));
}
__device__ __forceinline__ float red4(float x) { x += dpp_x1(x); x += dpp_x2(x); return x; }
__device__ __forceinline__ float wave_sum(float x) {
#pragma unroll
  for (int o = 32; o >= 1; o >>= 1) x += __shfl_xor(x, o);
  return x;
}

__device__ __forceinline__ void convert_weights(const Params& p, char* lds, int w0, int w1, int wstep, const int tid) {
  float* tile = (float*)lds;
  for (int w = w0; w < w1; w += wstep) {
    const int l = w / 3360; int r = w % 3360;
    int mat, kt, rt;
    if (r < 992) { mat = 0; kt = r / 62; rt = r % 62; }
    else if (r < 1248) { r -= 992; mat = 1; kt = r / 16; rt = r % 16; }
    else if (r < 2656) { r -= 1248; mat = 2; kt = r / 88; rt = r % 88; }
    else { r -= 2656; mat = 3; kt = r / 16; rt = r % 16; }
    {
      const int r4 = (tid & 15) * 4, R = rt * 64 + r4, kq = tid >> 4;
      const float* src; int ns; bool valid = true;
      if (mat == 0) { const int rho = R & 31, scol = (R & ~31) + 8 * ((rho & 15) >> 2) + 4 * (rho >> 4) + (rho & 3);
        src = p.I(10) + (size_t)l * 1024 * DIN + scol; ns = DIN; valid = scol < DIN; }
      else if (mat == 1) { src = p.I(21) + (size_t)l * 1024 * 1024 + R; ns = 1024; }
      else if (mat == 2) { const int q = R & 63, f = q >> 4, i = q & 15, ty = f & 1, hid = (R >> 6) * 32 + 8 * (i >> 2) + 4 * (f >> 1) + (i & 3);
        src = (ty ? p.I(25) : p.I(24)) + (size_t)l * 1024 * DFF + hid; ns = DFF; }
      else { src = p.I(26) + (size_t)l * DFF * 1024 + R; ns = 1024; }
      f32x4 v[4];
#pragma unroll
      for (int i = 0; i < 4; ++i) v[i] = valid ? *(const f32x4*)(src + (size_t)(kt * 64 + kq + 16 * i) * ns) : (f32x4){0.f, 0.f, 0.f, 0.f};
#pragma unroll
      for (int i = 0; i < 4; ++i) {
        const int k = kq + 16 * i;
        tile[(r4 + 0) * 65 + k] = v[i][0]; tile[(r4 + 1) * 65 + k] = v[i][1]; tile[(r4 + 2) * 65 + k] = v[i][2]; tile[(r4 + 3) * 65 + k] = v[i][3];
      }
    }
    __syncthreads();
    {
      const int rr = tid >> 2, kc = (tid & 3) * 16;
      const int Kd = (mat == 3) ? DFF : 1024;
      bf16_t* base;
      if (mat == 0) base = (bf16_t*)(p.W() + OFF_WIN + l * SZ_WIN);
      else if (mat == 1) base = (bf16_t*)(p.W() + OFF_WOUT + l * SZ_WOUT);
      else if (mat == 2) base = (bf16_t*)(p.W() + OFF_WGU + l * SZ_WGU);
      else base = (bf16_t*)(p.W() + OFF_WDN + l * SZ_WDN);
      bf16_t* dst = base + (size_t)(rt * 64 + rr) * Kd + kt * 64 + kc;
      const float* s = tile + rr * 65 + kc;
      uint4 a, b;
      a.x = pk2(s[0], s[1]); a.y = pk2(s[2], s[3]); a.z = pk2(s[4], s[5]); a.w = pk2(s[6], s[7]);
      b.x = pk2(s[8], s[9]); b.y = pk2(s[10], s[11]); b.z = pk2(s[12], s[13]); b.w = pk2(s[14], s[15]);
      *(uint4*)dst = a; *(uint4*)(dst + 8) = b;
    }
    __syncthreads();
  }
}

__device__ __forceinline__ void ln_row_regs(f32x4 (&v)[4], const float* g, const float* bb, int lane) {
  float s = 0.f;
#pragma unroll
  for (int i = 0; i < 4; ++i) s += (v[i][0] + v[i][1]) + (v[i][2] + v[i][3]);
  const float mu = wave_sum(s) * (1.0f / 1024.0f);
  float q = 0.f;
#pragma unroll
  for (int i = 0; i < 4; ++i) { const f32x4 d = v[i] - mu; q += (d[0] * d[0] + d[1] * d[1]) + (d[2] * d[2] + d[3] * d[3]); }
  const float rs = rsqrtf(wave_sum(q) * (1.0f / 1024.0f) + 1e-5f);
#pragma unroll
  for (int i = 0; i < 4; ++i) {
    const f32x4 gg = *(const f32x4*)(g + lane * 4 + i * 256), b4 = *(const f32x4*)(bb + lane * 4 + i * 256);
    v[i] = (v[i] - mu) * rs * gg + b4;
  }
}

__device__ __forceinline__ void embed_ln(const Params& p, int bid, int nb, const int tid) {
  const int lane = tid & 63, wv = tid >> 6;
  float* X = (float*)(p.W() + OFF_X);
  bf16_t* Xb = (bf16_t*)p.O();
  for (int row = bid * 4 + wv; row < MT; row += nb * 4) {
    const float* src;
    if (row < MP) { const int b = row / TPR, t = row % TPR;
      src = (t < 16) ? p.I(7) + (size_t)t * 1024 : p.I(0) + ((size_t)b * 2048 + (t - 16)) * 1024; }
    else src = p.I(1) + (size_t)(row - MP) * 1024;
    f32x4 v[4];
#pragma unroll
    for (int i = 0; i < 4; ++i) v[i] = *(const f32x4*)(src + lane * 4 + i * 256);
    ln_row_regs(v, p.I(8), p.I(9), lane);
#pragma unroll
    for (int i = 0; i < 4; ++i) {
      *(f32x4*)(X + (size_t)row * 1024 + lane * 4 + i * 256) = v[i];
      uint2 o; o.x = pk2(v[i][0], v[i][1]); o.y = pk2(v[i][2], v[i][3]);
      *(uint2*)(Xb + (size_t)row * 1024 + lane * 4 + i * 256) = o;
    }
  }
}

__device__ __forceinline__ void rope_table(const Params& p, int bid, int nb, const int tid) {
  float2* cs = (float2*)(p.W() + OFF_CS);
  for (int e = bid * 256 + tid; e < 2068 * 32; e += nb * 256) {
    const int idx = e >> 5, i = e & 31;
    const double pos = (idx < 2064) ? (double)idx : (double)(16384 + idx - 2064);
    const double inv = exp(-((double)i / 31.0) * 9.210340371976184);
    const double ang = pos * inv;
    cs[e] = make_float2((float)cos(ang), (float)sin(ang));
  }
}

__device__ __forceinline__ void ln_phase(const Params& p, const float* g, const float* bb, bf16_t* xb, int final_, int bid, int nb, const int tid) {
  const int lane = tid & 63, wv = tid >> 6;
  float* X = (float*)(p.W() + OFF_X);
  f32x4 nx[4];
  {
    const int r0 = min(bid * 4 + wv, MT - 1);
#pragma unroll
    for (int i = 0; i < 4; ++i) nx[i] = *(const f32x4*)(X + (size_t)r0 * 1024 + lane * 4 + i * 256);
  }
  for (int row = bid * 4 + wv; row < MT; row += nb * 4) {
    f32x4 v[4];
#pragma unroll
    for (int i = 0; i < 4; ++i) v[i] = nx[i];
    {
      const int rn = min(row + nb * 4, MT - 1);
#pragma unroll
      for (int i = 0; i < 4; ++i) nx[i] = *(const f32x4*)(X + (size_t)rn * 1024 + lane * 4 + i * 256);
    }
    ln_row_regs(v, g, bb, lane);
    if (!final_) {
#pragma unroll
      for (int i = 0; i < 4; ++i) {
        *(f32x4*)(X + (size_t)row * 1024 + lane * 4 + i * 256) = v[i];
        uint2 o; o.x = pk2(v[i][0], v[i][1]); o.y = pk2(v[i][2], v[i][3]);
        *(uint2*)(xb + (size_t)row * 1024 + lane * 4 + i * 256) = o;
      }
    } else {
      float* dst = nullptr;
      if (row < MP) { const int b = row / TPR, t = row % TPR; if (t >= 16) dst = p.O() + O_YP + ((size_t)b * 2048 + (t - 16)) * 1024; }
      else dst = p.O() + O_YS + (size_t)(row - MP) * 1024;
      if (dst) {
#pragma unroll
        for (int i = 0; i < 4; ++i) *(f32x4*)(dst + lane * 4 + i * 256) = v[i];
      }
    }
  }
}

enum { EPI_BF16 = 0, EPI_RESID = 1, EPI_SWIGLU = 2 };

template <int EPI>
__device__ __forceinline__ void gemm_tile(const bf16_t* __restrict__ A, const int lda, const bf16_t* __restrict__ Bt, const int ldb,
                                          const int K, const int m0, const int n0, void* Cout, const int ldc, char* lds, const int tid) {
  const int wid = tid >> 6, lane = tid & 63, wr = wid >> 1, wc = wid & 1, fr = lane & 15, fq = lane >> 4;
  f32x4 acc[4][4];
#pragma unroll
  for (int m = 0; m < 4; ++m)
#pragma unroll
    for (int n = 0; n < 4; ++n) acc[m][n] = (f32x4){0.f, 0.f, 0.f, 0.f};
  const int nt = K >> 6;
  const int st_row = tid >> 3, st_c = (tid & 7) ^ ((((tid >> 4) & 1) << 2) | ((tid >> 5) & 3));
  auto stage = [&](int kt, int buf) {
#pragma unroll
    for (int i = 0; i < 4; ++i) {
      const int off = tid * 16 + i * 4096, r = st_row + i * 32;
      const bf16_t* ga = A + (size_t)(m0 + r) * lda + kt * 64 + st_c * 8;
      const bf16_t* gb = Bt + (size_t)(n0 + r) * ldb + kt * 64 + st_c * 8;
      __builtin_amdgcn_global_load_lds((const unsigned*)ga, (__attribute__((address_space(3))) unsigned*)(lds + buf * 32768 + off), 16, 0, 0);
      __builtin_amdgcn_global_load_lds((const unsigned*)gb, (__attribute__((address_space(3))) unsigned*)(lds + buf * 32768 + 16384 + off), 16, 0, 0);
    }
  };
  const int fsw = (((fr >> 1) & 1) << 2) | ((fr >> 2) & 3);
  const int xk0 = (fq ^ fsw) << 4, xk1 = ((4 + fq) ^ fsw) << 4;
  stage(0, 0);
  for (int kt = 0; kt < nt; ++kt) {
    asm volatile("s_waitcnt vmcnt(0)" ::: "memory");
    __syncthreads();
    if (kt + 1 < nt) stage(kt + 1, (kt + 1) & 1);
    const char* sa = lds + (kt & 1) * 32768;
    const char* sb = sa + 16384;
    bf16x8 af[2][4], bfr[2][4];
#pragma unroll
    for (int ks = 0; ks < 2; ++ks) {
#pragma unroll
      for (int m = 0; m < 4; ++m) af[ks][m] = *(const bf16x8*)(sa + (wr * 64 + m * 16 + fr) * 128 + (ks ? xk1 : xk0));
#pragma unroll
      for (int n = 0; n < 4; ++n) bfr[ks][n] = *(const bf16x8*)(sb + (wc * 64 + n * 16 + fr) * 128 + (ks ? xk1 : xk0));
    }
#pragma unroll
    for (int ks = 0; ks < 2; ++ks)
#pragma unroll
      for (int m = 0; m < 4; ++m)
#pragma unroll
        for (int n = 0; n < 4; ++n) acc[m][n] = __builtin_amdgcn_mfma_f32_16x16x32_bf16(bfr[ks][n], af[ks][m], acc[m][n], 0, 0, 0);
  }
  if (EPI == EPI_RESID) {
    float* C0 = (float*)Cout + (size_t)(m0 + wr * 64 + fr) * ldc + n0 + wc * 64 + fq * 4;
#pragma unroll
    for (int mh = 0; mh < 2; ++mh) {
      f32x4 xin[2][4];
#pragma unroll
      for (int m = 0; m < 2; ++m)
#pragma unroll
        for (int n = 0; n < 4; ++n) xin[m][n] = *(const f32x4*)(C0 + (size_t)(mh * 2 + m) * 16 * ldc + n * 16);
#pragma unroll
      for (int m = 0; m < 2; ++m)
#pragma unroll
        for (int n = 0; n < 4; ++n) asm volatile("" : "+v"(xin[m][n]));
#pragma unroll
      for (int m = 0; m < 2; ++m)
#pragma unroll
        for (int n = 0; n < 4; ++n) *(f32x4*)(C0 + (size_t)(mh * 2 + m) * 16 * ldc + n * 16) = xin[m][n] * ALPHA + acc[mh * 2 + m][n];
    }
    return;
  }
#pragma unroll
  for (int m = 0; m < 4; ++m) {
    const int row = m0 + wr * 64 + m * 16 + fr;
    if (EPI == EPI_BF16) {
      bf16_t* C = (bf16_t*)Cout + (size_t)row * ldc + n0 + wc * 64 + fq * 8;
#pragma unroll
      for (int pq = 0; pq < 2; ++pq) { uint4 o; o.x = pk2(acc[m][2 * pq][0], acc[m][2 * pq][1]); o.y = pk2(acc[m][2 * pq][2], acc[m][2 * pq][3]);
        o.z = pk2(acc[m][2 * pq + 1][0], acc[m][2 * pq + 1][1]); o.w = pk2(acc[m][2 * pq + 1][2], acc[m][2 * pq + 1][3]); *(uint4*)(C + pq * 32) = o; }
    } else if (EPI == EPI_RESID) {
      float* C = (float*)Cout + (size_t)row * ldc + n0 + wc * 64 + fq * 4;
#pragma unroll
      for (int n = 0; n < 4; ++n) { const f32x4 x = *(const f32x4*)(C + n * 16); *(f32x4*)(C + n * 16) = x * ALPHA + acc[m][n]; }
    } else {
      bf16_t* C = (bf16_t*)Cout + (size_t)row * ldc + (n0 >> 1) + wc * 32 + fq * 8;
      const f32x4 g0 = acc[m][0], u0 = acc[m][1], g1 = acc[m][2], u1 = acc[m][3];
      uint4 o; o.x = pk2(siluf_(g0[0]) * u0[0], siluf_(g0[1]) * u0[1]); o.y = pk2(siluf_(g0[2]) * u0[2], siluf_(g0[3]) * u0[3]);
      o.z = pk2(siluf_(g1[0]) * u1[0], siluf_(g1[1]) * u1[1]); o.w = pk2(siluf_(g1[2]) * u1[2], siluf_(g1[3]) * u1[3]);
      *(uint4*)C = o;
    }
  }
}
template <int EPI>
__device__ __forceinline__ void gemm_phase(const bf16_t* A, int lda, const bf16_t* Bt, int ldb, int K, int ntn, void* C, int ldc, char* lds, int bid, int nb, const int tid) {
  constexpr int GM = 4, nM = MT / 128;
  const int ntiles = nM * ntn, nig = GM * ntn;
  const int pos = (EPI == EPI_BF16 && (nb & 7) == 0) ? (bid & 7) * (nb >> 3) + (bid >> 3) : bid;
  for (int L = pos; L < ntiles; L += nb) {
    int mt, nn;
    if (EPI != EPI_BF16) { mt = L / ntn; nn = L % ntn; }
    else { const int gid = L / nig, fm = gid * GM, gsz = min(nM - fm, GM), rem = L - gid * nig; mt = fm + rem % gsz; nn = rem / gsz; }
    gemm_tile<EPI>(A, lda, Bt, ldb, K, mt * 128, nn * 128, C, ldc, lds, tid);
  }
}

#define XB_TMO      128
#define XB_XCNT(j)  (256  + 64 * (j))
#define XB_XSUB(j)  (1280 + 64 * (j))
#define XB_XGEN(j)  (2304 + 64 * (j))
#define XB_TOP      3328
#define XB_TOPGEN   3392
#define XCD_BAR_WORDS 3456
#define XB_SPIN_CAP (1u << 22)
__device__ __forceinline__ unsigned xb_ld(unsigned* p) { return __hip_atomic_load(p, __ATOMIC_RELAXED, __HIP_MEMORY_SCOPE_AGENT); }
__device__ __forceinline__ unsigned xb_add(unsigned* p, unsigned v) { return __hip_atomic_fetch_add(p, v, __ATOMIC_RELAXED, __HIP_MEMORY_SCOPE_AGENT); }
__device__ __forceinline__ unsigned xb_xcc_id() { return (unsigned)__builtin_amdgcn_s_getreg((3 << 11) | 20) & 0xFu; }
#define XB_SPIN(cond, bar) do { unsigned _sp = 0; while (cond) { __builtin_amdgcn_s_sleep(1); \
    if ((++_sp & 255u) == 0u) { if (xb_ld(&(bar)[XB_TMO])) break; if (_sp > XB_SPIN_CAP) { atomicAdd(&(bar)[XB_TMO], 1u); break; } } } } while (0)
struct XcdBarrier { unsigned* bar; unsigned x; unsigned nloc, nx; };
__device__ __forceinline__ void xcd_barrier_complete(unsigned* bar, unsigned x, unsigned G, unsigned& nloc, unsigned& nx) {
  unsigned sum, cnt, mine, sp = 0u;
  for (;;) {
    sum = 0u; cnt = 0u; mine = 0u;
#pragma unroll
    for (unsigned j = 0; j < 16; ++j) { const unsigned c = xb_ld(&bar[XB_XCNT(j)]); sum += c; cnt += (c > 0u) ? 1u : 0u; mine = (j == x) ? c : mine; }
    if (sum == G) break;
    __builtin_amdgcn_s_sleep(1);
    if ((++sp & 255u) == 0u) { if (xb_ld(&bar[XB_TMO])) break; if (sp > XB_SPIN_CAP) { atomicAdd(&bar[XB_TMO], 1u); break; } }
  }
  nloc = mine > 0u ? mine : 1u; nx = cnt > 0u ? cnt : 1u;
}
__device__ __forceinline__ void xcd_barrier(XcdBarrier& b, const int tid, const unsigned G) {
  asm volatile("s_waitcnt vmcnt(0)" ::: "memory");
  __syncthreads();
  if (tid == 0) {
    unsigned* bar = b.bar;
    __builtin_amdgcn_s_waitcnt(0);
    if (b.nloc == 0u) xcd_barrier_complete(bar, b.x, G, b.nloc, b.nx);
    const unsigned nloc = b.nloc, nx = b.nx;
    const unsigned old = xb_add(&bar[XB_XSUB(b.x)], 1u);
    const unsigned gen = old / nloc;
    if (old + 1u == (gen + 1u) * nloc) {
      __builtin_amdgcn_fence(__ATOMIC_RELEASE, "agent");
      asm volatile("s_waitcnt vmcnt(0)" ::: "memory");
      const unsigned og = xb_add(&bar[XB_TOP], 1u);
      const unsigned tg = og / nx;
      if (og + 1u == (tg + 1u) * nx) xb_add(&bar[XB_TOPGEN], 1u);
      else XB_SPIN(xb_ld(&bar[XB_TOPGEN]) == tg, bar);
      __builtin_amdgcn_fence(__ATOMIC_ACQUIRE, "agent");
      xb_add(&bar[XB_XGEN(b.x)], 1u);
      asm volatile("s_waitcnt vmcnt(0)" ::: "memory");
    } else {
      XB_SPIN(xb_ld(&bar[XB_XGEN(b.x)]) == gen, bar);
      __builtin_amdgcn_fence(__ATOMIC_ACQUIRE, "agent");
      asm volatile("s_waitcnt vmcnt(0)" ::: "memory");
    }
  }
  __syncthreads();
}

template <int N, int RS>
__device__ __forceinline__ void convN(const bf16_t* rawb, const float (&w)[4][N], int tt, int off, float (&x)[N]) {
#pragma unroll
  for (int i = 0; i < N; ++i) x[i] = 0.f;
#pragma unroll
  for (int j = 0; j < 4; ++j) {
    float xv[N];
    if (N == 8) { const uint4 rv = *(const uint4*)(rawb + (tt + j) * RS + off); unpack8(rv, xv); }
    else if (N == 4) { const uint2 rv = *(const uint2*)(rawb + (tt + j) * RS + off); xv[0] = bflo(rv.x); xv[1] = bfhi(rv.x); xv[2 % N] = bflo(rv.y); xv[3 % N] = bfhi(rv.y); }
    else { const unsigned rv = *(const unsigned*)(rawb + (tt + j) * RS + off); xv[0] = bflo(rv); xv[1] = bfhi(rv); }
#pragma unroll
    for (int i = 0; i < N; ++i) x[i] += w[j][i] * xv[i];
  }
  if (N == 2) {
#pragma unroll
    for (int i = 0; i < N; ++i) asm volatile("" : "+v"(x[i]));
  }
#pragma unroll
  for (int i = 0; i < N; ++i) x[i] = siluf_(x[i]);
}

template <int MIX, int VN>
__device__ __forceinline__ void load_chunk_fn(const unsigned char* ws, const bf16_t* Pb, const int t, const int T, const int h, const int vcol, const int sub, const int posb,
                                              uint4& R0, uint4& R1, uint2& R2, uint4& R4, uint4& R5, unsigned& ex0, unsigned& ex1) {
  if (t < T) {
    const bf16_t* pr = Pb + (size_t)t * DINP;
    const int vbase = (MIX == 0) ? 512 : (MIX == 1) ? 1544 : (MIX == 2) ? 2312 : 3352;
    if (VN == 4) R2 = *(const uint2*)(pr + vbase + h * 64 + vcol);
    else R2.x = *(const unsigned*)(pr + vbase + h * 64 + vcol);
    if (MIX == 0) {
      R0 = *(const uint4*)(pr + 0 + h * 64 + sub * 8); R1 = *(const uint4*)(pr + 256 + h * 64 + sub * 8);
      ex0 = pr[768 + h]; ex1 = pr[772 + h];
    } else if (MIX == 1) {
      R0 = *(const uint4*)(pr + 1032 + h * 64 + sub * 8); R1 = *(const uint4*)(pr + 1288 + h * 64 + sub * 8);
    } else if (MIX == 2) {
      const uint2 q2 = *(const uint2*)(pr + 2056 + h * 32 + sub * 4), k2 = *(const uint2*)(pr + 2184 + h * 32 + sub * 4);
      R0 = make_uint4(q2.x, q2.y, k2.x, k2.y);
      R1 = *(const uint4*)(pr + 2568); R4 = *(const uint4*)(pr + 2576);
    } else {
      const uint2 ql = *(const uint2*)(pr + 2840 + h * 64 + sub * 4), qh = *(const uint2*)(pr + 2840 + h * 64 + 32 + sub * 4);
      const uint2 kl = *(const uint2*)(pr + 3096 + h * 64 + sub * 4), kh = *(const uint2*)(pr + 3096 + h * 64 + 32 + sub * 4);
      R0 = make_uint4(ql.x, ql.y, qh.x, qh.y); R1 = make_uint4(kl.x, kl.y, kh.x, kh.y);
      const uint4* cs = (const uint4*)(ws + OFF_CS + ((size_t)(posb + t) * 32 + sub * 4) * 8);
      R4 = cs[0]; R5 = cs[1];
    }
  }
}

__device__ __forceinline__ float dpp_hm(float x) {
  return __int_as_float(__builtin_amdgcn_update_dpp(0, __float_as_int(x), 0x141, 0xF, 0xF, true));
}
__device__ __forceinline__ float dpp_rm(float x) {
  return __int_as_float(__builtin_amdgcn_update_dpp(0, __float_as_int(x), 0x140, 0xF, 0xF, true));
}
__device__ __forceinline__ float red8d(float x) { x += dpp_x1(x); x += dpp_x2(x); x += dpp_hm(x); return x; }
template <int KG> __device__ __forceinline__ float redKG(float x) { x = red8d(x); if (KG == 16) x += dpp_rm(x); return x; }

template <int MIX, int KPL>
struct StepIn { float q[KPL], k[KPL], d[KPL]; float v, a, be, qk; };

template <int MIX, int KPL>
__device__ __forceinline__ void load_step(const float* qkdv, const float* scal, int t, int kg, int col, StepIn<MIX, KPL>& s) {
  const float* base = qkdv + t * 256;
#pragma unroll
  for (int i = 0; i < KPL; i += 4) {
    const f32x4 a = *(const f32x4*)(base + kg * KPL + i), b = *(const f32x4*)(base + 64 + kg * KPL + i);
    s.q[i] = a[0]; s.q[i + 1] = a[1]; s.q[i + 2] = a[2]; s.q[i + 3] = a[3];
    s.k[i] = b[0]; s.k[i + 1] = b[1]; s.k[i + 2] = b[2]; s.k[i + 3] = b[3];
    if (MIX == 1 || MIX == 2) { const f32x4 d = *(const f32x4*)(base + 128 + kg * KPL + i); s.d[i] = d[0]; s.d[i + 1] = d[1]; s.d[i + 2] = d[2]; s.d[i + 3] = d[3]; }
  }
  s.v = base[192 + col];
  if (MIX == 0) { const f32x4 c = *(const f32x4*)(scal + t * 4); s.a = c[0]; s.be = c[1]; s.qk = c[2]; }
}

template <int MIX, int KPL, int KG>
__device__ __forceinline__ float do_step(const StepIn<MIX, KPL>& s, float (&S)[KPL], const float gam) {
  if (MIX == 0) {
    float kS0 = 0.f, kS1 = 0.f, qS0 = 0.f, qS1 = 0.f;
#pragma unroll
    for (int i = 0; i < KPL; i += 2) { kS0 += s.k[i] * S[i]; kS1 += s.k[i + 1] * S[i + 1]; qS0 += s.q[i] * S[i]; qS1 += s.q[i + 1] * S[i + 1]; }
    const float kS = redKG<KG>(kS0 + kS1), qS = redKG<KG>(qS0 + qS1);
    const float w = s.be * (s.v - s.a * kS);
#pragma unroll
    for (int i = 0; i < KPL; ++i) S[i] = s.a * S[i] + s.k[i] * w;
    return s.a * qS + s.qk * w;
  } else {
    float o0 = 0.f, o1 = 0.f;
#pragma unroll
    for (int i = 0; i < KPL; i += 2) {
      const float d0 = (MIX == 3) ? gam : s.d[i], d1 = (MIX == 3) ? gam : s.d[i + 1];
      S[i] = d0 * S[i] + s.k[i] * s.v; S[i + 1] = d1 * S[i + 1] + s.k[i + 1] * s.v;
      o0 += s.q[i] * S[i]; o1 += s.q[i + 1] * S[i + 1];
    }
    return redKG<KG>(o0 + o1);
  }
}

template <int MIX>
__device__ __forceinline__ void scan_part(const Params& p, const int layer, const int smp, const int b0, const int bstep, const int bend, const int h, const int part, char* lds, const int tid) {
  constexpr int DK = (MIX == 2) ? 32 : 64;
  constexpr int NS = (MIX == 0) ? 4 : 2;
  constexpr int CW = 64 / NS;
  constexpr int CPW = CW / 4;
  constexpr int KG = 64 / CPW;
  constexpr int KPL = DK / KG;
  constexpr int VN = CW / 8;
  constexpr int RS = 128 + CW;
  float* qkdv = (float*)lds;
  float* obuf = (float*)(lds + 32768);
  float* scal = (float*)(lds + 36864);
  bf16_t* rawb = (bf16_t*)(lds + 37376);
  float* cwl = (float*)(lds + 48576);
  float* wgl = (float*)(lds + 37376);

  const int lane = tid & 63, wv = tid >> 6;
  const int tt = tid >> 3, sub = tid & 7;
  const int col = wv * CPW + lane / KG, kg = lane % KG;
  const int T = smp ? 4 : TPR;
  const int nBatch = smp ? NSB : NB;
  const int posb = smp ? 2064 : 0;
  const int vcol = part * CW + sub * VN;
  __syncthreads();
  float c8[8];
  float Aexp = 0.f, dtb = 0.f, gam = 0.f;
  float cwq[4][8], cwk[4][8];
  if (MIX == 0) {
    Aexp = __expf(p.I(12)[layer * 4 + h]); dtb = p.I(13)[layer * 4 + h];
#pragma unroll
    for (int j = 0; j < 4; ++j) {
      const float* cwp = p.I(11) + (size_t)(layer * 4 + j) * 768;
#pragma unroll
      for (int i = 0; i < 8; ++i) { cwq[j][i] = cwp[h * 64 + sub * 8 + i]; cwk[j][i] = cwp[256 + h * 64 + sub * 8 + i]; }
    }
    for (int e = tid; e < 4 * CW; e += 256) { const int j = e / CW, r = e % CW; cwl[j * RS + 128 + r] = p.I(11)[(size_t)(layer * 4 + j) * 768 + 512 + h * 64 + part * CW + r]; }
  } else if (MIX == 1) {
#pragma unroll
    for (int i = 0; i < 8; ++i) {
      const int d = h * 64 + sub * 8 + i;
      c8[i] = (layer == 0) ? 1.0f : sigmoidf_(p.I(15)[d] - p.I(15)[256 + d]);
    }
  } else if (MIX == 2) {
    for (int e = tid; e < 512; e += 256) { const int r = e >> 5, j = e & 31; wgl[e] = p.I(17)[(size_t)(layer * 16 + r) * 128 + h * 32 + j]; }
#pragma unroll
    for (int i = 0; i < 4; ++i) c8[i] = p.I(18)[layer * 128 + h * 32 + sub * 4 + i];
  } else {
    gam = 1.0f - exp2f(-5.0f - (float)h);
  }
  for (int b = b0; b < bend; b += bstep) {
  const int row0 = smp ? MP + b * 4 : b * TPR;
  const bf16_t* Pb = (const bf16_t*)(p.W() + OFF_P) + (size_t)row0 * DINP;
  bf16_t* Ob = (bf16_t*)p.O() + (size_t)row0 * 1024 + MIX * 256 + h * 64 + part * CW;
  float* PS = (float*)((unsigned char*)p.O() + DOUT_PS) + (size_t)row0 * 128 + (MIX * 4 + h) * 8 + part * 2;
  uint4 R0 = make_uint4(0, 0, 0, 0), R1 = R0, R4 = R0, R5 = R0; uint2 R2 = make_uint2(0, 0); unsigned ex0 = 0, ex1 = 0;
  load_chunk_fn<MIX, VN>(p.W(), Pb, tt, T, h, vcol, sub, posb, R0, R1, R2, R4, R5, ex0, ex1);
  float S[KPL];
  if (smp) {
    const float* sin_ = p.I(3 + MIX) + ((size_t)(layer * NSB + b) * 4 + h) * DK * 64 + part * CW;
#pragma unroll
    for (int i = 0; i < KPL; ++i) S[i] = sin_[(kg * KPL + i) * 64 + col];
  } else {
#pragma unroll
    for (int i = 0; i < KPL; ++i) S[i] = 0.f;
  }
  if (MIX == 0) {
    for (int e = tid; e < 3 * RS; e += 256) { const int j = e / RS, r = e % RS;
      const int cc = (r < 64) ? (h * 64 + r) : (r < 128) ? (256 + h * 64 + r - 64) : (512 + h * 64 + part * CW + r - 128);
      float v = 0.f; if (smp) v = p.I(2)[((size_t)(layer * NSB + b) * 3 + j) * 768 + cc];
      rawb[e] = (bf16_t)f2bf(v); }
  }
  __syncthreads();

  int ntok_last = 0;
  for (int t0 = 0; t0 < T; t0 += 32) {
    const int ntok = min(32, T - t0);
    ntok_last = ntok;
    const bool valid = tt < ntok;
    float* dst = qkdv + tt * 256;
    if (MIX != 0 && valid) {
      if (VN == 4) *(f32x4*)(dst + 192 + sub * 4) = (f32x4){bflo(R2.x), bfhi(R2.x), bflo(R2.y), bfhi(R2.y)};
      else *(float2*)(dst + 192 + sub * 2) = make_float2(bflo(R2.x), bfhi(R2.x));
    }
    if (MIX == 0) {
      if (valid) {
        *(uint4*)(rawb + (3 + tt) * RS + 0 + sub * 8) = R0;
        *(uint4*)(rawb + (3 + tt) * RS + 64 + sub * 8) = R1;
        if (VN == 4) *(uint2*)(rawb + (3 + tt) * RS + 128 + sub * 4) = R2;
        else *(unsigned*)(rawb + (3 + tt) * RS + 128 + sub * 2) = R2.x;
      }
      __syncthreads();
      if (valid) {
        float xq[8], xk[8], xv[VN];
        { float cwv[4][VN];
#pragma unroll
          for (int j = 0; j < 4; ++j)
#pragma unroll
            for (int i = 0; i < VN; ++i) cwv[j][i] = cwl[j * RS + 128 + sub * VN + i];
          convN<VN, RS>(rawb, cwv, tt, 128 + sub * VN, xv); }
        convN<8, RS>(rawb, cwq, tt, sub * 8, xq);
        convN<8, RS>(rawb, cwk, tt, 64 + sub * 8, xk);
#pragma unroll
        for (int i = 0; i < VN; ++i) dst[192 + sub * VN + i] = xv[i];
        float ssq = 0.f, ssk = 0.f;
#pragma unroll
        for (int i = 0; i < 8; ++i) { ssq += xq[i] * xq[i]; ssk += xk[i] * xk[i]; }
        ssq = red8d(ssq); ssk = red8d(ssk);
        const float rq = rsqrtf(ssq + 1e-6f) * 0.125f, rk = rsqrtf(ssk + 1e-6f);
        float qk = 0.f;
#pragma unroll
        for (int i = 0; i < 8; ++i) { xq[i] *= rq; xk[i] *= rk; qk += xq[i] * xk[i]; }
        qk = red8d(qk);
        *(f32x4*)(dst + sub * 8) = (f32x4){xq[0], xq[1], xq[2], xq[3]}; *(f32x4*)(dst + sub * 8 + 4) = (f32x4){xq[4], xq[5], xq[6], xq[7]};
        *(f32x4*)(dst + 64 + sub * 8) = (f32x4){xk[0], xk[1], xk[2], xk[3]}; *(f32x4*)(dst + 64 + sub * 8 + 4) = (f32x4){xk[4], xk[5], xk[6], xk[7]};
        if (sub == 0) {
          const float be = sigmoidf_(bflo(ex0)), al = bflo(ex1);
          const float a = __expf(-Aexp * softplusf_(al + dtb));
          *(f32x4*)(scal + tt * 4) = (f32x4){a, be, qk, 0.f};
        }
      }
    } else if (MIX == 1) {
      if (valid) {
        float q[8], z[8]; unpack8(R0, q); unpack8(R1, z);
        float kk[8], dd[8];
#pragma unroll
        for (int i = 0; i < 8; ++i) { q[i] = siluf_(q[i]); kk[i] = c8[i] * sigmoidf_(-z[i]); dd[i] = 1.0f - fminf(kk[i], 1.0f - 1e-6f); }
        *(f32x4*)(dst + sub * 8) = (f32x4){q[0], q[1], q[2], q[3]}; *(f32x4*)(dst + sub * 8 + 4) = (f32x4){q[4], q[5], q[6], q[7]};
        *(f32x4*)(dst + 64 + sub * 8) = (f32x4){kk[0], kk[1], kk[2], kk[3]}; *(f32x4*)(dst + 64 + sub * 8 + 4) = (f32x4){kk[4], kk[5], kk[6], kk[7]};
        *(f32x4*)(dst + 128 + sub * 8) = (f32x4){dd[0], dd[1], dd[2], dd[3]}; *(f32x4*)(dst + 128 + sub * 8 + 4) = (f32x4){dd[4], dd[5], dd[6], dd[7]};
      }
    } else if (MIX == 2) {
      if (valid) {
        float lr[16]; unpack8(R1, lr); unpack8(R4, lr + 8);
        const float q0 = bflo(R0.x), q1 = bfhi(R0.x), q2 = bflo(R0.y), q3 = bfhi(R0.y);
        const float k0 = bflo(R0.z), k1 = bfhi(R0.z), k2 = bflo(R0.w), k3 = bfhi(R0.w);
        const float sc = 0.17677669529663687f;
        f32x4 xg = (f32x4){c8[0], c8[1], c8[2], c8[3]};
#pragma unroll
        for (int r = 0; r < 16; ++r) xg += lr[r] * *(const f32x4*)(wgl + r * 32 + sub * 4);
        f32x4 dd;
#pragma unroll
        for (int i = 0; i < 4; ++i) { const float ls = fminf(xg[i], 0.f) - __logf(1.0f + __expf(-fabsf(xg[i]))); dd[i] = __expf(ls * 0.0625f); }
        *(f32x4*)(dst + sub * 4) = (f32x4){q0 * sc, q1 * sc, q2 * sc, q3 * sc};
        *(f32x4*)(dst + 64 + sub * 4) = (f32x4){k0, k1, k2, k3};
        *(f32x4*)(dst + 128 + sub * 4) = dd;
      }
    } else {
      if (valid) {
        const float ql[4] = {bflo(R0.x), bfhi(R0.x), bflo(R0.y), bfhi(R0.y)}, qh[4] = {bflo(R0.z), bfhi(R0.z), bflo(R0.w), bfhi(R0.w)};
        const float kl[4] = {bflo(R1.x), bfhi(R1.x), bflo(R1.y), bfhi(R1.y)}, kh[4] = {bflo(R1.z), bfhi(R1.z), bflo(R1.w), bfhi(R1.w)};
        const float cc[4] = {__uint_as_float(R4.x), __uint_as_float(R4.z), __uint_as_float(R5.x), __uint_as_float(R5.z)};
        const float sn[4] = {__uint_as_float(R4.y), __uint_as_float(R4.w), __uint_as_float(R5.y), __uint_as_float(R5.w)};
        f32x4 qa, qb, ka, kb;
#pragma unroll
        for (int i = 0; i < 4; ++i) {
          qa[i] = ql[i] * cc[i] - qh[i] * sn[i]; qb[i] = ql[i] * sn[i] + qh[i] * cc[i];
          ka[i] = (kl[i] * cc[i] - kh[i] * sn[i]) * 0.125f; kb[i] = (kl[i] * sn[i] + kh[i] * cc[i]) * 0.125f;
        }
        *(f32x4*)(dst + sub * 4) = qa; *(f32x4*)(dst + 32 + sub * 4) = qb;
        *(f32x4*)(dst + 64 + sub * 4) = ka; *(f32x4*)(dst + 96 + sub * 4) = kb;
      }
    }
    __syncthreads();
    if (MIX == 0 && t0 + 32 < T) {
      if (tid < 3 * RS / 8) { const uint4 v = *(const uint4*)(rawb + 32 * RS + tid * 8); *(uint4*)(rawb + tid * 8) = v; }
    }
    if (t0 + 32 < T) load_chunk_fn<MIX, VN>(p.W(), Pb, t0 + 32 + tt, T, h, vcol, sub, posb, R0, R1, R2, R4, R5, ex0, ex1);
    {
      StepIn<MIX, KPL> sa, sb;
      float osave = 0.f;
      load_step<MIX, KPL>(qkdv, scal, 0, kg, col, sa);
      for (int t = 0; t < ntok; t += 2) {
        load_step<MIX, KPL>(qkdv, scal, t + 1, kg, col, sb);
        __builtin_amdgcn_sched_barrier(0);
        const float oa = do_step<MIX, KPL, KG>(sa, S, gam);
        osave = (kg == (t & (KG - 1))) ? oa : osave;
        load_step<MIX, KPL>(qkdv, scal, min(t + 2, ntok - 1), kg, col, sa);
        __builtin_amdgcn_sched_barrier(0);
        const float ob = do_step<MIX, KPL, KG>(sb, S, gam);
        osave = (kg == ((t + 1) & (KG - 1))) ? ob : osave;
        if (((t + 2) & (KG - 1)) == 0) obuf[(t + 2 - KG + kg) * CW + col] = osave;
      }
      const int remn = ntok & (KG - 1);
      if (remn != 0 && kg < remn) obuf[(ntok - remn + kg) * CW + col] = osave;
    }
    __syncthreads();
    if (valid) {
      float o[VN];
#pragma unroll
      for (int i = 0; i < VN; ++i) o[i] = obuf[tt * CW + sub * VN + i];
      float s1 = 0.f, s2 = 0.f;
#pragma unroll
      for (int i = 0; i < VN; ++i) { s1 += o[i]; s2 += o[i] * o[i]; }
      s1 = red8d(s1); s2 = red8d(s2);
      if (VN == 4) { uint2 o2; o2.x = pk2(o[0], o[1]); o2.y = pk2(o[2 % VN], o[3 % VN]); *(uint2*)(Ob + (size_t)(t0 + tt) * 1024 + sub * 4) = o2; }
      else *(unsigned*)(Ob + (size_t)(t0 + tt) * 1024 + sub * 2) = pk2(o[0], o[1]);
      if (sub == 0) *(float2*)(PS + (size_t)(t0 + tt) * 128) = make_float2(s1, s2);
    }
  }
  {
    const size_t obase = (MIX == 0) ? (smp ? O_DS : O_DP) : (MIX == 1) ? (smp ? O_HS : O_HP) : (MIX == 2) ? (smp ? O_GS : O_GP) : (smp ? O_RS : O_RP);
    float* so = p.O() + obase + ((size_t)(layer * nBatch + b) * 4 + h) * DK * 64 + part * CW;
#pragma unroll
    for (int i = 0; i < KPL; ++i) so[(kg * KPL + i) * 64 + col] = S[i];
  }
  if (MIX == 0) {
    float* co = p.O() + (smp ? O_CS : O_CP) + (size_t)(layer * nBatch + b) * 3 * 768;
    for (int e = tid; e < 3 * RS; e += 256) { const int j = e / RS, r = e % RS;
      const float v = bflo((unsigned)rawb[(ntok_last + j) * RS + r]);
      if (r < 128) { if (part == 0) co[j * 768 + ((r < 64) ? (h * 64 + r) : (256 + h * 64 + r - 64))] = v; }
      else co[j * 768 + 512 + h * 64 + part * CW + r - 128] = v; }
  }
  __syncthreads();
  }
}

constexpr int ITEMS_PER_SEQ = 40;
__device__ __forceinline__ void scan_dispatch(const Params& p, int layer, int smp, int type, int b0, int bstep, int bend, char* lds, const int tid) {
  const int r = type;
  if (r < 16) scan_part<0>(p, layer, smp, b0, bstep, bend, r >> 2, r & 3, lds, tid);
  else {
    const int r2 = r - 16, mh = 4 + (r2 >> 1), part = r2 & 1, mix = mh >> 2, h = mh & 3;
    if (mix == 1) scan_part<1>(p, layer, smp, b0, bstep, bend, h, part, lds, tid);
    else if (mix == 2) scan_part<2>(p, layer, smp, b0, bstep, bend, h, part, lds, tid);
    else scan_part<3>(p, layer, smp, b0, bstep, bend, h, part, lds, tid);
  }
}

__device__ __forceinline__ int long_item_type(int u, int& b) {
  int type;
  if (u < 64) { b = u >> 3; type = 24 + (u & 7); }
  else if (u < 192) { const int v = u - 64; b = v >> 4; type = v & 15; }
  else if (u < 256) { const int v = u - 192; b = v >> 3; type = 16 + (v & 7); }
  else { const int v = u - 256; b = v >> 3; type = 32 + (v & 7); }
  return type;
}
__device__ __forceinline__ void scan_phase(const Params& p, int layer, char* lds, int bid, int nb, const int tid, const int role, const int ci, const int nprim, const int nsec) {
  constexpr int NPI = NB * ITEMS_PER_SEQ;
  const bool paired = (nprim == 256 && nsec == 256);
  int j = -1, nbs = 1;
  if (paired) {
    int u = -1;
    if (role == 0) u = ci; else if (ci < NPI - 256) u = 256 + ci;
    if (u >= 0) { int b; const int type = long_item_type(u, b); scan_dispatch(p, layer, 0, type, b, 1, b + 1, lds, tid); }
    else { j = ci - (NPI - 256); nbs = 256 - (NPI - 256); }
  } else {
    for (int u = bid; u < NPI; u += nb) { int b; const int type = long_item_type(u, b); scan_dispatch(p, layer, 0, type, b, 1, b + 1, lds, tid); }
    nbs = (nb > NPI) ? nb - NPI : nb; j = (nb > NPI) ? bid - NPI : bid;
  }
  if (j >= 0) {
    const int nsl = (nbs + ITEMS_PER_SEQ - 1) / ITEMS_PER_SEQ;
    for (int jj = j; jj < ITEMS_PER_SEQ * nsl; jj += nbs) scan_dispatch(p, layer, 1, jj % ITEMS_PER_SEQ, jj / ITEMS_PER_SEQ, nsl, NSB, lds, tid);
    if (layer == 0) { __syncthreads(); convert_weights(p, lds, 992 + j, 6720, nbs, tid); }
  }
}

__device__ __forceinline__ void norm_phase(const Params& p, int layer, int bid, int nb, const int tid) {
  bf16_t* O = (bf16_t*)p.O();
  const bf16_t* P = (const bf16_t*)(p.W() + OFF_P);
  const float* PS = (const float*)((const unsigned char*)p.O() + DOUT_PS);
  const int cg8 = tid & 127;
  const int mh = cg8 >> 3, mix = mh >> 2, h = mh & 3, j0 = (cg8 & 7) * 8;
  const int gcol = (mix == 0) ? 776 : (mix == 1) ? 1800 : (mix == 2) ? 2584 : 3608;
  const float* gsrc = (mix == 0) ? p.I(14) : (mix == 1) ? p.I(16) : (mix == 2) ? p.I(19) : p.I(20);
  float g8[8];
#pragma unroll
  for (int i = 0; i < 8; ++i) g8[i] = gsrc[layer * 256 + h * 64 + j0 + i];
  uint4 ovn, gvn; f32x4 psn, ps2n = (f32x4){0.f, 0.f, 0.f, 0.f};
  {
    const int r0 = min(bid * 2 + (tid >> 7), MT - 1);
    ovn = *(const uint4*)(O + (size_t)r0 * 1024 + cg8 * 8);
    gvn = *(const uint4*)(P + (size_t)r0 * DINP + gcol + h * 64 + j0);
    psn = *(const f32x4*)(PS + (size_t)r0 * 128 + mh * 8);
    if (mix == 0) ps2n = *(const f32x4*)(PS + (size_t)r0 * 128 + mh * 8 + 4);
  }
  for (int row = bid * 2 + (tid >> 7); row < MT; row += nb * 2) {
    const uint4 ov = ovn, gv = gvn; const f32x4 ps = psn, ps2 = ps2n;
    {
      const int rn = min(row + nb * 2, MT - 1);
      ovn = *(const uint4*)(O + (size_t)rn * 1024 + cg8 * 8);
      gvn = *(const uint4*)(P + (size_t)rn * DINP + gcol + h * 64 + j0);
      psn = *(const f32x4*)(PS + (size_t)rn * 128 + mh * 8);
      if (mix == 0) ps2n = *(const f32x4*)(PS + (size_t)rn * 128 + mh * 8 + 4);
    }
    float s1 = ps[0] + ps[2], s2 = ps[1] + ps[3];
    if (mix == 0) { s1 += ps2[0] + ps2[2]; s2 += ps2[1] + ps2[3]; }
    float o[8], gt[8]; unpack8(ov, o); unpack8(gv, gt);
    float mu = 0.f, rs;
    if (mix == 3) { mu = s1 * (1.0f / 64.0f); const float var = fmaxf(s2 * (1.0f / 64.0f) - mu * mu, 0.f); rs = rsqrtf(var + 1e-5f); }
    else rs = rsqrtf(s2 * (1.0f / 64.0f) + 1e-6f);
    float r[8];
#pragma unroll
    for (int i = 0; i < 8; ++i) r[i] = (o[i] - mu) * rs * g8[i] * siluf_(gt[i]);
    uint4 o4; o4.x = pk2(r[0], r[1]); o4.y = pk2(r[2], r[3]); o4.z = pk2(r[4], r[5]); o4.w = pk2(r[6], r[7]);
    *(uint4*)(O + (size_t)row * 1024 + cg8 * 8) = o4;
  }
}

constexpr int NPHASE = 17;
__global__ void __launch_bounds__(256, 2) hymba_fwd(Params p_, int ph_lo, int ph_hi) {
  __shared__ __attribute__((aligned(16))) char lds[65536];
  XcdBarrier xb; xb.bar = (unsigned*)(p_.ws + OFF_BAR); xb.x = xb_xcc_id(); xb.nloc = 0u; xb.nx = 0u;
  if (threadIdx.x == 0) (void)xb_add(&xb.bar[XB_XCNT(xb.x)], 1u);
  int role = 0, ci = 0;
  {
    const unsigned key = ((((unsigned)__builtin_amdgcn_s_getreg((31 << 11) | 4)) >> 8) & 0xFFu) | (xb.x << 8);
    if (threadIdx.x == 0) {
      const unsigned slot = xb_add(&xb.bar[CEN_TAB + key], 1u);
      unsigned r;
      if (slot == 0u) { r = xb_add(&xb.bar[CEN_CNT], 1u); __hip_atomic_store(&xb.bar[CEN_TAB2 + key], r + 1u, __ATOMIC_RELAXED, __HIP_MEMORY_SCOPE_AGENT); }
      else { (void)xb_add(&xb.bar[CEN_CNT + 1], 1u); r = 0u; }
      *(volatile unsigned*)(lds) = slot == 0u ? 0u : 1u; *(volatile unsigned*)(lds + 4) = r;
    }
    __syncthreads();
    role = (int)*(volatile unsigned*)(lds); ci = (int)*(volatile unsigned*)(lds + 4);
    __syncthreads();
    role = __builtin_amdgcn_readfirstlane(role); ci = __builtin_amdgcn_readfirstlane(ci);
    if (role != 0) ci = -1 - (int)key;
  }
  int nprim = 0, nsec = 0;
  if (ph_hi < 0) cg::this_grid().sync();
  for (int ph = ph_lo; ph < ph_hi; ++ph) {
    int tid = threadIdx.x, bid = blockIdx.x, nb = gridDim.x;
    asm volatile("" : "+v"(tid));
    asm volatile("" : "+s"(bid), "+s"(nb));
    if (ph > ph_lo) xcd_barrier(xb, tid, (unsigned)nb);
    if (ph == ph_lo + 1) {
      nprim = (int)xb_ld(&xb.bar[CEN_CNT]); nsec = (int)xb_ld(&xb.bar[CEN_CNT + 1]);
      if (role != 0) { const unsigned v = xb_ld(&xb.bar[CEN_TAB2 + (unsigned)(-1 - ci)]); ci = (v > 0u) ? (int)v - 1 : 0; }
      nprim = __builtin_amdgcn_readfirstlane(nprim); nsec = __builtin_amdgcn_readfirstlane(nsec); ci = __builtin_amdgcn_readfirstlane(ci);
    }
    const Params& p = p_;
    if (ph == 0) {
      convert_weights(p, lds, bid, 992, nb, tid);
      embed_ln(p, bid, nb, tid);
      rope_table(p, bid, nb, tid);
    } else {
      const int l = (ph - 1) / 8, s = (ph - 1) % 8;
      const bf16_t* Xb = (const bf16_t*)p.O();
      bf16_t* X1b = (bf16_t*)(p.W() + OFF_X1B);
      bf16_t* Hb = (bf16_t*)(p.W() + OFF_H);
      float* X = (float*)(p.W() + OFF_X);
      if (s == 0) gemm_phase<EPI_BF16>(Xb, 1024, (const bf16_t*)(p.W() + OFF_WIN + l * SZ_WIN), 1024, 1024, DINP / 128, p.W() + OFF_P, DINP, lds, bid, nb, tid);
      else if (s == 1) scan_phase(p, l, lds, bid, nb, tid, role, ci, nprim, nsec);
      else if (s == 2) norm_phase(p, l, bid, nb, tid);
      else if (s == 3) gemm_phase<EPI_RESID>(Xb, 1024, (const bf16_t*)(p.W() + OFF_WOUT + l * SZ_WOUT), 1024, 1024, 8, X, 1024, lds, bid, nb, tid);
      else if (s == 4) ln_phase(p, p.I(22) + l * 1024, p.I(23) + l * 1024, X1b, 0, bid, nb, tid);
      else if (s == 5) gemm_phase<EPI_SWIGLU>(X1b, 1024, (const bf16_t*)(p.W() + OFF_WGU + l * SZ_WGU), 1024, 1024, 44, Hb, DFF, lds, bid, nb, tid);
      else if (s == 6) gemm_phase<EPI_RESID>(Hb, DFF, (const bf16_t*)(p.W() + OFF_WDN + l * SZ_WDN), DFF, DFF, 8, X, 1024, lds, bid, nb, tid);
      else ln_phase(p, p.I(27) + l * 1024, p.I(28) + l * 1024, (bf16_t*)p.O(), l == 1, bid, nb, tid);
    }
  }
}

extern "C" void kernel_launch(void* const* d_in, const int* in_sizes, int n_in, void* d_out, int out_size, void* d_ws, size_t ws_size,
                              hipStream_t stream) {
  (void)in_sizes; (void)out_size;
  if (n_in < 29 || ws_size < WS_NEED) { fprintf(stderr, "bad args: n_in %d ws %zu need %zu\n", n_in, ws_size, (size_t)WS_NEED); return; }
  Params p{};
  for (int i = 0; i < 29; ++i) p.in[i] = (const float*)d_in[i];
  p.out = (float*)d_out;
  p.ws = (unsigned char*)d_ws;
  static int grid_blocks = 0;
  if (!grid_blocks) {
    int dev = 0, cus = 0, per_cu = 0;
    (void)hipGetDevice(&dev);
    (void)hipDeviceGetAttribute(&cus, hipDeviceAttributeMultiprocessorCount, dev);
    (void)hipOccupancyMaxActiveBlocksPerMultiprocessor(&per_cu, hymba_fwd, 256, 0);
    if (per_cu > 2) per_cu = 2;
    if (per_cu < 1) per_cu = 1;
    grid_blocks = cus * per_cu;
  }
  (void)hipMemsetAsync((unsigned char*)d_ws + OFF_BAR, 0, BAR_BYTES, stream);
  int lo = 0, hi = NPHASE;
  void* args[] = {&p, &lo, &hi};
  hipError_t e = hipLaunchCooperativeKernel((void*)hymba_fwd, dim3(grid_blocks), dim3(256), args, 0, stream);
  if (e != hipSuccess) fprintf(stderr, "cooperative launch failed: %s (grid %d)\n", hipGetErrorString(e), grid_blocks);
}
```

```cpp
#include <hip/hip_runtime.h>
#include <hip/hip_cooperative_groups.h>
#include <cstdio>
#include <cstdint>
namespace cg = cooperative_groups;

#ifndef COOP
#define COOP 1
#endif

typedef unsigned short bf16_t;
typedef short bf16x8 __attribute__((ext_vector_type(8)));
typedef float f32x4 __attribute__((ext_vector_type(4)));

constexpr int DM = 1024, NB = 8, TPR = 2064, NSB = 128, TS = 4;
constexpr int MP = NB * TPR;
constexpr int MS = NSB * TS;
constexpr int MT = MP + MS;
constexpr int DIN = 3864, DINP = 3968, DFF = 2816;
constexpr float ALPHA = 1.41421356237309515f;

constexpr size_t SZ_WIN = (size_t)DINP * 1024 * 2, SZ_WOUT = (size_t)1024 * 1024 * 2, SZ_WGU = (size_t)5632 * 1024 * 2, SZ_WDN = (size_t)1024 * 2816 * 2;
constexpr size_t OFF_CS = 0;
constexpr size_t OFF_WIN = 532480;
constexpr size_t OFF_WOUT = OFF_WIN + 2 * SZ_WIN;
constexpr size_t OFF_WGU = OFF_WOUT + 2 * SZ_WOUT;
constexpr size_t OFF_WDN = OFF_WGU + 2 * SZ_WGU;
constexpr size_t OFF_X = OFF_WDN + 2 * SZ_WDN;
constexpr size_t OFF_P = OFF_X + (size_t)MT * 1024 * 4;
constexpr size_t OFF_X1B = OFF_P;
constexpr size_t OFF_H = OFF_P + (size_t)MT * 1024 * 2;
constexpr size_t OFF_BAR = OFF_P + (size_t)MT * DINP * 2;
constexpr int CEN_CNT = 3520, CEN_TAB = 4096, CEN_TAB2 = 8192;
constexpr size_t BAR_BYTES = 12288 * 4;
constexpr size_t WS_NEED = OFF_BAR + BAR_BYTES;
constexpr size_t DOUT_PS = 36000000;

constexpr size_t O_YP = 0, O_YS = 16777216, O_CP = 17301504, O_CS = 17338368, O_DP = 17928192, O_DS = 18190336,
                 O_HP = 22384640, O_HS = 22646784, O_GP = 26841088, O_GS = 26972160, O_RP = 29069312, O_RS = 29331456;

#define GAS __attribute__((address_space(1)))
struct Params {
  const float* in[29];
  float* out;
  unsigned char* ws;
  __device__ __forceinline__ const float* I(int i) const { return (const float*)(const GAS float*)in[i]; }
  __device__ __forceinline__ float* O() const { return (float*)(GAS float*)out; }
  __device__ __forceinline__ unsigned char* W() const { return (unsigned char*)(GAS unsigned char*)ws; }
};

__device__ __forceinline__ unsigned f2bf(float f) {
  unsigned u = __float_as_uint(f);
  u += 0x7fffu + ((u >> 16) & 1u);
  return u >> 16;
}
typedef float f32x2_t __attribute__((ext_vector_type(2)));
typedef __bf16 bf16x2_t __attribute__((ext_vector_type(2)));
__device__ __forceinline__ unsigned pk2(float lo, float hi) { const f32x2_t v = {lo, hi}; const bf16x2_t b = __builtin_convertvector(v, bf16x2_t); return __builtin_bit_cast(unsigned, b); }
__device__ __forceinline__ float bflo(unsigned u) { return __uint_as_float(u << 16); }
__device__ __forceinline__ float bfhi(unsigned u) { return __uint_as_float(u & 0xffff0000u); }
__device__ __forceinline__ void unpack8(const uint4& r, float* x) {
  x[0] = bflo(r.x); x[1] = bfhi(r.x); x[2] = bflo(r.y); x[3] = bfhi(r.y);
  x[4] = bflo(r.z); x[5] = bfhi(r.z); x[6] = bflo(r.w); x[7] = bfhi(r.w);
}
__device__ __forceinline__ float sigmoidf_(float x) { return __builtin_amdgcn_rcpf(1.0f + __expf(-x)); }
__device__ __forceinline__ float siluf_(float x) { return x * __builtin_amdgcn_rcpf(1.0f + __expf(-x)); }
__device__ __forceinline__ float softplusf_(float x) { return fmaxf(x, 0.f) + __logf(1.0f + __expf(-fabsf(x))); }
__device__ __forceinline__ float red8(float x) {
  x += __shfl_xor(x, 1); x += __shfl_xor(x, 2); x += __shfl_xor(x, 4); return x;
}
__device__ __forceinline__ float dpp_x1(float x) {
  return __int_as_float(__builtin_amdgcn_update_dpp(0, __float_as_int(x), 0xB1, 0xF, 0xF, true));
}
__device__ __forceinline__ float dpp_x2(float x) {
  return __int_as_float(__builtin_amdgcn_update_dpp(0, __float_as_int(x), 0x4E, 0xF, 0xF, true));
}
__device__ __forceinline__ float red4(float x) { x += dpp_x1(x); x += dpp_x2(x); return x; }
__device__ __forceinline__ float wave_sum(float x) {
#pragma unroll
  for (int o = 32; o >= 1; o >>= 1) x += __shfl_xor(x, o);
  return x;
}

__device__ __forceinline__ void convert_weights(const Params& p, char* lds, int w0, int w1, int wstep, const int tid) {
  float* tile = (float*)lds;
  for (int w = w0; w < w1; w += wstep) {
    const int l = w / 3360; int r = w % 3360;
    int mat, kt, rt;
    if (r < 992) { mat = 0; kt = r / 62; rt = r % 62; }
    else if (r < 1248) { r -= 992; mat = 1; kt = r / 16; rt = r % 16; }
    else if (r < 2656) { r -= 1248; mat = 2; kt = r / 88; rt = r % 88; }
    else { r -= 2656; mat = 3; kt = r / 16; rt = r % 16; }
    {
      const int r4 = (tid & 15) * 4, R = rt * 64 + r4, kq = tid >> 4;
      const float* src; int ns; bool valid = true;
      if (mat == 0) { const int rho = R & 31, scol = (R & ~31) + 8 * ((rho & 15) >> 2) + 4 * (rho >> 4) + (rho & 3);
        src = p.I(10) + (size_t)l * 1024 * DIN + scol; ns = DIN; valid = scol < DIN; }
      else if (mat == 1) { src = p.I(21) + (size_t)l * 1024 * 1024 + R; ns = 1024; }
      else if (mat == 2) { const int q = R & 63, f = q >> 4, i = q & 15, ty = f & 1, hid = (R >> 6) * 32 + 8 * (i >> 2) + 4 * (f >> 1) + (i & 3);
        src = (ty ? p.I(25) : p.I(24)) + (size_t)l * 1024 * DFF + hid; ns = DFF; }
      else { src = p.I(26) + (size_t)l * DFF * 1024 + R; ns = 1024; }
      f32x4 v[4];
#pragma unroll
      for (int i = 0; i < 4; ++i) v[i] = valid ? *(const f32x4*)(src + (size_t)(kt * 64 + kq + 16 * i) * ns) : (f32x4){0.f, 0.f, 0.f, 0.f};
#pragma unroll
      for (int i = 0; i < 4; ++i) {
        const int k = kq + 16 * i;
        tile[(r4 + 0) * 65 + k] = v[i][0]; tile[(r4 + 1) * 65 + k] = v[i][1]; tile[(r4 + 2) * 65 + k] = v[i][2]; tile[(r4 + 3) * 65 + k] = v[i][3];
      }
    }
    __syncthreads();
    {
      const int rr = tid >> 2, kc = (tid & 3) * 16;
      const int Kd = (mat == 3) ? DFF : 1024;
      bf16_t* base;
      if (mat == 0) base = (bf16_t*)(p.W() + OFF_WIN + l * SZ_WIN);
      else if (mat == 1) base = (bf16_t*)(p.W() + OFF_WOUT + l * SZ_WOUT);
      else if (mat == 2) base = (bf16_t*)(p.W() + OFF_WGU + l * SZ_WGU);
      else base = (bf16_t*)(p.W() + OFF_WDN + l * SZ_WDN);
      bf16_t* dst = base + (size_t)(rt * 64 + rr) * Kd + kt * 64 + kc;
      const float* s = tile + rr * 65 + kc;
      uint4 a, b;
      a.x = pk2(s[0], s[1]); a.y = pk2(s[2], s[3]); a.z = pk2(s[4], s[5]); a.w = pk2(s[6], s[7]);
      b.x = pk2(s[8], s[9]); b.y = pk2(s[10], s[11]); b.z = pk2(s[12], s[13]); b.w = pk2(s[14], s[15]);
      *(uint4*)dst = a; *(uint4*)(dst + 8) = b;
    }
    __syncthreads();
  }
}

__device__ __forceinline__ void ln_row_regs(f32x4 (&v)[4], const float* g, const float* bb, int lane) {
  float s = 0.f;
#pragma unroll
  for (int i = 0; i < 4; ++i) s += (v[i][0] + v[i][1]) + (v[i][2] + v[i][3]);
  const float mu = wave_sum(s) * (1.0f / 1024.0f);
  float q = 0.f;
#pragma unroll
  for (int i = 0; i < 4; ++i) { const f32x4 d = v[i] - mu; q += (d[0] * d[0] + d[1] * d[1]) + (d[2] * d[2] + d[3] * d[3]); }
  const float rs = rsqrtf(wave_sum(q) * (1.0f / 1024.0f) + 1e-5f);
#pragma unroll
  for (int i = 0; i < 4; ++i) {
    const f32x4 gg = *(const f32x4*)(g + lane * 4 + i * 256), b4 = *(const f32x4*)(bb + lane * 4 + i * 256);
    v[i] = (v[i] - mu) * rs * gg + b4;
  }
}

__device__ __forceinline__ void embed_ln(const Params& p, int bid, int nb, const int tid) {
  const int lane = tid & 63, wv = tid >> 6;
  float* X = (float*)(p.W() + OFF_X);
  bf16_t* Xb = (bf16_t*)p.O();
  for (int row = bid * 4 + wv; row < MT; row += nb * 4) {
    const float* src;
    if (row < MP) { const int b = row / TPR, t = row % TPR;
      src = (t < 16) ? p.I(7) + (size_t)t * 1024 : p.I(0) + ((size_t)b * 2048 + (t - 16)) * 1024; }
    else src = p.I(1) + (size_t)(row - MP) * 1024;
    f32x4 v[4];
#pragma unroll
    for (int i = 0; i < 4; ++i) v[i] = *(const f32x4*)(src + lane * 4 + i * 256);
    ln_row_regs(v, p.I(8), p.I(9), lane);
#pragma unroll
    for (int i = 0; i < 4; ++i) {
      *(f32x4*)(X + (size_t)row * 1024 + lane * 4 + i * 256) = v[i];
      uint2 o; o.x = pk2(v[i][0], v[i][1]); o.y = pk2(v[i][2], v[i][3]);
      *(uint2*)(Xb + (size_t)row * 1024 + lane * 4 + i * 256) = o;
    }
  }
}

__device__ __forceinline__ void rope_table(const Params& p, int bid, int nb, const int tid) {
  float2* cs = (float2*)(p.W() + OFF_CS);
  for (int e = bid * 256 + tid; e < 2068 * 32; e += nb * 256) {
    const int idx = e >> 5, i = e & 31;
    const double pos = (idx < 2064) ? (double)idx : (double)(16384 + idx - 2064);
    const double inv = exp(-((double)i / 31.0) * 9.210340371976184);
    const double ang = pos * inv;
    cs[e] = make_float2((float)cos(ang), (float)sin(ang));
  }
}

__device__ __forceinline__ void ln_phase(const Params& p, const float* g, const float* bb, bf16_t* xb, int final_, int bid, int nb, const int tid) {
  const int lane = tid & 63, wv = tid >> 6;
  float* X = (float*)(p.W() + OFF_X);
  f32x4 nx[4];
  {
    const int r0 = min(bid * 4 + wv, MT - 1);
#pragma unroll
    for (int i = 0; i < 4; ++i) nx[i] = *(const f32x4*)(X + (size_t)r0 * 1024 + lane * 4 + i * 256);
  }
  for (int row = bid * 4 + wv; row < MT; row += nb * 4) {
    f32x4 v[4];
#pragma unroll
    for (int i = 0; i < 4; ++i) v[i] = nx[i];
    {
      const int rn = min(row + nb * 4, MT - 1);
#pragma unroll
      for (int i = 0; i < 4; ++i) nx[i] = *(const f32x4*)(X + (size_t)rn * 1024 + lane * 4 + i * 256);
    }
    ln_row_regs(v, g, bb, lane);
    if (!final_) {
#pragma unroll
      for (int i = 0; i < 4; ++i) {
        *(f32x4*)(X + (size_t)row * 1024 + lane * 4 + i * 256) = v[i];
        uint2 o; o.x = pk2(v[i][0], v[i][1]); o.y = pk2(v[i][2], v[i][3]);
        *(uint2*)(xb + (size_t)row * 1024 + lane * 4 + i * 256) = o;
      }
    } else {
      float* dst = nullptr;
      if (row < MP) { const int b = row / TPR, t = row % TPR; if (t >= 16) dst = p.O() + O_YP + ((size_t)b * 2048 + (t - 16)) * 1024; }
      else dst = p.O() + O_YS + (size_t)(row - MP) * 1024;
      if (dst) {
#pragma unroll
        for (int i = 0; i < 4; ++i) *(f32x4*)(dst + lane * 4 + i * 256) = v[i];
      }
    }
  }
}

enum { EPI_BF16 = 0, EPI_RESID = 1, EPI_SWIGLU = 2 };

template <int EPI>
__device__ __forceinline__ void gemm_tile(const bf16_t* __restrict__ A, const int lda, const bf16_t* __restrict__ Bt, const int ldb,
                                          const int K, const int m0, const int n0, void* Cout, const int ldc, char* lds, const int tid) {
  const int wid = tid >> 6, lane = tid & 63, wr = wid >> 1, wc = wid & 1, fr = lane & 15, fq = lane >> 4;
  f32x4 acc[4][4];
#pragma unroll
  for (int m = 0; m < 4; ++m)
#pragma unroll
    for (int n = 0; n < 4; ++n) acc[m][n] = (f32x4){0.f, 0.f, 0.f, 0.f};
  const int nt = K >> 6;
  const int st_row = tid >> 3, st_c = (tid & 7) ^ ((((tid >> 4) & 1) << 2) | ((tid >> 5) & 3));
  auto stage = [&](int kt, int buf) {
#pragma unroll
    for (int i = 0; i < 4; ++i) {
      const int off = tid * 16 + i * 4096, r = st_row + i * 32;
      const bf16_t* ga = A + (size_t)(m0 + r) * lda + kt * 64 + st_c * 8;
      const bf16_t* gb = Bt + (size_t)(n0 + r) * ldb + kt * 64 + st_c * 8;
      __builtin_amdgcn_global_load_lds((const unsigned*)ga, (__attribute__((address_space(3))) unsigned*)(lds + buf * 32768 + off), 16, 0, 0);
      __builtin_amdgcn_global_load_lds((const unsigned*)gb, (__attribute__((address_space(3))) unsigned*)(lds + buf * 32768 + 16384 + off), 16, 0, 0);
    }
  };
  const int fsw = (((fr >> 1) & 1) << 2) | ((fr >> 2) & 3);
  const int xk0 = (fq ^ fsw) << 4, xk1 = ((4 + fq) ^ fsw) << 4;
  stage(0, 0);
  for (int kt = 0; kt < nt; ++kt) {
    asm volatile("s_waitcnt vmcnt(0)" ::: "memory");
    __syncthreads();
    if (kt + 1 < nt) stage(kt + 1, (kt + 1) & 1);
    const char* sa = lds + (kt & 1) * 32768;
    const char* sb = sa + 16384;
    bf16x8 af[2][4], bfr[2][4];
#pragma unroll
    for (int ks = 0; ks < 2; ++ks) {
#pragma unroll
      for (int m = 0; m < 4; ++m) af[ks][m] = *(const bf16x8*)(sa + (wr * 64 + m * 16 + fr) * 128 + (ks ? xk1 : xk0));
#pragma unroll
      for (int n = 0; n < 4; ++n) bfr[ks][n] = *(const bf16x8*)(sb + (wc * 64 + n * 16 + fr) * 128 + (ks ? xk1 : xk0));
    }
#pragma unroll
    for (int ks = 0; ks < 2; ++ks)
#pragma unroll
      for (int m = 0; m < 4; ++m)
#pragma unroll
        for (int n = 0; n < 4; ++n) acc[m][n] = __builtin_amdgcn_mfma_f32_16x16x32_bf16(bfr[ks][n], af[ks][m], acc[m][n], 0, 0, 0);
  }
  if (EPI == EPI_RESID) {
    float* C0 = (float*)Cout + (size_t)(m0 + wr * 64 + fr) * ldc + n0 + wc * 64 + fq * 4;
#pragma unroll
    for (int mh = 0; mh < 2; ++mh) {
      f32x4 xin[2][4];
#pragma unroll
      for (int m = 0; m < 2; ++m)
#pragma unroll
        for (int n = 0; n < 4; ++n) xin[m][n] = *(const f32x4*)(C0 + (size_t)(mh * 2 + m) * 16 * ldc + n * 16);
#pragma unroll
      for (int m = 0; m < 2; ++m)
#pragma unroll
        for (int n = 0; n < 4; ++n) asm volatile("" : "+v"(xin[m][n]));
#pragma unroll
      for (int m = 0; m < 2; ++m)
#pragma unroll
        for (int n = 0; n < 4; ++n) *(f32x4*)(C0 + (size_t)(mh * 2 + m) * 16 * ldc + n * 16) = xin[m][n] * ALPHA + acc[mh * 2 + m][n];
    }
    return;
  }
#pragma unroll
  for (int m = 0; m < 4; ++m) {
    const int row = m0 + wr * 64 + m * 16 + fr;
    if (EPI == EPI_BF16) {
      bf16_t* C = (bf16_t*)Cout + (size_t)row * ldc + n0 + wc * 64 + fq * 8;
#pragma unroll
      for (int pq = 0; pq < 2; ++pq) { uint4 o; o.x = pk2(acc[m][2 * pq][0], acc[m][2 * pq][1]); o.y = pk2(acc[m][2 * pq][2], acc[m][2 * pq][3]);
        o.z = pk2(acc[m][2 * pq + 1][0], acc[m][2 * pq + 1][1]); o.w = pk2(acc[m][2 * pq + 1][2], acc[m][2 * pq + 1][3]); *(uint4*)(C + pq * 32) = o; }
    } else if (EPI == EPI_RESID) {
      float* C = (float*)Cout + (size_t)row * ldc + n0 + wc * 64 + fq * 4;
#pragma unroll
      for (int n = 0; n < 4; ++n) { const f32x4 x = *(const f32x4*)(C + n * 16); *(f32x4*)(C + n * 16) = x * ALPHA + acc[m][n]; }
    } else {
      bf16_t* C = (bf16_t*)Cout + (size_t)row * ldc + (n0 >> 1) + wc * 32 + fq * 8;
      const f32x4 g0 = acc[m][0], u0 = acc[m][1], g1 = acc[m][2], u1 = acc[m][3];
      uint4 o; o.x = pk2(siluf_(g0[0]) * u0[0], siluf_(g0[1]) * u0[1]); o.y = pk2(siluf_(g0[2]) * u0[2], siluf_(g0[3]) * u0[3]);
      o.z = pk2(siluf_(g1[0]) * u1[0], siluf_(g1[1]) * u1[1]); o.w = pk2(siluf_(g1[2]) * u1[2], siluf_(g1[3]) * u1[3]);
      *(uint4*)C = o;
    }
  }
}
template <int EPI>
__device__ __forceinline__ void gemm_phase(const bf16_t* A, int lda, const bf16_t* Bt, int ldb, int K, int ntn, void* C, int ldc, char* lds, int bid, int nb, const int tid) {
  constexpr int GM = 4, nM = MT / 128;
  const int ntiles = nM * ntn, nig = GM * ntn;
  const int pos = (EPI != EPI_SWIGLU && (nb & 7) == 0) ? (bid & 7) * (nb >> 3) + (bid >> 3) : bid;
  for (int L = pos; L < ntiles; L += nb) {
    int mt, nn;
    if (EPI == EPI_SWIGLU) { mt = L / ntn; nn = L % ntn; }
    else { const int gid = L / nig, fm = gid * GM, gsz = min(nM - fm, GM), rem = L - gid * nig; mt = fm + rem % gsz; nn = rem / gsz; }
    gemm_tile<EPI>(A, lda, Bt, ldb, K, mt * 128, nn * 128, C, ldc, lds, tid);
  }
}

#define XB_TMO      128
#define XB_XCNT(j)  (256  + 64 * (j))
#define XB_XSUB(j)  (1280 + 64 * (j))
#define XB_XGEN(j)  (2304 + 64 * (j))
#define XB_TOP      3328
#define XB_TOPGEN   3392
#define XCD_BAR_WORDS 3456
#define XB_SPIN_CAP (1u << 22)
__device__ __forceinline__ unsigned xb_ld(unsigned* p) { return __hip_atomic_load(p, __ATOMIC_RELAXED, __HIP_MEMORY_SCOPE_AGENT); }
__device__ __forceinline__ unsigned xb_add(unsigned* p, unsigned v) { return __hip_atomic_fetch_add(p, v, __ATOMIC_RELAXED, __HIP_MEMORY_SCOPE_AGENT); }
__device__ __forceinline__ unsigned xb_xcc_id() { return (unsigned)__builtin_amdgcn_s_getreg((3 << 11) | 20) & 0xFu; }
#define XB_SPIN(cond, bar) do { unsigned _sp = 0; while (cond) { __builtin_amdgcn_s_sleep(1); \
    if ((++_sp & 255u) == 0u) { if (xb_ld(&(bar)[XB_TMO])) break; if (_sp > XB_SPIN_CAP) { atomicAdd(&(bar)[XB_TMO], 1u); break; } } } } while (0)
struct XcdBarrier { unsigned* bar; unsigned x; unsigned nloc, nx; };
__device__ __forceinline__ void xcd_barrier_complete(unsigned* bar, unsigned x, unsigned G, unsigned& nloc, unsigned& nx) {
  unsigned sum, cnt, mine, sp = 0u;
  for (;;) {
    sum = 0u; cnt = 0u; mine = 0u;
#pragma unroll
    for (unsigned j = 0; j < 16; ++j) { const unsigned c = xb_ld(&bar[XB_XCNT(j)]); sum += c; cnt += (c > 0u) ? 1u : 0u; mine = (j == x) ? c : mine; }
    if (sum == G) break;
    __builtin_amdgcn_s_sleep(1);
    if ((++sp & 255u) == 0u) { if (xb_ld(&bar[XB_TMO])) break; if (sp > XB_SPIN_CAP) { atomicAdd(&bar[XB_TMO], 1u); break; } }
  }
  nloc = mine > 0u ? mine : 1u; nx = cnt > 0u ? cnt : 1u;
}
__device__ __forceinline__ void xcd_barrier(XcdBarrier& b, const int tid, const unsigned G) {
  asm volatile("s_waitcnt vmcnt(0)" ::: "memory");
  __syncthreads();
  if (tid == 0) {
    unsigned* bar = b.bar;
    __builtin_amdgcn_s_waitcnt(0);
    if (b.nloc == 0u) xcd_barrier_complete(bar, b.x, G, b.nloc, b.nx);
    const unsigned nloc = b.nloc, nx = b.nx;
    const unsigned old = xb_add(&bar[XB_XSUB(b.x)], 1u);
    const unsigned gen = old / nloc;
    if (old + 1u == (gen + 1u) * nloc) {
      __builtin_amdgcn_fence(__ATOMIC_RELEASE, "agent");
      asm volatile("s_waitcnt vmcnt(0)" ::: "memory");
      const unsigned og = xb_add(&bar[XB_TOP], 1u);
      const unsigned tg = og / nx;
      if (og + 1u == (tg + 1u) * nx) xb_add(&bar[XB_TOPGEN], 1u);
      else XB_SPIN(xb_ld(&bar[XB_TOPGEN]) == tg, bar);
      __builtin_amdgcn_fence(__ATOMIC_ACQUIRE, "agent");
      xb_add(&bar[XB_XGEN(b.x)], 1u);
      asm volatile("s_waitcnt vmcnt(0)" ::: "memory");
    } else {
      XB_SPIN(xb_ld(&bar[XB_XGEN(b.x)]) == gen, bar);
      __builtin_amdgcn_fence(__ATOMIC_ACQUIRE, "agent");
      asm volatile("s_waitcnt vmcnt(0)" ::: "memory");
    }
  }
  __syncthreads();
}

template <int N, int RS>
__device__ __forceinline__ void convN(const bf16_t* rawb, const float (&w)[4][N], int tt, int off, float (&x)[N]) {
#pragma unroll
  for (int i = 0; i < N; ++i) x[i] = 0.f;
#pragma unroll
  for (int j = 0; j < 4; ++j) {
    float xv[N];
    if (N == 8) { const uint4 rv = *(const uint4*)(rawb + (tt + j) * RS + off); unpack8(rv, xv); }
    else if (N == 4) { const uint2 rv = *(const uint2*)(rawb + (tt + j) * RS + off); xv[0] = bflo(rv.x); xv[1] = bfhi(rv.x); xv[2 % N] = bflo(rv.y); xv[3 % N] = bfhi(rv.y); }
    else { const unsigned rv = *(const unsigned*)(rawb + (tt + j) * RS + off); xv[0] = bflo(rv); xv[1] = bfhi(rv); }
#pragma unroll
    for (int i = 0; i < N; ++i) x[i] += w[j][i] * xv[i];
  }
  if (N == 2) {
#pragma unroll
    for (int i = 0; i < N; ++i) asm volatile("" : "+v"(x[i]));
  }
#pragma unroll
  for (int i = 0; i < N; ++i) x[i] = siluf_(x[i]);
}

template <int MIX, int VN>
__device__ __forceinline__ void load_chunk_fn(const unsigned char* ws, const bf16_t* Pb, const int t, const int T, const int h, const int vcol, const int sub, const int posb,
                                              uint4& R0, uint4& R1, uint2& R2, uint4& R4, uint4& R5, unsigned& ex0, unsigned& ex1) {
  if (t < T) {
    const bf16_t* pr = Pb + (size_t)t * DINP;
    const int vbase = (MIX == 0) ? 512 : (MIX == 1) ? 1544 : (MIX == 2) ? 2312 : 3352;
    if (VN == 4) R2 = *(const uint2*)(pr + vbase + h * 64 + vcol);
    else R2.x = *(const unsigned*)(pr + vbase + h * 64 + vcol);
    if (MIX == 0) {
      R0 = *(const uint4*)(pr + 0 + h * 64 + sub * 8); R1 = *(const uint4*)(pr + 256 + h * 64 + sub * 8);
      ex0 = pr[768 + h]; ex1 = pr[772 + h];
    } else if (MIX == 1) {
      R0 = *(const uint4*)(pr + 1032 + h * 64 + sub * 8); R1 = *(const uint4*)(pr + 1288 + h * 64 + sub * 8);
    } else if (MIX == 2) {
      const uint2 q2 = *(const uint2*)(pr + 2056 + h * 32 + sub * 4), k2 = *(const uint2*)(pr + 2184 + h * 32 + sub * 4);
      R0 = make_uint4(q2.x, q2.y, k2.x, k2.y);
      R1 = *(const uint4*)(pr + 2568); R4 = *(const uint4*)(pr + 2576);
    } else {
      const uint2 ql = *(const uint2*)(pr + 2840 + h * 64 + sub * 4), qh = *(const uint2*)(pr + 2840 + h * 64 + 32 + sub * 4);
      const uint2 kl = *(const uint2*)(pr + 3096 + h * 64 + sub * 4), kh = *(const uint2*)(pr + 3096 + h * 64 + 32 + sub * 4);
      R0 = make_uint4(ql.x, ql.y, qh.x, qh.y); R1 = make_uint4(kl.x, kl.y, kh.x, kh.y);
      const uint4* cs = (const uint4*)(ws + OFF_CS + ((size_t)(posb + t) * 32 + sub * 4) * 8);
      R4 = cs[0]; R5 = cs[1];
    }
  }
}

__device__ __forceinline__ float dpp_hm(float x) {
  return __int_as_float(__builtin_amdgcn_update_dpp(0, __float_as_int(x), 0x141, 0xF, 0xF, true));
}
__device__ __forceinline__ float dpp_rm(float x) {
  return __int_as_float(__builtin_amdgcn_update_dpp(0, __float_as_int(x), 0x140, 0xF, 0xF, true));
}
__device__ __forceinline__ float red8d(float x) { x += dpp_x1(x); x += dpp_x2(x); x += dpp_hm(x); return x; }
template <int KG> __device__ __forceinline__ float redKG(float x) { x = red8d(x); if (KG == 16) x += dpp_rm(x); return x; }

template <int MIX, int KPL>
struct StepIn { float q[KPL], k[KPL], d[KPL]; float v, a, be, qk; };

template <int MIX, int KPL>
__device__ __forceinline__ void load_step(const float* qkdv, const float* scal, int t, int kg, int col, StepIn<MIX, KPL>& s) {
  const float* base = qkdv + t * 256;
#pragma unroll
  for (int i = 0; i < KPL; i += 4) {
    const f32x4 a = *(const f32x4*)(base + kg * KPL + i), b = *(const f32x4*)(base + 64 + kg * KPL + i);
    s.q[i] = a[0]; s.q[i + 1] = a[1]; s.q[i + 2] = a[2]; s.q[i + 3] = a[3];
    s.k[i] = b[0]; s.k[i + 1] = b[1]; s.k[i + 2] = b[2]; s.k[i + 3] = b[3];
    if (MIX == 1 || MIX == 2) { const f32x4 d = *(const f32x4*)(base + 128 + kg * KPL + i); s.d[i] = d[0]; s.d[i + 1] = d[1]; s.d[i + 2] = d[2]; s.d[i + 3] = d[3]; }
  }
  s.v = base[192 + col];
  if (MIX == 0) { const f32x4 c = *(const f32x4*)(scal + t * 4); s.a = c[0]; s.be = c[1]; s.qk = c[2]; }
}

template <int MIX, int KPL, int KG>
__device__ __forceinline__ float do_step(const StepIn<MIX, KPL>& s, float (&S)[KPL], const float gam) {
  if (MIX == 0) {
    float kS0 = 0.f, kS1 = 0.f, qS0 = 0.f, qS1 = 0.f;
#pragma unroll
    for (int i = 0; i < KPL; i += 2) { kS0 += s.k[i] * S[i]; kS1 += s.k[i + 1] * S[i + 1]; qS0 += s.q[i] * S[i]; qS1 += s.q[i + 1] * S[i + 1]; }
    const float kS = redKG<KG>(kS0 + kS1), qS = redKG<KG>(qS0 + qS1);
    const float w = s.be * (s.v - s.a * kS);
#pragma unroll
    for (int i = 0; i < KPL; ++i) S[i] = s.a * S[i] + s.k[i] * w;
    return s.a * qS + s.qk * w;
  } else {
    float o0 = 0.f, o1 = 0.f;
#pragma unroll
    for (int i = 0; i < KPL; i += 2) {
      const float d0 = (MIX == 3) ? gam : s.d[i], d1 = (MIX == 3) ? gam : s.d[i + 1];
      S[i] = d0 * S[i] + s.k[i] * s.v; S[i + 1] = d1 * S[i + 1] + s.k[i + 1] * s.v;
      o0 += s.q[i] * S[i]; o1 += s.q[i + 1] * S[i + 1];
    }
    return redKG<KG>(o0 + o1);
  }
}

template <int MIX>
__device__ __forceinline__ void scan_part(const Params& p, const int layer, const int smp, const int b0, const int bstep, const int bend, const int h, const int part, char* lds, const int tid) {
  constexpr int DK = (MIX == 2) ? 32 : 64;
  constexpr int NS = (MIX == 0) ? 4 : 2;
  constexpr int CW = 64 / NS;
  constexpr int CPW = CW / 4;
  constexpr int KG = 64 / CPW;
  constexpr int KPL = DK / KG;
  constexpr int VN = CW / 8;
  constexpr int RS = 128 + CW;
  float* qkdv = (float*)lds;
  float* obuf = (float*)(lds + 32768);
  float* scal = (float*)(lds + 36864);
  bf16_t* rawb = (bf16_t*)(lds + 37376);
  float* cwl = (float*)(lds + 48576);
  float* wgl = (float*)(lds + 37376);

  const int lane = tid & 63, wv = tid >> 6;
  const int tt = tid >> 3, sub = tid & 7;
  const int col = wv * CPW + lane / KG, kg = lane % KG;
  const int T = smp ? 4 : TPR;
  const int nBatch = smp ? NSB : NB;
  const int posb = smp ? 2064 : 0;
  const int vcol = part * CW + sub * VN;
  __syncthreads();
  float c8[8];
  float Aexp = 0.f, dtb = 0.f, gam = 0.f;
  float cwq[4][8], cwk[4][8];
  if (MIX == 0) {
    Aexp = __expf(p.I(12)[layer * 4 + h]); dtb = p.I(13)[layer * 4 + h];
#pragma unroll
    for (int j = 0; j < 4; ++j) {
      const float* cwp = p.I(11) + (size_t)(layer * 4 + j) * 768;
#pragma unroll
      for (int i = 0; i < 8; ++i) { cwq[j][i] = cwp[h * 64 + sub * 8 + i]; cwk[j][i] = cwp[256 + h * 64 + sub * 8 + i]; }
    }
    for (int e = tid; e < 4 * CW; e += 256) { const int j = e / CW, r = e % CW; cwl[j * RS + 128 + r] = p.I(11)[(size_t)(layer * 4 + j) * 768 + 512 + h * 64 + part * CW + r]; }
  } else if (MIX == 1) {
#pragma unroll
    for (int i = 0; i < 8; ++i) {
      const int d = h * 64 + sub * 8 + i;
      c8[i] = (layer == 0) ? 1.0f : sigmoidf_(p.I(15)[d] - p.I(15)[256 + d]);
    }
  } else if (MIX == 2) {
    for (int e = tid; e < 512; e += 256) { const int r = e >> 5, j = e & 31; wgl[e] = p.I(17)[(size_t)(layer * 16 + r) * 128 + h * 32 + j]; }
#pragma unroll
    for (int i = 0; i < 4; ++i) c8[i] = p.I(18)[layer * 128 + h * 32 + sub * 4 + i];
  } else {
    gam = 1.0f - exp2f(-5.0f - (float)h);
  }
  for (int b = b0; b < bend; b += bstep) {
  const int row0 = smp ? MP + b * 4 : b * TPR;
  const bf16_t* Pb = (const bf16_t*)(p.W() + OFF_P) + (size_t)row0 * DINP;
  bf16_t* Ob = (bf16_t*)p.O() + (size_t)row0 * 1024 + MIX * 256 + h * 64 + part * CW;
  float* PS = (float*)((unsigned char*)p.O() + DOUT_PS) + (size_t)row0 * 128 + (MIX * 4 + h) * 8 + part * 2;
  uint4 R0 = make_uint4(0, 0, 0, 0), R1 = R0, R4 = R0, R5 = R0; uint2 R2 = make_uint2(0, 0); unsigned ex0 = 0, ex1 = 0;
  load_chunk_fn<MIX, VN>(p.W(), Pb, tt, T, h, vcol, sub, posb, R0, R1, R2, R4, R5, ex0, ex1);
  float S[KPL];
  if (smp) {
    const float* sin_ = p.I(3 + MIX) + ((size_t)(layer * NSB + b) * 4 + h) * DK * 64 + part * CW;
#pragma unroll
    for (int i = 0; i < KPL; ++i) S[i] = sin_[(kg * KPL + i) * 64 + col];
  } else {
#pragma unroll
    for (int i = 0; i < KPL; ++i) S[i] = 0.f;
  }
  if (MIX == 0) {
    for (int e = tid; e < 3 * RS; e += 256) { const int j = e / RS, r = e % RS;
      const int cc = (r < 64) ? (h * 64 + r) : (r < 128) ? (256 + h * 64 + r - 64) : (512 + h * 64 + part * CW + r - 128);
      float v = 0.f; if (smp) v = p.I(2)[((size_t)(layer * NSB + b) * 3 + j) * 768 + cc];
      rawb[e] = (bf16_t)f2bf(v); }
  }
  __syncthreads();

  int ntok_last = 0;
  for (int t0 = 0; t0 < T; t0 += 32) {
    const int ntok = min(32, T - t0);
    ntok_last = ntok;
    const bool valid = tt < ntok;
    float* dst = qkdv + tt * 256;
    if (MIX != 0 && valid) {
      if (VN == 4) *(f32x4*)(dst + 192 + sub * 4) = (f32x4){bflo(R2.x), bfhi(R2.x), bflo(R2.y), bfhi(R2.y)};
      else *(float2*)(dst + 192 + sub * 2) = make_float2(bflo(R2.x), bfhi(R2.x));
    }
    if (MIX == 0) {
      if (valid) {
        *(uint4*)(rawb + (3 + tt) * RS + 0 + sub * 8) = R0;
        *(uint4*)(rawb + (3 + tt) * RS + 64 + sub * 8) = R1;
        if (VN == 4) *(uint2*)(rawb + (3 + tt) * RS + 128 + sub * 4) = R2;
        else *(unsigned*)(rawb + (3 + tt) * RS + 128 + sub * 2) = R2.x;
      }
      __syncthreads();
      if (valid) {
        float xq[8], xk[8], xv[VN];
        { float cwv[4][VN];
#pragma unroll
          for (int j = 0; j < 4; ++j)
#pragma unroll
            for (int i = 0; i < VN; ++i) cwv[j][i] = cwl[j * RS + 128 + sub * VN + i];
          convN<VN, RS>(rawb, cwv, tt, 128 + sub * VN, xv); }
        convN<8, RS>(rawb, cwq, tt, sub * 8, xq);
        convN<8, RS>(rawb, cwk, tt, 64 + sub * 8, xk);
#pragma unroll
        for (int i = 0; i < VN; ++i) dst[192 + sub * VN + i] = xv[i];
        float ssq = 0.f, ssk = 0.f;
#pragma unroll
        for (int i = 0; i < 8; ++i) { ssq += xq[i] * xq[i]; ssk += xk[i] * xk[i]; }
        ssq = red8d(ssq); ssk = red8d(ssk);
        const float rq = rsqrtf(ssq + 1e-6f) * 0.125f, rk = rsqrtf(ssk + 1e-6f);
        float qk = 0.f;
#pragma unroll
        for (int i = 0; i < 8; ++i) { xq[i] *= rq; xk[i] *= rk; qk += xq[i] * xk[i]; }
        qk = red8d(qk);
        *(f32x4*)(dst + sub * 8) = (f32x4){xq[0], xq[1], xq[2], xq[3]}; *(f32x4*)(dst + sub * 8 + 4) = (f32x4){xq[4], xq[5], xq[6], xq[7]};
        *(f32x4*)(dst + 64 + sub * 8) = (f32x4){xk[0], xk[1], xk[2], xk[3]}; *(f32x4*)(dst + 64 + sub * 8 + 4) = (f32x4){xk[4], xk[5], xk[6], xk[7]};
        if (sub == 0) {
          const float be = sigmoidf_(bflo(ex0)), al = bflo(ex1);
          const float a = __expf(-Aexp * softplusf_(al + dtb));
          *(f32x4*)(scal + tt * 4) = (f32x4){a, be, qk, 0.f};
        }
      }
    } else if (MIX == 1) {
      if (valid) {
        float q[8], z[8]; unpack8(R0, q); unpack8(R1, z);
        float kk[8], dd[8];
#pragma unroll
        for (int i = 0; i < 8; ++i) { q[i] = siluf_(q[i]); kk[i] = c8[i] * sigmoidf_(-z[i]); dd[i] = 1.0f - fminf(kk[i], 1.0f - 1e-6f); }
        *(f32x4*)(dst + sub * 8) = (f32x4){q[0], q[1], q[2], q[3]}; *(f32x4*)(dst + sub * 8 + 4) = (f32x4){q[4], q[5], q[6], q[7]};
        *(f32x4*)(dst + 64 + sub * 8) = (f32x4){kk[0], kk[1], kk[2], kk[3]}; *(f32x4*)(dst + 64 + sub * 8 + 4) = (f32x4){kk[4], kk[5], kk[6], kk[7]};
        *(f32x4*)(dst + 128 + sub * 8) = (f32x4){dd[0], dd[1], dd[2], dd[3]}; *(f32x4*)(dst + 128 + sub * 8 + 4) = (f32x4){dd[4], dd[5], dd[6], dd[7]};
      }
    } else if (MIX == 2) {
      if (valid) {
        float lr[16]; unpack8(R1, lr); unpack8(R4, lr + 8);
        const float q0 = bflo(R0.x), q1 = bfhi(R0.x), q2 = bflo(R0.y), q3 = bfhi(R0.y);
        const float k0 = bflo(R0.z), k1 = bfhi(R0.z), k2 = bflo(R0.w), k3 = bfhi(R0.w);
        const float sc = 0.17677669529663687f;
        f32x4 xg = (f32x4){c8[0], c8[1], c8[2], c8[3]};
#pragma unroll
        for (int r = 0; r < 16; ++r) xg += lr[r] * *(const f32x4*)(wgl + r * 32 + sub * 4);
        f32x4 dd;
#pragma unroll
        for (int i = 0; i < 4; ++i) { const float ls = fminf(xg[i], 0.f) - __logf(1.0f + __expf(-fabsf(xg[i]))); dd[i] = __expf(ls * 0.0625f); }
        *(f32x4*)(dst + sub * 4) = (f32x4){q0 * sc, q1 * sc, q2 * sc, q3 * sc};
        *(f32x4*)(dst + 64 + sub * 4) = (f32x4){k0, k1, k2, k3};
        *(f32x4*)(dst + 128 + sub * 4) = dd;
      }
    } else {
      if (valid) {
        const float ql[4] = {bflo(R0.x), bfhi(R0.x), bflo(R0.y), bfhi(R0.y)}, qh[4] = {bflo(R0.z), bfhi(R0.z), bflo(R0.w), bfhi(R0.w)};
        const float kl[4] = {bflo(R1.x), bfhi(R1.x), bflo(R1.y), bfhi(R1.y)}, kh[4] = {bflo(R1.z), bfhi(R1.z), bflo(R1.w), bfhi(R1.w)};
        const float cc[4] = {__uint_as_float(R4.x), __uint_as_float(R4.z), __uint_as_float(R5.x), __uint_as_float(R5.z)};
        const float sn[4] = {__uint_as_float(R4.y), __uint_as_float(R4.w), __uint_as_float(R5.y), __uint_as_float(R5.w)};
        f32x4 qa, qb, ka, kb;
#pragma unroll
        for (int i = 0; i < 4; ++i) {
          qa[i] = ql[i] * cc[i] - qh[i] * sn[i]; qb[i] = ql[i] * sn[i] + qh[i] * cc[i];
          ka[i] = (kl[i] * cc[i] - kh[i] * sn[i]) * 0.125f; kb[i] = (kl[i] * sn[i] + kh[i] * cc[i]) * 0.125f;
        }
        *(f32x4*)(dst + sub * 4) = qa; *(f32x4*)(dst + 32 + sub * 4) = qb;
        *(f32x4*)(dst + 64 + sub * 4) = ka; *(f32x4*)(dst + 96 + sub * 4) = kb;
      }
    }
    __syncthreads();
    if (MIX == 0 && t0 + 32 < T) {
      if (tid < 3 * RS / 8) { const uint4 v = *(const uint4*)(rawb + 32 * RS + tid * 8); *(uint4*)(rawb + tid * 8) = v; }
    }
    if (t0 + 32 < T) load_chunk_fn<MIX, VN>(p.W(), Pb, t0 + 32 + tt, T, h, vcol, sub, posb, R0, R1, R2, R4, R5, ex0, ex1);
    {
      StepIn<MIX, KPL> sa, sb;
      float osave = 0.f;
      load_step<MIX, KPL>(qkdv, scal, 0, kg, col, sa);
      for (int t = 0; t < ntok; t += 2) {
        load_step<MIX, KPL>(qkdv, scal, t + 1, kg, col, sb);
        __builtin_amdgcn_sched_barrier(0);
        const float oa = do_step<MIX, KPL, KG>(sa, S, gam);
        osave = (kg == (t & (KG - 1))) ? oa : osave;
        load_step<MIX, KPL>(qkdv, scal, min(t + 2, ntok - 1), kg, col, sa);
        __builtin_amdgcn_sched_barrier(0);
        const float ob = do_step<MIX, KPL, KG>(sb, S, gam);
        osave = (kg == ((t + 1) & (KG - 1))) ? ob : osave;
        if (((t + 2) & (KG - 1)) == 0) obuf[(t + 2 - KG + kg) * CW + col] = osave;
      }
      const int remn = ntok & (KG - 1);
      if (remn != 0 && kg < remn) obuf[(ntok - remn + kg) * CW + col] = osave;
    }
    __syncthreads();
    if (valid) {
      float o[VN];
#pragma unroll
      for (int i = 0; i < VN; ++i) o[i] = obuf[tt * CW + sub * VN + i];
      float s1 = 0.f, s2 = 0.f;
#pragma unroll
      for (int i = 0; i < VN; ++i) { s1 += o[i]; s2 += o[i] * o[i]; }
      s1 = red8d(s1); s2 = red8d(s2);
      if (VN == 4) { uint2 o2; o2.x = pk2(o[0], o[1]); o2.y = pk2(o[2 % VN], o[3 % VN]); *(uint2*)(Ob + (size_t)(t0 + tt) * 1024 + sub * 4) = o2; }
      else *(unsigned*)(Ob + (size_t)(t0 + tt) * 1024 + sub * 2) = pk2(o[0], o[1]);
      if (sub == 0) *(float2*)(PS + (size_t)(t0 + tt) * 128) = make_float2(s1, s2);
    }
  }
  {
    const size_t obase = (MIX == 0) ? (smp ? O_DS : O_DP) : (MIX == 1) ? (smp ? O_HS : O_HP) : (MIX == 2) ? (smp ? O_GS : O_GP) : (smp ? O_RS : O_RP);
    float* so = p.O() + obase + ((size_t)(layer * nBatch + b) * 4 + h) * DK * 64 + part * CW;
#pragma unroll
    for (int i = 0; i < KPL; ++i) so[(kg * KPL + i) * 64 + col] = S[i];
  }
  if (MIX == 0) {
    float* co = p.O() + (smp ? O_CS : O_CP) + (size_t)(layer * nBatch + b) * 3 * 768;
    for (int e = tid; e < 3 * RS; e += 256) { const int j = e / RS, r = e % RS;
      const float v = bflo((unsigned)rawb[(ntok_last + j) * RS + r]);
      if (r < 128) { if (part == 0) co[j * 768 + ((r < 64) ? (h * 64 + r) : (256 + h * 64 + r - 64))] = v; }
      else co[j * 768 + 512 + h * 64 + part * CW + r - 128] = v; }
  }
  __syncthreads();
  }
}

constexpr int ITEMS_PER_SEQ = 40;
__device__ __forceinline__ void scan_dispatch(const Params& p, int layer, int smp, int type, int b0, int bstep, int bend, char* lds, const int tid) {
  const int r = type;
  if (r < 16) scan_part<0>(p, layer, smp, b0, bstep, bend, r >> 2, r & 3, lds, tid);
  else {
    const int r2 = r - 16, mh = 4 + (r2 >> 1), part = r2 & 1, mix = mh >> 2, h = mh & 3;
    if (mix == 1) scan_part<1>(p, layer, smp, b0, bstep, bend, h, part, lds, tid);
    else if (mix == 2) scan_part<2>(p, layer, smp, b0, bstep, bend, h, part, lds, tid);
    else scan_part<3>(p, layer, smp, b0, bstep, bend, h, part, lds, tid);
  }
}

__device__ __forceinline__ int long_item_type(int u, int& b) {
  int type;
  if (u < 64) { b = u >> 3; type = 24 + (u & 7); }
  else if (u < 192) { const int v = u - 64; b = v >> 4; type = v & 15; }
  else if (u < 256) { const int v = u - 192; b = v >> 3; type = 16 + (v & 7); }
  else { const int v = u - 256; b = v >> 3; type = 32 + (v & 7); }
  return type;
}
__device__ __forceinline__ void scan_phase(const Params& p, int layer, char* lds, int bid, int nb, const int tid, const int role, const int ci, const int nprim, const int nsec) {
  constexpr int NPI = NB * ITEMS_PER_SEQ;
  const bool paired = (nprim == 256 && nsec == 256);
  int j = -1, nbs = 1;
  if (paired) {
    int u = -1;
    if (role == 0) u = ci; else if (ci < NPI - 256) u = 256 + ci;
    if (u >= 0) { int b; const int type = long_item_type(u, b); scan_dispatch(p, layer, 0, type, b, 1, b + 1, lds, tid); }
    else { j = ci - (NPI - 256); nbs = 256 - (NPI - 256); }
  } else {
    for (int u = bid; u < NPI; u += nb) { int b; const int type = long_item_type(u, b); scan_dispatch(p, layer, 0, type, b, 1, b + 1, lds, tid); }
    nbs = (nb > NPI) ? nb - NPI : nb; j = (nb > NPI) ? bid - NPI : bid;
  }
  if (j >= 0) {
    const int nsl = (nbs + ITEMS_PER_SEQ - 1) / ITEMS_PER_SEQ;
    for (int jj = j; jj < ITEMS_PER_SEQ * nsl; jj += nbs) scan_dispatch(p, layer, 1, jj % ITEMS_PER_SEQ, jj / ITEMS_PER_SEQ, nsl, NSB, lds, tid);
    if (layer == 0) { __syncthreads(); convert_weights(p, lds, 992 + j, 6720, nbs, tid); }
  }
}

__device__ __forceinline__ void norm_phase(const Params& p, int layer, int bid, int nb, const int tid) {
  bf16_t* O = (bf16_t*)p.O();
  const bf16_t* P = (const bf16_t*)(p.W() + OFF_P);
  const float* PS = (const float*)((const unsigned char*)p.O() + DOUT_PS);
  const int cg8 = tid & 127;
  const int mh = cg8 >> 3, mix = mh >> 2, h = mh & 3, j0 = (cg8 & 7) * 8;
  const int gcol = (mix == 0) ? 776 : (mix == 1) ? 1800 : (mix == 2) ? 2584 : 3608;
  const float* gsrc = (mix == 0) ? p.I(14) : (mix == 1) ? p.I(16) : (mix == 2) ? p.I(19) : p.I(20);
  float g8[8];
#pragma unroll
  for (int i = 0; i < 8; ++i) g8[i] = gsrc[layer * 256 + h * 64 + j0 + i];
  uint4 ovn, gvn; f32x4 psn, ps2n = (f32x4){0.f, 0.f, 0.f, 0.f};
  {
    const int r0 = min(bid * 2 + (tid >> 7), MT - 1);
    ovn = *(const uint4*)(O + (size_t)r0 * 1024 + cg8 * 8);
    gvn = *(const uint4*)(P + (size_t)r0 * DINP + gcol + h * 64 + j0);
    psn = *(const f32x4*)(PS + (size_t)r0 * 128 + mh * 8);
    if (mix == 0) ps2n = *(const f32x4*)(PS + (size_t)r0 * 128 + mh * 8 + 4);
  }
  for (int row = bid * 2 + (tid >> 7); row < MT; row += nb * 2) {
    const uint4 ov = ovn, gv = gvn; const f32x4 ps = psn, ps2 = ps2n;
    {
      const int rn = min(row + nb * 2, MT - 1);
      ovn = *(const uint4*)(O + (size_t)rn * 1024 + cg8 * 8);
      gvn = *(const uint4*)(P + (size_t)rn * DINP + gcol + h * 64 + j0);
      psn = *(const f32x4*)(PS + (size_t)rn * 128 + mh * 8);
      if (mix == 0) ps2n = *(const f32x4*)(PS + (size_t)rn * 128 + mh * 8 + 4);
    }
    float s1 = ps[0] + ps[2], s2 = ps[1] + ps[3];
    if (mix == 0) { s1 += ps2[0] + ps2[2]; s2 += ps2[1] + ps2[3]; }
    float o[8], gt[8]; unpack8(ov, o); unpack8(gv, gt);
    float mu = 0.f, rs;
    if (mix == 3) { mu = s1 * (1.0f / 64.0f); const float var = fmaxf(s2 * (1.0f / 64.0f) - mu * mu, 0.f); rs = rsqrtf(var + 1e-5f); }
    else rs = rsqrtf(s2 * (1.0f / 64.0f) + 1e-6f);
    float r[8];
#pragma unroll
    for (int i = 0; i < 8; ++i) r[i] = (o[i] - mu) * rs * g8[i] * siluf_(gt[i]);
    uint4 o4; o4.x = pk2(r[0], r[1]); o4.y = pk2(r[2], r[3]); o4.z = pk2(r[4], r[5]); o4.w = pk2(r[6], r[7]);
    *(uint4*)(O + (size_t)row * 1024 + cg8 * 8) = o4;
  }
}

constexpr int NPHASE = 17;
__global__ void __launch_bounds__(256, 2) hymba_fwd(Params p_, int ph_lo, int ph_hi) {
  __shared__ __attribute__((aligned(16))) char lds[65536];
  XcdBarrier xb; xb.bar = (unsigned*)(p_.ws + OFF_BAR); xb.x = xb_xcc_id(); xb.nloc = 0u; xb.nx = 0u;
  if (threadIdx.x == 0) (void)xb_add(&xb.bar[XB_XCNT(xb.x)], 1u);
  int role = 0, ci = 0;
  {
    const unsigned key = ((((unsigned)__builtin_amdgcn_s_getreg((31 << 11) | 4)) >> 8) & 0xFFu) | (xb.x << 8);
    if (threadIdx.x == 0) {
      const unsigned slot = xb_add(&xb.bar[CEN_TAB + key], 1u);
      unsigned r;
      if (slot == 0u) { r = xb_add(&xb.bar[CEN_CNT], 1u); __hip_atomic_store(&xb.bar[CEN_TAB2 + key], r + 1u, __ATOMIC_RELAXED, __HIP_MEMORY_SCOPE_AGENT); }
      else { (void)xb_add(&xb.bar[CEN_CNT + 1], 1u); r = 0u; }
      *(volatile unsigned*)(lds) = slot == 0u ? 0u : 1u; *(volatile unsigned*)(lds + 4) = r;
    }
    __syncthreads();
    role = (int)*(volatile unsigned*)(lds); ci = (int)*(volatile unsigned*)(lds + 4);
    __syncthreads();
    role = __builtin_amdgcn_readfirstlane(role); ci = __builtin_amdgcn_readfirstlane(ci);
    if (role != 0) ci = -1 - (int)key;
  }
  int nprim = 0, nsec = 0;
  if (ph_hi < 0) cg::this_grid().sync();
  for (int ph = ph_lo; ph < ph_hi; ++ph) {
    int tid = threadIdx.x, bid = blockIdx.x, nb = gridDim.x;
    asm volatile("" : "+v"(tid));
    asm volatile("" : "+s"(bid), "+s"(nb));
    if (ph > ph_lo) xcd_barrier(xb, tid, (unsigned)nb);
    if (ph == ph_lo + 1) {
      nprim = (int)xb_ld(&xb.bar[CEN_CNT]); nsec = (int)xb_ld(&xb.bar[CEN_CNT + 1]);
      if (role != 0) { const unsigned v = xb_ld(&xb.bar[CEN_TAB2 + (unsigned)(-1 - ci)]); ci = (v > 0u) ? (int)v - 1 : 0; }
      nprim = __builtin_amdgcn_readfirstlane(nprim); nsec = __builtin_amdgcn_readfirstlane(nsec); ci = __builtin_amdgcn_readfirstlane(ci);
    }
    const Params& p = p_;
    if (ph == 0) {
      convert_weights(p, lds, bid, 992, nb, tid);
      embed_ln(p, bid, nb, tid);
      rope_table(p, bid, nb, tid);
    } else {
      const int l = (ph - 1) / 8, s = (ph - 1) % 8;
      const bf16_t* Xb = (const bf16_t*)p.O();
      bf16_t* X1b = (bf16_t*)(p.W() + OFF_X1B);
      bf16_t* Hb = (bf16_t*)(p.W() + OFF_H);
      float* X = (float*)(p.W() + OFF_X);
      if (s == 0) gemm_phase<EPI_BF16>(Xb, 1024, (const bf16_t*)(p.W() + OFF_WIN + l * SZ_WIN), 1024, 1024, DINP / 128, p.W() + OFF_P, DINP, lds, bid, nb, tid);
      else if (s == 1) scan_phase(p, l, lds, bid, nb, tid, role, ci, nprim, nsec);
      else if (s == 2) norm_phase(p, l, bid, nb, tid);
      else if (s == 3) gemm_phase<EPI_RESID>(Xb, 1024, (const bf16_t*)(p.W() + OFF_WOUT + l * SZ_WOUT), 1024, 1024, 8, X, 1024, lds, bid, nb, tid);
      else if (s == 4) ln_phase(p, p.I(22) + l * 1024, p.I(23) + l * 1024, X1b, 0, bid, nb, tid);
      else if (s == 5) gemm_phase<EPI_SWIGLU>(X1b, 1024, (const bf16_t*)(p.W() + OFF_WGU + l * SZ_WGU), 1024, 1024, 44, Hb, DFF, lds, bid, nb, tid);
      else if (s == 6) gemm_phase<EPI_RESID>(Hb, DFF, (const bf16_t*)(p.W() + OFF_WDN + l * SZ_WDN), DFF, DFF, 8, X, 1024, lds, bid, nb, tid);
      else ln_phase(p, p.I(27) + l * 1024, p.I(28) + l * 1024, (bf16_t*)p.O(), l == 1, bid, nb, tid);
    }
  }
}

extern "C" void kernel_launch(void* const* d_in, const int* in_sizes, int n_in, void* d_out, int out_size, void* d_ws, size_t ws_size,
                              hipStream_t stream) {
  (void)in_sizes; (void)out_size;
  if (n_in < 29 || ws_size < WS_NEED) { fprintf(stderr, "bad args: n_in %d ws %zu need %zu\n", n_in, ws_size, (size_t)WS_NEED); return; }
  Params p{};
  for (int i = 0; i < 29; ++i) p.in[i] = (const float*)d_in[i];
  p.out = (float*)d_out;
  p.ws = (unsigned char*)d_ws;
  static int grid_blocks = 0;
  if (!grid_blocks) {
    int dev = 0, cus = 0, per_cu = 0;
    (void)hipGetDevice(&dev);
    (void)hipDeviceGetAttribute(&cus, hipDeviceAttributeMultiprocessorCount, dev);
    (void)hipOccupancyMaxActiveBlocksPerMultiprocessor(&per_cu, hymba_fwd, 256, 0);
    if (per_cu > 2) per_cu = 2;
    if (per_cu < 1) per_cu = 1;
    grid_blocks = cus * per_cu;
  }
  (void)hipMemsetAsync((unsigned char*)d_ws + OFF_BAR, 0, BAR_BYTES, stream);
  int lo = 0, hi = NPHASE;
  void* args[] = {&p, &lo, &hi};
  hipError_t e = hipLaunchCooperativeKernel((void*)hymba_fwd, dim3(grid_blocks), dim3(256), args, 0, stream);
  if (e != hipSuccess) fprintf(stderr, "cooperative launch failed: %s (grid %d)\n", hipGetErrorString(e), grid_blocks);
}
```

```cpp
#include <hip/hip_runtime.h>
#include <hip/hip_cooperative_groups.h>
#include <cstdio>
#include <cstdint>
namespace cg = cooperative_groups;

#ifndef COOP
#define COOP 1
#endif

typedef unsigned short bf16_t;
typedef short bf16x8 __attribute__((ext_vector_type(8)));
typedef float f32x4 __attribute__((ext_vector_type(4)));

constexpr int DM = 1024, NB = 8, TPR = 2064, NSB = 128, TS = 4;
constexpr int MP = NB * TPR;
constexpr int MS = NSB * TS;
constexpr int MT = MP + MS;
constexpr int DIN = 3864, DINP = 3968, DFF = 2816;
constexpr float ALPHA = 1.41421356237309515f;

constexpr size_t SZ_WIN = (size_t)DINP * 1024 * 2, SZ_WOUT = (size_t)1024 * 1024 * 2, SZ_WGU = (size_t)5632 * 1024 * 2, SZ_WDN = (size_t)1024 * 2816 * 2;
constexpr size_t OFF_CS = 0;
constexpr size_t OFF_WIN = 532480;
constexpr size_t OFF_WOUT = OFF_WIN + 2 * SZ_WIN;
constexpr size_t OFF_WGU = OFF_WOUT + 2 * SZ_WOUT;
constexpr size_t OFF_WDN = OFF_WGU + 2 * SZ_WGU;
constexpr size_t OFF_X = OFF_WDN + 2 * SZ_WDN;
constexpr size_t OFF_P = OFF_X + (size_t)MT * 1024 * 4;
constexpr size_t OFF_X1B = OFF_P;
constexpr size_t OFF_H = OFF_P + (size_t)MT * 1024 * 2;
constexpr size_t OFF_BAR = OFF_P + (size_t)MT * DINP * 2;
constexpr int CEN_CNT = 3520, CEN_TAB = 4096, CEN_TAB2 = 8192;
constexpr size_t BAR_BYTES = 12288 * 4;
constexpr size_t WS_NEED = OFF_BAR + BAR_BYTES;
constexpr size_t DOUT_PS = 36000000;

constexpr size_t O_YP = 0, O_YS = 16777216, O_CP = 17301504, O_CS = 17338368, O_DP = 17928192, O_DS = 18190336,
                 O_HP = 22384640, O_HS = 22646784, O_GP = 26841088, O_GS = 26972160, O_RP = 29069312, O_RS = 29331456;

#define GAS __attribute__((address_space(1)))
struct Params {
  const float* in[29];
  float* out;
  unsigned char* ws;
  __device__ __forceinline__ const float* I(int i) const { return (const float*)(const GAS float*)in[i]; }
  __device__ __forceinline__ float* O() const { return (float*)(GAS float*)out; }
  __device__ __forceinline__ unsigned char* W() const { return (unsigned char*)(GAS unsigned char*)ws; }
};

__device__ __forceinline__ unsigned f2bf(float f) {
  unsigned u = __float_as_uint(f);
  u += 0x7fffu + ((u >> 16) & 1u);
  return u >> 16;
}
typedef float f32x2_t __attribute__((ext_vector_type(2)));
typedef __bf16 bf16x2_t __attribute__((ext_vector_type(2)));
__device__ __forceinline__ unsigned pk2(float lo, float hi) { const f32x2_t v = {lo, hi}; const bf16x2_t b = __builtin_convertvector(v, bf16x2_t); return __builtin_bit_cast(unsigned, b); }
__device__ __forceinline__ float bflo(unsigned u) { return __uint_as_float(u << 16); }
__device__ __forceinline__ float bfhi(unsigned u) { return __uint_as_float(u & 0xffff0000u); }
__device__ __forceinline__ void unpack8(const uint4& r, float* x) {
  x[0] = bflo(r.x); x[1] = bfhi(r.x); x[2] = bflo(r.y); x[3] = bfhi(r.y);
  x[4] = bflo(r.z); x[5] = bfhi(r.z); x[6] = bflo(r.w); x[7] = bfhi(r.w);
}
__device__ __forceinline__ float sigmoidf_(float x) { return __builtin_amdgcn_rcpf(1.0f + __expf(-x)); }
__device__ __forceinline__ float siluf_(float x) { return x * __builtin_amdgcn_rcpf(1.0f + __expf(-x)); }
__device__ __forceinline__ float softplusf_(float x) { return fmaxf(x, 0.f) + __logf(1.0f + __expf(-fabsf(x))); }
__device__ __forceinline__ float red8(float x) {
  x += __shfl_xor(x, 1); x += __shfl_xor(x, 2); x += __shfl_xor(x, 4); return x;
}
__device__ __forceinline__ float dpp_x1(float x) {
  return __int_as_float(__builtin_amdgcn_update_dpp(0, __float_as_int(x), 0xB1, 0xF, 0xF, true));
}
__device__ __forceinline__ float dpp_x2(float x) {
  return __int_as_float(__builtin_amdgcn_update_dpp(0, __float_as_int(x), 0x4E, 0xF, 0xF, true));
}
__device__ __forceinline__ float red4(float x) { x += dpp_x1(x); x += dpp_x2(x); return x; }
__device__ __forceinline__ float wave_sum(float x) {
#pragma unroll
  for (int o = 32; o >= 1; o >>= 1) x += __shfl_xor(x, o);
  return x;
}

__device__ __forceinline__ void convert_weights(const Params& p, char* lds, int w0, int w1, int wstep, const int tid) {
  float* tile = (float*)lds;
  for (int w = w0; w < w1; w += wstep) {
    const int l = w / 3360; int r = w % 3360;
    int mat, kt, rt;
    if (r < 992) { mat = 0; kt = r / 62; rt = r % 62; }
    else if (r < 1248) { r -= 992; mat = 1; kt = r / 16; rt = r % 16; }
    else if (r < 2656) { r -= 1248; mat = 2; kt = r / 88; rt = r % 88; }
    else { r -= 2656; mat = 3; kt = r / 16; rt = r % 16; }
    {
      const int r4 = (tid & 15) * 4, R = rt * 64 + r4, kq = tid >> 4;
      const float* src; int ns; bool valid = true;
      if (mat == 0) { const int rho = R & 31, scol = (R & ~31) + 8 * ((rho & 15) >> 2) + 4 * (rho >> 4) + (rho & 3);
        src = p.I(10) + (size_t)l * 1024 * DIN + scol; ns = DIN; valid = scol < DIN; }
      else if (mat == 1) { src = p.I(21) + (size_t)l * 1024 * 1024 + R; ns = 1024; }
      else if (mat == 2) { const int q = R & 63, f = q >> 4, i = q & 15, ty = f & 1, hid = (R >> 6) * 32 + 8 * (i >> 2) + 4 * (f >> 1) + (i & 3);
        src = (ty ? p.I(25) : p.I(24)) + (size_t)l * 1024 * DFF + hid; ns = DFF; }
      else { src = p.I(26) + (size_t)l * DFF * 1024 + R; ns = 1024; }
      f32x4 v[4];
#pragma unroll
      for (int i = 0; i < 4; ++i) v[i] = valid ? *(const f32x4*)(src + (size_t)(kt * 64 + kq + 16 * i) * ns) : (f32x4){0.f, 0.f, 0.f, 0.f};
#pragma unroll
      for (int i = 0; i < 4; ++i) {
        const int k = kq + 16 * i;
        tile[(r4 + 0) * 65 + k] = v[i][0]; tile[(r4 + 1) * 65 + k] = v[i][1]; tile[(r4 + 2) * 65 + k] = v[i][2]; tile[(r4 + 3) * 65 + k] = v[i][3];
      }
    }
    __syncthreads();
    {
      const int rr = tid >> 2, kc = (tid & 3) * 16;
      const int Kd = (mat == 3) ? DFF : 1024;
      bf16_t* base;
      if (mat == 0) base = (bf16_t*)(p.W() + OFF_WIN + l * SZ_WIN);
      else if (mat == 1) base = (bf16_t*)(p.W() + OFF_WOUT + l * SZ_WOUT);
      else if (mat == 2) base = (bf16_t*)(p.W() + OFF_WGU + l * SZ_WGU);
      else base = (bf16_t*)(p.W() + OFF_WDN + l * SZ_WDN);
      bf16_t* dst = base + (size_t)(rt * 64 + rr) * Kd + kt * 64 + kc;
      const float* s = tile + rr * 65 + kc;
      uint4 a, b;
      a.x = pk2(s[0], s[1]); a.y = pk2(s[2], s[3]); a.z = pk2(s[4], s[5]); a.w = pk2(s[6], s[7]);
      b.x = pk2(s[8], s[9]); b.y = pk2(s[10], s[11]); b.z = pk2(s[12], s[13]); b.w = pk2(s[14], s[15]);
      *(uint4*)dst = a; *(uint4*)(dst + 8) = b;
    }
    __syncthreads();
  }
}

__device__ __forceinline__ void ln_row_regs(f32x4 (&v)[4], const float* g, const float* bb, int lane) {
  float s = 0.f;
#pragma unroll
  for (int i = 0; i < 4; ++i) s += (v[i][0] + v[i][1]) + (v[i][2] + v[i][3]);
  const float mu = wave_sum(s) * (1.0f / 1024.0f);
  float q = 0.f;
#pragma unroll
  for (int i = 0; i < 4; ++i) { const f32x4 d = v[i] - mu; q += (d[0] * d[0] + d[1] * d[1]) + (d[2] * d[2] + d[3] * d[3]); }
  const float rs = rsqrtf(wave_sum(q) * (1.0f / 1024.0f) + 1e-5f);
#pragma unroll
  for (int i = 0; i < 4; ++i) {
    const f32x4 gg = *(const f32x4*)(g + lane * 4 + i * 256), b4 = *(const f32x4*)(bb + lane * 4 + i * 256);
    v[i] = (v[i] - mu) * rs * gg + b4;
  }
}

__device__ __forceinline__ void embed_ln(const Params& p, int bid, int nb, const int tid) {
  const int lane = tid & 63, wv = tid >> 6;
  float* X = (float*)(p.W() + OFF_X);
  bf16_t* Xb = (bf16_t*)p.O();
  auto src_of = [&](int row) -> const float* {
    if (row < MP) { const int b = row / TPR, t = row % TPR;
      return (t < 16) ? p.I(7) + (size_t)t * 1024 : p.I(0) + ((size_t)b * 2048 + (t - 16)) * 1024; }
    return p.I(1) + (size_t)(row - MP) * 1024;
  };
  f32x4 nx[4];
  { const float* s0 = src_of(min(bid * 4 + wv, MT - 1));
#pragma unroll
    for (int i = 0; i < 4; ++i) nx[i] = *(const f32x4*)(s0 + lane * 4 + i * 256); }
  for (int row = bid * 4 + wv; row < MT; row += nb * 4) {
    f32x4 v[4];
#pragma unroll
    for (int i = 0; i < 4; ++i) v[i] = nx[i];
    { const float* s1 = src_of(min(row + nb * 4, MT - 1));
#pragma unroll
      for (int i = 0; i < 4; ++i) nx[i] = *(const f32x4*)(s1 + lane * 4 + i * 256); }
    ln_row_regs(v, p.I(8), p.I(9), lane);
#pragma unroll
    for (int i = 0; i < 4; ++i) {
      *(f32x4*)(X + (size_t)row * 1024 + lane * 4 + i * 256) = v[i];
      uint2 o; o.x = pk2(v[i][0], v[i][1]); o.y = pk2(v[i][2], v[i][3]);
      *(uint2*)(Xb + (size_t)row * 1024 + lane * 4 + i * 256) = o;
    }
  }
}

__device__ __forceinline__ void rope_table(const Params& p, int bid, int nb, const int tid) {
  float2* cs = (float2*)(p.W() + OFF_CS);
  for (int e = bid * 256 + tid; e < 2068 * 32; e += nb * 256) {
    const int idx = e >> 5, i = e & 31;
    const double pos = (idx < 2064) ? (double)idx : (double)(16384 + idx - 2064);
    const double inv = exp(-((double)i / 31.0) * 9.210340371976184);
    const double ang = pos * inv;
    cs[e] = make_float2((float)cos(ang), (float)sin(ang));
  }
}

__device__ __forceinline__ void ln_phase(const Params& p, const float* g, const float* bb, bf16_t* xb, int final_, int bid, int nb, const int tid) {
  const int lane = tid & 63, wv = tid >> 6;
  float* X = (float*)(p.W() + OFF_X);
  f32x4 nx[4], nx2[4];
  {
    const int r0 = min(bid * 4 + wv, MT - 1), r1 = min(bid * 4 + wv + nb * 4, MT - 1);
#pragma unroll
    for (int i = 0; i < 4; ++i) nx[i] = *(const f32x4*)(X + (size_t)r0 * 1024 + lane * 4 + i * 256);
#pragma unroll
    for (int i = 0; i < 4; ++i) nx2[i] = *(const f32x4*)(X + (size_t)r1 * 1024 + lane * 4 + i * 256);
  }
  for (int row = bid * 4 + wv; row < MT; row += nb * 4) {
    f32x4 v[4];
#pragma unroll
    for (int i = 0; i < 4; ++i) { v[i] = nx[i]; nx[i] = nx2[i]; }
    {
      const int rn = min(row + nb * 8, MT - 1);
#pragma unroll
      for (int i = 0; i < 4; ++i) nx2[i] = *(const f32x4*)(X + (size_t)rn * 1024 + lane * 4 + i * 256);
    }
    ln_row_regs(v, g, bb, lane);
    if (!final_) {
#pragma unroll
      for (int i = 0; i < 4; ++i) {
        *(f32x4*)(X + (size_t)row * 1024 + lane * 4 + i * 256) = v[i];
        uint2 o; o.x = pk2(v[i][0], v[i][1]); o.y = pk2(v[i][2], v[i][3]);
        *(uint2*)(xb + (size_t)row * 1024 + lane * 4 + i * 256) = o;
      }
    } else {
      float* dst = nullptr;
      if (row < MP) { const int b = row / TPR, t = row % TPR; if (t >= 16) dst = p.O() + O_YP + ((size_t)b * 2048 + (t - 16)) * 1024; }
      else dst = p.O() + O_YS + (size_t)(row - MP) * 1024;
      if (dst) {
#pragma unroll
        for (int i = 0; i < 4; ++i) *(f32x4*)(dst + lane * 4 + i * 256) = v[i];
      }
    }
  }
}

enum { EPI_BF16 = 0, EPI_RESID = 1, EPI_SWIGLU = 2 };

template <int EPI>
__device__ __forceinline__ void gemm_tile(const bf16_t* __restrict__ A, const int lda, const bf16_t* __restrict__ Bt, const int ldb,
                                          const int K, const int m0, const int n0, void* Cout, const int ldc, char* lds, const int tid) {
  const int wid = tid >> 6, lane = tid & 63, wr = wid >> 1, wc = wid & 1, fr = lane & 15, fq = lane >> 4;
  f32x4 acc[4][4];
#pragma unroll
  for (int m = 0; m < 4; ++m)
#pragma unroll
    for (int n = 0; n < 4; ++n) acc[m][n] = (f32x4){0.f, 0.f, 0.f, 0.f};
  const int nt = K >> 6;
  const int st_row = tid >> 3, st_c = (tid & 7) ^ ((((tid >> 4) & 1) << 2) | ((tid >> 5) & 3));
  auto stage = [&](int kt, int buf) {
#pragma unroll
    for (int i = 0; i < 4; ++i) {
      const int off = tid * 16 + i * 4096, r = st_row + i * 32;
      const bf16_t* ga = A + (size_t)(m0 + r) * lda + kt * 64 + st_c * 8;
      const bf16_t* gb = Bt + (size_t)(n0 + r) * ldb + kt * 64 + st_c * 8;
      __builtin_amdgcn_global_load_lds((const unsigned*)ga, (__attribute__((address_space(3))) unsigned*)(lds + buf * 32768 + off), 16, 0, 0);
      __builtin_amdgcn_global_load_lds((const unsigned*)gb, (__attribute__((address_space(3))) unsigned*)(lds + buf * 32768 + 16384 + off), 16, 0, 0);
    }
  };
  const int fsw = (((fr >> 1) & 1) << 2) | ((fr >> 2) & 3);
  const int xk0 = (fq ^ fsw) << 4, xk1 = ((4 + fq) ^ fsw) << 4;
  stage(0, 0);
  for (int kt = 0; kt < nt; ++kt) {
    asm volatile("s_waitcnt vmcnt(0)" ::: "memory");
    __syncthreads();
    if (kt + 1 < nt) stage(kt + 1, (kt + 1) & 1);
    const char* sa = lds + (kt & 1) * 32768;
    const char* sb = sa + 16384;
    bf16x8 af[2][4], bfr[2][4];
#pragma unroll
    for (int ks = 0; ks < 2; ++ks) {
#pragma unroll
      for (int m = 0; m < 4; ++m) af[ks][m] = *(const bf16x8*)(sa + (wr * 64 + m * 16 + fr) * 128 + (ks ? xk1 : xk0));
#pragma unroll
      for (int n = 0; n < 4; ++n) bfr[ks][n] = *(const bf16x8*)(sb + (wc * 64 + n * 16 + fr) * 128 + (ks ? xk1 : xk0));
    }
#pragma unroll
    for (int ks = 0; ks < 2; ++ks)
#pragma unroll
      for (int m = 0; m < 4; ++m)
#pragma unroll
        for (int n = 0; n < 4; ++n) acc[m][n] = __builtin_amdgcn_mfma_f32_16x16x32_bf16(bfr[ks][n], af[ks][m], acc[m][n], 0, 0, 0);
  }
  if (EPI == EPI_RESID) {
    float* C0 = (float*)Cout + (size_t)(m0 + wr * 64 + fr) * ldc + n0 + wc * 64 + fq * 4;
#pragma unroll
    for (int mh = 0; mh < 2; ++mh) {
      f32x4 xin[2][4];
#pragma unroll
      for (int m = 0; m < 2; ++m)
#pragma unroll
        for (int n = 0; n < 4; ++n) xin[m][n] = *(const f32x4*)(C0 + (size_t)(mh * 2 + m) * 16 * ldc + n * 16);
#pragma unroll
      for (int m = 0; m < 2; ++m)
#pragma unroll
        for (int n = 0; n < 4; ++n) asm volatile("" : "+v"(xin[m][n]));
#pragma unroll
      for (int m = 0; m < 2; ++m)
#pragma unroll
        for (int n = 0; n < 4; ++n) *(f32x4*)(C0 + (size_t)(mh * 2 + m) * 16 * ldc + n * 16) = xin[m][n] * ALPHA + acc[mh * 2 + m][n];
    }
    return;
  }
#pragma unroll
  for (int m = 0; m < 4; ++m) {
    const int row = m0 + wr * 64 + m * 16 + fr;
    if (EPI == EPI_BF16) {
      bf16_t* C = (bf16_t*)Cout + (size_t)row * ldc + n0 + wc * 64 + fq * 8;
#pragma unroll
      for (int pq = 0; pq < 2; ++pq) { uint4 o; o.x = pk2(acc[m][2 * pq][0], acc[m][2 * pq][1]); o.y = pk2(acc[m][2 * pq][2], acc[m][2 * pq][3]);
        o.z = pk2(acc[m][2 * pq + 1][0], acc[m][2 * pq + 1][1]); o.w = pk2(acc[m][2 * pq + 1][2], acc[m][2 * pq + 1][3]); *(uint4*)(C + pq * 32) = o; }
    } else if (EPI == EPI_RESID) {
      float* C = (float*)Cout + (size_t)row * ldc + n0 + wc * 64 + fq * 4;
#pragma unroll
      for (int n = 0; n < 4; ++n) { const f32x4 x = *(const f32x4*)(C + n * 16); *(f32x4*)(C + n * 16) = x * ALPHA + acc[m][n]; }
    } else {
      bf16_t* C = (bf16_t*)Cout + (size_t)row * ldc + (n0 >> 1) + wc * 32 + fq * 8;
      const f32x4 g0 = acc[m][0], u0 = acc[m][1], g1 = acc[m][2], u1 = acc[m][3];
      uint4 o; o.x = pk2(siluf_(g0[0]) * u0[0], siluf_(g0[1]) * u0[1]); o.y = pk2(siluf_(g0[2]) * u0[2], siluf_(g0[3]) * u0[3]);
      o.z = pk2(siluf_(g1[0]) * u1[0], siluf_(g1[1]) * u1[1]); o.w = pk2(siluf_(g1[2]) * u1[2], siluf_(g1[3]) * u1[3]);
      *(uint4*)C = o;
    }
  }
}
template <int EPI>
__device__ __forceinline__ void gemm_phase(const bf16_t* A, int lda, const bf16_t* Bt, int ldb, int K, int ntn, void* C, int ldc, char* lds, int bid, int nb, const int tid) {
  constexpr int GM = 4, nM = MT / 128;
  const int ntiles = nM * ntn, nig = GM * ntn;
  const int pos = (EPI != EPI_SWIGLU && (nb & 7) == 0) ? (bid & 7) * (nb >> 3) + (bid >> 3) : bid;
  for (int L = pos; L < ntiles; L += nb) {
    int mt, nn;
    if (EPI == EPI_SWIGLU) { mt = L / ntn; nn = L % ntn; }
    else { const int gid = L / nig, fm = gid * GM, gsz = min(nM - fm, GM), rem = L - gid * nig; mt = fm + rem % gsz; nn = rem / gsz; }
    gemm_tile<EPI>(A, lda, Bt, ldb, K, mt * 128, nn * 128, C, ldc, lds, tid);
  }
}

#define XB_TMO      128
#define XB_XCNT(j)  (256  + 64 * (j))
#define XB_XSUB(j)  (1280 + 64 * (j))
#define XB_XGEN(j)  (2304 + 64 * (j))
#define XB_TOP      3328
#define XB_TOPGEN   3392
#define XCD_BAR_WORDS 3456
#define XB_SPIN_CAP (1u << 22)
__device__ __forceinline__ unsigned xb_ld(unsigned* p) { return __hip_atomic_load(p, __ATOMIC_RELAXED, __HIP_MEMORY_SCOPE_AGENT); }
__device__ __forceinline__ unsigned xb_add(unsigned* p, unsigned v) { return __hip_atomic_fetch_add(p, v, __ATOMIC_RELAXED, __HIP_MEMORY_SCOPE_AGENT); }
__device__ __forceinline__ unsigned xb_xcc_id() { return (unsigned)__builtin_amdgcn_s_getreg((3 << 11) | 20) & 0xFu; }
#define XB_SPIN(cond, bar) do { unsigned _sp = 0; while (cond) { __builtin_amdgcn_s_sleep(1); \
    if ((++_sp & 255u) == 0u) { if (xb_ld(&(bar)[XB_TMO])) break; if (_sp > XB_SPIN_CAP) { atomicAdd(&(bar)[XB_TMO], 1u); break; } } } } while (0)
struct XcdBarrier { unsigned* bar; unsigned x; unsigned nloc, nx; };
__device__ __forceinline__ void xcd_barrier_complete(unsigned* bar, unsigned x, unsigned G, unsigned& nloc, unsigned& nx) {
  unsigned sum, cnt, mine, sp = 0u;
  for (;;) {
    sum = 0u; cnt = 0u; mine = 0u;
#pragma unroll
    for (unsigned j = 0; j < 16; ++j) { const unsigned c = xb_ld(&bar[XB_XCNT(j)]); sum += c; cnt += (c > 0u) ? 1u : 0u; mine = (j == x) ? c : mine; }
    if (sum == G) break;
    __builtin_amdgcn_s_sleep(1);
    if ((++sp & 255u) == 0u) { if (xb_ld(&bar[XB_TMO])) break; if (sp > XB_SPIN_CAP) { atomicAdd(&bar[XB_TMO], 1u); break; } }
  }
  nloc = mine > 0u ? mine : 1u; nx = cnt > 0u ? cnt : 1u;
}
__device__ __forceinline__ void xcd_barrier(XcdBarrier& b, const int tid, const unsigned G) {
  asm volatile("s_waitcnt vmcnt(0)" ::: "memory");
  __syncthreads();
  if (tid == 0) {
    unsigned* bar = b.bar;
    __builtin_amdgcn_s_waitcnt(0);
    if (b.nloc == 0u) xcd_barrier_complete(bar, b.x, G, b.nloc, b.nx);
    const unsigned nloc = b.nloc, nx = b.nx;
    const unsigned old = xb_add(&bar[XB_XSUB(b.x)], 1u);
    const unsigned gen = old / nloc;
    if (old + 1u == (gen + 1u) * nloc) {
      __builtin_amdgcn_fence(__ATOMIC_RELEASE, "agent");
      asm volatile("s_waitcnt vmcnt(0)" ::: "memory");
      const unsigned og = xb_add(&bar[XB_TOP], 1u);
      const unsigned tg = og / nx;
      if (og + 1u == (tg + 1u) * nx) xb_add(&bar[XB_TOPGEN], 1u);
      else XB_SPIN(xb_ld(&bar[XB_TOPGEN]) == tg, bar);
      __builtin_amdgcn_fence(__ATOMIC_ACQUIRE, "agent");
      xb_add(&bar[XB_XGEN(b.x)], 1u);
      asm volatile("s_waitcnt vmcnt(0)" ::: "memory");
    } else {
      XB_SPIN(xb_ld(&bar[XB_XGEN(b.x)]) == gen, bar);
      __builtin_amdgcn_fence(__ATOMIC_ACQUIRE, "agent");
      asm volatile("s_waitcnt vmcnt(0)" ::: "memory");
    }
  }
  __syncthreads();
}

template <int N, int RS>
__device__ __forceinline__ void convN(const bf16_t* rawb, const float (&w)[4][N], int tt, int off, float (&x)[N]) {
#pragma unroll
  for (int i = 0; i < N; ++i) x[i] = 0.f;
#pragma unroll
  for (int j = 0; j < 4; ++j) {
    float xv[N];
    if (N == 8) { const uint4 rv = *(const uint4*)(rawb + (tt + j) * RS + off); unpack8(rv, xv); }
    else if (N == 4) { const uint2 rv = *(const uint2*)(rawb + (tt + j) * RS + off); xv[0] = bflo(rv.x); xv[1] = bfhi(rv.x); xv[2 % N] = bflo(rv.y); xv[3 % N] = bfhi(rv.y); }
    else { const unsigned rv = *(const unsigned*)(rawb + (tt + j) * RS + off); xv[0] = bflo(rv); xv[1] = bfhi(rv); }
#pragma unroll
    for (int i = 0; i < N; ++i) x[i] += w[j][i] * xv[i];
  }
  if (N == 2) {
#pragma unroll
    for (int i = 0; i < N; ++i) asm volatile("" : "+v"(x[i]));
  }
#pragma unroll
  for (int i = 0; i < N; ++i) x[i] = siluf_(x[i]);
}

template <int MIX, int VN>
__device__ __forceinline__ void load_chunk_fn(const unsigned char* ws, const bf16_t* Pb, const int t, const int T, const int h, const int vcol, const int sub, const int posb,
                                              uint4& R0, uint4& R1, uint2& R2, uint4& R4, uint4& R5, unsigned& ex0, unsigned& ex1) {
  if (t < T) {
    const bf16_t* pr = Pb + (size_t)t * DINP;
    const int vbase = (MIX == 0) ? 512 : (MIX == 1) ? 1544 : (MIX == 2) ? 2312 : 3352;
    if (VN == 4) R2 = *(const uint2*)(pr + vbase + h * 64 + vcol);
    else R2.x = *(const unsigned*)(pr + vbase + h * 64 + vcol);
    if (MIX == 0) {
      R0 = *(const uint4*)(pr + 0 + h * 64 + sub * 8); R1 = *(const uint4*)(pr + 256 + h * 64 + sub * 8);
      ex0 = pr[768 + h]; ex1 = pr[772 + h];
    } else if (MIX == 1) {
      R0 = *(const uint4*)(pr + 1032 + h * 64 + sub * 8); R1 = *(const uint4*)(pr + 1288 + h * 64 + sub * 8);
    } else if (MIX == 2) {
      const uint2 q2 = *(const uint2*)(pr + 2056 + h * 32 + sub * 4), k2 = *(const uint2*)(pr + 2184 + h * 32 + sub * 4);
      R0 = make_uint4(q2.x, q2.y, k2.x, k2.y);
      R1 = *(const uint4*)(pr + 2568); R4 = *(const uint4*)(pr + 2576);
    } else {
      const uint2 ql = *(const uint2*)(pr + 2840 + h * 64 + sub * 4), qh = *(const uint2*)(pr + 2840 + h * 64 + 32 + sub * 4);
      const uint2 kl = *(const uint2*)(pr + 3096 + h * 64 + sub * 4), kh = *(const uint2*)(pr + 3096 + h * 64 + 32 + sub * 4);
      R0 = make_uint4(ql.x, ql.y, qh.x, qh.y); R1 = make_uint4(kl.x, kl.y, kh.x, kh.y);
      const uint4* cs = (const uint4*)(ws + OFF_CS + ((size_t)(posb + t) * 32 + sub * 4) * 8);
      R4 = cs[0]; R5 = cs[1];
    }
  }
}

__device__ __forceinline__ float dpp_hm(float x) {
  return __int_as_float(__builtin_amdgcn_update_dpp(0, __float_as_int(x), 0x141, 0xF, 0xF, true));
}
__device__ __forceinline__ float dpp_rm(float x) {
  return __int_as_float(__builtin_amdgcn_update_dpp(0, __float_as_int(x), 0x140, 0xF, 0xF, true));
}
__device__ __forceinline__ float red8d(float x) { x += dpp_x1(x); x += dpp_x2(x); x += dpp_hm(x); return x; }
template <int KG> __device__ __forceinline__ float redKG(float x) { x = red8d(x); if (KG == 16) x += dpp_rm(x); return x; }

template <int MIX, int KPL>
struct StepIn { float q[KPL], k[KPL], d[KPL]; float v, a, be, qk; };

template <int MIX, int KPL>
__device__ __forceinline__ void load_step(const float* qkdv, const float* scal, int t, int kg, int col, StepIn<MIX, KPL>& s) {
  const float* base = qkdv + t * 256;
#pragma unroll
  for (int i = 0; i < KPL; i += 4) {
    const f32x4 a = *(const f32x4*)(base + kg * KPL + i), b = *(const f32x4*)(base + 64 + kg * KPL + i);
    s.q[i] = a[0]; s.q[i + 1] = a[1]; s.q[i + 2] = a[2]; s.q[i + 3] = a[3];
    s.k[i] = b[0]; s.k[i + 1] = b[1]; s.k[i + 2] = b[2]; s.k[i + 3] = b[3];
    if (MIX == 1 || MIX == 2) { const f32x4 d = *(const f32x4*)(base + 128 + kg * KPL + i); s.d[i] = d[0]; s.d[i + 1] = d[1]; s.d[i + 2] = d[2]; s.d[i + 3] = d[3]; }
  }
  s.v = base[192 + col];
  if (MIX == 0) { const f32x4 c = *(const f32x4*)(scal + t * 4); s.a = c[0]; s.be = c[1]; s.qk = c[2]; }
}

template <int MIX, int KPL, int KG>
__device__ __forceinline__ float do_step(const StepIn<MIX, KPL>& s, float (&S)[KPL], const float gam) {
  if (MIX == 0) {
    float kS0 = 0.f, kS1 = 0.f, qS0 = 0.f, qS1 = 0.f;
#pragma unroll
    for (int i = 0; i < KPL; i += 2) { kS0 += s.k[i] * S[i]; kS1 += s.k[i + 1] * S[i + 1]; qS0 += s.q[i] * S[i]; qS1 += s.q[i + 1] * S[i + 1]; }
    const float kS = redKG<KG>(kS0 + kS1), qS = redKG<KG>(qS0 + qS1);
    const float w = s.be * (s.v - s.a * kS);
#pragma unroll
    for (int i = 0; i < KPL; ++i) S[i] = s.a * S[i] + s.k[i] * w;
    return s.a * qS + s.qk * w;
  } else {
    float o0 = 0.f, o1 = 0.f;
#pragma unroll
    for (int i = 0; i < KPL; i += 2) {
      const float d0 = (MIX == 3) ? gam : s.d[i], d1 = (MIX == 3) ? gam : s.d[i + 1];
      S[i] = d0 * S[i] + s.k[i] * s.v; S[i + 1] = d1 * S[i + 1] + s.k[i + 1] * s.v;
      o0 += s.q[i] * S[i]; o1 += s.q[i + 1] * S[i + 1];
    }
    return redKG<KG>(o0 + o1);
  }
}

template <int MIX>
__device__ __forceinline__ void scan_part(const Params& p, const int layer, const int smp, const int b0, const int bstep, const int bend, const int h, const int part, char* lds, const int tid) {
  constexpr int DK = (MIX == 2) ? 32 : 64;
  constexpr int NS = (MIX == 0) ? 4 : 2;
  constexpr int CW = 64 / NS;
  constexpr int CPW = CW / 4;
  constexpr int KG = 64 / CPW;
  constexpr int KPL = DK / KG;
  constexpr int VN = CW / 8;
  constexpr int RS = 128 + CW;
  float* qkdv = (float*)lds;
  float* obuf = (float*)(lds + 32768);
  float* scal = (float*)(lds + 36864);
  bf16_t* rawb = (bf16_t*)(lds + 37376);
  float* cwl = (float*)(lds + 48576);
  float* wgl = (float*)(lds + 37376);

  const int lane = tid & 63, wv = tid >> 6;
  const int tt = tid >> 3, sub = tid & 7;
  const int col = wv * CPW + lane / KG, kg = lane % KG;
  const int T = smp ? 4 : TPR;
  const int nBatch = smp ? NSB : NB;
  const int posb = smp ? 2064 : 0;
  const int vcol = part * CW + sub * VN;
  __syncthreads();
  float c8[8];
  float Aexp = 0.f, dtb = 0.f, gam = 0.f;
  float cwq[4][8], cwk[4][8];
  if (MIX == 0) {
    Aexp = __expf(p.I(12)[layer * 4 + h]); dtb = p.I(13)[layer * 4 + h];
#pragma unroll
    for (int j = 0; j < 4; ++j) {
      const float* cwp = p.I(11) + (size_t)(layer * 4 + j) * 768;
#pragma unroll
      for (int i = 0; i < 8; ++i) { cwq[j][i] = cwp[h * 64 + sub * 8 + i]; cwk[j][i] = cwp[256 + h * 64 + sub * 8 + i]; }
    }
    for (int e = tid; e < 4 * CW; e += 256) { const int j = e / CW, r = e % CW; cwl[j * RS + 128 + r] = p.I(11)[(size_t)(layer * 4 + j) * 768 + 512 + h * 64 + part * CW + r]; }
  } else if (MIX == 1) {
#pragma unroll
    for (int i = 0; i < 8; ++i) {
      const int d = h * 64 + sub * 8 + i;
      c8[i] = (layer == 0) ? 1.0f : sigmoidf_(p.I(15)[d] - p.I(15)[256 + d]);
    }
  } else if (MIX == 2) {
    for (int e = tid; e < 512; e += 256) { const int r = e >> 5, j = e & 31; wgl[e] = p.I(17)[(size_t)(layer * 16 + r) * 128 + h * 32 + j]; }
#pragma unroll
    for (int i = 0; i < 4; ++i) c8[i] = p.I(18)[layer * 128 + h * 32 + sub * 4 + i];
  } else {
    gam = 1.0f - exp2f(-5.0f - (float)h);
  }
  for (int b = b0; b < bend; b += bstep) {
  const int row0 = smp ? MP + b * 4 : b * TPR;
  const bf16_t* Pb = (const bf16_t*)(p.W() + OFF_P) + (size_t)row0 * DINP;
  bf16_t* Ob = (bf16_t*)p.O() + (size_t)row0 * 1024 + MIX * 256 + h * 64 + part * CW;
  float* PS = (float*)((unsigned char*)p.O() + DOUT_PS) + (size_t)row0 * 128 + (MIX * 4 + h) * 8 + part * 2;
  uint4 R0 = make_uint4(0, 0, 0, 0), R1 = R0, R4 = R0, R5 = R0; uint2 R2 = make_uint2(0, 0); unsigned ex0 = 0, ex1 = 0;
  load_chunk_fn<MIX, VN>(p.W(), Pb, tt, T, h, vcol, sub, posb, R0, R1, R2, R4, R5, ex0, ex1);
  float S[KPL];
  if (smp) {
    const float* sin_ = p.I(3 + MIX) + ((size_t)(layer * NSB + b) * 4 + h) * DK * 64 + part * CW;
#pragma unroll
    for (int i = 0; i < KPL; ++i) S[i] = sin_[(kg * KPL + i) * 64 + col];
  } else {
#pragma unroll
    for (int i = 0; i < KPL; ++i) S[i] = 0.f;
  }
  if (MIX == 0) {
    for (int e = tid; e < 3 * RS; e += 256) { const int j = e / RS, r = e % RS;
      const int cc = (r < 64) ? (h * 64 + r) : (r < 128) ? (256 + h * 64 + r - 64) : (512 + h * 64 + part * CW + r - 128);
      float v = 0.f; if (smp) v = p.I(2)[((size_t)(layer * NSB + b) * 3 + j) * 768 + cc];
      rawb[e] = (bf16_t)f2bf(v); }
  }
  __syncthreads();

  int ntok_last = 0;
  for (int t0 = 0; t0 < T; t0 += 32) {
    const int ntok = min(32, T - t0);
    ntok_last = ntok;
    const bool valid = tt < ntok;
    float* dst = qkdv + tt * 256;
    if (MIX != 0 && valid) {
      if (VN == 4) *(f32x4*)(dst + 192 + sub * 4) = (f32x4){bflo(R2.x), bfhi(R2.x), bflo(R2.y), bfhi(R2.y)};
      else *(float2*)(dst + 192 + sub * 2) = make_float2(bflo(R2.x), bfhi(R2.x));
    }
    if (MIX == 0) {
      if (valid) {
        *(uint4*)(rawb + (3 + tt) * RS + 0 + sub * 8) = R0;
        *(uint4*)(rawb + (3 + tt) * RS + 64 + sub * 8) = R1;
        if (VN == 4) *(uint2*)(rawb + (3 + tt) * RS + 128 + sub * 4) = R2;
        else *(unsigned*)(rawb + (3 + tt) * RS + 128 + sub * 2) = R2.x;
      }
      __syncthreads();
      if (valid) {
        float xq[8], xk[8], xv[VN];
        { float cwv[4][VN];
#pragma unroll
          for (int j = 0; j < 4; ++j)
#pragma unroll
            for (int i = 0; i < VN; ++i) cwv[j][i] = cwl[j * RS + 128 + sub * VN + i];
          convN<VN, RS>(rawb, cwv, tt, 128 + sub * VN, xv); }
        convN<8, RS>(rawb, cwq, tt, sub * 8, xq);
        convN<8, RS>(rawb, cwk, tt, 64 + sub * 8, xk);
#pragma unroll
        for (int i = 0; i < VN; ++i) dst[192 + sub * VN + i] = xv[i];
        float ssq = 0.f, ssk = 0.f;
#pragma unroll
        for (int i = 0; i < 8; ++i) { ssq += xq[i] * xq[i]; ssk += xk[i] * xk[i]; }
        ssq = red8d(ssq); ssk = red8d(ssk);
        const float rq = rsqrtf(ssq + 1e-6f) * 0.125f, rk = rsqrtf(ssk + 1e-6f);
        float qk = 0.f;
#pragma unroll
        for (int i = 0; i < 8; ++i) { xq[i] *= rq; xk[i] *= rk; qk += xq[i] * xk[i]; }
        qk = red8d(qk);
        *(f32x4*)(dst + sub * 8) = (f32x4){xq[0], xq[1], xq[2], xq[3]}; *(f32x4*)(dst + sub * 8 + 4) = (f32x4){xq[4], xq[5], xq[6], xq[7]};
        *(f32x4*)(dst + 64 + sub * 8) = (f32x4){xk[0], xk[1], xk[2], xk[3]}; *(f32x4*)(dst + 64 + sub * 8 + 4) = (f32x4){xk[4], xk[5], xk[6], xk[7]};
        if (sub == 0) {
          const float be = sigmoidf_(bflo(ex0)), al = bflo(ex1);
          const float a = __expf(-Aexp * softplusf_(al + dtb));
          *(f32x4*)(scal + tt * 4) = (f32x4){a, be, qk, 0.f};
        }
      }
    } else if (MIX == 1) {
      if (valid) {
        float q[8], z[8]; unpack8(R0, q); unpack8(R1, z);
        float kk[8], dd[8];
#pragma unroll
        for (int i = 0; i < 8; ++i) { q[i] = siluf_(q[i]); kk[i] = c8[i] * sigmoidf_(-z[i]); dd[i] = 1.0f - fminf(kk[i], 1.0f - 1e-6f); }
        *(f32x4*)(dst + sub * 8) = (f32x4){q[0], q[1], q[2], q[3]}; *(f32x4*)(dst + sub * 8 + 4) = (f32x4){q[4], q[5], q[6], q[7]};
        *(f32x4*)(dst + 64 + sub * 8) = (f32x4){kk[0], kk[1], kk[2], kk[3]}; *(f32x4*)(dst + 64 + sub * 8 + 4) = (f32x4){kk[4], kk[5], kk[6], kk[7]};
        *(f32x4*)(dst + 128 + sub * 8) = (f32x4){dd[0], dd[1], dd[2], dd[3]}; *(f32x4*)(dst + 128 + sub * 8 + 4) = (f32x4){dd[4], dd[5], dd[6], dd[7]};
      }
    } else if (MIX == 2) {
      if (valid) {
        float lr[16]; unpack8(R1, lr); unpack8(R4, lr + 8);
        const float q0 = bflo(R0.x), q1 = bfhi(R0.x), q2 = bflo(R0.y), q3 = bfhi(R0.y);
        const float k0 = bflo(R0.z), k1 = bfhi(R0.z), k2 = bflo(R0.w), k3 = bfhi(R0.w);
        const float sc = 0.17677669529663687f;
        f32x4 xg = (f32x4){c8[0], c8[1], c8[2], c8[3]};
#pragma unroll
        for (int r = 0; r < 16; ++r) xg += lr[r] * *(const f32x4*)(wgl + r * 32 + sub * 4);
        f32x4 dd;
#pragma unroll
        for (int i = 0; i < 4; ++i) { const float ls = fminf(xg[i], 0.f) - __logf(1.0f + __expf(-fabsf(xg[i]))); dd[i] = __expf(ls * 0.0625f); }
        *(f32x4*)(dst + sub * 4) = (f32x4){q0 * sc, q1 * sc, q2 * sc, q3 * sc};
        *(f32x4*)(dst + 64 + sub * 4) = (f32x4){k0, k1, k2, k3};
        *(f32x4*)(dst + 128 + sub * 4) = dd;
      }
    } else {
      if (valid) {
        const float ql[4] = {bflo(R0.x), bfhi(R0.x), bflo(R0.y), bfhi(R0.y)}, qh[4] = {bflo(R0.z), bfhi(R0.z), bflo(R0.w), bfhi(R0.w)};
        const float kl[4] = {bflo(R1.x), bfhi(R1.x), bflo(R1.y), bfhi(R1.y)}, kh[4] = {bflo(R1.z), bfhi(R1.z), bflo(R1.w), bfhi(R1.w)};
        const float cc[4] = {__uint_as_float(R4.x), __uint_as_float(R4.z), __uint_as_float(R5.x), __uint_as_float(R5.z)};
        const float sn[4] = {__uint_as_float(R4.y), __uint_as_float(R4.w), __uint_as_float(R5.y), __uint_as_float(R5.w)};
        f32x4 qa, qb, ka, kb;
#pragma unroll
        for (int i = 0; i < 4; ++i) {
          qa[i] = ql[i] * cc[i] - qh[i] * sn[i]; qb[i] = ql[i] * sn[i] + qh[i] * cc[i];
          ka[i] = (kl[i] * cc[i] - kh[i] * sn[i]) * 0.125f; kb[i] = (kl[i] * sn[i] + kh[i] * cc[i]) * 0.125f;
        }
        *(f32x4*)(dst + sub * 4) = qa; *(f32x4*)(dst + 32 + sub * 4) = qb;
        *(f32x4*)(dst + 64 + sub * 4) = ka; *(f32x4*)(dst + 96 + sub * 4) = kb;
      }
    }
    __syncthreads();
    if (MIX == 0 && t0 + 32 < T) {
      if (tid < 3 * RS / 8) { const uint4 v = *(const uint4*)(rawb + 32 * RS + tid * 8); *(uint4*)(rawb + tid * 8) = v; }
    }
    if (t0 + 32 < T) load_chunk_fn<MIX, VN>(p.W(), Pb, t0 + 32 + tt, T, h, vcol, sub, posb, R0, R1, R2, R4, R5, ex0, ex1);
    {
      StepIn<MIX, KPL> sa, sb;
      float osave = 0.f;
      load_step<MIX, KPL>(qkdv, scal, 0, kg, col, sa);
      for (int t = 0; t < ntok; t += 2) {
        load_step<MIX, KPL>(qkdv, scal, t + 1, kg, col, sb);
        __builtin_amdgcn_sched_barrier(0);
        const float oa = do_step<MIX, KPL, KG>(sa, S, gam);
        osave = (kg == (t & (KG - 1))) ? oa : osave;
        load_step<MIX, KPL>(qkdv, scal, min(t + 2, ntok - 1), kg, col, sa);
        __builtin_amdgcn_sched_barrier(0);
        const float ob = do_step<MIX, KPL, KG>(sb, S, gam);
        osave = (kg == ((t + 1) & (KG - 1))) ? ob : osave;
        if (((t + 2) & (KG - 1)) == 0) obuf[(t + 2 - KG + kg) * CW + col] = osave;
      }
      const int remn = ntok & (KG - 1);
      if (remn != 0 && kg < remn) obuf[(ntok - remn + kg) * CW + col] = osave;
    }
    __syncthreads();
    if (valid) {
      float o[VN];
#pragma unroll
      for (int i = 0; i < VN; ++i) o[i] = obuf[tt * CW + sub * VN + i];
      float s1 = 0.f, s2 = 0.f;
#pragma unroll
      for (int i = 0; i < VN; ++i) { s1 += o[i]; s2 += o[i] * o[i]; }
      s1 = red8d(s1); s2 = red8d(s2);
      if (VN == 4) { uint2 o2; o2.x = pk2(o[0], o[1]); o2.y = pk2(o[2 % VN], o[3 % VN]); *(uint2*)(Ob + (size_t)(t0 + tt) * 1024 + sub * 4) = o2; }
      else *(unsigned*)(Ob + (size_t)(t0 + tt) * 1024 + sub * 2) = pk2(o[0], o[1]);
      if (sub == 0) *(float2*)(PS + (size_t)(t0 + tt) * 128) = make_float2(s1, s2);
    }
  }
  {
    const size_t obase = (MIX == 0) ? (smp ? O_DS : O_DP) : (MIX == 1) ? (smp ? O_HS : O_HP) : (MIX == 2) ? (smp ? O_GS : O_GP) : (smp ? O_RS : O_RP);
    float* so = p.O() + obase + ((size_t)(layer * nBatch + b) * 4 + h) * DK * 64 + part * CW;
#pragma unroll
    for (int i = 0; i < KPL; ++i) so[(kg * KPL + i) * 64 + col] = S[i];
  }
  if (MIX == 0) {
    float* co = p.O() + (smp ? O_CS : O_CP) + (size_t)(layer * nBatch + b) * 3 * 768;
    for (int e = tid; e < 3 * RS; e += 256) { const int j = e / RS, r = e % RS;
      const float v = bflo((unsigned)rawb[(ntok_last + j) * RS + r]);
      if (r < 128) { if (part == 0) co[j * 768 + ((r < 64) ? (h * 64 + r) : (256 + h * 64 + r - 64))] = v; }
      else co[j * 768 + 512 + h * 64 + part * CW + r - 128] = v; }
  }
  __syncthreads();
  }
}

constexpr int ITEMS_PER_SEQ = 40;
__device__ __forceinline__ void scan_dispatch(const Params& p, int layer, int smp, int type, int b0, int bstep, int bend, char* lds, const int tid) {
  const int r = type;
  if (r < 16) scan_part<0>(p, layer, smp, b0, bstep, bend, r >> 2, r & 3, lds, tid);
  else {
    const int r2 = r - 16, mh = 4 + (r2 >> 1), part = r2 & 1, mix = mh >> 2, h = mh & 3;
    if (mix == 1) scan_part<1>(p, layer, smp, b0, bstep, bend, h, part, lds, tid);
    else if (mix == 2) scan_part<2>(p, layer, smp, b0, bstep, bend, h, part, lds, tid);
    else scan_part<3>(p, layer, smp, b0, bstep, bend, h, part, lds, tid);
  }
}

__device__ __forceinline__ int long_item_type(int u, int& b) {
  int type;
  if (u < 64) { b = u >> 3; type = 24 + (u & 7); }
  else if (u < 192) { const int v = u - 64; b = v >> 4; type = v & 15; }
  else if (u < 256) { const int v = u - 192; b = v >> 3; type = 16 + (v & 7); }
  else { const int v = u - 256; b = v >> 3; type = 32 + (v & 7); }
  return type;
}
__device__ __forceinline__ void scan_phase(const Params& p, int layer, char* lds, int bid, int nb, const int tid, const int role, const int ci, const int nprim, const int nsec) {
  constexpr int NPI = NB * ITEMS_PER_SEQ;
  const bool paired = (nprim == 256 && nsec == 256);
  int j = -1, nbs = 1;
  if (paired) {
    int u = -1;
    if (role == 0) u = ci; else if (ci < NPI - 256) u = 256 + ci;
    if (u >= 0) { int b; const int type = long_item_type(u, b); scan_dispatch(p, layer, 0, type, b, 1, b + 1, lds, tid); }
    else { j = ci - (NPI - 256); nbs = 256 - (NPI - 256); }
  } else {
    for (int u = bid; u < NPI; u += nb) { int b; const int type = long_item_type(u, b); scan_dispatch(p, layer, 0, type, b, 1, b + 1, lds, tid); }
    nbs = (nb > NPI) ? nb - NPI : nb; j = (nb > NPI) ? bid - NPI : bid;
  }
  if (j >= 0) {
    const int nsl = (nbs + ITEMS_PER_SEQ - 1) / ITEMS_PER_SEQ;
    for (int jj = j; jj < ITEMS_PER_SEQ * nsl; jj += nbs) scan_dispatch(p, layer, 1, jj % ITEMS_PER_SEQ, jj / ITEMS_PER_SEQ, nsl, NSB, lds, tid);
    if (layer == 0) { __syncthreads(); convert_weights(p, lds, 992 + j, 6720, nbs, tid); }
  }
}

__device__ __forceinline__ void norm_phase(const Params& p, int layer, int bid, int nb, const int tid) {
  bf16_t* O = (bf16_t*)p.O();
  const bf16_t* P = (const bf16_t*)(p.W() + OFF_P);
  const float* PS = (const float*)((const unsigned char*)p.O() + DOUT_PS);
  const int cg8 = tid & 127;
  const int mh = cg8 >> 3, mix = mh >> 2, h = mh & 3, j0 = (cg8 & 7) * 8;
  const int gcol = (mix == 0) ? 776 : (mix == 1) ? 1800 : (mix == 2) ? 2584 : 3608;
  const float* gsrc = (mix == 0) ? p.I(14) : (mix == 1) ? p.I(16) : (mix == 2) ? p.I(19) : p.I(20);
  float g8[8];
#pragma unroll
  for (int i = 0; i < 8; ++i) g8[i] = gsrc[layer * 256 + h * 64 + j0 + i];
  uint4 ovn, gvn; f32x4 psn, ps2n = (f32x4){0.f, 0.f, 0.f, 0.f};
  {
    const int r0 = min(bid * 2 + (tid >> 7), MT - 1);
    ovn = *(const uint4*)(O + (size_t)r0 * 1024 + cg8 * 8);
    gvn = *(const uint4*)(P + (size_t)r0 * DINP + gcol + h * 64 + j0);
    psn = *(const f32x4*)(PS + (size_t)r0 * 128 + mh * 8);
    if (mix == 0) ps2n = *(const f32x4*)(PS + (size_t)r0 * 128 + mh * 8 + 4);
  }
  for (int row = bid * 2 + (tid >> 7); row < MT; row += nb * 2) {
    const uint4 ov = ovn, gv = gvn; const f32x4 ps = psn, ps2 = ps2n;
    {
      const int rn = min(row + nb * 2, MT - 1);
      ovn = *(const uint4*)(O + (size_t)rn * 1024 + cg8 * 8);
      gvn = *(const uint4*)(P + (size_t)rn * DINP + gcol + h * 64 + j0);
      psn = *(const f32x4*)(PS + (size_t)rn * 128 + mh * 8);
      if (mix == 0) ps2n = *(const f32x4*)(PS + (size_t)rn * 128 + mh * 8 + 4);
    }
    float s1 = ps[0] + ps[2], s2 = ps[1] + ps[3];
    if (mix == 0) { s1 += ps2[0] + ps2[2]; s2 += ps2[1] + ps2[3]; }
    float o[8], gt[8]; unpack8(ov, o); unpack8(gv, gt);
    float mu = 0.f, rs;
    if (mix == 3) { mu = s1 * (1.0f / 64.0f); const float var = fmaxf(s2 * (1.0f / 64.0f) - mu * mu, 0.f); rs = rsqrtf(var + 1e-5f); }
    else rs = rsqrtf(s2 * (1.0f / 64.0f) + 1e-6f);
    float r[8];
#pragma unroll
    for (int i = 0; i < 8; ++i) r[i] = (o[i] - mu) * rs * g8[i] * siluf_(gt[i]);
    uint4 o4; o4.x = pk2(r[0], r[1]); o4.y = pk2(r[2], r[3]); o4.z = pk2(r[4], r[5]); o4.w = pk2(r[6], r[7]);
    *(uint4*)(O + (size_t)row * 1024 + cg8 * 8) = o4;
  }
}

constexpr int NPHASE = 17;
__global__ void __launch_bounds__(256, 2) hymba_fwd(Params p_, int ph_lo, int ph_hi) {
  __shared__ __attribute__((aligned(16))) char lds[65536];
  XcdBarrier xb; xb.bar = (unsigned*)(p_.ws + OFF_BAR); xb.x = xb_xcc_id(); xb.nloc = 0u; xb.nx = 0u;
  if (threadIdx.x == 0) (void)xb_add(&xb.bar[XB_XCNT(xb.x)], 1u);
  int role = 0, ci = 0;
  {
    const unsigned key = ((((unsigned)__builtin_amdgcn_s_getreg((31 << 11) | 4)) >> 8) & 0xFFu) | (xb.x << 8);
    if (threadIdx.x == 0) {
      const unsigned slot = xb_add(&xb.bar[CEN_TAB + key], 1u);
      unsigned r;
      if (slot == 0u) { r = xb_add(&xb.bar[CEN_CNT], 1u); __hip_atomic_store(&xb.bar[CEN_TAB2 + key], r + 1u, __ATOMIC_RELAXED, __HIP_MEMORY_SCOPE_AGENT); }
      else { (void)xb_add(&xb.bar[CEN_CNT + 1], 1u); r = 0u; }
      *(volatile unsigned*)(lds) = slot == 0u ? 0u : 1u; *(volatile unsigned*)(lds + 4) = r;
    }
    __syncthreads();
    role = (int)*(volatile unsigned*)(lds); ci = (int)*(volatile unsigned*)(lds + 4);
    __syncthreads();
    role = __builtin_amdgcn_readfirstlane(role); ci = __builtin_amdgcn_readfirstlane(ci);
    if (role != 0) ci = -1 - (int)key;
  }
  int nprim = 0, nsec = 0;
  if (ph_hi < 0) cg::this_grid().sync();
  for (int ph = ph_lo; ph < ph_hi; ++ph) {
    int tid = threadIdx.x, bid = blockIdx.x, nb = gridDim.x;
    asm volatile("" : "+v"(tid));
    asm volatile("" : "+s"(bid), "+s"(nb));
    if (ph > ph_lo) xcd_barrier(xb, tid, (unsigned)nb);
    if (ph == ph_lo + 1) {
      nprim = (int)xb_ld(&xb.bar[CEN_CNT]); nsec = (int)xb_ld(&xb.bar[CEN_CNT + 1]);
      if (role != 0) { const unsigned v = xb_ld(&xb.bar[CEN_TAB2 + (unsigned)(-1 - ci)]); ci = (v > 0u) ? (int)v - 1 : 0; }
      nprim = __builtin_amdgcn_readfirstlane(nprim); nsec = __builtin_amdgcn_readfirstlane(nsec); ci = __builtin_amdgcn_readfirstlane(ci);
    }
    const Params& p = p_;
    if (ph == 0) {
      convert_weights(p, lds, bid, 992, nb, tid);
      embed_ln(p, bid, nb, tid);
      rope_table(p, bid, nb, tid);
    } else {
      const int l = (ph - 1) / 8, s = (ph - 1) % 8;
      const bf16_t* Xb = (const bf16_t*)p.O();
      bf16_t* X1b = (bf16_t*)(p.W() + OFF_X1B);
      bf16_t* Hb = (bf16_t*)(p.W() + OFF_H);
      float* X = (float*)(p.W() + OFF_X);
      if (s == 0) gemm_phase<EPI_BF16>(Xb, 1024, (const bf16_t*)(p.W() + OFF_WIN + l * SZ_WIN), 1024, 1024, DINP / 128, p.W() + OFF_P, DINP, lds, bid, nb, tid);
      else if (s == 1) scan_phase(p, l, lds, bid, nb, tid, role, ci, nprim, nsec);
      else if (s == 2) norm_phase(p, l, bid, nb, tid);
      else if (s == 3) gemm_phase<EPI_RESID>(Xb, 1024, (const bf16_t*)(p.W() + OFF_WOUT + l * SZ_WOUT), 1024, 1024, 8, X, 1024, lds, bid, nb, tid);
      else if (s == 4) ln_phase(p, p.I(22) + l * 1024, p.I(23) + l * 1024, X1b, 0, bid, nb, tid);
      else if (s == 5) gemm_phase<EPI_SWIGLU>(X1b, 1024, (const bf16_t*)(p.W() + OFF_WGU + l * SZ_WGU), 1024, 1024, 44, Hb, DFF, lds, bid, nb, tid);
      else if (s == 6) gemm_phase<EPI_RESID>(Hb, DFF, (const bf16_t*)(p.W() + OFF_WDN + l * SZ_WDN), DFF, DFF, 8, X, 1024, lds, bid, nb, tid);
      else ln_phase(p, p.I(27) + l * 1024, p.I(28) + l * 1024, (bf16_t*)p.O(), l == 1, bid, nb, tid);
    }
  }
}

extern "C" void kernel_launch(void* const* d_in, const int* in_sizes, int n_in, void* d_out, int out_size, void* d_ws, size_t ws_size,
                              hipStream_t stream) {
  (void)in_sizes; (void)out_size;
  if (n_in < 29 || ws_size < WS_NEED) { fprintf(stderr, "bad args: n_in %d ws %zu need %zu\n", n_in, ws_size, (size_t)WS_NEED); return; }
  Params p{};
  for (int i = 0; i < 29; ++i) p.in[i] = (const float*)d_in[i];
  p.out = (float*)d_out;
  p.ws = (unsigned char*)d_ws;
  static int grid_blocks = 0;
  if (!grid_blocks) {
    int dev = 0, cus = 0, per_cu = 0;
    (void)hipGetDevice(&dev);
    (void)hipDeviceGetAttribute(&cus, hipDeviceAttributeMultiprocessorCount, dev);
    (void)hipOccupancyMaxActiveBlocksPerMultiprocessor(&per_cu, hymba_fwd, 256, 0);
    if (per_cu > 2) per_cu = 2;
    if (per_cu < 1) per_cu = 1;
    grid_blocks = cus * per_cu;
  }
  (void)hipMemsetAsync((unsigned char*)d_ws + OFF_BAR, 0, BAR_BYTES, stream);
  int lo = 0, hi = NPHASE;
  void* args[] = {&p, &lo, &hi};
  hipError_t e = hipLaunchCooperativeKernel((void*)hymba_fwd, dim3(grid_blocks), dim3(256), args, 0, stream);
  if (e != hipSuccess) fprintf(stderr, "cooperative launch failed: %s (grid %d)\n", hipGetErrorString(e), grid_blocks);
}
```

```cpp
#include <hip/hip_runtime.h>
#include <hip/hip_cooperative_groups.h>
#include <cstdio>
#include <cstdint>
namespace cg = cooperative_groups;

#ifndef COOP
#define COOP 1
#endif

typedef unsigned short bf16_t;
typedef short bf16x8 __attribute__((ext_vector_type(8)));
typedef float f32x4 __attribute__((ext_vector_type(4)));

constexpr int DM = 1024, NB = 8, TPR = 2064, NSB = 128, TS = 4;
constexpr int MP = NB * TPR;
constexpr int MS = NSB * TS;
constexpr int MT = MP + MS;
constexpr int DIN = 3864, DINP = 3968, DFF = 2816;
constexpr float ALPHA = 1.41421356237309515f;

constexpr size_t SZ_WIN = (size_t)DINP * 1024 * 2, SZ_WOUT = (size_t)1024 * 1024 * 2, SZ_WGU = (size_t)5632 * 1024 * 2, SZ_WDN = (size_t)1024 * 2816 * 2;
constexpr size_t OFF_CS = 0;
constexpr size_t OFF_WIN = 532480;
constexpr size_t OFF_WOUT = OFF_WIN + 2 * SZ_WIN;
constexpr size_t OFF_WGU = OFF_WOUT + 2 * SZ_WOUT;
constexpr size_t OFF_WDN = OFF_WGU + 2 * SZ_WGU;
constexpr size_t OFF_X = OFF_WDN + 2 * SZ_WDN;
constexpr size_t OFF_P = OFF_X + (size_t)MT * 1024 * 4;
constexpr size_t OFF_X1B = OFF_P;
constexpr size_t OFF_H = OFF_P + (size_t)MT * 1024 * 2;
constexpr size_t OFF_BAR = OFF_P + (size_t)MT * DINP * 2;
constexpr int CEN_CNT = 3520, CEN_TAB = 4096, CEN_TAB2 = 8192;
constexpr size_t BAR_BYTES = 12288 * 4;
constexpr size_t WS_NEED = OFF_BAR + BAR_BYTES;
constexpr size_t DOUT_PS = 36000000;

constexpr size_t O_YP = 0, O_YS = 16777216, O_CP = 17301504, O_CS = 17338368, O_DP = 17928192, O_DS = 18190336,
                 O_HP = 22384640, O_HS = 22646784, O_GP = 26841088, O_GS = 26972160, O_RP = 29069312, O_RS = 29331456;

#define GAS __attribute__((address_space(1)))
struct Params {
  const float* in[29];
  float* out;
  unsigned char* ws;
  __device__ __forceinline__ const float* I(int i) const { return (const float*)(const GAS float*)in[i]; }
  __device__ __forceinline__ float* O() const { return (float*)(GAS float*)out; }
  __device__ __forceinline__ unsigned char* W() const { return (unsigned char*)(GAS unsigned char*)ws; }
};

__device__ __forceinline__ unsigned f2bf(float f) {
  unsigned u = __float_as_uint(f);
  u += 0x7fffu + ((u >> 16) & 1u);
  return u >> 16;
}
typedef float f32x2_t __attribute__((ext_vector_type(2)));
typedef __bf16 bf16x2_t __attribute__((ext_vector_type(2)));
__device__ __forceinline__ unsigned pk2(float lo, float hi) { const f32x2_t v = {lo, hi}; const bf16x2_t b = __builtin_convertvector(v, bf16x2_t); return __builtin_bit_cast(unsigned, b); }
__device__ __forceinline__ float bflo(unsigned u) { return __uint_as_float(u << 16); }
__device__ __forceinline__ float bfhi(unsigned u) { return __uint_as_float(u & 0xffff0000u); }
__device__ __forceinline__ void unpack8(const uint4& r, float* x) {
  x[0] = bflo(r.x); x[1] = bfhi(r.x); x[2] = bflo(r.y); x[3] = bfhi(r.y);
  x[4] = bflo(r.z); x[5] = bfhi(r.z); x[6] = bflo(r.w); x[7] = bfhi(r.w);
}
__device__ __forceinline__ float sigmoidf_(float x) { return __builtin_amdgcn_rcpf(1.0f + __expf(-x)); }
__device__ __forceinline__ float siluf_(float x) { return x * __builtin_amdgcn_rcpf(1.0f + __expf(-x)); }
__device__ __forceinline__ float softplusf_(float x) { return fmaxf(x, 0.f) + __logf(1.0f + __expf(-fabsf(x))); }
__device__ __forceinline__ float red8(float x) {
  x += __shfl_xor(x, 1); x += __shfl_xor(x, 2); x += __shfl_xor(x, 4); return x;
}
__device__ __forceinline__ float dpp_x1(float x) {
  return __int_as_float(__builtin_amdgcn_update_dpp(0, __float_as_int(x), 0xB1, 0xF, 0xF, true));
}
__device__ __forceinline__ float dpp_x2(float x) {
  return __int_as_float(__builtin_amdgcn_update_dpp(0, __float_as_int(x), 0x4E, 0xF, 0xF, true));
}
__device__ __forceinline__ float red4(float x) { x += dpp_x1(x); x += dpp_x2(x); return x; }
__device__ __forceinline__ float wave_sum(float x) {
#pragma unroll
  for (int o = 32; o >= 1; o >>= 1) x += __shfl_xor(x, o);
  return x;
}

__device__ __forceinline__ void convert_weights(const Params& p, char* lds, int w0, int w1, int wstep, const int tid) {
  float* tile = (float*)lds;
  for (int w = w0; w < w1; w += wstep) {
    const int l = w / 3360; int r = w % 3360;
    int mat, kt, rt;
    if (r < 992) { mat = 0; kt = r / 62; rt = r % 62; }
    else if (r < 1248) { r -= 992; mat = 1; kt = r / 16; rt = r % 16; }
    else if (r < 2656) { r -= 1248; mat = 2; kt = r / 88; rt = r % 88; }
    else { r -= 2656; mat = 3; kt = r / 16; rt = r % 16; }
    {
      const int r4 = (tid & 15) * 4, R = rt * 64 + r4, kq = tid >> 4;
      const float* src; int ns; bool valid = true;
      if (mat == 0) { const int rho = R & 31, scol = (R & ~31) + 8 * ((rho & 15) >> 2) + 4 * (rho >> 4) + (rho & 3);
        src = p.I(10) + (size_t)l * 1024 * DIN + scol; ns = DIN; valid = scol < DIN; }
      else if (mat == 1) { src = p.I(21) + (size_t)l * 1024 * 1024 + R; ns = 1024; }
      else if (mat == 2) { const int q = R & 63, f = q >> 4, i = q & 15, ty = f & 1, hid = (R >> 6) * 32 + 8 * (i >> 2) + 4 * (f >> 1) + (i & 3);
        src = (ty ? p.I(25) : p.I(24)) + (size_t)l * 1024 * DFF + hid; ns = DFF; }
      else { src = p.I(26) + (size_t)l * DFF * 1024 + R; ns = 1024; }
      f32x4 v[4];
#pragma unroll
      for (int i = 0; i < 4; ++i) v[i] = valid ? *(const f32x4*)(src + (size_t)(kt * 64 + kq + 16 * i) * ns) : (f32x4){0.f, 0.f, 0.f, 0.f};
#pragma unroll
      for (int i = 0; i < 4; ++i) {
        const int k = kq + 16 * i;
        tile[(r4 + 0) * 65 + k] = v[i][0]; tile[(r4 + 1) * 65 + k] = v[i][1]; tile[(r4 + 2) * 65 + k] = v[i][2]; tile[(r4 + 3) * 65 + k] = v[i][3];
      }
    }
    __syncthreads();
    {
      const int rr = tid >> 2, kc = (tid & 3) * 16;
      const int Kd = (mat == 3) ? DFF : 1024;
      bf16_t* base;
      if (mat == 0) base = (bf16_t*)(p.W() + OFF_WIN + l * SZ_WIN);
      else if (mat == 1) base = (bf16_t*)(p.W() + OFF_WOUT + l * SZ_WOUT);
      else if (mat == 2) base = (bf16_t*)(p.W() + OFF_WGU + l * SZ_WGU);
      else base = (bf16_t*)(p.W() + OFF_WDN + l * SZ_WDN);
      bf16_t* dst = base + (size_t)(rt * 64 + rr) * Kd + kt * 64 + kc;
      const float* s = tile + rr * 65 + kc;
      uint4 a, b;
      a.x = pk2(s[0], s[1]); a.y = pk2(s[2], s[3]); a.z = pk2(s[4], s[5]); a.w = pk2(s[6], s[7]);
      b.x = pk2(s[8], s[9]); b.y = pk2(s[10], s[11]); b.z = pk2(s[12], s[13]); b.w = pk2(s[14], s[15]);
      *(uint4*)dst = a; *(uint4*)(dst + 8) = b;
    }
    __syncthreads();
  }
}

__device__ __forceinline__ void ln_row_regs(f32x4 (&v)[4], const float* g, const float* bb, int lane) {
  float s = 0.f;
#pragma unroll
  for (int i = 0; i < 4; ++i) s += (v[i][0] + v[i][1]) + (v[i][2] + v[i][3]);
  const float mu = wave_sum(s) * (1.0f / 1024.0f);
  float q = 0.f;
#pragma unroll
  for (int i = 0; i < 4; ++i) { const f32x4 d = v[i] - mu; q += (d[0] * d[0] + d[1] * d[1]) + (d[2] * d[2] + d[3] * d[3]); }
  const float rs = rsqrtf(wave_sum(q) * (1.0f / 1024.0f) + 1e-5f);
#pragma unroll
  for (int i = 0; i < 4; ++i) {
    const f32x4 gg = *(const f32x4*)(g + lane * 4 + i * 256), b4 = *(const f32x4*)(bb + lane * 4 + i * 256);
    v[i] = (v[i] - mu) * rs * gg + b4;
  }
}

__device__ __forceinline__ void embed_ln(const Params& p, int bid, int nb, const int tid) {
  const int lane = tid & 63, wv = tid >> 6;
  float* X = (float*)(p.W() + OFF_X);
  bf16_t* Xb = (bf16_t*)p.O();
  auto src_of = [&](int row) -> const float* {
    if (row < MP) { const int b = row / TPR, t = row % TPR;
      return (t < 16) ? p.I(7) + (size_t)t * 1024 : p.I(0) + ((size_t)b * 2048 + (t - 16)) * 1024; }
    return p.I(1) + (size_t)(row - MP) * 1024;
  };
  f32x4 nx[4];
  { const float* s0 = src_of(min(bid * 4 + wv, MT - 1));
#pragma unroll
    for (int i = 0; i < 4; ++i) nx[i] = *(const f32x4*)(s0 + lane * 4 + i * 256); }
  for (int row = bid * 4 + wv; row < MT; row += nb * 4) {
    f32x4 v[4];
#pragma unroll
    for (int i = 0; i < 4; ++i) v[i] = nx[i];
    { const float* s1 = src_of(min(row + nb * 4, MT - 1));
#pragma unroll
      for (int i = 0; i < 4; ++i) nx[i] = *(const f32x4*)(s1 + lane * 4 + i * 256); }
    ln_row_regs(v, p.I(8), p.I(9), lane);
#pragma unroll
    for (int i = 0; i < 4; ++i) {
      *(f32x4*)(X + (size_t)row * 1024 + lane * 4 + i * 256) = v[i];
      uint2 o; o.x = pk2(v[i][0], v[i][1]); o.y = pk2(v[i][2], v[i][3]);
      *(uint2*)(Xb + (size_t)row * 1024 + lane * 4 + i * 256) = o;
    }
  }
}

__device__ __forceinline__ void rope_table(const Params& p, int bid, int nb, const int tid) {
  float2* cs = (float2*)(p.W() + OFF_CS);
  for (int e = bid * 256 + tid; e < 2068 * 32; e += nb * 256) {
    const int idx = e >> 5, i = e & 31;
    const double pos = (idx < 2064) ? (double)idx : (double)(16384 + idx - 2064);
    const double inv = exp(-((double)i / 31.0) * 9.210340371976184);
    const double ang = pos * inv;
    cs[e] = make_float2((float)cos(ang), (float)sin(ang));
  }
}

__device__ __forceinline__ void ln_phase(const Params& p, const float* g, const float* bb, bf16_t* xb, int final_, int bid, int nb, const int tid) {
  const int lane = tid & 63, wv = tid >> 6;
  float* X = (float*)(p.W() + OFF_X);
  f32x4 nx[4], nx2[4];
  {
    const int r0 = min(bid * 4 + wv, MT - 1), r1 = min(bid * 4 + wv + nb * 4, MT - 1);
#pragma unroll
    for (int i = 0; i < 4; ++i) nx[i] = *(const f32x4*)(X + (size_t)r0 * 1024 + lane * 4 + i * 256);
#pragma unroll
    for (int i = 0; i < 4; ++i) nx2[i] = *(const f32x4*)(X + (size_t)r1 * 1024 + lane * 4 + i * 256);
  }
  for (int row = bid * 4 + wv; row < MT; row += nb * 4) {
    f32x4 v[4];
#pragma unroll
    for (int i = 0; i < 4; ++i) { v[i] = nx[i]; nx[i] = nx2[i]; }
    {
      const int rn = min(row + nb * 8, MT - 1);
#pragma unroll
      for (int i = 0; i < 4; ++i) nx2[i] = *(const f32x4*)(X + (size_t)rn * 1024 + lane * 4 + i * 256);
    }
    ln_row_regs(v, g, bb, lane);
    if (!final_) {
#pragma unroll
      for (int i = 0; i < 4; ++i) {
        *(f32x4*)(X + (size_t)row * 1024 + lane * 4 + i * 256) = v[i];
        uint2 o; o.x = pk2(v[i][0], v[i][1]); o.y = pk2(v[i][2], v[i][3]);
        *(uint2*)(xb + (size_t)row * 1024 + lane * 4 + i * 256) = o;
      }
    } else {
      float* dst = nullptr;
      if (row < MP) { const int b = row / TPR, t = row % TPR; if (t >= 16) dst = p.O() + O_YP + ((size_t)b * 2048 + (t - 16)) * 1024; }
      else dst = p.O() + O_YS + (size_t)(row - MP) * 1024;
      if (dst) {
#pragma unroll
        for (int i = 0; i < 4; ++i) *(f32x4*)(dst + lane * 4 + i * 256) = v[i];
      }
    }
  }
}

enum { EPI_BF16 = 0, EPI_RESID = 1, EPI_SWIGLU = 2 };

template <int EPI>
__device__ __forceinline__ void gemm_tile(const bf16_t* __restrict__ A, const int lda, const bf16_t* __restrict__ Bt, const int ldb,
                                          const int K, const int m0, const int n0, void* Cout, const int ldc, char* lds, const int tid) {
  const int wid = tid >> 6, lane = tid & 63, wr = wid >> 1, wc = wid & 1, fr = lane & 15, fq = lane >> 4;
  f32x4 acc[4][4];
#pragma unroll
  for (int m = 0; m < 4; ++m)
#pragma unroll
    for (int n = 0; n < 4; ++n) acc[m][n] = (f32x4){0.f, 0.f, 0.f, 0.f};
  const int nt = K >> 6;
  const int st_row = tid >> 3, st_c = (tid & 7) ^ ((tid >> 4) & 7);
  auto stage = [&](int kt, int buf) {
#pragma unroll
    for (int i = 0; i < 4; ++i) {
      const int off = tid * 16 + i * 4096, r = st_row + i * 32;
      const bf16_t* ga = A + (size_t)(m0 + r) * lda + kt * 64 + st_c * 8;
      const bf16_t* gb = Bt + (size_t)(n0 + r) * ldb + kt * 64 + st_c * 8;
      __builtin_amdgcn_global_load_lds((const unsigned*)ga, (__attribute__((address_space(3))) unsigned*)(lds + buf * 32768 + off), 16, 0, 0);
      __builtin_amdgcn_global_load_lds((const unsigned*)gb, (__attribute__((address_space(3))) unsigned*)(lds + buf * 32768 + 16384 + off), 16, 0, 0);
    }
  };
  const int fsw = (fr >> 1) & 7;
  const int xk0 = (fq ^ fsw) << 4, xk1 = ((4 + fq) ^ fsw) << 4;
  stage(0, 0);
  for (int kt = 0; kt < nt; ++kt) {
    asm volatile("s_waitcnt vmcnt(0)" ::: "memory");
    __syncthreads();
    if (kt + 1 < nt) stage(kt + 1, (kt + 1) & 1);
    const char* sa = lds + (kt & 1) * 32768;
    const char* sb = sa + 16384;
    bf16x8 af[2][4], bfr[2][4];
#pragma unroll
    for (int ks = 0; ks < 2; ++ks) {
#pragma unroll
      for (int m = 0; m < 4; ++m) af[ks][m] = *(const bf16x8*)(sa + (wr * 64 + m * 16 + fr) * 128 + (ks ? xk1 : xk0));
#pragma unroll
      for (int n = 0; n < 4; ++n) bfr[ks][n] = *(const bf16x8*)(sb + (wc * 64 + n * 16 + fr) * 128 + (ks ? xk1 : xk0));
    }
#pragma unroll
    for (int ks = 0; ks < 2; ++ks)
#pragma unroll
      for (int m = 0; m < 4; ++m)
#pragma unroll
        for (int n = 0; n < 4; ++n) acc[m][n] = __builtin_amdgcn_mfma_f32_16x16x32_bf16(bfr[ks][n], af[ks][m], acc[m][n], 0, 0, 0);
  }
  if (EPI == EPI_RESID) {
    float* C0 = (float*)Cout + (size_t)(m0 + wr * 64 + fr) * ldc + n0 + wc * 64 + fq * 4;
#pragma unroll
    for (int mh = 0; mh < 2; ++mh) {
      f32x4 xin[2][4];
#pragma unroll
      for (int m = 0; m < 2; ++m)
#pragma unroll
        for (int n = 0; n < 4; ++n) xin[m][n] = *(const f32x4*)(C0 + (size_t)(mh * 2 + m) * 16 * ldc + n * 16);
#pragma unroll
      for (int m = 0; m < 2; ++m)
#pragma unroll
        for (int n = 0; n < 4; ++n) asm volatile("" : "+v"(xin[m][n]));
#pragma unroll
      for (int m = 0; m < 2; ++m)
#pragma unroll
        for (int n = 0; n < 4; ++n) *(f32x4*)(C0 + (size_t)(mh * 2 + m) * 16 * ldc + n * 16) = xin[m][n] * ALPHA + acc[mh * 2 + m][n];
    }
    return;
  }
#pragma unroll
  for (int m = 0; m < 4; ++m) {
    const int row = m0 + wr * 64 + m * 16 + fr;
    if (EPI == EPI_BF16) {
      bf16_t* C = (bf16_t*)Cout + (size_t)row * ldc + n0 + wc * 64 + fq * 8;
#pragma unroll
      for (int pq = 0; pq < 2; ++pq) { uint4 o; o.x = pk2(acc[m][2 * pq][0], acc[m][2 * pq][1]); o.y = pk2(acc[m][2 * pq][2], acc[m][2 * pq][3]);
        o.z = pk2(acc[m][2 * pq + 1][0], acc[m][2 * pq + 1][1]); o.w = pk2(acc[m][2 * pq + 1][2], acc[m][2 * pq + 1][3]); *(uint4*)(C + pq * 32) = o; }
    } else if (EPI == EPI_RESID) {
      float* C = (float*)Cout + (size_t)row * ldc + n0 + wc * 64 + fq * 4;
#pragma unroll
      for (int n = 0; n < 4; ++n) { const f32x4 x = *(const f32x4*)(C + n * 16); *(f32x4*)(C + n * 16) = x * ALPHA + acc[m][n]; }
    } else {
      bf16_t* C = (bf16_t*)Cout + (size_t)row * ldc + (n0 >> 1) + wc * 32 + fq * 8;
      const f32x4 g0 = acc[m][0], u0 = acc[m][1], g1 = acc[m][2], u1 = acc[m][3];
      uint4 o; o.x = pk2(siluf_(g0[0]) * u0[0], siluf_(g0[1]) * u0[1]); o.y = pk2(siluf_(g0[2]) * u0[2], siluf_(g0[3]) * u0[3]);
      o.z = pk2(siluf_(g1[0]) * u1[0], siluf_(g1[1]) * u1[1]); o.w = pk2(siluf_(g1[2]) * u1[2], siluf_(g1[3]) * u1[3]);
      *(uint4*)C = o;
    }
  }
}
template <int EPI>
__device__ __forceinline__ void gemm_phase(const bf16_t* A, int lda, const bf16_t* Bt, int ldb, int K, int ntn, void* C, int ldc, char* lds, int bid, int nb, const int tid) {
  constexpr int GM = 4, nM = MT / 128;
  const int ntiles = nM * ntn, nig = GM * ntn;
  const int pos = (EPI != EPI_SWIGLU && (nb & 7) == 0) ? (bid & 7) * (nb >> 3) + (bid >> 3) : bid;
  for (int L = pos; L < ntiles; L += nb) {
    int mt, nn;
    if (EPI == EPI_SWIGLU) { mt = L / ntn; nn = L % ntn; }
    else { const int gid = L / nig, fm = gid * GM, gsz = min(nM - fm, GM), rem = L - gid * nig; mt = fm + rem % gsz; nn = rem / gsz; }
    gemm_tile<EPI>(A, lda, Bt, ldb, K, mt * 128, nn * 128, C, ldc, lds, tid);
  }
}

#define XB_TMO      128
#define XB_XCNT(j)  (256  + 64 * (j))
#define XB_XSUB(j)  (1280 + 64 * (j))
#define XB_XGEN(j)  (2304 + 64 * (j))
#define XB_TOP      3328
#define XB_TOPGEN   3392
#define XCD_BAR_WORDS 3456
#define XB_SPIN_CAP (1u << 22)
__device__ __forceinline__ unsigned xb_ld(unsigned* p) { return __hip_atomic_load(p, __ATOMIC_RELAXED, __HIP_MEMORY_SCOPE_AGENT); }
__device__ __forceinline__ unsigned xb_add(unsigned* p, unsigned v) { return __hip_atomic_fetch_add(p, v, __ATOMIC_RELAXED, __HIP_MEMORY_SCOPE_AGENT); }
__device__ __forceinline__ unsigned xb_xcc_id() { return (unsigned)__builtin_amdgcn_s_getreg((3 << 11) | 20) & 0xFu; }
#define XB_SPIN(cond, bar) do { unsigned _sp = 0; while (cond) { __builtin_amdgcn_s_sleep(1); \
    if ((++_sp & 255u) == 0u) { if (xb_ld(&(bar)[XB_TMO])) break; if (_sp > XB_SPIN_CAP) { atomicAdd(&(bar)[XB_TMO], 1u); break; } } } } while (0)
struct XcdBarrier { unsigned* bar; unsigned x; unsigned nloc, nx; };
__device__ __forceinline__ void xcd_barrier_complete(unsigned* bar, unsigned x, unsigned G, unsigned& nloc, unsigned& nx) {
  unsigned sum, cnt, mine, sp = 0u;
  for (;;) {
    sum = 0u; cnt = 0u; mine = 0u;
#pragma unroll
    for (unsigned j = 0; j < 16; ++j) { const unsigned c = xb_ld(&bar[XB_XCNT(j)]); sum += c; cnt += (c > 0u) ? 1u : 0u; mine = (j == x) ? c : mine; }
    if (sum == G) break;
    __builtin_amdgcn_s_sleep(1);
    if ((++sp & 255u) == 0u) { if (xb_ld(&bar[XB_TMO])) break; if (sp > XB_SPIN_CAP) { atomicAdd(&bar[XB_TMO], 1u); break; } }
  }
  nloc = mine > 0u ? mine : 1u; nx = cnt > 0u ? cnt : 1u;
}
__device__ __forceinline__ void xcd_barrier(XcdBarrier& b, const int tid, const unsigned G) {
  asm volatile("s_waitcnt vmcnt(0)" ::: "memory");
  __syncthreads();
  if (tid == 0) {
    unsigned* bar = b.bar;
    __builtin_amdgcn_s_waitcnt(0);
    if (b.nloc == 0u) xcd_barrier_complete(bar, b.x, G, b.nloc, b.nx);
    const unsigned nloc = b.nloc, nx = b.nx;
    const unsigned old = xb_add(&bar[XB_XSUB(b.x)], 1u);
    const unsigned gen = old / nloc;
    if (old + 1u == (gen + 1u) * nloc) {
      __builtin_amdgcn_fence(__ATOMIC_RELEASE, "agent");
      asm volatile("s_waitcnt vmcnt(0)" ::: "memory");
      const unsigned og = xb_add(&bar[XB_TOP], 1u);
      const unsigned tg = og / nx;
      if (og + 1u == (tg + 1u) * nx) xb_add(&bar[XB_TOPGEN], 1u);
      else XB_SPIN(xb_ld(&bar[XB_TOPGEN]) == tg, bar);
      __builtin_amdgcn_fence(__ATOMIC_ACQUIRE, "agent");
      xb_add(&bar[XB_XGEN(b.x)], 1u);
      asm volatile("s_waitcnt vmcnt(0)" ::: "memory");
    } else {
      XB_SPIN(xb_ld(&bar[XB_XGEN(b.x)]) == gen, bar);
      __builtin_amdgcn_fence(__ATOMIC_ACQUIRE, "agent");
      asm volatile("s_waitcnt vmcnt(0)" ::: "memory");
    }
  }
  __syncthreads();
}

template <int N, int RS>
__device__ __forceinline__ void convN(const bf16_t* rawb, const float (&w)[4][N], int tt, int off, float (&x)[N]) {
#pragma unroll
  for (int i = 0; i < N; ++i) x[i] = 0.f;
#pragma unroll
  for (int j = 0; j < 4; ++j) {
    float xv[N];
    if (N == 8) { const uint4 rv = *(const uint4*)(rawb + (tt + j) * RS + off); unpack8(rv, xv); }
    else if (N == 4) { const uint2 rv = *(const uint2*)(rawb + (tt + j) * RS + off); xv[0] = bflo(rv.x); xv[1] = bfhi(rv.x); xv[2 % N] = bflo(rv.y); xv[3 % N] = bfhi(rv.y); }
    else { const unsigned rv = *(const unsigned*)(rawb + (tt + j) * RS + off); xv[0] = bflo(rv); xv[1] = bfhi(rv); }
#pragma unroll
    for (int i = 0; i < N; ++i) x[i] += w[j][i] * xv[i];
  }
  if (N == 2) {
#pragma unroll
    for (int i = 0; i < N; ++i) asm volatile("" : "+v"(x[i]));
  }
#pragma unroll
  for (int i = 0; i < N; ++i) x[i] = siluf_(x[i]);
}

template <int MIX, int VN>
__device__ __forceinline__ void load_chunk_fn(const unsigned char* ws, const bf16_t* Pb, const int t, const int T, const int h, const int vcol, const int sub, const int posb,
                                              uint4& R0, uint4& R1, uint2& R2, uint4& R4, uint4& R5, unsigned& ex0, unsigned& ex1) {
  if (t < T) {
    const bf16_t* pr = Pb + (size_t)t * DINP;
    const int vbase = (MIX == 0) ? 512 : (MIX == 1) ? 1544 : (MIX == 2) ? 2312 : 3352;
    if (VN == 4) R2 = *(const uint2*)(pr + vbase + h * 64 + vcol);
    else R2.x = *(const unsigned*)(pr + vbase + h * 64 + vcol);
    if (MIX == 0) {
      R0 = *(const uint4*)(pr + 0 + h * 64 + sub * 8); R1 = *(const uint4*)(pr + 256 + h * 64 + sub * 8);
      ex0 = pr[768 + h]; ex1 = pr[772 + h];
    } else if (MIX == 1) {
      R0 = *(const uint4*)(pr + 1032 + h * 64 + sub * 8); R1 = *(const uint4*)(pr + 1288 + h * 64 + sub * 8);
    } else if (MIX == 2) {
      const uint2 q2 = *(const uint2*)(pr + 2056 + h * 32 + sub * 4), k2 = *(const uint2*)(pr + 2184 + h * 32 + sub * 4);
      R0 = make_uint4(q2.x, q2.y, k2.x, k2.y);
      R1 = *(const uint4*)(pr + 2568); R4 = *(const uint4*)(pr + 2576);
    } else {
      const uint2 ql = *(const uint2*)(pr + 2840 + h * 64 + sub * 4), qh = *(const uint2*)(pr + 2840 + h * 64 + 32 + sub * 4);
      const uint2 kl = *(const uint2*)(pr + 3096 + h * 64 + sub * 4), kh = *(const uint2*)(pr + 3096 + h * 64 + 32 + sub * 4);
      R0 = make_uint4(ql.x, ql.y, qh.x, qh.y); R1 = make_uint4(kl.x, kl.y, kh.x, kh.y);
      const uint4* cs = (const uint4*)(ws + OFF_CS + ((size_t)(posb + t) * 32 + sub * 4) * 8);
      R4 = cs[0]; R5 = cs[1];
    }
  }
}

__device__ __forceinline__ float dpp_hm(float x) {
  return __int_as_float(__builtin_amdgcn_update_dpp(0, __float_as_int(x), 0x141, 0xF, 0xF, true));
}
__device__ __forceinline__ float dpp_rm(float x) {
  return __int_as_float(__builtin_amdgcn_update_dpp(0, __float_as_int(x), 0x140, 0xF, 0xF, true));
}
__device__ __forceinline__ float red8d(float x) { x += dpp_x1(x); x += dpp_x2(x); x += dpp_hm(x); return x; }
template <int KG> __device__ __forceinline__ float redKG(float x) { x = red8d(x); if (KG == 16) x += dpp_rm(x); return x; }

template <int MIX, int KPL>
struct StepIn { float q[KPL], k[KPL], d[KPL]; float v, a, be, qk; };

template <int MIX, int KPL>
__device__ __forceinline__ void load_step(const float* qkdv, const float* scal, int t, int kg, int col, StepIn<MIX, KPL>& s) {
  const float* base = qkdv + t * 256;
#pragma unroll
  for (int i = 0; i < KPL; i += 4) {
    const f32x4 a = *(const f32x4*)(base + kg * KPL + i), b = *(const f32x4*)(base + 64 + kg * KPL + i);
    s.q[i] = a[0]; s.q[i + 1] = a[1]; s.q[i + 2] = a[2]; s.q[i + 3] = a[3];
    s.k[i] = b[0]; s.k[i + 1] = b[1]; s.k[i + 2] = b[2]; s.k[i + 3] = b[3];
    if (MIX == 1 || MIX == 2) { const f32x4 d = *(const f32x4*)(base + 128 + kg * KPL + i); s.d[i] = d[0]; s.d[i + 1] = d[1]; s.d[i + 2] = d[2]; s.d[i + 3] = d[3]; }
  }
  s.v = base[192 + col];
  if (MIX == 0) { const f32x4 c = *(const f32x4*)(scal + t * 4); s.a = c[0]; s.be = c[1]; s.qk = c[2]; }
}

template <int MIX, int KPL, int KG>
__device__ __forceinline__ float do_step(const StepIn<MIX, KPL>& s, float (&S)[KPL], const float gam) {
  if (MIX == 0) {
    float kS0 = 0.f, kS1 = 0.f, qS0 = 0.f, qS1 = 0.f;
#pragma unroll
    for (int i = 0; i < KPL; i += 2) { kS0 += s.k[i] * S[i]; kS1 += s.k[i + 1] * S[i + 1]; qS0 += s.q[i] * S[i]; qS1 += s.q[i + 1] * S[i + 1]; }
    const float kS = redKG<KG>(kS0 + kS1), qS = redKG<KG>(qS0 + qS1);
    const float w = s.be * (s.v - s.a * kS);
#pragma unroll
    for (int i = 0; i < KPL; ++i) S[i] = s.a * S[i] + s.k[i] * w;
    return s.a * qS + s.qk * w;
  } else {
    float o0 = 0.f, o1 = 0.f;
#pragma unroll
    for (int i = 0; i < KPL; i += 2) {
      const float d0 = (MIX == 3) ? gam : s.d[i], d1 = (MIX == 3) ? gam : s.d[i + 1];
      S[i] = d0 * S[i] + s.k[i] * s.v; S[i + 1] = d1 * S[i + 1] + s.k[i + 1] * s.v;
      o0 += s.q[i] * S[i]; o1 += s.q[i + 1] * S[i + 1];
    }
    return redKG<KG>(o0 + o1);
  }
}

template <int MIX>
__device__ __forceinline__ void scan_part(const Params& p, const int layer, const int smp, const int b0, const int bstep, const int bend, const int h, const int part, char* lds, const int tid) {
  constexpr int DK = (MIX == 2) ? 32 : 64;
  constexpr int NS = (MIX == 0) ? 4 : 2;
  constexpr int CW = 64 / NS;
  constexpr int CPW = CW / 4;
  constexpr int KG = 64 / CPW;
  constexpr int KPL = DK / KG;
  constexpr int VN = CW / 8;
  constexpr int RS = 128 + CW;
  float* qkdv = (float*)lds;
  float* obuf = (float*)(lds + 32768);
  float* scal = (float*)(lds + 36864);
  bf16_t* rawb = (bf16_t*)(lds + 37376);
  float* cwl = (float*)(lds + 48576);
  float* wgl = (float*)(lds + 37376);

  const int lane = tid & 63, wv = tid >> 6;
  const int tt = tid >> 3, sub = tid & 7;
  const int col = wv * CPW + lane / KG, kg = lane % KG;
  const int T = smp ? 4 : TPR;
  const int nBatch = smp ? NSB : NB;
  const int posb = smp ? 2064 : 0;
  const int vcol = part * CW + sub * VN;
  __syncthreads();
  float c8[8];
  float Aexp = 0.f, dtb = 0.f, gam = 0.f;
  float cwq[4][8], cwk[4][8];
  if (MIX == 0) {
    Aexp = __expf(p.I(12)[layer * 4 + h]); dtb = p.I(13)[layer * 4 + h];
#pragma unroll
    for (int j = 0; j < 4; ++j) {
      const float* cwp = p.I(11) + (size_t)(layer * 4 + j) * 768;
#pragma unroll
      for (int i = 0; i < 8; ++i) { cwq[j][i] = cwp[h * 64 + sub * 8 + i]; cwk[j][i] = cwp[256 + h * 64 + sub * 8 + i]; }
    }
    for (int e = tid; e < 4 * CW; e += 256) { const int j = e / CW, r = e % CW; cwl[j * RS + 128 + r] = p.I(11)[(size_t)(layer * 4 + j) * 768 + 512 + h * 64 + part * CW + r]; }
  } else if (MIX == 1) {
#pragma unroll
    for (int i = 0; i < 8; ++i) {
      const int d = h * 64 + sub * 8 + i;
      c8[i] = (layer == 0) ? 1.0f : sigmoidf_(p.I(15)[d] - p.I(15)[256 + d]);
    }
  } else if (MIX == 2) {
    for (int e = tid; e < 512; e += 256) { const int r = e >> 5, j = e & 31; wgl[e] = p.I(17)[(size_t)(layer * 16 + r) * 128 + h * 32 + j]; }
#pragma unroll
    for (int i = 0; i < 4; ++i) c8[i] = p.I(18)[layer * 128 + h * 32 + sub * 4 + i];
  } else {
    gam = 1.0f - exp2f(-5.0f - (float)h);
  }
  for (int b = b0; b < bend; b += bstep) {
  const int row0 = smp ? MP + b * 4 : b * TPR;
  const bf16_t* Pb = (const bf16_t*)(p.W() + OFF_P) + (size_t)row0 * DINP;
  bf16_t* Ob = (bf16_t*)p.O() + (size_t)row0 * 1024 + MIX * 256 + h * 64 + part * CW;
  float* PS = (float*)((unsigned char*)p.O() + DOUT_PS) + (size_t)row0 * 128 + (MIX * 4 + h) * 8 + part * 2;
  uint4 R0 = make_uint4(0, 0, 0, 0), R1 = R0, R4 = R0, R5 = R0; uint2 R2 = make_uint2(0, 0); unsigned ex0 = 0, ex1 = 0;
  load_chunk_fn<MIX, VN>(p.W(), Pb, tt, T, h, vcol, sub, posb, R0, R1, R2, R4, R5, ex0, ex1);
  float S[KPL];
  if (smp) {
    const float* sin_ = p.I(3 + MIX) + ((size_t)(layer * NSB + b) * 4 + h) * DK * 64 + part * CW;
#pragma unroll
    for (int i = 0; i < KPL; ++i) S[i] = sin_[(kg * KPL + i) * 64 + col];
  } else {
#pragma unroll
    for (int i = 0; i < KPL; ++i) S[i] = 0.f;
  }
  if (MIX == 0) {
    for (int e = tid; e < 3 * RS; e += 256) { const int j = e / RS, r = e % RS;
      const int cc = (r < 64) ? (h * 64 + r) : (r < 128) ? (256 + h * 64 + r - 64) : (512 + h * 64 + part * CW + r - 128);
      float v = 0.f; if (smp) v = p.I(2)[((size_t)(layer * NSB + b) * 3 + j) * 768 + cc];
      rawb[e] = (bf16_t)f2bf(v); }
  }
  __syncthreads();

  int ntok_last = 0;
  for (int t0 = 0; t0 < T; t0 += 32) {
    const int ntok = min(32, T - t0);
    ntok_last = ntok;
    const bool valid = tt < ntok;
    float* dst = qkdv + tt * 256;
    if (MIX != 0 && valid) {
      if (VN == 4) *(f32x4*)(dst + 192 + sub * 4) = (f32x4){bflo(R2.x), bfhi(R2.x), bflo(R2.y), bfhi(R2.y)};
      else *(float2*)(dst + 192 + sub * 2) = make_float2(bflo(R2.x), bfhi(R2.x));
    }
    if (MIX == 0) {
      if (valid) {
        *(uint4*)(rawb + (3 + tt) * RS + 0 + sub * 8) = R0;
        *(uint4*)(rawb + (3 + tt) * RS + 64 + sub * 8) = R1;
        if (VN == 4) *(uint2*)(rawb + (3 + tt) * RS + 128 + sub * 4) = R2;
        else *(unsigned*)(rawb + (3 + tt) * RS + 128 + sub * 2) = R2.x;
      }
      __syncthreads();
      if (valid) {
        float xq[8], xk[8], xv[VN];
        { float cwv[4][VN];
#pragma unroll
          for (int j = 0; j < 4; ++j)
#pragma unroll
            for (int i = 0; i < VN; ++i) cwv[j][i] = cwl[j * RS + 128 + sub * VN + i];
          convN<VN, RS>(rawb, cwv, tt, 128 + sub * VN, xv); }
        convN<8, RS>(rawb, cwq, tt, sub * 8, xq);
        convN<8, RS>(rawb, cwk, tt, 64 + sub * 8, xk);
#pragma unroll
        for (int i = 0; i < VN; ++i) dst[192 + sub * VN + i] = xv[i];
        float ssq = 0.f, ssk = 0.f;
#pragma unroll
        for (int i = 0; i < 8; ++i) { ssq += xq[i] * xq[i]; ssk += xk[i] * xk[i]; }
        ssq = red8d(ssq); ssk = red8d(ssk);
        const float rq = rsqrtf(ssq + 1e-6f) * 0.125f, rk = rsqrtf(ssk + 1e-6f);
        float qk = 0.f;
#pragma unroll
        for (int i = 0; i < 8; ++i) { xq[i] *= rq; xk[i] *= rk; qk += xq[i] * xk[i]; }
        qk = red8d(qk);
        *(f32x4*)(dst + sub * 8) = (f32x4){xq[0], xq[1], xq[2], xq[3]}; *(f32x4*)(dst + sub * 8 + 4) = (f32x4){xq[4], xq[5], xq[6], xq[7]};
        *(f32x4*)(dst + 64 + sub * 8) = (f32x4){xk[0], xk[1], xk[2], xk[3]}; *(f32x4*)(dst + 64 + sub * 8 + 4) = (f32x4){xk[4], xk[5], xk[6], xk[7]};
        if (sub == 0) {
          const float be = sigmoidf_(bflo(ex0)), al = bflo(ex1);
          const float a = __expf(-Aexp * softplusf_(al + dtb));
          *(f32x4*)(scal + tt * 4) = (f32x4){a, be, qk, 0.f};
        }
      }
    } else if (MIX == 1) {
      if (valid) {
        float q[8], z[8]; unpack8(R0, q); unpack8(R1, z);
        float kk[8], dd[8];
#pragma unroll
        for (int i = 0; i < 8; ++i) { q[i] = siluf_(q[i]); kk[i] = c8[i] * sigmoidf_(-z[i]); dd[i] = 1.0f - fminf(kk[i], 1.0f - 1e-6f); }
        *(f32x4*)(dst + sub * 8) = (f32x4){q[0], q[1], q[2], q[3]}; *(f32x4*)(dst + sub * 8 + 4) = (f32x4){q[4], q[5], q[6], q[7]};
        *(f32x4*)(dst + 64 + sub * 8) = (f32x4){kk[0], kk[1], kk[2], kk[3]}; *(f32x4*)(dst + 64 + sub * 8 + 4) = (f32x4){kk[4], kk[5], kk[6], kk[7]};
        *(f32x4*)(dst + 128 + sub * 8) = (f32x4){dd[0], dd[1], dd[2], dd[3]}; *(f32x4*)(dst + 128 + sub * 8 + 4) = (f32x4){dd[4], dd[5], dd[6], dd[7]};
      }
    } else if (MIX == 2) {
      if (valid) {
        float lr[16]; unpack8(R1, lr); unpack8(R4, lr + 8);
        const float q0 = bflo(R0.x), q1 = bfhi(R0.x), q2 = bflo(R0.y), q3 = bfhi(R0.y);
        const float k0 = bflo(R0.z), k1 = bfhi(R0.z), k2 = bflo(R0.w), k3 = bfhi(R0.w);
        const float sc = 0.17677669529663687f;
        f32x4 xg = (f32x4){c8[0], c8[1], c8[2], c8[3]};
#pragma unroll
        for (int r = 0; r < 16; ++r) xg += lr[r] * *(const f32x4*)(wgl + r * 32 + sub * 4);
        f32x4 dd;
#pragma unroll
        for (int i = 0; i < 4; ++i) { const float ls = fminf(xg[i], 0.f) - __logf(1.0f + __expf(-fabsf(xg[i]))); dd[i] = __expf(ls * 0.0625f); }
        *(f32x4*)(dst + sub * 4) = (f32x4){q0 * sc, q1 * sc, q2 * sc, q3 * sc};
        *(f32x4*)(dst + 64 + sub * 4) = (f32x4){k0, k1, k2, k3};
        *(f32x4*)(dst + 128 + sub * 4) = dd;
      }
    } else {
      if (valid) {
        const float ql[4] = {bflo(R0.x), bfhi(R0.x), bflo(R0.y), bfhi(R0.y)}, qh[4] = {bflo(R0.z), bfhi(R0.z), bflo(R0.w), bfhi(R0.w)};
        const float kl[4] = {bflo(R1.x), bfhi(R1.x), bflo(R1.y), bfhi(R1.y)}, kh[4] = {bflo(R1.z), bfhi(R1.z), bflo(R1.w), bfhi(R1.w)};
        const float cc[4] = {__uint_as_float(R4.x), __uint_as_float(R4.z), __uint_as_float(R5.x), __uint_as_float(R5.z)};
        const float sn[4] = {__uint_as_float(R4.y), __uint_as_float(R4.w), __uint_as_float(R5.y), __uint_as_float(R5.w)};
        f32x4 qa, qb, ka, kb;
#pragma unroll
        for (int i = 0; i < 4; ++i) {
          qa[i] = ql[i] * cc[i] - qh[i] * sn[i]; qb[i] = ql[i] * sn[i] + qh[i] * cc[i];
          ka[i] = (kl[i] * cc[i] - kh[i] * sn[i]) * 0.125f; kb[i] = (kl[i] * sn[i] + kh[i] * cc[i]) * 0.125f;
        }
        *(f32x4*)(dst + sub * 4) = qa; *(f32x4*)(dst + 32 + sub * 4) = qb;
        *(f32x4*)(dst + 64 + sub * 4) = ka; *(f32x4*)(dst + 96 + sub * 4) = kb;
      }
    }
    __syncthreads();
    if (MIX == 0 && t0 + 32 < T) {
      if (tid < 3 * RS / 8) { const uint4 v = *(const uint4*)(rawb + 32 * RS + tid * 8); *(uint4*)(rawb + tid * 8) = v; }
    }
    if (t0 + 32 < T) load_chunk_fn<MIX, VN>(p.W(), Pb, t0 + 32 + tt, T, h, vcol, sub, posb, R0, R1, R2, R4, R5, ex0, ex1);
    {
      StepIn<MIX, KPL> sa, sb;
      float osave = 0.f;
      load_step<MIX, KPL>(qkdv, scal, 0, kg, col, sa);
      for (int t = 0; t < ntok; t += 2) {
        load_step<MIX, KPL>(qkdv, scal, t + 1, kg, col, sb);
        __builtin_amdgcn_sched_barrier(0);
        const float oa = do_step<MIX, KPL, KG>(sa, S, gam);
        osave = (kg == (t & (KG - 1))) ? oa : osave;
        load_step<MIX, KPL>(qkdv, scal, min(t + 2, ntok - 1), kg, col, sa);
        __builtin_amdgcn_sched_barrier(0);
        const float ob = do_step<MIX, KPL, KG>(sb, S, gam);
        osave = (kg == ((t + 1) & (KG - 1))) ? ob : osave;
        if (((t + 2) & (KG - 1)) == 0) obuf[(t + 2 - KG + kg) * CW + col] = osave;
      }
      const int remn = ntok & (KG - 1);
      if (remn != 0 && kg < remn) obuf[(ntok - remn + kg) * CW + col] = osave;
    }
    __syncthreads();
    if (valid) {
      float o[VN];
#pragma unroll
      for (int i = 0; i < VN; ++i) o[i] = obuf[tt * CW + sub * VN + i];
      float s1 = 0.f, s2 = 0.f;
#pragma unroll
      for (int i = 0; i < VN; ++i) { s1 += o[i]; s2 += o[i] * o[i]; }
      s1 = red8d(s1); s2 = red8d(s2);
      if (VN == 4) { uint2 o2; o2.x = pk2(o[0], o[1]); o2.y = pk2(o[2 % VN], o[3 % VN]); *(uint2*)(Ob + (size_t)(t0 + tt) * 1024 + sub * 4) = o2; }
      else *(unsigned*)(Ob + (size_t)(t0 + tt) * 1024 + sub * 2) = pk2(o[0], o[1]);
      if (sub == 0) *(float2*)(PS + (size_t)(t0 + tt) * 128) = make_float2(s1, s2);
    }
  }
  {
    const size_t obase = (MIX == 0) ? (smp ? O_DS : O_DP) : (MIX == 1) ? (smp ? O_HS : O_HP) : (MIX == 2) ? (smp ? O_GS : O_GP) : (smp ? O_RS : O_RP);
    float* so = p.O() + obase + ((size_t)(layer * nBatch + b) * 4 + h) * DK * 64 + part * CW;
#pragma unroll
    for (int i = 0; i < KPL; ++i) so[(kg * KPL + i) * 64 + col] = S[i];
  }
  if (MIX == 0) {
    float* co = p.O() + (smp ? O_CS : O_CP) + (size_t)(layer * nBatch + b) * 3 * 768;
    for (int e = tid; e < 3 * RS; e += 256) { const int j = e / RS, r = e % RS;
      const float v = bflo((unsigned)rawb[(ntok_last + j) * RS + r]);
      if (r < 128) { if (part == 0) co[j * 768 + ((r < 64) ? (h * 64 + r) : (256 + h * 64 + r - 64))] = v; }
      else co[j * 768 + 512 + h * 64 + part * CW + r - 128] = v; }
  }
  __syncthreads();
  }
}

constexpr int ITEMS_PER_SEQ = 40;
__device__ __forceinline__ void scan_dispatch(const Params& p, int layer, int smp, int type, int b0, int bstep, int bend, char* lds, const int tid) {
  const int r = type;
  if (r < 16) scan_part<0>(p, layer, smp, b0, bstep, bend, r >> 2, r & 3, lds, tid);
  else {
    const int r2 = r - 16, mh = 4 + (r2 >> 1), part = r2 & 1, mix = mh >> 2, h = mh & 3;
    if (mix == 1) scan_part<1>(p, layer, smp, b0, bstep, bend, h, part, lds, tid);
    else if (mix == 2) scan_part<2>(p, layer, smp, b0, bstep, bend, h, part, lds, tid);
    else scan_part<3>(p, layer, smp, b0, bstep, bend, h, part, lds, tid);
  }
}

__device__ __forceinline__ int long_item_type(int u, int& b) {
  int type;
  if (u < 64) { b = u >> 3; type = 24 + (u & 7); }
  else if (u < 192) { const int v = u - 64; b = v >> 4; type = v & 15; }
  else if (u < 256) { const int v = u - 192; b = v >> 3; type = 16 + (v & 7); }
  else { const int v = u - 256; b = v >> 3; type = 32 + (v & 7); }
  return type;
}
__device__ __forceinline__ void scan_phase(const Params& p, int layer, char* lds, int bid, int nb, const int tid, const int role, const int ci, const int nprim, const int nsec) {
  constexpr int NPI = NB * ITEMS_PER_SEQ;
  const bool paired = (nprim == 256 && nsec == 256);
  int j = -1, nbs = 1;
  if (paired) {
    int u = -1;
    if (role == 0) u = ci; else if (ci < NPI - 256) u = 256 + ci;
    if (u >= 0) { int b; const int type = long_item_type(u, b); scan_dispatch(p, layer, 0, type, b, 1, b + 1, lds, tid); }
    else { j = ci - (NPI - 256); nbs = 256 - (NPI - 256); }
  } else {
    for (int u = bid; u < NPI; u += nb) { int b; const int type = long_item_type(u, b); scan_dispatch(p, layer, 0, type, b, 1, b + 1, lds, tid); }
    nbs = (nb > NPI) ? nb - NPI : nb; j = (nb > NPI) ? bid - NPI : bid;
  }
  if (j >= 0) {
    const int nsl = (nbs + ITEMS_PER_SEQ - 1) / ITEMS_PER_SEQ;
    for (int jj = j; jj < ITEMS_PER_SEQ * nsl; jj += nbs) scan_dispatch(p, layer, 1, jj % ITEMS_PER_SEQ, jj / ITEMS_PER_SEQ, nsl, NSB, lds, tid);
    if (layer == 0) { __syncthreads(); convert_weights(p, lds, 992 + j, 6720, nbs, tid); }
  }
}

__device__ __forceinline__ void norm_phase(const Params& p, int layer, int bid, int nb, const int tid) {
  bf16_t* O = (bf16_t*)p.O();
  const bf16_t* P = (const bf16_t*)(p.W() + OFF_P);
  const float* PS = (const float*)((const unsigned char*)p.O() + DOUT_PS);
  const int cg8 = tid & 127;
  const int mh = cg8 >> 3, mix = mh >> 2, h = mh & 3, j0 = (cg8 & 7) * 8;
  const int gcol = (mix == 0) ? 776 : (mix == 1) ? 1800 : (mix == 2) ? 2584 : 3608;
  const float* gsrc = (mix == 0) ? p.I(14) : (mix == 1) ? p.I(16) : (mix == 2) ? p.I(19) : p.I(20);
  float g8[8];
#pragma unroll
  for (int i = 0; i < 8; ++i) g8[i] = gsrc[layer * 256 + h * 64 + j0 + i];
  uint4 ovn, gvn; f32x4 psn, ps2n = (f32x4){0.f, 0.f, 0.f, 0.f};
  {
    const int r0 = min(bid * 2 + (tid >> 7), MT - 1);
    ovn = *(const uint4*)(O + (size_t)r0 * 1024 + cg8 * 8);
    gvn = *(const uint4*)(P + (size_t)r0 * DINP + gcol + h * 64 + j0);
    psn = *(const f32x4*)(PS + (size_t)r0 * 128 + mh * 8);
    if (mix == 0) ps2n = *(const f32x4*)(PS + (size_t)r0 * 128 + mh * 8 + 4);
  }
  for (int row = bid * 2 + (tid >> 7); row < MT; row += nb * 2) {
    const uint4 ov = ovn, gv = gvn; const f32x4 ps = psn, ps2 = ps2n;
    {
      const int rn = min(row + nb * 2, MT - 1);
      ovn = *(const uint4*)(O + (size_t)rn * 1024 + cg8 * 8);
      gvn = *(const uint4*)(P + (size_t)rn * DINP + gcol + h * 64 + j0);
      psn = *(const f32x4*)(PS + (size_t)rn * 128 + mh * 8);
      if (mix == 0) ps2n = *(const f32x4*)(PS + (size_t)rn * 128 + mh * 8 + 4);
    }
    float s1 = ps[0] + ps[2], s2 = ps[1] + ps[3];
    if (mix == 0) { s1 += ps2[0] + ps2[2]; s2 += ps2[1] + ps2[3]; }
    float o[8], gt[8]; unpack8(ov, o); unpack8(gv, gt);
    float mu = 0.f, rs;
    if (mix == 3) { mu = s1 * (1.0f / 64.0f); const float var = fmaxf(s2 * (1.0f / 64.0f) - mu * mu, 0.f); rs = rsqrtf(var + 1e-5f); }
    else rs = rsqrtf(s2 * (1.0f / 64.0f) + 1e-6f);
    float r[8];
#pragma unroll
    for (int i = 0; i < 8; ++i) r[i] = (o[i] - mu) * rs * g8[i] * siluf_(gt[i]);
    uint4 o4; o4.x = pk2(r[0], r[1]); o4.y = pk2(r[2], r[3]); o4.z = pk2(r[4], r[5]); o4.w = pk2(r[6], r[7]);
    *(uint4*)(O + (size_t)row * 1024 + cg8 * 8) = o4;
  }
}

constexpr int NPHASE = 17;
__global__ void __launch_bounds__(256, 2) hymba_fwd(Params p_, int ph_lo, int ph_hi) {
  __shared__ __attribute__((aligned(16))) char lds[65536];
  XcdBarrier xb; xb.bar = (unsigned*)(p_.ws + OFF_BAR); xb.x = xb_xcc_id(); xb.nloc = 0u; xb.nx = 0u;
  if (threadIdx.x == 0) (void)xb_add(&xb.bar[XB_XCNT(xb.x)], 1u);
  int role = 0, ci = 0;
  {
    const unsigned key = ((((unsigned)__builtin_amdgcn_s_getreg((31 << 11) | 4)) >> 8) & 0xFFu) | (xb.x << 8);
    if (threadIdx.x == 0) {
      const unsigned slot = xb_add(&xb.bar[CEN_TAB + key], 1u);
      unsigned r;
      if (slot == 0u) { r = xb_add(&xb.bar[CEN_CNT], 1u); __hip_atomic_store(&xb.bar[CEN_TAB2 + key], r + 1u, __ATOMIC_RELAXED, __HIP_MEMORY_SCOPE_AGENT); }
      else { (void)xb_add(&xb.bar[CEN_CNT + 1], 1u); r = 0u; }
      *(volatile unsigned*)(lds) = slot == 0u ? 0u : 1u; *(volatile unsigned*)(lds + 4) = r;
    }
    __syncthreads();
    role = (int)*(volatile unsigned*)(lds); ci = (int)*(volatile unsigned*)(lds + 4);
    __syncthreads();
    role = __builtin_amdgcn_readfirstlane(role); ci = __builtin_amdgcn_readfirstlane(ci);
    if (role != 0) ci = -1 - (int)key;
  }
  int nprim = 0, nsec = 0;
  if (ph_hi < 0) cg::this_grid().sync();
  for (int ph = ph_lo; ph < ph_hi; ++ph) {
    int tid = threadIdx.x, bid = blockIdx.x, nb = gridDim.x;
    asm volatile("" : "+v"(tid));
    asm volatile("" : "+s"(bid), "+s"(nb));
    if (ph > ph_lo) xcd_barrier(xb, tid, (unsigned)nb);
    if (ph == ph_lo + 1) {
      nprim = (int)xb_ld(&xb.bar[CEN_CNT]); nsec = (int)xb_ld(&xb.bar[CEN_CNT + 1]);
      if (role != 0) { const unsigned v = xb_ld(&xb.bar[CEN_TAB2 + (unsigned)(-1 - ci)]); ci = (v > 0u) ? (int)v - 1 : 0; }
      nprim = __builtin_amdgcn_readfirstlane(nprim); nsec = __builtin_amdgcn_readfirstlane(nsec); ci = __builtin_amdgcn_readfirstlane(ci);
    }
    const Params& p = p_;
    if (ph == 0) {
      convert_weights(p, lds, bid, 992, nb, tid);
      embed_ln(p, bid, nb, tid);
      rope_table(p, bid, nb, tid);
    } else {
      const int l = (ph - 1) / 8, s = (ph - 1) % 8;
      const bf16_t* Xb = (const bf16_t*)p.O();
      bf16_t* X1b = (bf16_t*)(p.W() + OFF_X1B);
      bf16_t* Hb = (bf16_t*)(p.W() + OFF_H);
      float* X = (float*)(p.W() + OFF_X);
      if (s == 0) gemm_phase<EPI_BF16>(Xb, 1024, (const bf16_t*)(p.W() + OFF_WIN + l * SZ_WIN), 1024, 1024, DINP / 128, p.W() + OFF_P, DINP, lds, bid, nb, tid);
      else if (s == 1) scan_phase(p, l, lds, bid, nb, tid, role, ci, nprim, nsec);
      else if (s == 2) norm_phase(p, l, bid, nb, tid);
      else if (s == 3) gemm_phase<EPI_RESID>(Xb, 1024, (const bf16_t*)(p.W() + OFF_WOUT + l * SZ_WOUT), 1024, 1024, 8, X, 1024, lds, bid, nb, tid);
      else if (s == 4) ln_phase(p, p.I(22) + l * 1024, p.I(23) + l * 1024, X1b, 0, bid, nb, tid);
      else if (s == 5) gemm_phase<EPI_SWIGLU>(X1b, 1024, (const bf16_t*)(p.W() + OFF_WGU + l * SZ_WGU), 1024, 1024, 44, Hb, DFF, lds, bid, nb, tid);
      else if (s == 6) gemm_phase<EPI_RESID>(Hb, DFF, (const bf16_t*)(p.W() + OFF_WDN + l * SZ_WDN), DFF, DFF, 8, X, 1024, lds, bid, nb, tid);
      else ln_phase(p, p.I(27) + l * 1024, p.I(28) + l * 1024, (bf16_t*)p.O(), l == 1, bid, nb, tid);
    }
  }
}

extern "C" void kernel_launch(void* const* d_in, const int* in_sizes, int n_in, void* d_out, int out_size, void* d_ws, size_t ws_size,
                              hipStream_t stream) {
  (void)in_sizes; (void)out_size;
  if (n_in < 29 || ws_size < WS_NEED) { fprintf(stderr, "bad args: n_in %d ws %zu need %zu\n", n_in, ws_size, (size_t)WS_NEED); return; }
  Params p{};
  for (int i = 0; i < 29; ++i) p.in[i] = (const float*)d_in[i];
  p.out = (float*)d_out;
  p.ws = (unsigned char*)d_ws;
  static int grid_blocks = 0;
  if (!grid_blocks) {
    int dev = 0, cus = 0, per_cu = 0;
    (void)hipGetDevice(&dev);
    (void)hipDeviceGetAttribute(&cus, hipDeviceAttributeMultiprocessorCount, dev);
    (void)hipOccupancyMaxActiveBlocksPerMultiprocessor(&per_cu, hymba_fwd, 256, 0);
    if (per_cu > 2) per_cu = 2;
    if (per_cu < 1) per_cu = 1;
    grid_blocks = cus * per_cu;
  }
  (void)hipMemsetAsync((unsigned char*)d_ws + OFF_BAR, 0, BAR_BYTES, stream);
  int lo = 0, hi = NPHASE;
  void* args[] = {&p, &lo, &hi};
  hipError_t e = hipLaunchCooperativeKernel((void*)hymba_fwd, dim3(grid_blocks), dim3(256), args, 0, stream);
  if (e != hipSuccess) fprintf(stderr, "cooperative launch failed: %s (grid %d)\n", hipGetErrorString(e), grid_blocks);
}
```

```cpp
#include <hip/hip_runtime.h>
#include <hip/hip_cooperative_groups.h>
#include <cstdio>
#include <cstdint>
namespace cg = cooperative_groups;

#ifndef COOP
#define COOP 1
#endif

typedef unsigned short bf16_t;
typedef short bf16x8 __attribute__((ext_vector_type(8)));
typedef float f32x4 __attribute__((ext_vector_type(4)));

constexpr int DM = 1024, NB = 8, TPR = 2064, NSB = 128, TS = 4;
constexpr int MP = NB * TPR;
constexpr int MS = NSB * TS;
constexpr int MT = MP + MS;
constexpr int DIN = 3864, DINP = 3968, DFF = 2816;
constexpr float ALPHA = 1.41421356237309515f;

constexpr size_t SZ_WIN = (size_t)DINP * 1024 * 2, SZ_WOUT = (size_t)1024 * 1024 * 2, SZ_WGU = (size_t)5632 * 1024 * 2, SZ_WDN = (size_t)1024 * 2816 * 2;
constexpr size_t OFF_CS = 0;
constexpr size_t OFF_WIN = 532480;
constexpr size_t OFF_WOUT = OFF_WIN + 2 * SZ_WIN;
constexpr size_t OFF_WGU = OFF_WOUT + 2 * SZ_WOUT;
constexpr size_t OFF_WDN = OFF_WGU + 2 * SZ_WGU;
constexpr size_t OFF_X = OFF_WDN + 2 * SZ_WDN;
constexpr size_t OFF_P = OFF_X + (size_t)MT * 1024 * 4;
constexpr size_t OFF_X1B = OFF_P;
constexpr size_t OFF_H = OFF_P + (size_t)MT * 1024 * 2;
constexpr size_t OFF_BAR = OFF_P + (size_t)MT * DINP * 2;
constexpr int CEN_CNT = 3520, CEN_TAB = 4096, CEN_TAB2 = 8192;
constexpr size_t BAR_BYTES = 12288 * 4;
constexpr size_t WS_NEED = OFF_BAR + BAR_BYTES;
constexpr size_t DOUT_PS = 36000000;

constexpr size_t O_YP = 0, O_YS = 16777216, O_CP = 17301504, O_CS = 17338368, O_DP = 17928192, O_DS = 18190336,
                 O_HP = 22384640, O_HS = 22646784, O_GP = 26841088, O_GS = 26972160, O_RP = 29069312, O_RS = 29331456;

#define GAS __attribute__((address_space(1)))
struct Params {
  const float* in[29];
  float* out;
  unsigned char* ws;
  __device__ __forceinline__ const float* I(int i) const { return (const float*)(const GAS float*)in[i]; }
  __device__ __forceinline__ float* O() const { return (float*)(GAS float*)out; }
  __device__ __forceinline__ unsigned char* W() const { return (unsigned char*)(GAS unsigned char*)ws; }
};

__device__ __forceinline__ unsigned f2bf(float f) {
  unsigned u = __float_as_uint(f);
  u += 0x7fffu + ((u >> 16) & 1u);
  return u >> 16;
}
typedef float f32x2_t __attribute__((ext_vector_type(2)));
typedef __bf16 bf16x2_t __attribute__((ext_vector_type(2)));
__device__ __forceinline__ unsigned pk2(float lo, float hi) { const f32x2_t v = {lo, hi}; const bf16x2_t b = __builtin_convertvector(v, bf16x2_t); return __builtin_bit_cast(unsigned, b); }
__device__ __forceinline__ float bflo(unsigned u) { return __uint_as_float(u << 16); }
__device__ __forceinline__ float bfhi(unsigned u) { return __uint_as_float(u & 0xffff0000u); }
__device__ __forceinline__ void unpack8(const uint4& r, float* x) {
  x[0] = bflo(r.x); x[1] = bfhi(r.x); x[2] = bflo(r.y); x[3] = bfhi(r.y);
  x[4] = bflo(r.z); x[5] = bfhi(r.z); x[6] = bflo(r.w); x[7] = bfhi(r.w);
}
__device__ __forceinline__ float sigmoidf_(float x) { return __builtin_amdgcn_rcpf(1.0f + __expf(-x)); }
__device__ __forceinline__ float siluf_(float x) { return x * __builtin_amdgcn_rcpf(1.0f + __expf(-x)); }
__device__ __forceinline__ float softplusf_(float x) { return fmaxf(x, 0.f) + __logf(1.0f + __expf(-fabsf(x))); }
__device__ __forceinline__ float red8(float x) {
  x += __shfl_xor(x, 1); x += __shfl_xor(x, 2); x += __shfl_xor(x, 4); return x;
}
__device__ __forceinline__ float dpp_x1(float x) {
  return __int_as_float(__builtin_amdgcn_update_dpp(0, __float_as_int(x), 0xB1, 0xF, 0xF, true));
}
__device__ __forceinline__ float dpp_x2(float x) {
  return __int_as_float(__builtin_amdgcn_update_dpp(0, __float_as_int(x), 0x4E, 0xF, 0xF, true));
}
__device__ __forceinline__ float red4(float x) { x += dpp_x1(x); x += dpp_x2(x); return x; }
__device__ __forceinline__ float wave_sum(float x) {
#pragma unroll
  for (int o = 32; o >= 1; o >>= 1) x += __shfl_xor(x, o);
  return x;
}

__device__ __forceinline__ void convert_weights(const Params& p, char* lds, int w0, int w1, int wstep, const int tid) {
  float* tile = (float*)lds;
  for (int w = w0; w < w1; w += wstep) {
    const int l = w / 3360; int r = w % 3360;
    int mat, kt, rt;
    if (r < 992) { mat = 0; kt = r / 62; rt = r % 62; }
    else if (r < 1248) { r -= 992; mat = 1; kt = r / 16; rt = r % 16; }
    else if (r < 2656) { r -= 1248; mat = 2; kt = r / 88; rt = r % 88; }
    else { r -= 2656; mat = 3; kt = r / 16; rt = r % 16; }
    {
      const int r4 = (tid & 15) * 4, R = rt * 64 + r4, kq = tid >> 4;
      const float* src; int ns; bool valid = true;
      if (mat == 0) { const int rho = R & 31, scol = (R & ~31) + 8 * ((rho & 15) >> 2) + 4 * (rho >> 4) + (rho & 3);
        src = p.I(10) + (size_t)l * 1024 * DIN + scol; ns = DIN; valid = scol < DIN; }
      else if (mat == 1) { src = p.I(21) + (size_t)l * 1024 * 1024 + R; ns = 1024; }
      else if (mat == 2) { const int q = R & 63, f = q >> 4, i = q & 15, ty = f & 1, hid = (R >> 6) * 32 + 8 * (i >> 2) + 4 * (f >> 1) + (i & 3);
        src = (ty ? p.I(25) : p.I(24)) + (size_t)l * 1024 * DFF + hid; ns = DFF; }
      else { src = p.I(26) + (size_t)l * DFF * 1024 + R; ns = 1024; }
      f32x4 v[4];
#pragma unroll
      for (int i = 0; i < 4; ++i) v[i] = valid ? *(const f32x4*)(src + (size_t)(kt * 64 + kq + 16 * i) * ns) : (f32x4){0.f, 0.f, 0.f, 0.f};
#pragma unroll
      for (int i = 0; i < 4; ++i) {
        const int k = kq + 16 * i;
        tile[(r4 + 0) * 65 + k] = v[i][0]; tile[(r4 + 1) * 65 + k] = v[i][1]; tile[(r4 + 2) * 65 + k] = v[i][2]; tile[(r4 + 3) * 65 + k] = v[i][3];
      }
    }
    __syncthreads();
    {
      const int rr = tid >> 2, kc = (tid & 3) * 16;
      const int Kd = (mat == 3) ? DFF : 1024;
      bf16_t* base;
      if (mat == 0) base = (bf16_t*)(p.W() + OFF_WIN + l * SZ_WIN);
      else if (mat == 1) base = (bf16_t*)(p.W() + OFF_WOUT + l * SZ_WOUT);
      else if (mat == 2) base = (bf16_t*)(p.W() + OFF_WGU + l * SZ_WGU);
      else base = (bf16_t*)(p.W() + OFF_WDN + l * SZ_WDN);
      bf16_t* dst = base + (size_t)(rt * 64 + rr) * Kd + kt * 64 + kc;
      const float* s = tile + rr * 65 + kc;
      uint4 a, b;
      a.x = pk2(s[0], s[1]); a.y = pk2(s[2], s[3]); a.z = pk2(s[4], s[5]); a.w = pk2(s[6], s[7]);
      b.x = pk2(s[8], s[9]); b.y = pk2(s[10], s[11]); b.z = pk2(s[12], s[13]); b.w = pk2(s[14], s[15]);
      *(uint4*)dst = a; *(uint4*)(dst + 8) = b;
    }
    __syncthreads();
  }
}

__device__ __forceinline__ void ln_row_regs(f32x4 (&v)[4], const float* g, const float* bb, int lane) {
  float s = 0.f;
#pragma unroll
  for (int i = 0; i < 4; ++i) s += (v[i][0] + v[i][1]) + (v[i][2] + v[i][3]);
  const float mu = wave_sum(s) * (1.0f / 1024.0f);
  float q = 0.f;
#pragma unroll
  for (int i = 0; i < 4; ++i) { const f32x4 d = v[i] - mu; q += (d[0] * d[0] + d[1] * d[1]) + (d[2] * d[2] + d[3] * d[3]); }
  const float rs = rsqrtf(wave_sum(q) * (1.0f / 1024.0f) + 1e-5f);
#pragma unroll
  for (int i = 0; i < 4; ++i) {
    const f32x4 gg = *(const f32x4*)(g + lane * 4 + i * 256), b4 = *(const f32x4*)(bb + lane * 4 + i * 256);
    v[i] = (v[i] - mu) * rs * gg + b4;
  }
}

__device__ __forceinline__ void embed_ln(const Params& p, int bid, int nb, const int tid) {
  const int lane = tid & 63, wv = tid >> 6;
  float* X = (float*)(p.W() + OFF_X);
  bf16_t* Xb = (bf16_t*)p.O();
  auto src_of = [&](int row) -> const float* {
    if (row < MP) { const int b = row / TPR, t = row % TPR;
      return (t < 16) ? p.I(7) + (size_t)t * 1024 : p.I(0) + ((size_t)b * 2048 + (t - 16)) * 1024; }
    return p.I(1) + (size_t)(row - MP) * 1024;
  };
  f32x4 nx[4];
  { const float* s0 = src_of(min(bid * 4 + wv, MT - 1));
#pragma unroll
    for (int i = 0; i < 4; ++i) nx[i] = *(const f32x4*)(s0 + lane * 4 + i * 256); }
  for (int row = bid * 4 + wv; row < MT; row += nb * 4) {
    f32x4 v[4];
#pragma unroll
    for (int i = 0; i < 4; ++i) v[i] = nx[i];
    { const float* s1 = src_of(min(row + nb * 4, MT - 1));
#pragma unroll
      for (int i = 0; i < 4; ++i) nx[i] = *(const f32x4*)(s1 + lane * 4 + i * 256); }
    ln_row_regs(v, p.I(8), p.I(9), lane);
#pragma unroll
    for (int i = 0; i < 4; ++i) {
      *(f32x4*)(X + (size_t)row * 1024 + lane * 4 + i * 256) = v[i];
      uint2 o; o.x = pk2(v[i][0], v[i][1]); o.y = pk2(v[i][2], v[i][3]);
      *(uint2*)(Xb + (size_t)row * 1024 + lane * 4 + i * 256) = o;
    }
  }
}

__device__ __forceinline__ void rope_table(const Params& p, int bid, int nb, const int tid) {
  float2* cs = (float2*)(p.W() + OFF_CS);
  for (int e = bid * 256 + tid; e < 2068 * 32; e += nb * 256) {
    const int idx = e >> 5, i = e & 31;
    const double pos = (idx < 2064) ? (double)idx : (double)(16384 + idx - 2064);
    const double inv = exp(-((double)i / 31.0) * 9.210340371976184);
    const double ang = pos * inv;
    cs[e] = make_float2((float)cos(ang), (float)sin(ang));
  }
}

__device__ __forceinline__ void ln_phase(const Params& p, const float* g, const float* bb, bf16_t* xb, int final_, int bid, int nb, const int tid) {
  const int lane = tid & 63, wv = tid >> 6;
  float* X = (float*)(p.W() + OFF_X);
  f32x4 nx[4], nx2[4];
  {
    const int r0 = min(bid * 4 + wv, MT - 1), r1 = min(bid * 4 + wv + nb * 4, MT - 1);
#pragma unroll
    for (int i = 0; i < 4; ++i) nx[i] = *(const f32x4*)(X + (size_t)r0 * 1024 + lane * 4 + i * 256);
#pragma unroll
    for (int i = 0; i < 4; ++i) nx2[i] = *(const f32x4*)(X + (size_t)r1 * 1024 + lane * 4 + i * 256);
  }
  for (int row = bid * 4 + wv; row < MT; row += nb * 4) {
    f32x4 v[4];
#pragma unroll
    for (int i = 0; i < 4; ++i) { v[i] = nx[i]; nx[i] = nx2[i]; }
    {
      const int rn = min(row + nb * 8, MT - 1);
#pragma unroll
      for (int i = 0; i < 4; ++i) nx2[i] = *(const f32x4*)(X + (size_t)rn * 1024 + lane * 4 + i * 256);
    }
    ln_row_regs(v, g, bb, lane);
    if (!final_) {
#pragma unroll
      for (int i = 0; i < 4; ++i) {
        *(f32x4*)(X + (size_t)row * 1024 + lane * 4 + i * 256) = v[i];
        uint2 o; o.x = pk2(v[i][0], v[i][1]); o.y = pk2(v[i][2], v[i][3]);
        *(uint2*)(xb + (size_t)row * 1024 + lane * 4 + i * 256) = o;
      }
    } else {
      float* dst = nullptr;
      if (row < MP) { const int b = row / TPR, t = row % TPR; if (t >= 16) dst = p.O() + O_YP + ((size_t)b * 2048 + (t - 16)) * 1024; }
      else dst = p.O() + O_YS + (size_t)(row - MP) * 1024;
      if (dst) {
#pragma unroll
        for (int i = 0; i < 4; ++i) *(f32x4*)(dst + lane * 4 + i * 256) = v[i];
      }
    }
  }
}

enum { EPI_BF16 = 0, EPI_RESID = 1, EPI_SWIGLU = 2 };

template <int EPI>
__device__ __forceinline__ void gemm_tile(const bf16_t* __restrict__ A, const int lda, const bf16_t* __restrict__ Bt, const int ldb,
                                          const int K, const int m0, const int n0, void* Cout, const int ldc, char* lds, const int tid) {
  const int wid = tid >> 6, lane = tid & 63, wr = wid >> 1, wc = wid & 1, fr = lane & 15, fq = lane >> 4;
  f32x4 acc[4][4];
#pragma unroll
  for (int m = 0; m < 4; ++m)
#pragma unroll
    for (int n = 0; n < 4; ++n) acc[m][n] = (f32x4){0.f, 0.f, 0.f, 0.f};
  const int nt = K >> 6;
  const int st_row = tid >> 3, st_c = (tid & 7) ^ ((tid >> 4) & 7);
  auto stageA = [&](int kt, int buf) {
#pragma unroll
    for (int i = 0; i < 4; ++i) {
      const int off = tid * 16 + i * 4096, r = st_row + i * 32;
      const bf16_t* ga = A + (size_t)(m0 + r) * lda + kt * 64 + st_c * 8;
      __builtin_amdgcn_global_load_lds((const unsigned*)ga, (__attribute__((address_space(3))) unsigned*)(lds + buf * 32768 + off), 16, 0, 0);
    }
  };
  auto stageB = [&](int kt, int buf) {
#pragma unroll
    for (int i = 0; i < 4; ++i) {
      const int off = tid * 16 + i * 4096, r = st_row + i * 32;
      const bf16_t* gb = Bt + (size_t)(n0 + r) * ldb + kt * 64 + st_c * 8;
      __builtin_amdgcn_global_load_lds((const unsigned*)gb, (__attribute__((address_space(3))) unsigned*)(lds + buf * 32768 + 16384 + off), 16, 0, 0);
    }
  };
  auto stage = [&](int kt, int buf) { stageA(kt, buf); stageB(kt, buf); };
  const int fsw = (fr >> 1) & 7;
  const int xk0 = (fq ^ fsw) << 4, xk1 = ((4 + fq) ^ fsw) << 4;
  stage(0, 0);
  for (int kt = 0; kt < nt; ++kt) {
    asm volatile("s_waitcnt vmcnt(0)" ::: "memory");
    __syncthreads();
    if (kt + 1 < nt) stageA(kt + 1, (kt + 1) & 1);
    const char* sa = lds + (kt & 1) * 32768;
    const char* sb = sa + 16384;
    bf16x8 af[2][4], bfr[2][4];
#pragma unroll
    for (int ks = 0; ks < 2; ++ks) {
#pragma unroll
      for (int m = 0; m < 4; ++m) af[ks][m] = *(const bf16x8*)(sa + (wr * 64 + m * 16 + fr) * 128 + (ks ? xk1 : xk0));
#pragma unroll
      for (int n = 0; n < 4; ++n) bfr[ks][n] = *(const bf16x8*)(sb + (wc * 64 + n * 16 + fr) * 128 + (ks ? xk1 : xk0));
    }
    if (kt + 1 < nt) stageB(kt + 1, (kt + 1) & 1);
#pragma unroll
    for (int ks = 0; ks < 2; ++ks)
#pragma unroll
      for (int m = 0; m < 4; ++m)
#pragma unroll
        for (int n = 0; n < 4; ++n) acc[m][n] = __builtin_amdgcn_mfma_f32_16x16x32_bf16(bfr[ks][n], af[ks][m], acc[m][n], 0, 0, 0);
  }
  if (EPI == EPI_RESID) {
    float* C0 = (float*)Cout + (size_t)(m0 + wr * 64 + fr) * ldc + n0 + wc * 64 + fq * 4;
#pragma unroll
    for (int mh = 0; mh < 2; ++mh) {
      f32x4 xin[2][4];
#pragma unroll
      for (int m = 0; m < 2; ++m)
#pragma unroll
        for (int n = 0; n < 4; ++n) xin[m][n] = *(const f32x4*)(C0 + (size_t)(mh * 2 + m) * 16 * ldc + n * 16);
#pragma unroll
      for (int m = 0; m < 2; ++m)
#pragma unroll
        for (int n = 0; n < 4; ++n) asm volatile("" : "+v"(xin[m][n]));
#pragma unroll
      for (int m = 0; m < 2; ++m)
#pragma unroll
        for (int n = 0; n < 4; ++n) *(f32x4*)(C0 + (size_t)(mh * 2 + m) * 16 * ldc + n * 16) = xin[m][n] * ALPHA + acc[mh * 2 + m][n];
    }
    return;
  }
#pragma unroll
  for (int m = 0; m < 4; ++m) {
    const int row = m0 + wr * 64 + m * 16 + fr;
    if (EPI == EPI_BF16) {
      bf16_t* C = (bf16_t*)Cout + (size_t)row * ldc + n0 + wc * 64 + fq * 8;
#pragma unroll
      for (int pq = 0; pq < 2; ++pq) { uint4 o; o.x = pk2(acc[m][2 * pq][0], acc[m][2 * pq][1]); o.y = pk2(acc[m][2 * pq][2], acc[m][2 * pq][3]);
        o.z = pk2(acc[m][2 * pq + 1][0], acc[m][2 * pq + 1][1]); o.w = pk2(acc[m][2 * pq + 1][2], acc[m][2 * pq + 1][3]); *(uint4*)(C + pq * 32) = o; }
    } else if (EPI == EPI_RESID) {
      float* C = (float*)Cout + (size_t)row * ldc + n0 + wc * 64 + fq * 4;
#pragma unroll
      for (int n = 0; n < 4; ++n) { const f32x4 x = *(const f32x4*)(C + n * 16); *(f32x4*)(C + n * 16) = x * ALPHA + acc[m][n]; }
    } else {
      bf16_t* C = (bf16_t*)Cout + (size_t)row * ldc + (n0 >> 1) + wc * 32 + fq * 8;
      const f32x4 g0 = acc[m][0], u0 = acc[m][1], g1 = acc[m][2], u1 = acc[m][3];
      uint4 o; o.x = pk2(siluf_(g0[0]) * u0[0], siluf_(g0[1]) * u0[1]); o.y = pk2(siluf_(g0[2]) * u0[2], siluf_(g0[3]) * u0[3]);
      o.z = pk2(siluf_(g1[0]) * u1[0], siluf_(g1[1]) * u1[1]); o.w = pk2(siluf_(g1[2]) * u1[2], siluf_(g1[3]) * u1[3]);
      *(uint4*)C = o;
    }
  }
}
template <int EPI>
__device__ __forceinline__ void gemm_phase(const bf16_t* A, int lda, const bf16_t* Bt, int ldb, int K, int ntn, void* C, int ldc, char* lds, int bid, int nb, const int tid) {
  constexpr int GM = 4, nM = MT / 128;
  const int ntiles = nM * ntn, nig = GM * ntn;
  const int pos = (EPI != EPI_SWIGLU && (nb & 7) == 0) ? (bid & 7) * (nb >> 3) + (bid >> 3) : bid;
  for (int L = pos; L < ntiles; L += nb) {
    int mt, nn;
    if (EPI == EPI_SWIGLU) { mt = L / ntn; nn = L % ntn; }
    else { const int gid = L / nig, fm = gid * GM, gsz = min(nM - fm, GM), rem = L - gid * nig; mt = fm + rem % gsz; nn = rem / gsz; }
    gemm_tile<EPI>(A, lda, Bt, ldb, K, mt * 128, nn * 128, C, ldc, lds, tid);
  }
}

#define XB_TMO      128
#define XB_XCNT(j)  (256  + 64 * (j))
#define XB_XSUB(j)  (1280 + 64 * (j))
#define XB_XGEN(j)  (2304 + 64 * (j))
#define XB_TOP      3328
#define XB_TOPGEN   3392
#define XCD_BAR_WORDS 3456
#define XB_SPIN_CAP (1u << 22)
__device__ __forceinline__ unsigned xb_ld(unsigned* p) { return __hip_atomic_load(p, __ATOMIC_RELAXED, __HIP_MEMORY_SCOPE_AGENT); }
__device__ __forceinline__ unsigned xb_add(unsigned* p, unsigned v) { return __hip_atomic_fetch_add(p, v, __ATOMIC_RELAXED, __HIP_MEMORY_SCOPE_AGENT); }
__device__ __forceinline__ unsigned xb_xcc_id() { return (unsigned)__builtin_amdgcn_s_getreg((3 << 11) | 20) & 0xFu; }
#define XB_SPIN(cond, bar) do { unsigned _sp = 0; while (cond) { __builtin_amdgcn_s_sleep(1); \
    if ((++_sp & 255u) == 0u) { if (xb_ld(&(bar)[XB_TMO])) break; if (_sp > XB_SPIN_CAP) { atomicAdd(&(bar)[XB_TMO], 1u); break; } } } } while (0)
struct XcdBarrier { unsigned* bar; unsigned x; unsigned nloc, nx; };
__device__ __forceinline__ void xcd_barrier_complete(unsigned* bar, unsigned x, unsigned G, unsigned& nloc, unsigned& nx) {
  unsigned sum, cnt, mine, sp = 0u;
  for (;;) {
    sum = 0u; cnt = 0u; mine = 0u;
#pragma unroll
    for (unsigned j = 0; j < 16; ++j) { const unsigned c = xb_ld(&bar[XB_XCNT(j)]); sum += c; cnt += (c > 0u) ? 1u : 0u; mine = (j == x) ? c : mine; }
    if (sum == G) break;
    __builtin_amdgcn_s_sleep(1);
    if ((++sp & 255u) == 0u) { if (xb_ld(&bar[XB_TMO])) break; if (sp > XB_SPIN_CAP) { atomicAdd(&bar[XB_TMO], 1u); break; } }
  }
  nloc = mine > 0u ? mine : 1u; nx = cnt > 0u ? cnt : 1u;
}
__device__ __forceinline__ void xcd_barrier(XcdBarrier& b, const int tid, const unsigned G) {
  asm volatile("s_waitcnt vmcnt(0)" ::: "memory");
  __syncthreads();
  if (tid == 0) {
    unsigned* bar = b.bar;
    __builtin_amdgcn_s_waitcnt(0);
    if (b.nloc == 0u) xcd_barrier_complete(bar, b.x, G, b.nloc, b.nx);
    const unsigned nloc = b.nloc, nx = b.nx;
    const unsigned old = xb_add(&bar[XB_XSUB(b.x)], 1u);
    const unsigned gen = old / nloc;
    if (old + 1u == (gen + 1u) * nloc) {
      __builtin_amdgcn_fence(__ATOMIC_RELEASE, "agent");
      asm volatile("s_waitcnt vmcnt(0)" ::: "memory");
      const unsigned og = xb_add(&bar[XB_TOP], 1u);
      const unsigned tg = og / nx;
      if (og + 1u == (tg + 1u) * nx) xb_add(&bar[XB_TOPGEN], 1u);
      else XB_SPIN(xb_ld(&bar[XB_TOPGEN]) == tg, bar);
      __builtin_amdgcn_fence(__ATOMIC_ACQUIRE, "agent");
      xb_add(&bar[XB_XGEN(b.x)], 1u);
      asm volatile("s_waitcnt vmcnt(0)" ::: "memory");
    } else {
      XB_SPIN(xb_ld(&bar[XB_XGEN(b.x)]) == gen, bar);
      __builtin_amdgcn_fence(__ATOMIC_ACQUIRE, "agent");
      asm volatile("s_waitcnt vmcnt(0)" ::: "memory");
    }
  }
  __syncthreads();
}

template <int N, int RS>
__device__ __forceinline__ void convN(const bf16_t* rawb, const float (&w)[4][N], int tt, int off, float (&x)[N]) {
#pragma unroll
  for (int i = 0; i < N; ++i) x[i] = 0.f;
#pragma unroll
  for (int j = 0; j < 4; ++j) {
    float xv[N];
    if (N == 8) { const uint4 rv = *(const uint4*)(rawb + (tt + j) * RS + off); unpack8(rv, xv); }
    else if (N == 4) { const uint2 rv = *(const uint2*)(rawb + (tt + j) * RS + off); xv[0] = bflo(rv.x); xv[1] = bfhi(rv.x); xv[2 % N] = bflo(rv.y); xv[3 % N] = bfhi(rv.y); }
    else { const unsigned rv = *(const unsigned*)(rawb + (tt + j) * RS + off); xv[0] = bflo(rv); xv[1] = bfhi(rv); }
#pragma unroll
    for (int i = 0; i < N; ++i) x[i] += w[j][i] * xv[i];
  }
  if (N == 2) {
#pragma unroll
    for (int i = 0; i < N; ++i) asm volatile("" : "+v"(x[i]));
  }
#pragma unroll
  for (int i = 0; i < N; ++i) x[i] = siluf_(x[i]);
}

template <int MIX, int VN>
__device__ __forceinline__ void load_chunk_fn(const unsigned char* ws, const bf16_t* Pb, const int t, const int T, const int h, const int vcol, const int sub, const int posb,
                                              uint4& R0, uint4& R1, uint2& R2, uint4& R4, uint4& R5, unsigned& ex0, unsigned& ex1) {
  if (t < T) {
    const bf16_t* pr = Pb + (size_t)t * DINP;
    const int vbase = (MIX == 0) ? 512 : (MIX == 1) ? 1544 : (MIX == 2) ? 2312 : 3352;
    if (VN == 4) R2 = *(const uint2*)(pr + vbase + h * 64 + vcol);
    else R2.x = *(const unsigned*)(pr + vbase + h * 64 + vcol);
    if (MIX == 0) {
      R0 = *(const uint4*)(pr + 0 + h * 64 + sub * 8); R1 = *(const uint4*)(pr + 256 + h * 64 + sub * 8);
      ex0 = pr[768 + h]; ex1 = pr[772 + h];
    } else if (MIX == 1) {
      R0 = *(const uint4*)(pr + 1032 + h * 64 + sub * 8); R1 = *(const uint4*)(pr + 1288 + h * 64 + sub * 8);
    } else if (MIX == 2) {
      const uint2 q2 = *(const uint2*)(pr + 2056 + h * 32 + sub * 4), k2 = *(const uint2*)(pr + 2184 + h * 32 + sub * 4);
      R0 = make_uint4(q2.x, q2.y, k2.x, k2.y);
      R1 = *(const uint4*)(pr + 2568); R4 = *(const uint4*)(pr + 2576);
    } else {
      const uint2 ql = *(const uint2*)(pr + 2840 + h * 64 + sub * 4), qh = *(const uint2*)(pr + 2840 + h * 64 + 32 + sub * 4);
      const uint2 kl = *(const uint2*)(pr + 3096 + h * 64 + sub * 4), kh = *(const uint2*)(pr + 3096 + h * 64 + 32 + sub * 4);
      R0 = make_uint4(ql.x, ql.y, qh.x, qh.y); R1 = make_uint4(kl.x, kl.y, kh.x, kh.y);
      const uint4* cs = (const uint4*)(ws + OFF_CS + ((size_t)(posb + t) * 32 + sub * 4) * 8);
      R4 = cs[0]; R5 = cs[1];
    }
  }
}

__device__ __forceinline__ float dpp_hm(float x) {
  return __int_as_float(__builtin_amdgcn_update_dpp(0, __float_as_int(x), 0x141, 0xF, 0xF, true));
}
__device__ __forceinline__ float dpp_rm(float x) {
  return __int_as_float(__builtin_amdgcn_update_dpp(0, __float_as_int(x), 0x140, 0xF, 0xF, true));
}
__device__ __forceinline__ float red8d(float x) { x += dpp_x1(x); x += dpp_x2(x); x += dpp_hm(x); return x; }
template <int KG> __device__ __forceinline__ float redKG(float x) { x = red8d(x); if (KG == 16) x += dpp_rm(x); return x; }

template <int MIX, int KPL>
struct StepIn { float q[KPL], k[KPL], d[KPL]; float v, a, be, qk; };

template <int MIX, int KPL>
__device__ __forceinline__ void load_step(const float* qkdv, const float* scal, int t, int kg, int col, StepIn<MIX, KPL>& s) {
  const float* base = qkdv + t * 256;
#pragma unroll
  for (int i = 0; i < KPL; i += 4) {
    const f32x4 a = *(const f32x4*)(base + kg * KPL + i), b = *(const f32x4*)(base + 64 + kg * KPL + i);
    s.q[i] = a[0]; s.q[i + 1] = a[1]; s.q[i + 2] = a[2]; s.q[i + 3] = a[3];
    s.k[i] = b[0]; s.k[i + 1] = b[1]; s.k[i + 2] = b[2]; s.k[i + 3] = b[3];
    if (MIX == 1 || MIX == 2) { const f32x4 d = *(const f32x4*)(base + 128 + kg * KPL + i); s.d[i] = d[0]; s.d[i + 1] = d[1]; s.d[i + 2] = d[2]; s.d[i + 3] = d[3]; }
  }
  s.v = base[192 + col];
  if (MIX == 0) { const f32x4 c = *(const f32x4*)(scal + t * 4); s.a = c[0]; s.be = c[1]; s.qk = c[2]; }
}

template <int MIX, int KPL, int KG>
__device__ __forceinline__ float do_step(const StepIn<MIX, KPL>& s, float (&S)[KPL], const float gam) {
  if (MIX == 0) {
    float kS0 = 0.f, kS1 = 0.f, qS0 = 0.f, qS1 = 0.f;
#pragma unroll
    for (int i = 0; i < KPL; i += 2) { kS0 += s.k[i] * S[i]; kS1 += s.k[i + 1] * S[i + 1]; qS0 += s.q[i] * S[i]; qS1 += s.q[i + 1] * S[i + 1]; }
    const float kS = redKG<KG>(kS0 + kS1), qS = redKG<KG>(qS0 + qS1);
    const float w = s.be * (s.v - s.a * kS);
#pragma unroll
    for (int i = 0; i < KPL; ++i) S[i] = s.a * S[i] + s.k[i] * w;
    return s.a * qS + s.qk * w;
  } else {
    float o0 = 0.f, o1 = 0.f;
#pragma unroll
    for (int i = 0; i < KPL; i += 2) {
      const float d0 = (MIX == 3) ? gam : s.d[i], d1 = (MIX == 3) ? gam : s.d[i + 1];
      S[i] = d0 * S[i] + s.k[i] * s.v; S[i + 1] = d1 * S[i + 1] + s.k[i + 1] * s.v;
      o0 += s.q[i] * S[i]; o1 += s.q[i + 1] * S[i + 1];
    }
    return redKG<KG>(o0 + o1);
  }
}

template <int MIX>
__device__ __forceinline__ void scan_part(const Params& p, const int layer, const int smp, const int b0, const int bstep, const int bend, const int h, const int part, char* lds, const int tid) {
  constexpr int DK = (MIX == 2) ? 32 : 64;
  constexpr int NS = (MIX == 0) ? 4 : 2;
  constexpr int CW = 64 / NS;
  constexpr int CPW = CW / 4;
  constexpr int KG = 64 / CPW;
  constexpr int KPL = DK / KG;
  constexpr int VN = CW / 8;
  constexpr int RS = 128 + CW;
  float* qkdv = (float*)lds;
  float* obuf = (float*)(lds + 32768);
  float* scal = (float*)(lds + 36864);
  bf16_t* rawb = (bf16_t*)(lds + 37376);
  float* cwl = (float*)(lds + 48576);
  float* wgl = (float*)(lds + 37376);

  const int lane = tid & 63, wv = tid >> 6;
  const int tt = tid >> 3, sub = tid & 7;
  const int col = wv * CPW + lane / KG, kg = lane % KG;
  const int T = smp ? 4 : TPR;
  const int nBatch = smp ? NSB : NB;
  const int posb = smp ? 2064 : 0;
  const int vcol = part * CW + sub * VN;
  __syncthreads();
  float c8[8];
  float Aexp = 0.f, dtb = 0.f, gam = 0.f;
  float cwq[4][8], cwk[4][8];
  if (MIX == 0) {
    Aexp = __expf(p.I(12)[layer * 4 + h]); dtb = p.I(13)[layer * 4 + h];
#pragma unroll
    for (int j = 0; j < 4; ++j) {
      const float* cwp = p.I(11) + (size_t)(layer * 4 + j) * 768;
#pragma unroll
      for (int i = 0; i < 8; ++i) { cwq[j][i] = cwp[h * 64 + sub * 8 + i]; cwk[j][i] = cwp[256 + h * 64 + sub * 8 + i]; }
    }
    for (int e = tid; e < 4 * CW; e += 256) { const int j = e / CW, r = e % CW; cwl[j * RS + 128 + r] = p.I(11)[(size_t)(layer * 4 + j) * 768 + 512 + h * 64 + part * CW + r]; }
  } else if (MIX == 1) {
#pragma unroll
    for (int i = 0; i < 8; ++i) {
      const int d = h * 64 + sub * 8 + i;
      c8[i] = (layer == 0) ? 1.0f : sigmoidf_(p.I(15)[d] - p.I(15)[256 + d]);
    }
  } else if (MIX == 2) {
    for (int e = tid; e < 512; e += 256) { const int r = e >> 5, j = e & 31; wgl[e] = p.I(17)[(size_t)(layer * 16 + r) * 128 + h * 32 + j]; }
#pragma unroll
    for (int i = 0; i < 4; ++i) c8[i] = p.I(18)[layer * 128 + h * 32 + sub * 4 + i];
  } else {
    gam = 1.0f - exp2f(-5.0f - (float)h);
  }
  for (int b = b0; b < bend; b += bstep) {
  const int row0 = smp ? MP + b * 4 : b * TPR;
  const bf16_t* Pb = (const bf16_t*)(p.W() + OFF_P) + (size_t)row0 * DINP;
  bf16_t* Ob = (bf16_t*)p.O() + (size_t)row0 * 1024 + MIX * 256 + h * 64 + part * CW;
  float* PS = (float*)((unsigned char*)p.O() + DOUT_PS) + (size_t)row0 * 128 + (MIX * 4 + h) * 8 + part * 2;
  uint4 R0 = make_uint4(0, 0, 0, 0), R1 = R0, R4 = R0, R5 = R0; uint2 R2 = make_uint2(0, 0); unsigned ex0 = 0, ex1 = 0;
  load_chunk_fn<MIX, VN>(p.W(), Pb, tt, T, h, vcol, sub, posb, R0, R1, R2, R4, R5, ex0, ex1);
  float S[KPL];
  if (smp) {
    const float* sin_ = p.I(3 + MIX) + ((size_t)(layer * NSB + b) * 4 + h) * DK * 64 + part * CW;
#pragma unroll
    for (int i = 0; i < KPL; ++i) S[i] = sin_[(kg * KPL + i) * 64 + col];
  } else {
#pragma unroll
    for (int i = 0; i < KPL; ++i) S[i] = 0.f;
  }
  if (MIX == 0) {
    for (int e = tid; e < 3 * RS; e += 256) { const int j = e / RS, r = e % RS;
      const int cc = (r < 64) ? (h * 64 + r) : (r < 128) ? (256 + h * 64 + r - 64) : (512 + h * 64 + part * CW + r - 128);
      float v = 0.f; if (smp) v = p.I(2)[((size_t)(layer * NSB + b) * 3 + j) * 768 + cc];
      rawb[e] = (bf16_t)f2bf(v); }
  }
  __syncthreads();

  int ntok_last = 0;
  for (int t0 = 0; t0 < T; t0 += 32) {
    const int ntok = min(32, T - t0);
    ntok_last = ntok;
    const bool valid = tt < ntok;
    float* dst = qkdv + tt * 256;
    if (MIX != 0 && valid) {
      if (VN == 4) *(f32x4*)(dst + 192 + sub * 4) = (f32x4){bflo(R2.x), bfhi(R2.x), bflo(R2.y), bfhi(R2.y)};
      else *(float2*)(dst + 192 + sub * 2) = make_float2(bflo(R2.x), bfhi(R2.x));
    }
    if (MIX == 0) {
      if (valid) {
        *(uint4*)(rawb + (3 + tt) * RS + 0 + sub * 8) = R0;
        *(uint4*)(rawb + (3 + tt) * RS + 64 + sub * 8) = R1;
        if (VN == 4) *(uint2*)(rawb + (3 + tt) * RS + 128 + sub * 4) = R2;
        else *(unsigned*)(rawb + (3 + tt) * RS + 128 + sub * 2) = R2.x;
      }
      __syncthreads();
      if (valid) {
        float xq[8], xk[8], xv[VN];
        { float cwv[4][VN];
#pragma unroll
          for (int j = 0; j < 4; ++j)
#pragma unroll
            for (int i = 0; i < VN; ++i) cwv[j][i] = cwl[j * RS + 128 + sub * VN + i];
          convN<VN, RS>(rawb, cwv, tt, 128 + sub * VN, xv); }
        convN<8, RS>(rawb, cwq, tt, sub * 8, xq);
        convN<8, RS>(rawb, cwk, tt, 64 + sub * 8, xk);
#pragma unroll
        for (int i = 0; i < VN; ++i) dst[192 + sub * VN + i] = xv[i];
        float ssq = 0.f, ssk = 0.f;
#pragma unroll
        for (int i = 0; i < 8; ++i) { ssq += xq[i] * xq[i]; ssk += xk[i] * xk[i]; }
        ssq = red8d(ssq); ssk = red8d(ssk);
        const float rq = rsqrtf(ssq + 1e-6f) * 0.125f, rk = rsqrtf(ssk + 1e-6f);
        float qk = 0.f;
#pragma unroll
        for (int i = 0; i < 8; ++i) { xq[i] *= rq; xk[i] *= rk; qk += xq[i] * xk[i]; }
        qk = red8d(qk);
        *(f32x4*)(dst + sub * 8) = (f32x4){xq[0], xq[1], xq[2], xq[3]}; *(f32x4*)(dst + sub * 8 + 4) = (f32x4){xq[4], xq[5], xq[6], xq[7]};
        *(f32x4*)(dst + 64 + sub * 8) = (f32x4){xk[0], xk[1], xk[2], xk[3]}; *(f32x4*)(dst + 64 + sub * 8 + 4) = (f32x4){xk[4], xk[5], xk[6], xk[7]};
        if (sub == 0) {
          const float be = sigmoidf_(bflo(ex0)), al = bflo(ex1);
          const float a = __expf(-Aexp * softplusf_(al + dtb));
          *(f32x4*)(scal + tt * 4) = (f32x4){a, be, qk, 0.f};
        }
      }
    } else if (MIX == 1) {
      if (valid) {
        float q[8], z[8]; unpack8(R0, q); unpack8(R1, z);
        float kk[8], dd[8];
#pragma unroll
        for (int i = 0; i < 8; ++i) { q[i] = siluf_(q[i]); kk[i] = c8[i] * sigmoidf_(-z[i]); dd[i] = 1.0f - fminf(kk[i], 1.0f - 1e-6f); }
        *(f32x4*)(dst + sub * 8) = (f32x4){q[0], q[1], q[2], q[3]}; *(f32x4*)(dst + sub * 8 + 4) = (f32x4){q[4], q[5], q[6], q[7]};
        *(f32x4*)(dst + 64 + sub * 8) = (f32x4){kk[0], kk[1], kk[2], kk[3]}; *(f32x4*)(dst + 64 + sub * 8 + 4) = (f32x4){kk[4], kk[5], kk[6], kk[7]};
        *(f32x4*)(dst + 128 + sub * 8) = (f32x4){dd[0], dd[1], dd[2], dd[3]}; *(f32x4*)(dst + 128 + sub * 8 + 4) = (f32x4){dd[4], dd[5], dd[6], dd[7]};
      }
    } else if (MIX == 2) {
      if (valid) {
        float lr[16]; unpack8(R1, lr); unpack8(R4, lr + 8);
        const float q0 = bflo(R0.x), q1 = bfhi(R0.x), q2 = bflo(R0.y), q3 = bfhi(R0.y);
        const float k0 = bflo(R0.z), k1 = bfhi(R0.z), k2 = bflo(R0.w), k3 = bfhi(R0.w);
        const float sc = 0.17677669529663687f;
        f32x4 xg = (f32x4){c8[0], c8[1], c8[2], c8[3]};
#pragma unroll
        for (int r = 0; r < 16; ++r) xg += lr[r] * *(const f32x4*)(wgl + r * 32 + sub * 4);
        f32x4 dd;
#pragma unroll
        for (int i = 0; i < 4; ++i) { const float ls = fminf(xg[i], 0.f) - __logf(1.0f + __expf(-fabsf(xg[i]))); dd[i] = __expf(ls * 0.0625f); }
        *(f32x4*)(dst + sub * 4) = (f32x4){q0 * sc, q1 * sc, q2 * sc, q3 * sc};
        *(f32x4*)(dst + 64 + sub * 4) = (f32x4){k0, k1, k2, k3};
        *(f32x4*)(dst + 128 + sub * 4) = dd;
      }
    } else {
      if (valid) {
        const float ql[4] = {bflo(R0.x), bfhi(R0.x), bflo(R0.y), bfhi(R0.y)}, qh[4] = {bflo(R0.z), bfhi(R0.z), bflo(R0.w), bfhi(R0.w)};
        const float kl[4] = {bflo(R1.x), bfhi(R1.x), bflo(R1.y), bfhi(R1.y)}, kh[4] = {bflo(R1.z), bfhi(R1.z), bflo(R1.w), bfhi(R1.w)};
        const float cc[4] = {__uint_as_float(R4.x), __uint_as_float(R4.z), __uint_as_float(R5.x), __uint_as_float(R5.z)};
        const float sn[4] = {__uint_as_float(R4.y), __uint_as_float(R4.w), __uint_as_float(R5.y), __uint_as_float(R5.w)};
        f32x4 qa, qb, ka, kb;
#pragma unroll
        for (int i = 0; i < 4; ++i) {
          qa[i] = ql[i] * cc[i] - qh[i] * sn[i]; qb[i] = ql[i] * sn[i] + qh[i] * cc[i];
          ka[i] = (kl[i] * cc[i] - kh[i] * sn[i]) * 0.125f; kb[i] = (kl[i] * sn[i] + kh[i] * cc[i]) * 0.125f;
        }
        *(f32x4*)(dst + sub * 4) = qa; *(f32x4*)(dst + 32 + sub * 4) = qb;
        *(f32x4*)(dst + 64 + sub * 4) = ka; *(f32x4*)(dst + 96 + sub * 4) = kb;
      }
    }
    __syncthreads();
    if (MIX == 0 && t0 + 32 < T) {
      if (tid < 3 * RS / 8) { const uint4 v = *(const uint4*)(rawb + 32 * RS + tid * 8); *(uint4*)(rawb + tid * 8) = v; }
    }
    if (t0 + 32 < T) load_chunk_fn<MIX, VN>(p.W(), Pb, t0 + 32 + tt, T, h, vcol, sub, posb, R0, R1, R2, R4, R5, ex0, ex1);
    {
      StepIn<MIX, KPL> sa, sb;
      float osave = 0.f;
      load_step<MIX, KPL>(qkdv, scal, 0, kg, col, sa);
      for (int t = 0; t < ntok; t += 2) {
        load_step<MIX, KPL>(qkdv, scal, t + 1, kg, col, sb);
        __builtin_amdgcn_sched_barrier(0);
        const float oa = do_step<MIX, KPL, KG>(sa, S, gam);
        osave = (kg == (t & (KG - 1))) ? oa : osave;
        load_step<MIX, KPL>(qkdv, scal, min(t + 2, ntok - 1), kg, col, sa);
        __builtin_amdgcn_sched_barrier(0);
        const float ob = do_step<MIX, KPL, KG>(sb, S, gam);
        osave = (kg == ((t + 1) & (KG - 1))) ? ob : osave;
        if (((t + 2) & (KG - 1)) == 0) obuf[(t + 2 - KG + kg) * CW + col] = osave;
      }
      const int remn = ntok & (KG - 1);
      if (remn != 0 && kg < remn) obuf[(ntok - remn + kg) * CW + col] = osave;
    }
    __syncthreads();
    if (valid) {
      float o[VN];
#pragma unroll
      for (int i = 0; i < VN; ++i) o[i] = obuf[tt * CW + sub * VN + i];
      float s1 = 0.f, s2 = 0.f;
#pragma unroll
      for (int i = 0; i < VN; ++i) { s1 += o[i]; s2 += o[i] * o[i]; }
      s1 = red8d(s1); s2 = red8d(s2);
      if (VN == 4) { uint2 o2; o2.x = pk2(o[0], o[1]); o2.y = pk2(o[2 % VN], o[3 % VN]); *(uint2*)(Ob + (size_t)(t0 + tt) * 1024 + sub * 4) = o2; }
      else *(unsigned*)(Ob + (size_t)(t0 + tt) * 1024 + sub * 2) = pk2(o[0], o[1]);
      if (sub == 0) *(float2*)(PS + (size_t)(t0 + tt) * 128) = make_float2(s1, s2);
    }
  }
  {
    const size_t obase = (MIX == 0) ? (smp ? O_DS : O_DP) : (MIX == 1) ? (smp ? O_HS : O_HP) : (MIX == 2) ? (smp ? O_GS : O_GP) : (smp ? O_RS : O_RP);
    float* so = p.O() + obase + ((size_t)(layer * nBatch + b) * 4 + h) * DK * 64 + part * CW;
#pragma unroll
    for (int i = 0; i < KPL; ++i) so[(kg * KPL + i) * 64 + col] = S[i];
  }
  if (MIX == 0) {
    float* co = p.O() + (smp ? O_CS : O_CP) + (size_t)(layer * nBatch + b) * 3 * 768;
    for (int e = tid; e < 3 * RS; e += 256) { const int j = e / RS, r = e % RS;
      const float v = bflo((unsigned)rawb[(ntok_last + j) * RS + r]);
      if (r < 128) { if (part == 0) co[j * 768 + ((r < 64) ? (h * 64 + r) : (256 + h * 64 + r - 64))] = v; }
      else co[j * 768 + 512 + h * 64 + part * CW + r - 128] = v; }
  }
  __syncthreads();
  }
}

constexpr int ITEMS_PER_SEQ = 40;
__device__ __forceinline__ void scan_dispatch(const Params& p, int layer, int smp, int type, int b0, int bstep, int bend, char* lds, const int tid) {
  const int r = type;
  if (r < 16) scan_part<0>(p, layer, smp, b0, bstep, bend, r >> 2, r & 3, lds, tid);
  else {
    const int r2 = r - 16, mh = 4 + (r2 >> 1), part = r2 & 1, mix = mh >> 2, h = mh & 3;
    if (mix == 1) scan_part<1>(p, layer, smp, b0, bstep, bend, h, part, lds, tid);
    else if (mix == 2) scan_part<2>(p, layer, smp, b0, bstep, bend, h, part, lds, tid);
    else scan_part<3>(p, layer, smp, b0, bstep, bend, h, part, lds, tid);
  }
}

__device__ __forceinline__ int long_item_type(int u, int& b) {
  int type;
  if (u < 64) { b = u >> 3; type = 24 + (u & 7); }
  else if (u < 192) { const int v = u - 64; b = v >> 4; type = v & 15; }
  else if (u < 256) { const int v = u - 192; b = v >> 3; type = 16 + (v & 7); }
  else { const int v = u - 256; b = v >> 3; type = 32 + (v & 7); }
  return type;
}
__device__ __forceinline__ void scan_phase(const Params& p, int layer, char* lds, int bid, int nb, const int tid, const int role, const int ci, const int nprim, const int nsec) {
  constexpr int NPI = NB * ITEMS_PER_SEQ;
  const bool paired = (nprim == 256 && nsec == 256);
  int j = -1, nbs = 1;
  if (paired) {
    int u = -1;
    if (role == 0) u = ci; else if (ci < NPI - 256) u = 256 + ci;
    if (u >= 0) { int b; const int type = long_item_type(u, b); scan_dispatch(p, layer, 0, type, b, 1, b + 1, lds, tid); }
    else { j = ci - (NPI - 256); nbs = 256 - (NPI - 256); }
  } else {
    for (int u = bid; u < NPI; u += nb) { int b; const int type = long_item_type(u, b); scan_dispatch(p, layer, 0, type, b, 1, b + 1, lds, tid); }
    nbs = (nb > NPI) ? nb - NPI : nb; j = (nb > NPI) ? bid - NPI : bid;
  }
  if (j >= 0) {
    const int nsl = (nbs + ITEMS_PER_SEQ - 1) / ITEMS_PER_SEQ;
    for (int jj = j; jj < ITEMS_PER_SEQ * nsl; jj += nbs) scan_dispatch(p, layer, 1, jj % ITEMS_PER_SEQ, jj / ITEMS_PER_SEQ, nsl, NSB, lds, tid);
    if (layer == 0) { __syncthreads(); convert_weights(p, lds, 992 + j, 6720, nbs, tid); }
  }
}

__device__ __forceinline__ void norm_phase(const Params& p, int layer, int bid, int nb, const int tid) {
  bf16_t* O = (bf16_t*)p.O();
  const bf16_t* P = (const bf16_t*)(p.W() + OFF_P);
  const float* PS = (const float*)((const unsigned char*)p.O() + DOUT_PS);
  const int cg8 = tid & 127;
  const int mh = cg8 >> 3, mix = mh >> 2, h = mh & 3, j0 = (cg8 & 7) * 8;
  const int gcol = (mix == 0) ? 776 : (mix == 1) ? 1800 : (mix == 2) ? 2584 : 3608;
  const float* gsrc = (mix == 0) ? p.I(14) : (mix == 1) ? p.I(16) : (mix == 2) ? p.I(19) : p.I(20);
  float g8[8];
#pragma unroll
  for (int i = 0; i < 8; ++i) g8[i] = gsrc[layer * 256 + h * 64 + j0 + i];
  uint4 ovn, gvn; f32x4 psn, ps2n = (f32x4){0.f, 0.f, 0.f, 0.f};
  {
    const int r0 = min(bid * 2 + (tid >> 7), MT - 1);
    ovn = *(const uint4*)(O + (size_t)r0 * 1024 + cg8 * 8);
    gvn = *(const uint4*)(P + (size_t)r0 * DINP + gcol + h * 64 + j0);
    psn = *(const f32x4*)(PS + (size_t)r0 * 128 + mh * 8);
    if (mix == 0) ps2n = *(const f32x4*)(PS + (size_t)r0 * 128 + mh * 8 + 4);
  }
  for (int row = bid * 2 + (tid >> 7); row < MT; row += nb * 2) {
    const uint4 ov = ovn, gv = gvn; const f32x4 ps = psn, ps2 = ps2n;
    {
      const int rn = min(row + nb * 2, MT - 1);
      ovn = *(const uint4*)(O + (size_t)rn * 1024 + cg8 * 8);
      gvn = *(const uint4*)(P + (size_t)rn * DINP + gcol + h * 64 + j0);
      psn = *(const f32x4*)(PS + (size_t)rn * 128 + mh * 8);
      if (mix == 0) ps2n = *(const f32x4*)(PS + (size_t)rn * 128 + mh * 8 + 4);
    }
    float s1 = ps[0] + ps[2], s2 = ps[1] + ps[3];
    if (mix == 0) { s1 += ps2[0] + ps2[2]; s2 += ps2[1] + ps2[3]; }
    float o[8], gt[8]; unpack8(ov, o); unpack8(gv, gt);
    float mu = 0.f, rs;
    if (mix == 3) { mu = s1 * (1.0f / 64.0f); const float var = fmaxf(s2 * (1.0f / 64.0f) - mu * mu, 0.f); rs = rsqrtf(var + 1e-5f); }
    else rs = rsqrtf(s2 * (1.0f / 64.0f) + 1e-6f);
    float r[8];
#pragma unroll
    for (int i = 0; i < 8; ++i) r[i] = (o[i] - mu) * rs * g8[i] * siluf_(gt[i]);
    uint4 o4; o4.x = pk2(r[0], r[1]); o4.y = pk2(r[2], r[3]); o4.z = pk2(r[4], r[5]); o4.w = pk2(r[6], r[7]);
    *(uint4*)(O + (size_t)row * 1024 + cg8 * 8) = o4;
  }
}

constexpr int NPHASE = 17;
__global__ void __launch_bounds__(256, 2) hymba_fwd(Params p_, int ph_lo, int ph_hi) {
  __shared__ __attribute__((aligned(16))) char lds[65536];
  XcdBarrier xb; xb.bar = (unsigned*)(p_.ws + OFF_BAR); xb.x = xb_xcc_id(); xb.nloc = 0u; xb.nx = 0u;
  if (threadIdx.x == 0) (void)xb_add(&xb.bar[XB_XCNT(xb.x)], 1u);
  int role = 0, ci = 0;
  {
    const unsigned key = ((((unsigned)__builtin_amdgcn_s_getreg((31 << 11) | 4)) >> 8) & 0xFFu) | (xb.x << 8);
    if (threadIdx.x == 0) {
      const unsigned slot = xb_add(&xb.bar[CEN_TAB + key], 1u);
      unsigned r;
      if (slot == 0u) { r = xb_add(&xb.bar[CEN_CNT], 1u); __hip_atomic_store(&xb.bar[CEN_TAB2 + key], r + 1u, __ATOMIC_RELAXED, __HIP_MEMORY_SCOPE_AGENT); }
      else { (void)xb_add(&xb.bar[CEN_CNT + 1], 1u); r = 0u; }
      *(volatile unsigned*)(lds) = slot == 0u ? 0u : 1u; *(volatile unsigned*)(lds + 4) = r;
    }
    __syncthreads();
    role = (int)*(volatile unsigned*)(lds); ci = (int)*(volatile unsigned*)(lds + 4);
    __syncthreads();
    role = __builtin_amdgcn_readfirstlane(role); ci = __builtin_amdgcn_readfirstlane(ci);
    if (role != 0) ci = -1 - (int)key;
  }
  int nprim = 0, nsec = 0;
  if (ph_hi < 0) cg::this_grid().sync();
  for (int ph = ph_lo; ph < ph_hi; ++ph) {
    int tid = threadIdx.x, bid = blockIdx.x, nb = gridDim.x;
    asm volatile("" : "+v"(tid));
    asm volatile("" : "+s"(bid), "+s"(nb));
    if (ph > ph_lo) xcd_barrier(xb, tid, (unsigned)nb);
    if (ph == ph_lo + 1) {
      nprim = (int)xb_ld(&xb.bar[CEN_CNT]); nsec = (int)xb_ld(&xb.bar[CEN_CNT + 1]);
      if (role != 0) { const unsigned v = xb_ld(&xb.bar[CEN_TAB2 + (unsigned)(-1 - ci)]); ci = (v > 0u) ? (int)v - 1 : 0; }
      nprim = __builtin_amdgcn_readfirstlane(nprim); nsec = __builtin_amdgcn_readfirstlane(nsec); ci = __builtin_amdgcn_readfirstlane(ci);
    }
    const Params& p = p_;
    if (ph == 0) {
      convert_weights(p, lds, bid, 992, nb, tid);
      embed_ln(p, bid, nb, tid);
      rope_table(p, bid, nb, tid);
    } else {
      const int l = (ph - 1) / 8, s = (ph - 1) % 8;
      const bf16_t* Xb = (const bf16_t*)p.O();
      bf16_t* X1b = (bf16_t*)(p.W() + OFF_X1B);
      bf16_t* Hb = (bf16_t*)(p.W() + OFF_H);
      float* X = (float*)(p.W() + OFF_X);
      if (s == 0) gemm_phase<EPI_BF16>(Xb, 1024, (const bf16_t*)(p.W() + OFF_WIN + l * SZ_WIN), 1024, 1024, DINP / 128, p.W() + OFF_P, DINP, lds, bid, nb, tid);
      else if (s == 1) scan_phase(p, l, lds, bid, nb, tid, role, ci, nprim, nsec);
      else if (s == 2) norm_phase(p, l, bid, nb, tid);
      else if (s == 3) gemm_phase<EPI_RESID>(Xb, 1024, (const bf16_t*)(p.W() + OFF_WOUT + l * SZ_WOUT), 1024, 1024, 8, X, 1024, lds, bid, nb, tid);
      else if (s == 4) ln_phase(p, p.I(22) + l * 1024, p.I(23) + l * 1024, X1b, 0, bid, nb, tid);
      else if (s == 5) gemm_phase<EPI_SWIGLU>(X1b, 1024, (const bf16_t*)(p.W() + OFF_WGU + l * SZ_WGU), 1024, 1024, 44, Hb, DFF, lds, bid, nb, tid);
      else if (s == 6) gemm_phase<EPI_RESID>(Hb, DFF, (const bf16_t*)(p.W() + OFF_WDN + l * SZ_WDN), DFF, DFF, 8, X, 1024, lds, bid, nb, tid);
      else ln_phase(p, p.I(27) + l * 1024, p.I(28) + l * 1024, (bf16_t*)p.O(), l == 1, bid, nb, tid);
    }
  }
}

extern "C" void kernel_launch(void* const* d_in, const int* in_sizes, int n_in, void* d_out, int out_size, void* d_ws, size_t ws_size,
                              hipStream_t stream) {
  (void)in_sizes; (void)out_size;
  if (n_in < 29 || ws_size < WS_NEED) { fprintf(stderr, "bad args: n_in %d ws %zu need %zu\n", n_in, ws_size, (size_t)WS_NEED); return; }
  Params p{};
  for (int i = 0; i < 29; ++i) p.in[i] = (const float*)d_in[i];
  p.out = (float*)d_out;
  p.ws = (unsigned char*)d_ws;
  static int grid_blocks = 0;
  if (!grid_blocks) {
    int dev = 0, cus = 0, per_cu = 0;
    (void)hipGetDevice(&dev);
    (void)hipDeviceGetAttribute(&cus, hipDeviceAttributeMultiprocessorCount, dev);
    (void)hipOccupancyMaxActiveBlocksPerMultiprocessor(&per_cu, hymba_fwd, 256, 0);
    if (per_cu > 2) per_cu = 2;
    if (per_cu < 1) per_cu = 1;
    grid_blocks = cus * per_cu;
  }
  (void)hipMemsetAsync((unsigned char*)d_ws + OFF_BAR, 0, BAR_BYTES, stream);
  int lo = 0, hi = NPHASE;
  void* args[] = {&p, &lo, &hi};
  hipError_t e = hipLaunchCooperativeKernel((void*)hymba_fwd, dim3(grid_blocks), dim3(256), args, 0, stream);
  if (e != hipSuccess) fprintf(stderr, "cooperative launch failed: %s (grid %d)\n", hipGetErrorString(e), grid_blocks);
}
```

```cpp
#include <hip/hip_runtime.h>
#include <hip/hip_cooperative_groups.h>
#include <cstdio>
#include <cstdint>
namespace cg = cooperative_groups;

#ifndef COOP
#define COOP 1
#endif

typedef unsigned short bf16_t;
typedef short bf16x8 __attribute__((ext_vector_type(8)));
typedef float f32x4 __attribute__((ext_vector_type(4)));

constexpr int DM = 1024, NB = 8, TPR = 2064, NSB = 128, TS = 4;
constexpr int MP = NB * TPR;
constexpr int MS = NSB * TS;
constexpr int MT = MP + MS;
constexpr int DIN = 3864, DINP = 3968, DFF = 2816;
constexpr float ALPHA = 1.41421356237309515f;

constexpr size_t SZ_WIN = (size_t)DINP * 1024 * 2, SZ_WOUT = (size_t)1024 * 1024 * 2, SZ_WGU = (size_t)5632 * 1024 * 2, SZ_WDN = (size_t)1024 * 2816 * 2;
constexpr size_t OFF_CS = 0;
constexpr size_t OFF_WIN = 532480;
constexpr size_t OFF_WOUT = OFF_WIN + 2 * SZ_WIN;
constexpr size_t OFF_WGU = OFF_WOUT + 2 * SZ_WOUT;
constexpr size_t OFF_WDN = OFF_WGU + 2 * SZ_WGU;
constexpr size_t OFF_X = OFF_WDN + 2 * SZ_WDN;
constexpr size_t OFF_P = OFF_X + (size_t)MT * 1024 * 4;
constexpr size_t OFF_X1B = OFF_P;
constexpr size_t OFF_H = OFF_P + (size_t)MT * 1024 * 2;
constexpr size_t OFF_BAR = OFF_P + (size_t)MT * DINP * 2;
constexpr int CEN_CNT = 3520, CEN_TAB = 4096, CEN_TAB2 = 8192;
constexpr size_t BAR_BYTES = 12288 * 4;
constexpr size_t WS_NEED = OFF_BAR + BAR_BYTES;
constexpr size_t DOUT_PS = 36000000;

constexpr size_t O_YP = 0, O_YS = 16777216, O_CP = 17301504, O_CS = 17338368, O_DP = 17928192, O_DS = 18190336,
                 O_HP = 22384640, O_HS = 22646784, O_GP = 26841088, O_GS = 26972160, O_RP = 29069312, O_RS = 29331456;

#define GAS __attribute__((address_space(1)))
struct Params {
  const float* in[29];
  float* out;
  unsigned char* ws;
  __device__ __forceinline__ const float* I(int i) const { return (const float*)(const GAS float*)in[i]; }
  __device__ __forceinline__ float* O() const { return (float*)(GAS float*)out; }
  __device__ __forceinline__ unsigned char* W() const { return (unsigned char*)(GAS unsigned char*)ws; }
};

__device__ __forceinline__ unsigned f2bf(float f) {
  unsigned u = __float_as_uint(f);
  u += 0x7fffu + ((u >> 16) & 1u);
  return u >> 16;
}
typedef float f32x2_t __attribute__((ext_vector_type(2)));
typedef __bf16 bf16x2_t __attribute__((ext_vector_type(2)));
__device__ __forceinline__ unsigned pk2(float lo, float hi) { const f32x2_t v = {lo, hi}; const bf16x2_t b = __builtin_convertvector(v, bf16x2_t); return __builtin_bit_cast(unsigned, b); }
__device__ __forceinline__ float bflo(unsigned u) { return __uint_as_float(u << 16); }
__device__ __forceinline__ float bfhi(unsigned u) { return __uint_as_float(u & 0xffff0000u); }
__device__ __forceinline__ void unpack8(const uint4& r, float* x) {
  x[0] = bflo(r.x); x[1] = bfhi(r.x); x[2] = bflo(r.y); x[3] = bfhi(r.y);
  x[4] = bflo(r.z); x[5] = bfhi(r.z); x[6] = bflo(r.w); x[7] = bfhi(r.w);
}
__device__ __forceinline__ float sigmoidf_(float x) { return __builtin_amdgcn_rcpf(1.0f + __expf(-x)); }
__device__ __forceinline__ float siluf_(float x) { return x * __builtin_amdgcn_rcpf(1.0f + __expf(-x)); }
__device__ __forceinline__ float softplusf_(float x) { return fmaxf(x, 0.f) + __logf(1.0f + __expf(-fabsf(x))); }
__device__ __forceinline__ float red8(float x) {
  x += __shfl_xor(x, 1); x += __shfl_xor(x, 2); x += __shfl_xor(x, 4); return x;
}
__device__ __forceinline__ float dpp_x1(float x) {
  return __int_as_float(__builtin_amdgcn_update_dpp(0, __float_as_int(x), 0xB1, 0xF, 0xF, true));
}
__device__ __forceinline__ float dpp_x2(float x) {
  return __int_as_float(__builtin_amdgcn_update_dpp(0, __float_as_int(x), 0x4E, 0xF, 0xF, true));
}
__device__ __forceinline__ float red4(float x) { x += dpp_x1(x); x += dpp_x2(x); return x; }
__device__ __forceinline__ float wave_sum(float x) {
#pragma unroll
  for (int o = 32; o >= 1; o >>= 1) x += __shfl_xor(x, o);
  return x;
}

__device__ __forceinline__ void convert_weights(const Params& p, char* lds, int w0, int w1, int wstep, const int tid) {
  float* tile = (float*)lds;
  for (int w = w0; w < w1; w += wstep) {
    const int l = w / 3360; int r = w % 3360;
    int mat, kt, rt;
    if (r < 992) { mat = 0; kt = r / 62; rt = r % 62; }
    else if (r < 1248) { r -= 992; mat = 1; kt = r / 16; rt = r % 16; }
    else if (r < 2656) { r -= 1248; mat = 2; kt = r / 88; rt = r % 88; }
    else { r -= 2656; mat = 3; kt = r / 16; rt = r % 16; }
    {
      const int r4 = (tid & 15) * 4, R = rt * 64 + r4, kq = tid >> 4;
      const float* src; int ns; bool valid = true;
      if (mat == 0) { const int rho = R & 31, scol = (R & ~31) + 8 * ((rho & 15) >> 2) + 4 * (rho >> 4) + (rho & 3);
        src = p.I(10) + (size_t)l * 1024 * DIN + scol; ns = DIN; valid = scol < DIN; }
      else if (mat == 1) { src = p.I(21) + (size_t)l * 1024 * 1024 + R; ns = 1024; }
      else if (mat == 2) { const int q = R & 63, f = q >> 4, i = q & 15, ty = f & 1, hid = (R >> 6) * 32 + 8 * (i >> 2) + 4 * (f >> 1) + (i & 3);
        src = (ty ? p.I(25) : p.I(24)) + (size_t)l * 1024 * DFF + hid; ns = DFF; }
      else { src = p.I(26) + (size_t)l * DFF * 1024 + R; ns = 1024; }
      f32x4 v[4];
#pragma unroll
      for (int i = 0; i < 4; ++i) v[i] = valid ? *(const f32x4*)(src + (size_t)(kt * 64 + kq + 16 * i) * ns) : (f32x4){0.f, 0.f, 0.f, 0.f};
#pragma unroll
      for (int i = 0; i < 4; ++i) {
        const int k = kq + 16 * i;
        tile[(r4 + 0) * 65 + k] = v[i][0]; tile[(r4 + 1) * 65 + k] = v[i][1]; tile[(r4 + 2) * 65 + k] = v[i][2]; tile[(r4 + 3) * 65 + k] = v[i][3];
      }
    }
    __syncthreads();
    {
      const int rr = tid >> 2, kc = (tid & 3) * 16;
      const int Kd = (mat == 3) ? DFF : 1024;
      bf16_t* base;
      if (mat == 0) base = (bf16_t*)(p.W() + OFF_WIN + l * SZ_WIN);
      else if (mat == 1) base = (bf16_t*)(p.W() + OFF_WOUT + l * SZ_WOUT);
      else if (mat == 2) base = (bf16_t*)(p.W() + OFF_WGU + l * SZ_WGU);
      else base = (bf16_t*)(p.W() + OFF_WDN + l * SZ_WDN);
      bf16_t* dst = base + (size_t)(rt * 64 + rr) * Kd + kt * 64 + kc;
      const float* s = tile + rr * 65 + kc;
      uint4 a, b;
      a.x = pk2(s[0], s[1]); a.y = pk2(s[2], s[3]); a.z = pk2(s[4], s[5]); a.w = pk2(s[6], s[7]);
      b.x = pk2(s[8], s[9]); b.y = pk2(s[10], s[11]); b.z = pk2(s[12], s[13]); b.w = pk2(s[14], s[15]);
      *(uint4*)dst = a; *(uint4*)(dst + 8) = b;
    }
    __syncthreads();
  }
}

__device__ __forceinline__ void ln_row_regs(f32x4 (&v)[4], const float* g, const float* bb, int lane) {
  float s = 0.f;
#pragma unroll
  for (int i = 0; i < 4; ++i) s += (v[i][0] + v[i][1]) + (v[i][2] + v[i][3]);
  const float mu = wave_sum(s) * (1.0f / 1024.0f);
  float q = 0.f;
#pragma unroll
  for (int i = 0; i < 4; ++i) { const f32x4 d = v[i] - mu; q += (d[0] * d[0] + d[1] * d[1]) + (d[2] * d[2] + d[3] * d[3]); }
  const float rs = rsqrtf(wave_sum(q) * (1.0f / 1024.0f) + 1e-5f);
#pragma unroll
  for (int i = 0; i < 4; ++i) {
    const f32x4 gg = *(const f32x4*)(g + lane * 4 + i * 256), b4 = *(const f32x4*)(bb + lane * 4 + i * 256);
    v[i] = (v[i] - mu) * rs * gg + b4;
  }
}

__device__ __forceinline__ void embed_ln(const Params& p, int bid, int nb, const int tid) {
  const int lane = tid & 63, wv = tid >> 6;
  float* X = (float*)(p.W() + OFF_X);
  bf16_t* Xb = (bf16_t*)p.O();
  auto src_of = [&](int row) -> const float* {
    if (row < MP) { const int b = row / TPR, t = row % TPR;
      return (t < 16) ? p.I(7) + (size_t)t * 1024 : p.I(0) + ((size_t)b * 2048 + (t - 16)) * 1024; }
    return p.I(1) + (size_t)(row - MP) * 1024;
  };
  f32x4 nx[4];
  { const float* s0 = src_of(min(bid * 4 + wv, MT - 1));
#pragma unroll
    for (int i = 0; i < 4; ++i) nx[i] = *(const f32x4*)(s0 + lane * 4 + i * 256); }
  for (int row = bid * 4 + wv; row < MT; row += nb * 4) {
    f32x4 v[4];
#pragma unroll
    for (int i = 0; i < 4; ++i) v[i] = nx[i];
    { const float* s1 = src_of(min(row + nb * 4, MT - 1));
#pragma unroll
      for (int i = 0; i < 4; ++i) nx[i] = *(const f32x4*)(s1 + lane * 4 + i * 256); }
    ln_row_regs(v, p.I(8), p.I(9), lane);
#pragma unroll
    for (int i = 0; i < 4; ++i) {
      *(f32x4*)(X + (size_t)row * 1024 + lane * 4 + i * 256) = v[i];
      uint2 o; o.x = pk2(v[i][0], v[i][1]); o.y = pk2(v[i][2], v[i][3]);
      *(uint2*)(Xb + (size_t)row * 1024 + lane * 4 + i * 256) = o;
    }
  }
}

__device__ __forceinline__ void rope_table(const Params& p, int bid, int nb, const int tid) {
  float2* cs = (float2*)(p.W() + OFF_CS);
  for (int e = bid * 256 + tid; e < 2068 * 32; e += nb * 256) {
    const int idx = e >> 5, i = e & 31;
    const double pos = (idx < 2064) ? (double)idx : (double)(16384 + idx - 2064);
    const double inv = exp(-((double)i / 31.0) * 9.210340371976184);
    const double ang = pos * inv;
    cs[e] = make_float2((float)cos(ang), (float)sin(ang));
  }
}

__device__ __forceinline__ void ln_phase(const Params& p, const float* g, const float* bb, bf16_t* xb, int final_, int bid, int nb, const int tid) {
  const int lane = tid & 63, wv = tid >> 6;
  float* X = (float*)(p.W() + OFF_X);
  f32x4 nx[4], nx2[4];
  {
    const int r0 = min(bid * 4 + wv, MT - 1), r1 = min(bid * 4 + wv + nb * 4, MT - 1);
#pragma unroll
    for (int i = 0; i < 4; ++i) nx[i] = *(const f32x4*)(X + (size_t)r0 * 1024 + lane * 4 + i * 256);
#pragma unroll
    for (int i = 0; i < 4; ++i) nx2[i] = *(const f32x4*)(X + (size_t)r1 * 1024 + lane * 4 + i * 256);
  }
  for (int row = bid * 4 + wv; row < MT; row += nb * 4) {
    f32x4 v[4];
#pragma unroll
    for (int i = 0; i < 4; ++i) { v[i] = nx[i]; nx[i] = nx2[i]; }
    {
      const int rn = min(row + nb * 8, MT - 1);
#pragma unroll
      for (int i = 0; i < 4; ++i) nx2[i] = *(const f32x4*)(X + (size_t)rn * 1024 + lane * 4 + i * 256);
    }
    ln_row_regs(v, g, bb, lane);
    if (!final_) {
#pragma unroll
      for (int i = 0; i < 4; ++i) {
        *(f32x4*)(X + (size_t)row * 1024 + lane * 4 + i * 256) = v[i];
        uint2 o; o.x = pk2(v[i][0], v[i][1]); o.y = pk2(v[i][2], v[i][3]);
        *(uint2*)(xb + (size_t)row * 1024 + lane * 4 + i * 256) = o;
      }
    } else {
      float* dst = nullptr;
      if (row < MP) { const int b = row / TPR, t = row % TPR; if (t >= 16) dst = p.O() + O_YP + ((size_t)b * 2048 + (t - 16)) * 1024; }
      else dst = p.O() + O_YS + (size_t)(row - MP) * 1024;
      if (dst) {
#pragma unroll
        for (int i = 0; i < 4; ++i) *(f32x4*)(dst + lane * 4 + i * 256) = v[i];
      }
    }
  }
}

enum { EPI_BF16 = 0, EPI_RESID = 1, EPI_SWIGLU = 2 };

template <int EPI>
__device__ __forceinline__ void gemm_tile(const bf16_t* __restrict__ A, const int lda, const bf16_t* __restrict__ Bt, const int ldb,
                                          const int K, const int m0, const int n0, void* Cout, const int ldc, char* lds, const int tid) {
  const int wid = tid >> 6, lane = tid & 63, wr = wid >> 1, wc = wid & 1, fr = lane & 15, fq = lane >> 4;
  f32x4 acc[4][4];
#pragma unroll
  for (int m = 0; m < 4; ++m)
#pragma unroll
    for (int n = 0; n < 4; ++n) acc[m][n] = (f32x4){0.f, 0.f, 0.f, 0.f};
  const int nt = K >> 6;
  const int st_row = tid >> 3, st_c = (tid & 7) ^ ((tid >> 4) & 7);
  auto stageA = [&](int kt, int buf) {
#pragma unroll
    for (int i = 0; i < 4; ++i) {
      const int off = tid * 16 + i * 4096, r = st_row + i * 32;
      const bf16_t* ga = A + (size_t)(m0 + r) * lda + kt * 64 + st_c * 8;
      __builtin_amdgcn_global_load_lds((const unsigned*)ga, (__attribute__((address_space(3))) unsigned*)(lds + buf * 32768 + off), 16, 0, 0);
    }
  };
  auto stageB = [&](int kt, int buf) {
#pragma unroll
    for (int i = 0; i < 4; ++i) {
      const int off = tid * 16 + i * 4096, r = st_row + i * 32;
      const bf16_t* gb = Bt + (size_t)(n0 + r) * ldb + kt * 64 + st_c * 8;
      __builtin_amdgcn_global_load_lds((const unsigned*)gb, (__attribute__((address_space(3))) unsigned*)(lds + buf * 32768 + 16384 + off), 16, 0, 0);
    }
  };
  auto stage = [&](int kt, int buf) { stageA(kt, buf); stageB(kt, buf); };
  const int fsw = (fr >> 1) & 7;
  const int xk0 = (fq ^ fsw) << 4, xk1 = ((4 + fq) ^ fsw) << 4;
  stage(0, 0);
  for (int kt = 0; kt < nt; ++kt) {
    asm volatile("s_waitcnt vmcnt(0)" ::: "memory");
    __syncthreads();
    if (kt + 1 < nt) stageB(kt + 1, (kt + 1) & 1);
    const char* sa = lds + (kt & 1) * 32768;
    const char* sb = sa + 16384;
    bf16x8 af[2][4], bfr[2][4];
#pragma unroll
    for (int ks = 0; ks < 2; ++ks) {
#pragma unroll
      for (int m = 0; m < 4; ++m) af[ks][m] = *(const bf16x8*)(sa + (wr * 64 + m * 16 + fr) * 128 + (ks ? xk1 : xk0));
#pragma unroll
      for (int n = 0; n < 4; ++n) bfr[ks][n] = *(const bf16x8*)(sb + (wc * 64 + n * 16 + fr) * 128 + (ks ? xk1 : xk0));
    }
    if (kt + 1 < nt) stageA(kt + 1, (kt + 1) & 1);
#pragma unroll
    for (int ks = 0; ks < 2; ++ks)
#pragma unroll
      for (int m = 0; m < 4; ++m)
#pragma unroll
        for (int n = 0; n < 4; ++n) acc[m][n] = __builtin_amdgcn_mfma_f32_16x16x32_bf16(bfr[ks][n], af[ks][m], acc[m][n], 0, 0, 0);
  }
  if (EPI == EPI_RESID) {
    float* C0 = (float*)Cout + (size_t)(m0 + wr * 64 + fr) * ldc + n0 + wc * 64 + fq * 4;
#pragma unroll
    for (int mh = 0; mh < 2; ++mh) {
      f32x4 xin[2][4];
#pragma unroll
      for (int m = 0; m < 2; ++m)
#pragma unroll
        for (int n = 0; n < 4; ++n) xin[m][n] = *(const f32x4*)(C0 + (size_t)(mh * 2 + m) * 16 * ldc + n * 16);
#pragma unroll
      for (int m = 0; m < 2; ++m)
#pragma unroll
        for (int n = 0; n < 4; ++n) asm volatile("" : "+v"(xin[m][n]));
#pragma unroll
      for (int m = 0; m < 2; ++m)
#pragma unroll
        for (int n = 0; n < 4; ++n) *(f32x4*)(C0 + (size_t)(mh * 2 + m) * 16 * ldc + n * 16) = xin[m][n] * ALPHA + acc[mh * 2 + m][n];
    }
    return;
  }
#pragma unroll
  for (int m = 0; m < 4; ++m) {
    const int row = m0 + wr * 64 + m * 16 + fr;
    if (EPI == EPI_BF16) {
      bf16_t* C = (bf16_t*)Cout + (size_t)row * ldc + n0 + wc * 64 + fq * 8;
#pragma unroll
      for (int pq = 0; pq < 2; ++pq) { uint4 o; o.x = pk2(acc[m][2 * pq][0], acc[m][2 * pq][1]); o.y = pk2(acc[m][2 * pq][2], acc[m][2 * pq][3]);
        o.z = pk2(acc[m][2 * pq + 1][0], acc[m][2 * pq + 1][1]); o.w = pk2(acc[m][2 * pq + 1][2], acc[m][2 * pq + 1][3]); *(uint4*)(C + pq * 32) = o; }
    } else if (EPI == EPI_RESID) {
      float* C = (float*)Cout + (size_t)row * ldc + n0 + wc * 64 + fq * 4;
#pragma unroll
      for (int n = 0; n < 4; ++n) { const f32x4 x = *(const f32x4*)(C + n * 16); *(f32x4*)(C + n * 16) = x * ALPHA + acc[m][n]; }
    } else {
      bf16_t* C = (bf16_t*)Cout + (size_t)row * ldc + (n0 >> 1) + wc * 32 + fq * 8;
      const f32x4 g0 = acc[m][0], u0 = acc[m][1], g1 = acc[m][2], u1 = acc[m][3];
      uint4 o; o.x = pk2(siluf_(g0[0]) * u0[0], siluf_(g0[1]) * u0[1]); o.y = pk2(siluf_(g0[2]) * u0[2], siluf_(g0[3]) * u0[3]);
      o.z = pk2(siluf_(g1[0]) * u1[0], siluf_(g1[1]) * u1[1]); o.w = pk2(siluf_(g1[2]) * u1[2], siluf_(g1[3]) * u1[3]);
      *(uint4*)C = o;
    }
  }
}
template <int EPI>
__device__ __forceinline__ void gemm_phase(const bf16_t* A, int lda, const bf16_t* Bt, int ldb, int K, int ntn, void* C, int ldc, char* lds, int bid, int nb, const int tid) {
  constexpr int GM = 4, nM = MT / 128;
  const int ntiles = nM * ntn, nig = GM * ntn;
  const int pos = (EPI != EPI_SWIGLU && (nb & 7) == 0) ? (bid & 7) * (nb >> 3) + (bid >> 3) : bid;
  for (int L = pos; L < ntiles; L += nb) {
    int mt, nn;
    if (EPI == EPI_SWIGLU) { mt = L / ntn; nn = L % ntn; }
    else { const int gid = L / nig, fm = gid * GM, gsz = min(nM - fm, GM), rem = L - gid * nig; mt = fm + rem % gsz; nn = rem / gsz; }
    gemm_tile<EPI>(A, lda, Bt, ldb, K, mt * 128, nn * 128, C, ldc, lds, tid);
  }
}

#define XB_TMO      128
#define XB_XCNT(j)  (256  + 64 * (j))
#define XB_XSUB(j)  (1280 + 64 * (j))
#define XB_XGEN(j)  (2304 + 64 * (j))
#define XB_TOP      3328
#define XB_TOPGEN   3392
#define XCD_BAR_WORDS 3456
#define XB_SPIN_CAP (1u << 22)
__device__ __forceinline__ unsigned xb_ld(unsigned* p) { return __hip_atomic_load(p, __ATOMIC_RELAXED, __HIP_MEMORY_SCOPE_AGENT); }
__device__ __forceinline__ unsigned xb_add(unsigned* p, unsigned v) { return __hip_atomic_fetch_add(p, v, __ATOMIC_RELAXED, __HIP_MEMORY_SCOPE_AGENT); }
__device__ __forceinline__ unsigned xb_xcc_id() { return (unsigned)__builtin_amdgcn_s_getreg((3 << 11) | 20) & 0xFu; }
#define XB_SPIN(cond, bar) do { unsigned _sp = 0; while (cond) { __builtin_amdgcn_s_sleep(1); \
    if ((++_sp & 255u) == 0u) { if (xb_ld(&(bar)[XB_TMO])) break; if (_sp > XB_SPIN_CAP) { atomicAdd(&(bar)[XB_TMO], 1u); break; } } } } while (0)
struct XcdBarrier { unsigned* bar; unsigned x; unsigned nloc, nx; };
__device__ __forceinline__ void xcd_barrier_complete(unsigned* bar, unsigned x, unsigned G, unsigned& nloc, unsigned& nx) {
  unsigned sum, cnt, mine, sp = 0u;
  for (;;) {
    sum = 0u; cnt = 0u; mine = 0u;
#pragma unroll
    for (unsigned j = 0; j < 16; ++j) { const unsigned c = xb_ld(&bar[XB_XCNT(j)]); sum += c; cnt += (c > 0u) ? 1u : 0u; mine = (j == x) ? c : mine; }
    if (sum == G) break;
    __builtin_amdgcn_s_sleep(1);
    if ((++sp & 255u) == 0u) { if (xb_ld(&bar[XB_TMO])) break; if (sp > XB_SPIN_CAP) { atomicAdd(&bar[XB_TMO], 1u); break; } }
  }
  nloc = mine > 0u ? mine : 1u; nx = cnt > 0u ? cnt : 1u;
}
__device__ __forceinline__ void xcd_barrier(XcdBarrier& b, const int tid, const unsigned G) {
  asm volatile("s_waitcnt vmcnt(0)" ::: "memory");
  __syncthreads();
  if (tid == 0) {
    unsigned* bar = b.bar;
    __builtin_amdgcn_s_waitcnt(0);
    if (b.nloc == 0u) xcd_barrier_complete(bar, b.x, G, b.nloc, b.nx);
    const unsigned nloc = b.nloc, nx = b.nx;
    const unsigned old = xb_add(&bar[XB_XSUB(b.x)], 1u);
    const unsigned gen = old / nloc;
    if (old + 1u == (gen + 1u) * nloc) {
      __builtin_amdgcn_fence(__ATOMIC_RELEASE, "agent");
      asm volatile("s_waitcnt vmcnt(0)" ::: "memory");
      const unsigned og = xb_add(&bar[XB_TOP], 1u);
      const unsigned tg = og / nx;
      if (og + 1u == (tg + 1u) * nx) xb_add(&bar[XB_TOPGEN], 1u);
      else XB_SPIN(xb_ld(&bar[XB_TOPGEN]) == tg, bar);
      __builtin_amdgcn_fence(__ATOMIC_ACQUIRE, "agent");
      xb_add(&bar[XB_XGEN(b.x)], 1u);
      asm volatile("s_waitcnt vmcnt(0)" ::: "memory");
    } else {
      XB_SPIN(xb_ld(&bar[XB_XGEN(b.x)]) == gen, bar);
      __builtin_amdgcn_fence(__ATOMIC_ACQUIRE, "agent");
      asm volatile("s_waitcnt vmcnt(0)" ::: "memory");
    }
  }
  __syncthreads();
}

template <int N, int RS>
__device__ __forceinline__ void convN(const bf16_t* rawb, const float (&w)[4][N], int tt, int off, float (&x)[N]) {
#pragma unroll
  for (int i = 0; i < N; ++i) x[i] = 0.f;
#pragma unroll
  for (int j = 0; j < 4; ++j) {
    float xv[N];
    if (N == 8) { const uint4 rv = *(const uint4*)(rawb + (tt + j) * RS + off); unpack8(rv, xv); }
    else if (N == 4) { const uint2 rv = *(const uint2*)(rawb + (tt + j) * RS + off); xv[0] = bflo(rv.x); xv[1] = bfhi(rv.x); xv[2 % N] = bflo(rv.y); xv[3 % N] = bfhi(rv.y); }
    else { const unsigned rv = *(const unsigned*)(rawb + (tt + j) * RS + off); xv[0] = bflo(rv); xv[1] = bfhi(rv); }
#pragma unroll
    for (int i = 0; i < N; ++i) x[i] += w[j][i] * xv[i];
  }
  if (N == 2) {
#pragma unroll
    for (int i = 0; i < N; ++i) asm volatile("" : "+v"(x[i]));
  }
#pragma unroll
  for (int i = 0; i < N; ++i) x[i] = siluf_(x[i]);
}

template <int MIX, int VN>
__device__ __forceinline__ void load_chunk_fn(const unsigned char* ws, const bf16_t* Pb, const int t, const int T, const int h, const int vcol, const int sub, const int posb,
                                              uint4& R0, uint4& R1, uint2& R2, uint4& R4, uint4& R5, unsigned& ex0, unsigned& ex1) {
  if (t < T) {
    const bf16_t* pr = Pb + (size_t)t * DINP;
    const int vbase = (MIX == 0) ? 512 : (MIX == 1) ? 1544 : (MIX == 2) ? 2312 : 3352;
    if (VN == 4) R2 = *(const uint2*)(pr + vbase + h * 64 + vcol);
    else R2.x = *(const unsigned*)(pr + vbase + h * 64 + vcol);
    if (MIX == 0) {
      R0 = *(const uint4*)(pr + 0 + h * 64 + sub * 8); R1 = *(const uint4*)(pr + 256 + h * 64 + sub * 8);
      ex0 = pr[768 + h]; ex1 = pr[772 + h];
    } else if (MIX == 1) {
      R0 = *(const uint4*)(pr + 1032 + h * 64 + sub * 8); R1 = *(const uint4*)(pr + 1288 + h * 64 + sub * 8);
    } else if (MIX == 2) {
      const uint2 q2 = *(const uint2*)(pr + 2056 + h * 32 + sub * 4), k2 = *(const uint2*)(pr + 2184 + h * 32 + sub * 4);
      R0 = make_uint4(q2.x, q2.y, k2.x, k2.y);
      R1 = *(const uint4*)(pr + 2568); R4 = *(const uint4*)(pr + 2576);
    } else {
      const uint2 ql = *(const uint2*)(pr + 2840 + h * 64 + sub * 4), qh = *(const uint2*)(pr + 2840 + h * 64 + 32 + sub * 4);
      const uint2 kl = *(const uint2*)(pr + 3096 + h * 64 + sub * 4), kh = *(const uint2*)(pr + 3096 + h * 64 + 32 + sub * 4);
      R0 = make_uint4(ql.x, ql.y, qh.x, qh.y); R1 = make_uint4(kl.x, kl.y, kh.x, kh.y);
      const uint4* cs = (const uint4*)(ws + OFF_CS + ((size_t)(posb + t) * 32 + sub * 4) * 8);
      R4 = cs[0]; R5 = cs[1];
    }
  }
}

__device__ __forceinline__ float dpp_hm(float x) {
  return __int_as_float(__builtin_amdgcn_update_dpp(0, __float_as_int(x), 0x141, 0xF, 0xF, true));
}
__device__ __forceinline__ float dpp_rm(float x) {
  return __int_as_float(__builtin_amdgcn_update_dpp(0, __float_as_int(x), 0x140, 0xF, 0xF, true));
}
__device__ __forceinline__ float red8d(float x) { x += dpp_x1(x); x += dpp_x2(x); x += dpp_hm(x); return x; }
template <int KG> __device__ __forceinline__ float redKG(float x) { x = red8d(x); if (KG == 16) x += dpp_rm(x); return x; }

template <int MIX, int KPL>
struct StepIn { float q[KPL], k[KPL], d[KPL]; float v, a, be, qk; };

template <int MIX, int KPL>
__device__ __forceinline__ void load_step(const float* qkdv, const float* scal, int t, int kg, int col, StepIn<MIX, KPL>& s) {
  const float* base = qkdv + t * 256;
#pragma unroll
  for (int i = 0; i < KPL; i += 4) {
    const f32x4 a = *(const f32x4*)(base + kg * KPL + i), b = *(const f32x4*)(base + 64 + kg * KPL + i);
    s.q[i] = a[0]; s.q[i + 1] = a[1]; s.q[i + 2] = a[2]; s.q[i + 3] = a[3];
    s.k[i] = b[0]; s.k[i + 1] = b[1]; s.k[i + 2] = b[2]; s.k[i + 3] = b[3];
    if (MIX == 1 || MIX == 2) { const f32x4 d = *(const f32x4*)(base + 128 + kg * KPL + i); s.d[i] = d[0]; s.d[i + 1] = d[1]; s.d[i + 2] = d[2]; s.d[i + 3] = d[3]; }
  }
  s.v = base[192 + col];
  if (MIX == 0) { const f32x4 c = *(const f32x4*)(scal + t * 4); s.a = c[0]; s.be = c[1]; s.qk = c[2]; }
}

template <int MIX, int KPL, int KG>
__device__ __forceinline__ float do_step(const StepIn<MIX, KPL>& s, float (&S)[KPL], const float gam) {
  if (MIX == 0) {
    float kS0 = 0.f, kS1 = 0.f, qS0 = 0.f, qS1 = 0.f;
#pragma unroll
    for (int i = 0; i < KPL; i += 2) { kS0 += s.k[i] * S[i]; kS1 += s.k[i + 1] * S[i + 1]; qS0 += s.q[i] * S[i]; qS1 += s.q[i + 1] * S[i + 1]; }
    const float kS = redKG<KG>(kS0 + kS1), qS = redKG<KG>(qS0 + qS1);
    const float w = s.be * (s.v - s.a * kS);
#pragma unroll
    for (int i = 0; i < KPL; ++i) S[i] = s.a * S[i] + s.k[i] * w;
    return s.a * qS + s.qk * w;
  } else {
    float o0 = 0.f, o1 = 0.f;
#pragma unroll
    for (int i = 0; i < KPL; i += 2) {
      const float d0 = (MIX == 3) ? gam : s.d[i], d1 = (MIX == 3) ? gam : s.d[i + 1];
      S[i] = d0 * S[i] + s.k[i] * s.v; S[i + 1] = d1 * S[i + 1] + s.k[i + 1] * s.v;
      o0 += s.q[i] * S[i]; o1 += s.q[i + 1] * S[i + 1];
    }
    return redKG<KG>(o0 + o1);
  }
}

template <int MIX>
__device__ __forceinline__ void scan_part(const Params& p, const int layer, const int smp, const int b0, const int bstep, const int bend, const int h, const int part, char* lds, const int tid) {
  constexpr int DK = (MIX == 2) ? 32 : 64;
  constexpr int NS = (MIX == 0) ? 4 : 2;
  constexpr int CW = 64 / NS;
  constexpr int CPW = CW / 4;
  constexpr int KG = 64 / CPW;
  constexpr int KPL = DK / KG;
  constexpr int VN = CW / 8;
  constexpr int RS = 128 + CW;
  float* qkdv = (float*)lds;
  float* obuf = (float*)(lds + 32768);
  float* scal = (float*)(lds + 36864);
  bf16_t* rawb = (bf16_t*)(lds + 37376);
  float* cwl = (float*)(lds + 48576);
  float* wgl = (float*)(lds + 37376);

  const int lane = tid & 63, wv = tid >> 6;
  const int tt = tid >> 3, sub = tid & 7;
  const int col = wv * CPW + lane / KG, kg = lane % KG;
  const int T = smp ? 4 : TPR;
  const int nBatch = smp ? NSB : NB;
  const int posb = smp ? 2064 : 0;
  const int vcol = part * CW + sub * VN;
  __syncthreads();
  float c8[8];
  float Aexp = 0.f, dtb = 0.f, gam = 0.f;
  float cwq[4][8], cwk[4][8];
  if (MIX == 0) {
    Aexp = __expf(p.I(12)[layer * 4 + h]); dtb = p.I(13)[layer * 4 + h];
#pragma unroll
    for (int j = 0; j < 4; ++j) {
      const float* cwp = p.I(11) + (size_t)(layer * 4 + j) * 768;
#pragma unroll
      for (int i = 0; i < 8; ++i) { cwq[j][i] = cwp[h * 64 + sub * 8 + i]; cwk[j][i] = cwp[256 + h * 64 + sub * 8 + i]; }
    }
    for (int e = tid; e < 4 * CW; e += 256) { const int j = e / CW, r = e % CW; cwl[j * RS + 128 + r] = p.I(11)[(size_t)(layer * 4 + j) * 768 + 512 + h * 64 + part * CW + r]; }
  } else if (MIX == 1) {
#pragma unroll
    for (int i = 0; i < 8; ++i) {
      const int d = h * 64 + sub * 8 + i;
      c8[i] = (layer == 0) ? 1.0f : sigmoidf_(p.I(15)[d] - p.I(15)[256 + d]);
    }
  } else if (MIX == 2) {
    for (int e = tid; e < 512; e += 256) { const int r = e >> 5, j = e & 31; wgl[e] = p.I(17)[(size_t)(layer * 16 + r) * 128 + h * 32 + j]; }
#pragma unroll
    for (int i = 0; i < 4; ++i) c8[i] = p.I(18)[layer * 128 + h * 32 + sub * 4 + i];
  } else {
    gam = 1.0f - exp2f(-5.0f - (float)h);
  }
  for (int b = b0; b < bend; b += bstep) {
  const int row0 = smp ? MP + b * 4 : b * TPR;
  const bf16_t* Pb = (const bf16_t*)(p.W() + OFF_P) + (size_t)row0 * DINP;
  bf16_t* Ob = (bf16_t*)p.O() + (size_t)row0 * 1024 + MIX * 256 + h * 64 + part * CW;
  float* PS = (float*)((unsigned char*)p.O() + DOUT_PS) + (size_t)row0 * 128 + (MIX * 4 + h) * 8 + part * 2;
  uint4 R0 = make_uint4(0, 0, 0, 0), R1 = R0, R4 = R0, R5 = R0; uint2 R2 = make_uint2(0, 0); unsigned ex0 = 0, ex1 = 0;
  load_chunk_fn<MIX, VN>(p.W(), Pb, tt, T, h, vcol, sub, posb, R0, R1, R2, R4, R5, ex0, ex1);
  float S[KPL];
  if (smp) {
    const float* sin_ = p.I(3 + MIX) + ((size_t)(layer * NSB + b) * 4 + h) * DK * 64 + part * CW;
#pragma unroll
    for (int i = 0; i < KPL; ++i) S[i] = sin_[(kg * KPL + i) * 64 + col];
  } else {
#pragma unroll
    for (int i = 0; i < KPL; ++i) S[i] = 0.f;
  }
  if (MIX == 0) {
    for (int e = tid; e < 3 * RS; e += 256) { const int j = e / RS, r = e % RS;
      const int cc = (r < 64) ? (h * 64 + r) : (r < 128) ? (256 + h * 64 + r - 64) : (512 + h * 64 + part * CW + r - 128);
      float v = 0.f; if (smp) v = p.I(2)[((size_t)(layer * NSB + b) * 3 + j) * 768 + cc];
      rawb[e] = (bf16_t)f2bf(v); }
  }
  __syncthreads();

  int ntok_last = 0;
  for (int t0 = 0; t0 < T; t0 += 32) {
    const int ntok = min(32, T - t0);
    ntok_last = ntok;
    const bool valid = tt < ntok;
    float* dst = qkdv + tt * 256;
    if (MIX != 0 && valid) {
      if (VN == 4) *(f32x4*)(dst + 192 + sub * 4) = (f32x4){bflo(R2.x), bfhi(R2.x), bflo(R2.y), bfhi(R2.y)};
      else *(float2*)(dst + 192 + sub * 2) = make_float2(bflo(R2.x), bfhi(R2.x));
    }
    if (MIX == 0) {
      if (valid) {
        *(uint4*)(rawb + (3 + tt) * RS + 0 + sub * 8) = R0;
        *(uint4*)(rawb + (3 + tt) * RS + 64 + sub * 8) = R1;
        if (VN == 4) *(uint2*)(rawb + (3 + tt) * RS + 128 + sub * 4) = R2;
        else *(unsigned*)(rawb + (3 + tt) * RS + 128 + sub * 2) = R2.x;
      }
      __syncthreads();
      if (valid) {
        float xq[8], xk[8], xv[VN];
        { float cwv[4][VN];
#pragma unroll
          for (int j = 0; j < 4; ++j)
#pragma unroll
            for (int i = 0; i < VN; ++i) cwv[j][i] = cwl[j * RS + 128 + sub * VN + i];
          convN<VN, RS>(rawb, cwv, tt, 128 + sub * VN, xv); }
        convN<8, RS>(rawb, cwq, tt, sub * 8, xq);
        convN<8, RS>(rawb, cwk, tt, 64 + sub * 8, xk);
#pragma unroll
        for (int i = 0; i < VN; ++i) dst[192 + sub * VN + i] = xv[i];
        float ssq = 0.f, ssk = 0.f;
#pragma unroll
        for (int i = 0; i < 8; ++i) { ssq += xq[i] * xq[i]; ssk += xk[i] * xk[i]; }
        ssq = red8d(ssq); ssk = red8d(ssk);
        const float rq = rsqrtf(ssq + 1e-6f) * 0.125f, rk = rsqrtf(ssk + 1e-6f);
        float qk = 0.f;
#pragma unroll
        for (int i = 0; i < 8; ++i) { xq[i] *= rq; xk[i] *= rk; qk += xq[i] * xk[i]; }
        qk = red8d(qk);
        *(f32x4*)(dst + sub * 8) = (f32x4){xq[0], xq[1], xq[2], xq[3]}; *(f32x4*)(dst + sub * 8 + 4) = (f32x4){xq[4], xq[5], xq[6], xq[7]};
        *(f32x4*)(dst + 64 + sub * 8) = (f32x4){xk[0], xk[1], xk[2], xk[3]}; *(f32x4*)(dst + 64 + sub * 8 + 4) = (f32x4){xk[4], xk[5], xk[6], xk[7]};
        if (sub == 0) {
          const float be = sigmoidf_(bflo(ex0)), al = bflo(ex1);
          const float a = __expf(-Aexp * softplusf_(al + dtb));
          *(f32x4*)(scal + tt * 4) = (f32x4){a, be, qk, 0.f};
        }
      }
    } else if (MIX == 1) {
      if (valid) {
        float q[8], z[8]; unpack8(R0, q); unpack8(R1, z);
        float kk[8], dd[8];
#pragma unroll
        for (int i = 0; i < 8; ++i) { q[i] = siluf_(q[i]); kk[i] = c8[i] * sigmoidf_(-z[i]); dd[i] = 1.0f - fminf(kk[i], 1.0f - 1e-6f); }
        *(f32x4*)(dst + sub * 8) = (f32x4){q[0], q[1], q[2], q[3]}; *(f32x4*)(dst + sub * 8 + 4) = (f32x4){q[4], q[5], q[6], q[7]};
        *(f32x4*)(dst + 64 + sub * 8) = (f32x4){kk[0], kk[1], kk[2], kk[3]}; *(f32x4*)(dst + 64 + sub * 8 + 4) = (f32x4){kk[4], kk[5], kk[6], kk[7]};
        *(f32x4*)(dst + 128 + sub * 8) = (f32x4){dd[0], dd[1], dd[2], dd[3]}; *(f32x4*)(dst + 128 + sub * 8 + 4) = (f32x4){dd[4], dd[5], dd[6], dd[7]};
      }
    } else if (MIX == 2) {
      if (valid) {
        float lr[16]; unpack8(R1, lr); unpack8(R4, lr + 8);
        const float q0 = bflo(R0.x), q1 = bfhi(R0.x), q2 = bflo(R0.y), q3 = bfhi(R0.y);
        const float k0 = bflo(R0.z), k1 = bfhi(R0.z), k2 = bflo(R0.w), k3 = bfhi(R0.w);
        const float sc = 0.17677669529663687f;
        f32x4 xg = (f32x4){c8[0], c8[1], c8[2], c8[3]};
#pragma unroll
        for (int r = 0; r < 16; ++r) xg += lr[r] * *(const f32x4*)(wgl + r * 32 + sub * 4);
        f32x4 dd;
#pragma unroll
        for (int i = 0; i < 4; ++i) { const float ls = fminf(xg[i], 0.f) - __logf(1.0f + __expf(-fabsf(xg[i]))); dd[i] = __expf(ls * 0.0625f); }
        *(f32x4*)(dst + sub * 4) = (f32x4){q0 * sc, q1 * sc, q2 * sc, q3 * sc};
        *(f32x4*)(dst + 64 + sub * 4) = (f32x4){k0, k1, k2, k3};
        *(f32x4*)(dst + 128 + sub * 4) = dd;
      }
    } else {
      if (valid) {
        const float ql[4] = {bflo(R0.x), bfhi(R0.x), bflo(R0.y), bfhi(R0.y)}, qh[4] = {bflo(R0.z), bfhi(R0.z), bflo(R0.w), bfhi(R0.w)};
        const float kl[4] = {bflo(R1.x), bfhi(R1.x), bflo(R1.y), bfhi(R1.y)}, kh[4] = {bflo(R1.z), bfhi(R1.z), bflo(R1.w), bfhi(R1.w)};
        const float cc[4] = {__uint_as_float(R4.x), __uint_as_float(R4.z), __uint_as_float(R5.x), __uint_as_float(R5.z)};
        const float sn[4] = {__uint_as_float(R4.y), __uint_as_float(R4.w), __uint_as_float(R5.y), __uint_as_float(R5.w)};
        f32x4 qa, qb, ka, kb;
#pragma unroll
        for (int i = 0; i < 4; ++i) {
          qa[i] = ql[i] * cc[i] - qh[i] * sn[i]; qb[i] = ql[i] * sn[i] + qh[i] * cc[i];
          ka[i] = (kl[i] * cc[i] - kh[i] * sn[i]) * 0.125f; kb[i] = (kl[i] * sn[i] + kh[i] * cc[i]) * 0.125f;
        }
        *(f32x4*)(dst + sub * 4) = qa; *(f32x4*)(dst + 32 + sub * 4) = qb;
        *(f32x4*)(dst + 64 + sub * 4) = ka; *(f32x4*)(dst + 96 + sub * 4) = kb;
      }
    }
    __syncthreads();
    if (MIX == 0 && t0 + 32 < T) {
      if (tid < 3 * RS / 8) { const uint4 v = *(const uint4*)(rawb + 32 * RS + tid * 8); *(uint4*)(rawb + tid * 8) = v; }
    }
    if (t0 + 32 < T) load_chunk_fn<MIX, VN>(p.W(), Pb, t0 + 32 + tt, T, h, vcol, sub, posb, R0, R1, R2, R4, R5, ex0, ex1);
    {
      StepIn<MIX, KPL> sa, sb;
      float osave = 0.f;
      load_step<MIX, KPL>(qkdv, scal, 0, kg, col, sa);
      for (int t = 0; t < ntok; t += 2) {
        load_step<MIX, KPL>(qkdv, scal, t + 1, kg, col, sb);
        __builtin_amdgcn_sched_barrier(0);
        const float oa = do_step<MIX, KPL, KG>(sa, S, gam);
        osave = (kg == (t & (KG - 1))) ? oa : osave;
        load_step<MIX, KPL>(qkdv, scal, min(t + 2, ntok - 1), kg, col, sa);
        __builtin_amdgcn_sched_barrier(0);
        const float ob = do_step<MIX, KPL, KG>(sb, S, gam);
        osave = (kg == ((t + 1) & (KG - 1))) ? ob : osave;
        if (((t + 2) & (KG - 1)) == 0) obuf[(t + 2 - KG + kg) * CW + col] = osave;
      }
      const int remn = ntok & (KG - 1);
      if (remn != 0 && kg < remn) obuf[(ntok - remn + kg) * CW + col] = osave;
    }
    __syncthreads();
    if (valid) {
      float o[VN];
#pragma unroll
      for (int i = 0; i < VN; ++i) o[i] = obuf[tt * CW + sub * VN + i];
      float s1 = 0.f, s2 = 0.f;
#pragma unroll
      for (int i = 0; i < VN; ++i) { s1 += o[i]; s2 += o[i] * o[i]; }
      s1 = red8d(s1); s2 = red8d(s2);
      if (VN == 4) { uint2 o2; o2.x = pk2(o[0], o[1]); o2.y = pk2(o[2 % VN], o[3 % VN]); *(uint2*)(Ob + (size_t)(t0 + tt) * 1024 + sub * 4) = o2; }
      else *(unsigned*)(Ob + (size_t)(t0 + tt) * 1024 + sub * 2) = pk2(o[0], o[1]);
      if (sub == 0) *(float2*)(PS + (size_t)(t0 + tt) * 128) = make_float2(s1, s2);
    }
  }
  {
    const size_t obase = (MIX == 0) ? (smp ? O_DS : O_DP) : (MIX == 1) ? (smp ? O_HS : O_HP) : (MIX == 2) ? (smp ? O_GS : O_GP) : (smp ? O_RS : O_RP);
    float* so = p.O() + obase + ((size_t)(layer * nBatch + b) * 4 + h) * DK * 64 + part * CW;
#pragma unroll
    for (int i = 0; i < KPL; ++i) so[(kg * KPL + i) * 64 + col] = S[i];
  }
  if (MIX == 0) {
    float* co = p.O() + (smp ? O_CS : O_CP) + (size_t)(layer * nBatch + b) * 3 * 768;
    for (int e = tid; e < 3 * RS; e += 256) { const int j = e / RS, r = e % RS;
      const float v = bflo((unsigned)rawb[(ntok_last + j) * RS + r]);
      if (r < 128) { if (part == 0) co[j * 768 + ((r < 64) ? (h * 64 + r) : (256 + h * 64 + r - 64))] = v; }
      else co[j * 768 + 512 + h * 64 + part * CW + r - 128] = v; }
  }
  __syncthreads();
  }
}

constexpr int ITEMS_PER_SEQ = 40;
__device__ __forceinline__ void scan_dispatch(const Params& p, int layer, int smp, int type, int b0, int bstep, int bend, char* lds, const int tid) {
  const int r = type;
  if (r < 16) scan_part<0>(p, layer, smp, b0, bstep, bend, r >> 2, r & 3, lds, tid);
  else {
    const int r2 = r - 16, mh = 4 + (r2 >> 1), part = r2 & 1, mix = mh >> 2, h = mh & 3;
    if (mix == 1) scan_part<1>(p, layer, smp, b0, bstep, bend, h, part, lds, tid);
    else if (mix == 2) scan_part<2>(p, layer, smp, b0, bstep, bend, h, part, lds, tid);
    else scan_part<3>(p, layer, smp, b0, bstep, bend, h, part, lds, tid);
  }
}

__device__ __forceinline__ int long_item_type(int u, int& b) {
  int type;
  if (u < 64) { b = u >> 3; type = 24 + (u & 7); }
  else if (u < 192) { const int v = u - 64; b = v >> 4; type = v & 15; }
  else if (u < 256) { const int v = u - 192; b = v >> 3; type = 16 + (v & 7); }
  else { const int v = u - 256; b = v >> 3; type = 32 + (v & 7); }
  return type;
}
__device__ __forceinline__ void scan_phase(const Params& p, int layer, char* lds, int bid, int nb, const int tid, const int role, const int ci, const int nprim, const int nsec) {
  constexpr int NPI = NB * ITEMS_PER_SEQ;
  const bool paired = (nprim == 256 && nsec == 256);
  int j = -1, nbs = 1;
  if (paired) {
    int u = -1;
    if (role == 0) u = ci; else if (ci < NPI - 256) u = 256 + ci;
    if (u >= 0) { int b; const int type = long_item_type(u, b); scan_dispatch(p, layer, 0, type, b, 1, b + 1, lds, tid); }
    else { j = ci - (NPI - 256); nbs = 256 - (NPI - 256); }
  } else {
    for (int u = bid; u < NPI; u += nb) { int b; const int type = long_item_type(u, b); scan_dispatch(p, layer, 0, type, b, 1, b + 1, lds, tid); }
    nbs = (nb > NPI) ? nb - NPI : nb; j = (nb > NPI) ? bid - NPI : bid;
  }
  if (j >= 0) {
    const int nsl = (nbs + ITEMS_PER_SEQ - 1) / ITEMS_PER_SEQ;
    for (int jj = j; jj < ITEMS_PER_SEQ * nsl; jj += nbs) scan_dispatch(p, layer, 1, jj % ITEMS_PER_SEQ, jj / ITEMS_PER_SEQ, nsl, NSB, lds, tid);
    if (layer == 0) { __syncthreads(); convert_weights(p, lds, 992 + j, 6720, nbs, tid); }
  }
}

__device__ __forceinline__ void norm_phase(const Params& p, int layer, int bid, int nb, const int tid) {
  bf16_t* O = (bf16_t*)p.O();
  const bf16_t* P = (const bf16_t*)(p.W() + OFF_P);
  const float* PS = (const float*)((const unsigned char*)p.O() + DOUT_PS);
  const int cg8 = tid & 127;
  const int mh = cg8 >> 3, mix = mh >> 2, h = mh & 3, j0 = (cg8 & 7) * 8;
  const int gcol = (mix == 0) ? 776 : (mix == 1) ? 1800 : (mix == 2) ? 2584 : 3608;
  const float* gsrc = (mix == 0) ? p.I(14) : (mix == 1) ? p.I(16) : (mix == 2) ? p.I(19) : p.I(20);
  float g8[8];
#pragma unroll
  for (int i = 0; i < 8; ++i) g8[i] = gsrc[layer * 256 + h * 64 + j0 + i];
  uint4 ovn, gvn; f32x4 psn, ps2n = (f32x4){0.f, 0.f, 0.f, 0.f};
  {
    const int r0 = min(bid * 2 + (tid >> 7), MT - 1);
    ovn = *(const uint4*)(O + (size_t)r0 * 1024 + cg8 * 8);
    gvn = *(const uint4*)(P + (size_t)r0 * DINP + gcol + h * 64 + j0);
    psn = *(const f32x4*)(PS + (size_t)r0 * 128 + mh * 8);
    if (mix == 0) ps2n = *(const f32x4*)(PS + (size_t)r0 * 128 + mh * 8 + 4);
  }
  for (int row = bid * 2 + (tid >> 7); row < MT; row += nb * 2) {
    const uint4 ov = ovn, gv = gvn; const f32x4 ps = psn, ps2 = ps2n;
    {
      const int rn = min(row + nb * 2, MT - 1);
      ovn = *(const uint4*)(O + (size_t)rn * 1024 + cg8 * 8);
      gvn = *(const uint4*)(P + (size_t)rn * DINP + gcol + h * 64 + j0);
      psn = *(const f32x4*)(PS + (size_t)rn * 128 + mh * 8);
      if (mix == 0) ps2n = *(const f32x4*)(PS + (size_t)rn * 128 + mh * 8 + 4);
    }
    float s1 = ps[0] + ps[2], s2 = ps[1] + ps[3];
    if (mix == 0) { s1 += ps2[0] + ps2[2]; s2 += ps2[1] + ps2[3]; }
    float o[8], gt[8]; unpack8(ov, o); unpack8(gv, gt);
    float mu = 0.f, rs;
    if (mix == 3) { mu = s1 * (1.0f / 64.0f); const float var = fmaxf(s2 * (1.0f / 64.0f) - mu * mu, 0.f); rs = rsqrtf(var + 1e-5f); }
    else rs = rsqrtf(s2 * (1.0f / 64.0f) + 1e-6f);
    float r[8];
#pragma unroll
    for (int i = 0; i < 8; ++i) r[i] = (o[i] - mu) * rs * g8[i] * siluf_(gt[i]);
    uint4 o4; o4.x = pk2(r[0], r[1]); o4.y = pk2(r[2], r[3]); o4.z = pk2(r[4], r[5]); o4.w = pk2(r[6], r[7]);
    *(uint4*)(O + (size_t)row * 1024 + cg8 * 8) = o4;
  }
}

constexpr int NPHASE = 17;
__global__ void __launch_bounds__(256, 2) hymba_fwd(Params p_, int ph_lo, int ph_hi) {
  __shared__ __attribute__((aligned(16))) char lds[65536];
  XcdBarrier xb; xb.bar = (unsigned*)(p_.ws + OFF_BAR); xb.x = xb_xcc_id(); xb.nloc = 0u; xb.nx = 0u;
  if (threadIdx.x == 0) (void)xb_add(&xb.bar[XB_XCNT(xb.x)], 1u);
  int role = 0, ci = 0;
  {
    const unsigned key = ((((unsigned)__builtin_amdgcn_s_getreg((31 << 11) | 4)) >> 8) & 0xFFu) | (xb.x << 8);
    if (threadIdx.x == 0) {
      const unsigned slot = xb_add(&xb.bar[CEN_TAB + key], 1u);
      unsigned r;
      if (slot == 0u) { r = xb_add(&xb.bar[CEN_CNT], 1u); __hip_atomic_store(&xb.bar[CEN_TAB2 + key], r + 1u, __ATOMIC_RELAXED, __HIP_MEMORY_SCOPE_AGENT); }
      else { (void)xb_add(&xb.bar[CEN_CNT + 1], 1u); r = 0u; }
      *(volatile unsigned*)(lds) = slot == 0u ? 0u : 1u; *(volatile unsigned*)(lds + 4) = r;
    }
    __syncthreads();
    role = (int)*(volatile unsigned*)(lds); ci = (int)*(volatile unsigned*)(lds + 4);
    __syncthreads();
    role = __builtin_amdgcn_readfirstlane(role); ci = __builtin_amdgcn_readfirstlane(ci);
    if (role != 0) ci = -1 - (int)key;
  }
  int nprim = 0, nsec = 0;
  if (ph_hi < 0) cg::this_grid().sync();
  for (int ph = ph_lo; ph < ph_hi; ++ph) {
    int tid = threadIdx.x, bid = blockIdx.x, nb = gridDim.x;
    asm volatile("" : "+v"(tid));
    asm volatile("" : "+s"(bid), "+s"(nb));
    if (ph > ph_lo) xcd_barrier(xb, tid, (unsigned)nb);
    if (ph == ph_lo + 1) {
      nprim = (int)xb_ld(&xb.bar[CEN_CNT]); nsec = (int)xb_ld(&xb.bar[CEN_CNT + 1]);
      if (role != 0) { const unsigned v = xb_ld(&xb.bar[CEN_TAB2 + (unsigned)(-1 - ci)]); ci = (v > 0u) ? (int)v - 1 : 0; }
      nprim = __builtin_amdgcn_readfirstlane(nprim); nsec = __builtin_amdgcn_readfirstlane(nsec); ci = __builtin_amdgcn_readfirstlane(ci);
    }
    const Params& p = p_;
    if (ph == 0) {
      convert_weights(p, lds, bid, 992, nb, tid);
      embed_ln(p, bid, nb, tid);
      rope_table(p, bid, nb, tid);
    } else {
      const int l = (ph - 1) / 8, s = (ph - 1) % 8;
      const bf16_t* Xb = (const bf16_t*)p.O();
      bf16_t* X1b = (bf16_t*)(p.W() + OFF_X1B);
      bf16_t* Hb = (bf16_t*)(p.W() + OFF_H);
      float* X = (float*)(p.W() + OFF_X);
      if (s == 0) gemm_phase<EPI_BF16>(Xb, 1024, (const bf16_t*)(p.W() + OFF_WIN + l * SZ_WIN), 1024, 1024, DINP / 128, p.W() + OFF_P, DINP, lds, bid, nb, tid);
      else if (s == 1) scan_phase(p, l, lds, bid, nb, tid, role, ci, nprim, nsec);
      else if (s == 2) norm_phase(p, l, bid, nb, tid);
      else if (s == 3) gemm_phase<EPI_RESID>(Xb, 1024, (const bf16_t*)(p.W() + OFF_WOUT + l * SZ_WOUT), 1024, 1024, 8, X, 1024, lds, bid, nb, tid);
      else if (s == 4) ln_phase(p, p.I(22) + l * 1024, p.I(23) + l * 1024, X1b, 0, bid, nb, tid);
      else if (s == 5) gemm_phase<EPI_SWIGLU>(X1b, 1024, (const bf16_t*)(p.W() + OFF_WGU + l * SZ_WGU), 1024, 1024, 44, Hb, DFF, lds, bid, nb, tid);
      else if (s == 6) gemm_phase<EPI_RESID>(Hb, DFF, (const bf16_t*)(p.W() + OFF_WDN + l * SZ_WDN), DFF, DFF, 8, X, 1024, lds, bid, nb, tid);
      else ln_phase(p, p.I(27) + l * 1024, p.I(28) + l * 1024, (bf16_t*)p.O(), l == 1, bid, nb, tid);
    }
  }
}

extern "C" void kernel_launch(void* const* d_in, const int* in_sizes, int n_in, void* d_out, int out_size, void* d_ws, size_t ws_size,
                              hipStream_t stream) {
  (void)in_sizes; (void)out_size;
  if (n_in < 29 || ws_size < WS_NEED) { fprintf(stderr, "bad args: n_in %d ws %zu need %zu\n", n_in, ws_size, (size_t)WS_NEED); return; }
  Params p{};
  for (int i = 0; i < 29; ++i) p.in[i] = (const float*)d_in[i];
  p.out = (float*)d_out;
  p.ws = (unsigned char*)d_ws;
  static int grid_blocks = 0;
  if (!grid_blocks) {
    int dev = 0, cus = 0, per_cu = 0;
    (void)hipGetDevice(&dev);
    (void)hipDeviceGetAttribute(&cus, hipDeviceAttributeMultiprocessorCount, dev);
    (void)hipOccupancyMaxActiveBlocksPerMultiprocessor(&per_cu, hymba_fwd, 256, 0);
    if (per_cu > 2) per_cu = 2;
    if (per_cu < 1) per_cu = 1;
    grid_blocks = cus * per_cu;
  }
  (void)hipMemsetAsync((unsigned char*)d_ws + OFF_BAR, 0, BAR_BYTES, stream);
  int lo = 0, hi = NPHASE;
  void* args[] = {&p, &lo, &hi};
  hipError_t e = hipLaunchCooperativeKernel((void*)hymba_fwd, dim3(grid_blocks), dim3(256), args, 0, stream);
  if (e != hipSuccess) fprintf(stderr, "cooperative launch failed: %s (grid %d)\n", hipGetErrorString(e), grid_blocks);
}
```
